# Optimizing an MI355X kernel written in HIP

```python
import jax, jax.numpy as jnp
from jax import lax
import numpy as np

D_MODEL = 1024
BATCH = 2
SEQ = 8192
DEPTH = 1

D_MIX = D_MODEL
M_HEADS = 4
M_HEAD_DIM = 128
D_MLSTM = M_HEADS * M_HEAD_DIM
D_GMLP = D_MIX - D_MLSTM
G_GROUPS = 4
G_DIM = D_GMLP // G_GROUPS
CHUNK = 128
CONV_K = 4
N_EXPERTS = 32
TOP_K = 4
D_FF = D_MODEL
SWIGLU_LIMIT = 7.0
SWIGLU_ALPHA = 1.702
MOE_BLOCK = 128
EPS = 1e-6
PROJ_SIZES = (D_MLSTM, D_MLSTM, D_MLSTM, D_MLSTM, M_HEADS, M_HEADS, D_GMLP, D_GMLP)
D_PROJ = sum(PROJ_SIZES)

kernel_name = "hybrid_mlstm_gmlp_moe"


def rms_norm(x, gain):
    xf = x.astype(jnp.float32)
    y = xf * lax.rsqrt(jnp.mean(xf * xf, axis=-1, keepdims=True) + EPS)
    return (y * gain).astype(x.dtype)


def layer_norm(x, gain):
    xf = x.astype(jnp.float32)
    mu = jnp.mean(xf, axis=-1, keepdims=True)
    xc = xf - mu
    y = xc * lax.rsqrt(jnp.mean(xc * xc, axis=-1, keepdims=True) + EPS)
    return (y * gain).astype(x.dtype)


def causal_dwconv(x, w):
    S = x.shape[1]
    xp = jnp.pad(x, ((0, 0), (CONV_K - 1, 0), (0, 0)))
    y = xp[:, 0:S] * w[0]
    for j in range(1, CONV_K):
        y = y + xp[:, j:j + S] * w[j]
    return y


def mlstm_chunkwise(q, k, v, i_pre, f_pre):
    B, S, H, DH = q.shape
    nc = S // CHUNK
    out_dtype = q.dtype

    def chunks(t):
        return t.astype(jnp.float32).reshape(B, nc, CHUNK, H, DH).transpose(0, 3, 1, 2, 4)

    q = chunks(q)
    k = chunks(k) * (DH ** -0.5)
    v = chunks(v)
    log_i = i_pre.astype(jnp.float32).reshape(B, nc, CHUNK, H).transpose(0, 3, 1, 2)
    log_f = jax.nn.log_sigmoid(f_pre.astype(jnp.float32)).reshape(B, nc, CHUNK, H).transpose(0, 3, 1, 2)
    b = jnp.cumsum(log_f, axis=-1)
    b_last = b[..., -1]

    g = b_last[..., None] - b + log_i
    m_loc = jnp.max(g, axis=-1)
    w_loc = jnp.exp(g - m_loc[..., None])
    C_loc = jnp.einsum('bhcs,bhcsv,bhcsk->bhcvk', w_loc, v, k)
    n_loc = jnp.einsum('bhcs,bhcsk->bhck', w_loc, k)

    def step(carry, inp):
        C, n, m = carry
        Cl, nl, ml, bl = inp
        m_new = jnp.maximum(bl + m, ml)
        a = jnp.exp(bl + m - m_new)
        c = jnp.exp(ml - m_new)
        C_new = a[..., None, None] * C + c[..., None, None] * Cl
        n_new = a[..., None] * n + c[..., None] * nl
        return (C_new, n_new, m_new), (C, n, m)

    init = (jnp.zeros((B, H, DH, DH), jnp.float32),
            jnp.zeros((B, H, DH), jnp.float32),
            jnp.zeros((B, H), jnp.float32))
    xs = (jnp.moveaxis(C_loc, 2, 0), jnp.moveaxis(n_loc, 2, 0),
          jnp.moveaxis(m_loc, 2, 0), jnp.moveaxis(b_last, 2, 0))
    _, (C_prev, n_prev, m_prev) = lax.scan(step, init, xs)
    C_prev = jnp.moveaxis(C_prev, 0, 2)
    n_prev = jnp.moveaxis(n_prev, 0, 2)
    m_prev = jnp.moveaxis(m_prev, 0, 2)

    causal = jnp.tril(jnp.ones((CHUNK, CHUNK), dtype=bool))
    D = jnp.where(causal, b[..., :, None] - b[..., None, :] + log_i[..., None, :], -jnp.inf)
    a_inter = b + m_prev[..., None]
    m = jnp.maximum(a_inter, jnp.max(D, axis=-1))
    W = jnp.exp(D - m[..., None]) * jnp.einsum('bhctd,bhcsd->bhcts', q, k)
    inter = jnp.exp(a_inter - m)
    num = (jnp.einsum('bhcts,bhcsv->bhctv', W, v)
           + inter[..., None] * jnp.einsum('bhcvk,bhctk->bhctv', C_prev, q))
    den = jnp.sum(W, axis=-1) + inter * jnp.einsum('bhck,bhctk->bhct', n_prev, q)
    h = num / jnp.maximum(jnp.abs(den), jnp.exp(-m))[..., None]
    return h.transpose(0, 2, 3, 1, 4).reshape(B, S, H, DH).astype(out_dtype)


def spatial_gating(u, vg, ln_gain, w_spatial, b_spatial, out_gain):
    B, S, _ = u.shape
    nc = S // CHUNK
    u = jax.nn.gelu(u)
    vg = layer_norm(jax.nn.gelu(vg), ln_gain)
    vc = vg.reshape(B, nc, CHUNK, G_GROUPS, G_DIM)
    causal = jnp.tril(jnp.ones((CHUNK, CHUNK), dtype=bool))
    w = jnp.where(causal[None], w_spatial, 0.0)
    mixed = jnp.einsum('gts,bcsgd->bctgd', w, vc) + b_spatial.T[:, :, None]
    return rms_norm(u * mixed.reshape(B, S, D_GMLP), out_gain)


def hybrid_mixer(xn, w_in, conv_qk, b_igate, b_fgate, mlstm_norm_gain,
                 gmlp_ln_gain, w_spatial, b_spatial, gmlp_out_gain, w_out):
    B, S, _ = xn.shape
    proj = xn @ w_in
    splits = np.cumsum(PROJ_SIZES)[:-1].tolist()
    q, k, v, o, ig, fg, u, vg = jnp.split(proj, splits, axis=-1)
    qk = jax.nn.silu(causal_dwconv(jnp.concatenate([q, k], axis=-1), conv_qk))
    q, k = jnp.split(qk, 2, axis=-1)
    heads = lambda t: t.reshape(B, S, M_HEADS, M_HEAD_DIM)
    h = mlstm_chunkwise(heads(q), heads(k), heads(v), ig + b_igate, fg + b_fgate)
    h = layer_norm(h, mlstm_norm_gain)
    h_m = jax.nn.sigmoid(o) * h.reshape(B, S, D_MLSTM)
    h_g = spatial_gating(u, vg, gmlp_ln_gain, w_spatial, b_spatial, gmlp_out_gain)
    return jnp.concatenate([h_m, h_g], axis=-1) @ w_out


def moe_ffn(x, w_router, b_router, w_up, b_up, w_down, b_down):
    T, D = x.shape
    logits = (x @ w_router + b_router).astype(jnp.float32)
    top_logit, top_idx = lax.top_k(logits, TOP_K)
    gate = jax.nn.softmax(top_logit, axis=-1).astype(x.dtype)
    A = T * TOP_K
    flat_e = top_idx.reshape(A)
    flat_tok = jnp.arange(A, dtype=jnp.int32) // TOP_K
    flat_g = gate.reshape(A)
    order = jnp.argsort(flat_e)
    se, stok, sg = flat_e[order], flat_tok[order], flat_g[order]
    counts = jnp.bincount(flat_e, length=N_EXPERTS)
    padded = (counts + MOE_BLOCK - 1) // MOE_BLOCK * MOE_BLOCK
    start = jnp.cumsum(counts) - counts
    pend = jnp.cumsum(padded)
    pstart = pend - padded
    dest = pstart[se] + (jnp.arange(A) - start[se])
    n_blocks = -(-A // MOE_BLOCK) + N_EXPERTS
    nbuf = n_blocks * MOE_BLOCK
    tok_buf = jnp.zeros((nbuf,), jnp.int32).at[dest].set(stok)
    g_buf = jnp.zeros((nbuf,), x.dtype).at[dest].set(sg)
    block_e = jnp.minimum(jnp.searchsorted(pend, jnp.arange(n_blocks) * MOE_BLOCK, side='right'),
                          N_EXPERTS - 1)

    def block_fn(args):
        toks, g, e = args
        xb = x[toks]
        hb = xb @ w_up[e] + b_up[e]
        h_glu, h_lin = jnp.split(hb, 2, axis=-1)
        h_glu = jnp.minimum(h_glu, SWIGLU_LIMIT)
        h_lin = jnp.clip(h_lin, -SWIGLU_LIMIT, SWIGLU_LIMIT)
        act = h_glu * jax.nn.sigmoid(SWIGLU_ALPHA * h_glu) * (h_lin + 1.0)
        return (act @ w_down[e] + b_down[e]) * g[:, None]

    yb = lax.map(block_fn, (tok_buf.reshape(n_blocks, MOE_BLOCK),
                            g_buf.reshape(n_blocks, MOE_BLOCK), block_e))
    return jax.ops.segment_sum(yb.reshape(nbuf, D), tok_buf, num_segments=T)


def setup_inputs(seed: int = 0) -> dict:
    key = jax.random.key(seed)
    ks = jax.random.split(key, 24)
    nrm = lambda k, shape, s: jax.random.normal(k, shape, jnp.float32) * s
    L = DEPTH
    return {
        "x": nrm(ks[0], (BATCH, SEQ, D_MODEL), 1.0),
        "norm1_gain": 1.0 + nrm(ks[1], (L, D_MODEL), 0.05),
        "w_in": nrm(ks[2], (L, D_MODEL, D_PROJ), D_MODEL ** -0.5),
        "conv_qk": nrm(ks[3], (L, CONV_K, 2 * D_MLSTM), CONV_K ** -0.5),
        "b_igate": nrm(ks[4], (L, M_HEADS), 0.1),
        "b_fgate": jnp.linspace(3.0, 6.0, M_HEADS, dtype=jnp.float32)[None] + nrm(ks[5], (L, M_HEADS), 0.1),
        "mlstm_norm_gain": 1.0 + nrm(ks[6], (L, M_HEADS, M_HEAD_DIM), 0.05),
        "gmlp_ln_gain": 1.0 + nrm(ks[7], (L, D_GMLP), 0.05),
        "w_spatial": nrm(ks[8], (L, G_GROUPS, CHUNK, CHUNK), CHUNK ** -0.5),
        "b_spatial": 1.0 + nrm(ks[9], (L, G_GROUPS, CHUNK), 0.1),
        "gmlp_out_gain": 1.0 + nrm(ks[10], (L, D_GMLP), 0.05),
        "w_out": nrm(ks[11], (L, D_MIX, D_MODEL), D_MIX ** -0.5),
        "norm2_gain": 1.0 + nrm(ks[12], (L, D_MODEL), 0.05),
        "w_router": nrm(ks[13], (L, D_MODEL, N_EXPERTS), D_MODEL ** -0.5),
        "b_router": nrm(ks[14], (L, N_EXPERTS), 0.01),
        "w_up": nrm(ks[15], (L, N_EXPERTS, D_MODEL, 2 * D_FF), D_MODEL ** -0.5),
        "b_up": nrm(ks[16], (L, N_EXPERTS, 2 * D_FF), 0.02),
        "w_down": nrm(ks[17], (L, N_EXPERTS, D_FF, D_MODEL), D_FF ** -0.5),
        "b_down": nrm(ks[18], (L, N_EXPERTS, D_MODEL), 0.02),
        "final_gain": 1.0 + nrm(ks[19], (D_MODEL,), 0.05),
    }


def reference(x, norm1_gain, w_in, conv_qk, b_igate, b_fgate, mlstm_norm_gain, gmlp_ln_gain,
              w_spatial, b_spatial, gmlp_out_gain, w_out, norm2_gain, w_router, b_router,
              w_up, b_up, w_down, b_down, final_gain):
    B, S, D = x.shape
    h = x
    for l in range(DEPTH):
        xn = rms_norm(h, norm1_gain[l])
        h = h + hybrid_mixer(xn, w_in[l], conv_qk[l], b_igate[l], b_fgate[l], mlstm_norm_gain[l],
                             gmlp_ln_gain[l], w_spatial[l], b_spatial[l], gmlp_out_gain[l], w_out[l])
        hn = rms_norm(h, norm2_gain[l])
        h = h + moe_ffn(hn.reshape(B * S, D), w_router[l], b_router[l], w_up[l], b_up[l],
                        w_down[l], b_down[l]).reshape(B, S, D)
    return rms_norm(h, final_gain)
```

```cpp
#include <hip/hip_runtime.h>
#include <cstdio>
#include <cstdint>

namespace {
constexpr int M = 16384, D = 1024, SEQ = 8192;
constexpr int DPROJ = 3080;
constexpr int NH = 4, DH = 128, CL = 128, NC = SEQ / CL;
constexpr int NE = 32, DFF = 1024;
constexpr int NUNIT = 2 * NH * NC;
constexpr float EPS = 1e-6f;
constexpr int PQ = 0, PK = 512, PV = 1024, PO = 1536, PIG = 2048, PFG = 2052, PU = 2056, PVG = 2568;

__device__ __forceinline__ float wave_sum(float v) {
#pragma unroll
    for (int o = 32; o > 0; o >>= 1) v += __shfl_xor(v, o);
    return v;
}
__device__ __forceinline__ float gelu_tanh(float x) {
    const float c = 0.7978845608028654f;
    float u = c * (x + 0.044715f * x * x * x);
    return 0.5f * x * (1.0f + tanhf(u));
}
__device__ __forceinline__ float sigmoidf_(float x) { return 1.0f / (1.0f + expf(-x)); }
__device__ __forceinline__ float logsigmoid(float x) { return fminf(x, 0.0f) - log1pf(expf(-fabsf(x))); }

__global__ void k_rmsnorm(const float* __restrict__ x, const float* __restrict__ g, float* __restrict__ y, int rows) {
    const int w = (blockIdx.x * blockDim.x + threadIdx.x) >> 6, lane = threadIdx.x & 63;
    if (w >= rows) return;
    const float4* xr = (const float4*)(x + (size_t)w * D);
    float4 v[4]; float s = 0.f;
#pragma unroll
    for (int j = 0; j < 4; ++j) { v[j] = xr[lane + 64 * j]; s += v[j].x * v[j].x + v[j].y * v[j].y + v[j].z * v[j].z + v[j].w * v[j].w; }
    s = wave_sum(s);
    const float r = 1.0f / sqrtf(s * (1.0f / D) + EPS);
    float4* yr = (float4*)(y + (size_t)w * D);
#pragma unroll
    for (int j = 0; j < 4; ++j) { const float4 gg = ((const float4*)g)[lane + 64 * j];
        float4 o; o.x = v[j].x * r * gg.x; o.y = v[j].y * r * gg.y; o.z = v[j].z * r * gg.z; o.w = v[j].w * r * gg.w; yr[lane + 64 * j] = o; }
}

struct GemmP {
    const float* A; const float* B; float* C; const float* R;
    int lda, ldb, ldc, N, K;
    const int* cnt; const int* tokidx; const int* tile_e; const int* tile_r; const int* ntiles; const float* bias; const float* gate;
};
template <int MODE>
__global__ void __launch_bounds__(256) k_gemm(GemmP p) {
    __shared__ float As[16][64 + 4];
    __shared__ float Bs[16][64 + 4];
    __shared__ float Bs2[MODE == 2 ? 16 : 1][64 + 4];
    __shared__ int rowsrc[64];
    const int tid = threadIdx.x, tx = tid & 15, ty = tid >> 4;
    const int n0 = blockIdx.x * 64;
    int m0 = blockIdx.y * 64;
    const float* Bp = p.B;
    int e = 0, rt = 0, cnte = 0;
    if (MODE >= 2) {
        const int tile = blockIdx.y;
        if (tile >= *p.ntiles) return;
        e = p.tile_e[tile]; rt = p.tile_r[tile]; cnte = p.cnt[e];
        if (tid < 64) { const int r = rt * 64 + tid; rowsrc[tid] = p.tokidx[(size_t)e * 65536 + (r < cnte ? r : 0)]; }
        __syncthreads();
        if (MODE == 2) Bp = p.B + (size_t)e * 1024 * 2048; else Bp = p.B + (size_t)e * 1024 * 1024;
    }
    float acc[4][4], acc2[4][4];
#pragma unroll
    for (int i = 0; i < 4; ++i)
#pragma unroll
        for (int j = 0; j < 4; ++j) { acc[i][j] = 0.f; acc2[i][j] = 0.f; }
    const int ar = tid >> 2, ak = (tid & 3) * 4;
    const int bk = tid >> 4, bn = (tid & 15) * 4;
    const float* arow;
    if (MODE == 2) arow = p.A + (size_t)(rowsrc[ar] >> 2) * p.lda;
    else if (MODE == 3) arow = p.A + (size_t)(blockIdx.y * 64 + ar) * p.lda;
    else arow = p.A + (size_t)(m0 + ar) * p.lda;
    for (int k0 = 0; k0 < p.K; k0 += 16) {
        const float4 av = *(const float4*)(arow + k0 + ak);
        As[ak + 0][ar] = av.x; As[ak + 1][ar] = av.y; As[ak + 2][ar] = av.z; As[ak + 3][ar] = av.w;
        float4 bv = make_float4(0.f, 0.f, 0.f, 0.f);
        if (n0 + bn < p.N) bv = *(const float4*)(Bp + (size_t)(k0 + bk) * p.ldb + n0 + bn);
        *(float4*)&Bs[bk][bn] = bv;
        if (MODE == 2) { const float4 b2 = *(const float4*)(Bp + (size_t)(k0 + bk) * p.ldb + 1024 + n0 + bn); *(float4*)&Bs2[bk][bn] = b2; }
        __syncthreads();
#pragma unroll
        for (int kk = 0; kk < 16; ++kk) {
            const float4 a = *(const float4*)&As[kk][ty * 4];
            const float4 b = *(const float4*)&Bs[kk][tx * 4];
            const float aa[4] = {a.x, a.y, a.z, a.w}, bb[4] = {b.x, b.y, b.z, b.w};
#pragma unroll
            for (int i = 0; i < 4; ++i)
#pragma unroll
                for (int j = 0; j < 4; ++j) acc[i][j] += aa[i] * bb[j];
            if (MODE == 2) {
                const float4 c = *(const float4*)&Bs2[kk][tx * 4];
                const float cc[4] = {c.x, c.y, c.z, c.w};
#pragma unroll
                for (int i = 0; i < 4; ++i)
#pragma unroll
                    for (int j = 0; j < 4; ++j) acc2[i][j] += aa[i] * cc[j];
            }
        }
        __syncthreads();
    }
#pragma unroll
    for (int i = 0; i < 4; ++i) {
        const int lr = ty * 4 + i;
#pragma unroll
        for (int j = 0; j < 4; ++j) {
            const int n = n0 + tx * 4 + j;
            if (MODE == 0) { if (n < p.N) p.C[(size_t)(m0 + lr) * p.ldc + n] = acc[i][j]; }
            else if (MODE == 1) { p.C[(size_t)(m0 + lr) * p.ldc + n] = p.R[(size_t)(m0 + lr) * p.ldc + n] + acc[i][j]; }
            else if (MODE == 2) {
                float gl = acc[i][j] + p.bias[(size_t)e * 2048 + n], ln = acc2[i][j] + p.bias[(size_t)e * 2048 + 1024 + n];
                gl = fminf(gl, 7.0f); ln = fminf(fmaxf(ln, -7.0f), 7.0f);
                p.C[(size_t)(blockIdx.y * 64 + lr) * p.ldc + n] = gl * sigmoidf_(1.702f * gl) * (ln + 1.0f);
            } else {
                const int r = rt * 64 + lr;
                if (r < cnte) { const int idx = rowsrc[lr]; p.C[(size_t)idx * p.ldc + n] = (acc[i][j] + p.bias[(size_t)e * 1024 + n]) * p.gate[idx]; }
            }
        }
    }
}

__global__ void k_conv(const float* __restrict__ proj, const float* __restrict__ w, float* __restrict__ qc) {
    const size_t i = (size_t)blockIdx.x * blockDim.x + threadIdx.x;
    if (i >= (size_t)M * 1024) return;
    const int row = (int)(i >> 10), c = (int)(i & 1023), t = row % SEQ;
    float acc = 0.f;
#pragma unroll
    for (int j = 0; j < 4; ++j) { const int tt = t - 3 + j; if (tt >= 0) acc += w[j * 1024 + c] * proj[(size_t)(row - 3 + j) * DPROJ + c]; }
    float y = acc * sigmoidf_(acc);
    if (c >= 512) y *= 0.08838834764831845f;
    qc[i] = y;
}

__global__ void __launch_bounds__(256) k_mlstm_local(const float* __restrict__ proj, const float* __restrict__ qc, const float* __restrict__ b_i, const float* __restrict__ b_f,
                                                     float* __restrict__ CLOC, float* __restrict__ NLOC, float* __restrict__ MLOC, float* __restrict__ BLAST) {
    extern __shared__ float sm[];
    float* Vs = sm;
    float* Ks = sm + 16384;
    float* li = sm + 32768;
    float* bc = li + 128;
    float* wl = bc + 128;
    const int u = blockIdx.x, c = u % NC, h = (u / NC) % NH, b = u / (NC * NH);
    const int row0 = b * SEQ + c * CL, tid = threadIdx.x;
    for (int i = tid; i < 16384; i += 256) { const int s = i >> 7, d = i & 127;
        Vs[i] = proj[(size_t)(row0 + s) * DPROJ + PV + h * DH + d];
        Ks[i] = qc[(size_t)(row0 + s) * 1024 + 512 + h * DH + d]; }
    if (tid < 128) { li[tid] = proj[(size_t)(row0 + tid) * DPROJ + PIG + h] + b_i[h];
        bc[tid] = logsigmoid(proj[(size_t)(row0 + tid) * DPROJ + PFG + h] + b_f[h]); }
    __syncthreads();
    if (tid == 0) { float a = 0.f; for (int s = 0; s < 128; ++s) { a += bc[s]; bc[s] = a; } }
    __syncthreads();
    if (tid < 128) wl[tid] = bc[127] - bc[tid] + li[tid];
    __syncthreads();
    float mloc = -INFINITY;
    for (int s = 0; s < 128; ++s) mloc = fmaxf(mloc, wl[s]);
    __syncthreads();
    if (tid < 128) wl[tid] = expf(wl[tid] - mloc);
    __syncthreads();
    for (int j = 0; j < 64; ++j) { const int idx = tid + 256 * j, v = idx >> 7, k = idx & 127;
        float a = 0.f;
        for (int s = 0; s < 128; ++s) a += wl[s] * Vs[s * 128 + v] * Ks[s * 128 + k];
        CLOC[(size_t)u * 16384 + idx] = a; }
    if (tid < 128) { float a = 0.f; for (int s = 0; s < 128; ++s) a += wl[s] * Ks[s * 128 + tid]; NLOC[(size_t)u * 128 + tid] = a; }
    if (tid == 0) { MLOC[u] = mloc; BLAST[u] = bc[127]; }
}

__global__ void k_mlstm_scan(const float* __restrict__ CLOC, const float* __restrict__ NLOC, const float* __restrict__ MLOC, const float* __restrict__ BLAST,
                             float* __restrict__ CPREV, float* __restrict__ NPREV, float* __restrict__ MPREV) {
    const int bh = blockIdx.y, e = blockIdx.x * 256 + threadIdx.x;
    if (e >= 16384 + 128) return;
    float m = 0.f, val = 0.f;
    for (int c = 0; c < NC; ++c) {
        const int u = bh * NC + c;
        if (e < 16384) CPREV[(size_t)u * 16384 + e] = val; else NPREV[(size_t)u * 128 + e - 16384] = val;
        if (e == 0) MPREV[u] = m;
        const float ml = MLOC[u], bl = BLAST[u];
        const float mn = fmaxf(bl + m, ml), a = expf(bl + m - mn), cc = expf(ml - mn);
        const float x = (e < 16384) ? CLOC[(size_t)u * 16384 + e] : NLOC[(size_t)u * 128 + e - 16384];
        val = a * val + cc * x; m = mn;
    }
}

__global__ void __launch_bounds__(512) k_mlstm_outA(const float* __restrict__ proj, const float* __restrict__ qc, const float* __restrict__ b_i, const float* __restrict__ b_f,
                                                    const float* __restrict__ NPREV, const float* __restrict__ MPREV,
                                                    float* __restrict__ WS, float* __restrict__ ROWS  ) {
    extern __shared__ float sm[];
    float* Qs = sm;
    float* Ks = sm + 128 * 129;
    float* li = Ks + 128 * 129;
    float* bc = li + 128;
    float* mr = bc + 128;
    float* it = mr + 128;
    float* red = it + 128;
    const int u = blockIdx.x, c = u % NC, h = (u / NC) % NH, b = u / (NC * NH);
    const int row0 = b * SEQ + c * CL, tid = threadIdx.x;
    for (int i = tid; i < 16384; i += 512) { const int s = i >> 7, d = i & 127;
        Qs[s * 129 + d] = qc[(size_t)(row0 + s) * 1024 + h * DH + d];
        Ks[s * 129 + d] = qc[(size_t)(row0 + s) * 1024 + 512 + h * DH + d]; }
    if (tid < 128) { li[tid] = proj[(size_t)(row0 + tid) * DPROJ + PIG + h] + b_i[h];
        bc[tid] = logsigmoid(proj[(size_t)(row0 + tid) * DPROJ + PFG + h] + b_f[h]); }
    __syncthreads();
    if (tid == 0) { float a = 0.f; for (int s = 0; s < 128; ++s) { a += bc[s]; bc[s] = a; } }
    __syncthreads();
    const float mprev = MPREV[u];
    if (tid < 128) { const int t = tid; const float ai = bc[t] + mprev; float mm = ai;
        for (int s = 0; s <= t; ++s) mm = fmaxf(mm, bc[t] - bc[s] + li[s]);
        mr[t] = mm; it[t] = expf(ai - mm); }
    __syncthreads();
    const int t = tid & 127, qt = tid >> 7;
    float rs = 0.f;
#pragma nounroll
    for (int j = 0; j < 32; ++j) { const int s = qt * 32 + j; float a = 0.f;
        if (s <= t) {
#pragma nounroll
            for (int k = 0; k < 128; ++k) a += Qs[t * 129 + k] * Ks[s * 129 + k];
            a *= expf(bc[t] - bc[s] + li[s] - mr[t]); }
        WS[(size_t)u * 16384 + t * 128 + s] = a; rs += a; }
    red[qt * 128 + t] = rs;
    __syncthreads();
    if (tid < 128) { float q = 0.f;
#pragma nounroll
        for (int k = 0; k < 128; ++k) q += NPREV[(size_t)u * 128 + k] * Qs[tid * 129 + k];
        const float dn = red[tid] + red[128 + tid] + red[256 + tid] + red[384 + tid] + it[tid] * q;
        ROWS[(size_t)u * 384 + tid] = mr[tid]; ROWS[(size_t)u * 384 + 128 + tid] = it[tid]; ROWS[(size_t)u * 384 + 256 + tid] = dn; }
}
__global__ void __launch_bounds__(512) k_mlstm_outB(const float* __restrict__ proj, const float* __restrict__ qc, const float* __restrict__ CPREV,
                                                    const float* __restrict__ WS, const float* __restrict__ ROWS, const float* __restrict__ ngain, float* __restrict__ MIX) {
    extern __shared__ float sm[];
    float* Qs = sm;
    float* Wm = sm + 128 * 129;
    float* red = Wm + 128 * 129;
    const int u = blockIdx.x, c = u % NC, h = (u / NC) % NH, b = u / (NC * NH);
    const int row0 = b * SEQ + c * CL, tid = threadIdx.x;
    for (int i = tid; i < 16384; i += 512) { const int s = i >> 7, d = i & 127;
        Qs[s * 129 + d] = qc[(size_t)(row0 + s) * 1024 + h * DH + d];
        Wm[s * 129 + d] = WS[(size_t)u * 16384 + i]; }
    __syncthreads();
    const int t = tid & 127, qt = tid >> 7;
    const float mrow = ROWS[(size_t)u * 384 + t], inter = ROWS[(size_t)u * 384 + 128 + t], den = fmaxf(fabsf(ROWS[(size_t)u * 384 + 256 + t]), expf(-mrow));
    float s1 = 0.f, s2 = 0.f;
#pragma nounroll
    for (int j = 0; j < 32; ++j) { const int v = qt * 32 + j; float a = 0.f, q = 0.f;
#pragma nounroll
        for (int s = 0; s < 128; ++s) a += Wm[t * 129 + s] * proj[(size_t)(row0 + s) * DPROJ + PV + h * DH + v];
#pragma nounroll
        for (int k = 0; k < 128; ++k) q += CPREV[(size_t)u * 16384 + v * 128 + k] * Qs[t * 129 + k];
        const float x = (a + inter * q) / den; s1 += x; s2 += x * x; }
    red[(qt * 128 + t) * 2] = s1; red[(qt * 128 + t) * 2 + 1] = s2;
    __syncthreads();
    const float mean = (red[t * 2] + red[(128 + t) * 2] + red[(256 + t) * 2] + red[(384 + t) * 2]) * (1.0f / 128.0f);
    const float ex2 = (red[t * 2 + 1] + red[(128 + t) * 2 + 1] + red[(256 + t) * 2 + 1] + red[(384 + t) * 2 + 1]) * (1.0f / 128.0f);
    const float rstd = 1.0f / sqrtf(fmaxf(ex2 - mean * mean, 0.f) + EPS);
#pragma nounroll
    for (int j = 0; j < 32; ++j) { const int v = qt * 32 + j; float a = 0.f, q = 0.f;
#pragma nounroll
        for (int s = 0; s < 128; ++s) a += Wm[t * 129 + s] * proj[(size_t)(row0 + s) * DPROJ + PV + h * DH + v];
#pragma nounroll
        for (int k = 0; k < 128; ++k) q += CPREV[(size_t)u * 16384 + v * 128 + k] * Qs[t * 129 + k];
        const float x = (a + inter * q) / den;
        const float o = proj[(size_t)(row0 + t) * DPROJ + PO + h * DH + v];
        MIX[(size_t)(row0 + t) * 1024 + h * DH + v] = sigmoidf_(o) * (x - mean) * rstd * ngain[h * DH + v]; }
}

__global__ void k_gmlp_ln(const float* __restrict__ proj, const float* __restrict__ g, float* __restrict__ VGN) {
    const int w = (blockIdx.x * blockDim.x + threadIdx.x) >> 6, lane = threadIdx.x & 63;
    if (w >= M) return;
    float v[8]; float s = 0.f;
#pragma unroll
    for (int j = 0; j < 8; ++j) { v[j] = gelu_tanh(proj[(size_t)w * DPROJ + PVG + lane + 64 * j]); s += v[j]; }
    const float mean = wave_sum(s) * (1.0f / 512.0f); float q = 0.f;
#pragma unroll
    for (int j = 0; j < 8; ++j) { v[j] -= mean; q += v[j] * v[j]; }
    const float rstd = 1.0f / sqrtf(wave_sum(q) * (1.0f / 512.0f) + EPS);
#pragma unroll
    for (int j = 0; j < 8; ++j) VGN[(size_t)w * 512 + lane + 64 * j] = v[j] * rstd * g[lane + 64 * j];
}
__global__ void __launch_bounds__(512) k_gmlp_mix(const float* __restrict__ proj, const float* __restrict__ VGN, const float* __restrict__ wsp, const float* __restrict__ bsp,
                                                  const float* __restrict__ og, float* __restrict__ MIX) {
    __shared__ float red[8];
    const int row = blockIdx.x, ch = threadIdx.x, g = ch >> 7, t = row & 127, row0 = row - t;
    float a = bsp[g * 128 + t];
    for (int s = 0; s <= t; ++s) a += wsp[(size_t)(g * 128 + t) * 128 + s] * VGN[(size_t)(row0 + s) * 512 + ch];
    const float val = gelu_tanh(proj[(size_t)row * DPROJ + PU + ch]) * a;
    float q = wave_sum(val * val);
    if ((ch & 63) == 0) red[ch >> 6] = q;
    __syncthreads();
    float tot = 0.f;
#pragma unroll
    for (int i = 0; i < 8; ++i) tot += red[i];
    MIX[(size_t)row * 1024 + 512 + ch] = val / sqrtf(tot * (1.0f / 512.0f) + EPS) * og[ch];
}

__global__ void k_router(const float* __restrict__ Hh, const float* __restrict__ g2, const float* __restrict__ wr, const float* __restrict__ br,
                         float* __restrict__ HN, int* __restrict__ cnt, int* __restrict__ tokidx, float* __restrict__ gate) {
    const int w = (blockIdx.x * blockDim.x + threadIdx.x) >> 6, lane = threadIdx.x & 63;
    if (w >= M) return;
    const float4* xr = (const float4*)(Hh + (size_t)w * D);
    float4 v[4]; float s = 0.f;
#pragma unroll
    for (int j = 0; j < 4; ++j) { v[j] = xr[lane + 64 * j]; s += v[j].x * v[j].x + v[j].y * v[j].y + v[j].z * v[j].z + v[j].w * v[j].w; }
    const float r = 1.0f / sqrtf(wave_sum(s) * (1.0f / D) + EPS);
    float4* yr = (float4*)(HN + (size_t)w * D);
#pragma unroll
    for (int j = 0; j < 4; ++j) { const float4 gg = ((const float4*)g2)[lane + 64 * j];
        v[j].x *= r * gg.x; v[j].y *= r * gg.y; v[j].z *= r * gg.z; v[j].w *= r * gg.w; yr[lane + 64 * j] = v[j]; }
    float lg[NE];
#pragma unroll
    for (int e = 0; e < NE; ++e) lg[e] = 0.f;
#pragma unroll
    for (int j = 0; j < 4; ++j) { const int d0 = (lane + 64 * j) * 4;
        const float xs[4] = {v[j].x, v[j].y, v[j].z, v[j].w};
#pragma unroll
        for (int i = 0; i < 4; ++i) { const float4* wrow = (const float4*)(wr + (size_t)(d0 + i) * NE);
#pragma unroll
            for (int e4 = 0; e4 < 8; ++e4) { const float4 ww = wrow[e4];
                lg[e4 * 4 + 0] += xs[i] * ww.x; lg[e4 * 4 + 1] += xs[i] * ww.y; lg[e4 * 4 + 2] += xs[i] * ww.z; lg[e4 * 4 + 3] += xs[i] * ww.w; } } }
#pragma unroll
    for (int e = 0; e < NE; ++e) lg[e] = wave_sum(lg[e]) + br[e];
    int be[4]; float bv[4];
#pragma unroll
    for (int k = 0; k < 4; ++k) { float best = -INFINITY; int bi = 0;
#pragma unroll
        for (int e = 0; e < NE; ++e) if (lg[e] > best) { best = lg[e]; bi = e; }
        be[k] = bi; bv[k] = best;
#pragma unroll
        for (int e = 0; e < NE; ++e) lg[e] = (e == bi) ? -INFINITY : lg[e]; }
    float den = 0.f, ex[4];
#pragma unroll
    for (int k = 0; k < 4; ++k) { ex[k] = expf(bv[k] - bv[0]); den += ex[k]; }
    if (lane == 0) {
#pragma unroll
        for (int k = 0; k < 4; ++k) { const int rk = atomicAdd(&cnt[be[k]], 1); tokidx[(size_t)be[k] * 65536 + rk] = w * 4 + k; gate[w * 4 + k] = ex[k] / den; } }
}
__global__ void k_tiles(const int* __restrict__ cnt, int* __restrict__ tile_e, int* __restrict__ tile_r, int* __restrict__ ntiles, int TM) {
    if (threadIdx.x == 0) { int n = 0;
        for (int e = 0; e < NE; ++e) { const int nt = (cnt[e] + TM - 1) / TM; for (int r = 0; r < nt; ++r) { tile_e[n] = e; tile_r[n] = r; ++n; } }
        *ntiles = n; }
}
__global__ void k_final(const float* __restrict__ Hh, const float* __restrict__ Y, const float* __restrict__ g, float* __restrict__ out) {
    const int w = (blockIdx.x * blockDim.x + threadIdx.x) >> 6, lane = threadIdx.x & 63;
    if (w >= M) return;
    float4 v[4]; float s = 0.f;
#pragma unroll
    for (int j = 0; j < 4; ++j) { v[j] = ((const float4*)(Hh + (size_t)w * D))[lane + 64 * j];
#pragma unroll
        for (int k = 0; k < 4; ++k) { const float4 y = ((const float4*)(Y + (size_t)(w * 4 + k) * D))[lane + 64 * j]; v[j].x += y.x; v[j].y += y.y; v[j].z += y.z; v[j].w += y.w; }
        s += v[j].x * v[j].x + v[j].y * v[j].y + v[j].z * v[j].z + v[j].w * v[j].w; }
    const float r = 1.0f / sqrtf(wave_sum(s) * (1.0f / D) + EPS);
#pragma unroll
    for (int j = 0; j < 4; ++j) { const float4 gg = ((const float4*)g)[lane + 64 * j];
        float4 o; o.x = v[j].x * r * gg.x; o.y = v[j].y * r * gg.y; o.z = v[j].z * r * gg.z; o.w = v[j].w * r * gg.w; ((float4*)(out + (size_t)w * D))[lane + 64 * j] = o; }
}
}

extern "C" void kernel_launch(void* const* d_in, const int* in_sizes, int n_in, void* d_out, int out_size, void* d_ws, size_t ws_size, hipStream_t stream) {
    const float* x = (const float*)d_in[0]; const float* g1 = (const float*)d_in[1]; const float* w_in = (const float*)d_in[2]; const float* conv = (const float*)d_in[3];
    const float* b_i = (const float*)d_in[4]; const float* b_f = (const float*)d_in[5]; const float* ngain = (const float*)d_in[6]; const float* lng = (const float*)d_in[7];
    const float* wsp = (const float*)d_in[8]; const float* bsp = (const float*)d_in[9]; const float* og = (const float*)d_in[10]; const float* w_out = (const float*)d_in[11];
    const float* g2 = (const float*)d_in[12]; const float* wr = (const float*)d_in[13]; const float* br = (const float*)d_in[14]; const float* w_up = (const float*)d_in[15];
    const float* b_up = (const float*)d_in[16]; const float* w_dn = (const float*)d_in[17]; const float* b_dn = (const float*)d_in[18]; const float* gf = (const float*)d_in[19];
    float* out = (float*)d_out;
    char* ws = (char*)d_ws;
    const size_t MiB = 1u << 20;
    int* cnt = (int*)(ws + 0);
    int* ntiles = (int*)(ws + 256);
    int* tile_e = (int*)(ws + 4096);
    int* tile_r = (int*)(ws + 4096 + 8192);
    float* MLOC = (float*)(ws + 32768); float* BLAST = MLOC + 512; float* MPREV = BLAST + 512;
    float* NLOC = (float*)(ws + 65536);
    float* NPREV = NLOC + 512 * 128;
    float* gate = (float*)(ws + 1 * MiB);
    int* tokidx = (int*)(ws + 2 * MiB);
    float* XN = (float*)(ws + 16 * MiB);
    float* MIX = (float*)(ws + 80 * MiB);
    float* Hh = (float*)(ws + 144 * MiB);
    float* Y = (float*)(ws + 208 * MiB);
    float* PROJ = (float*)(ws + 464 * MiB);
    float* QC = (float*)(ws + 660 * MiB);
    float* CLOC = (float*)(ws + 724 * MiB);
    float* CPREV = (float*)(ws + 756 * MiB);
    float* VGN = (float*)(ws + 788 * MiB);
    float* WSCR = (float*)(ws + 820 * MiB);
    float* ROWS = (float*)(ws + 852 * MiB);
    float* ACT = PROJ;
    float* HN = XN;
    if (ws_size < 856 * MiB) { fprintf(stderr, "ws too small: %zu\n", ws_size); return; }

    hipMemsetAsync(cnt, 0, 512, stream);
    k_rmsnorm<<<M / 4, 256, 0, stream>>>(x, g1, XN, M);
    { GemmP p{}; p.A = XN; p.B = w_in; p.C = PROJ; p.lda = D; p.ldb = DPROJ; p.ldc = DPROJ; p.N = DPROJ; p.K = D;
      k_gemm<0><<<dim3((DPROJ + 63) / 64, M / 64), 256, 0, stream>>>(p); }
    k_conv<<<(M * 1024) / 256, 256, 0, stream>>>(PROJ, conv, QC);
    const int lds_local = (32768 + 384) * 4, lds_out = (2 * 128 * 129 + 2048) * 4;
    static bool attr = false;
    if (!attr) { hipFuncSetAttribute((const void*)k_mlstm_local, hipFuncAttributeMaxDynamicSharedMemorySize, lds_local);
                 hipFuncSetAttribute((const void*)k_mlstm_outA, hipFuncAttributeMaxDynamicSharedMemorySize, lds_out);
                 hipFuncSetAttribute((const void*)k_mlstm_outB, hipFuncAttributeMaxDynamicSharedMemorySize, lds_out); attr = true; }
    k_mlstm_local<<<NUNIT, 256, lds_local, stream>>>(PROJ, QC, b_i, b_f, CLOC, NLOC, MLOC, BLAST);
    k_mlstm_scan<<<dim3((16384 + 128 + 255) / 256, 8), 256, 0, stream>>>(CLOC, NLOC, MLOC, BLAST, CPREV, NPREV, MPREV);
    k_mlstm_outA<<<NUNIT, 512, lds_out, stream>>>(PROJ, QC, b_i, b_f, NPREV, MPREV, WSCR, ROWS);
    k_mlstm_outB<<<NUNIT, 512, lds_out, stream>>>(PROJ, QC, CPREV, WSCR, ROWS, ngain, MIX);
    k_gmlp_ln<<<M / 4, 256, 0, stream>>>(PROJ, lng, VGN);
    k_gmlp_mix<<<M, 512, 0, stream>>>(PROJ, VGN, wsp, bsp, og, MIX);
    { GemmP p{}; p.A = MIX; p.B = w_out; p.C = Hh; p.R = x; p.lda = D; p.ldb = D; p.ldc = D; p.N = D; p.K = D;
      k_gemm<1><<<dim3(D / 64, M / 64), 256, 0, stream>>>(p); }
    k_router<<<M / 4, 256, 0, stream>>>(Hh, g2, wr, br, HN, cnt, tokidx, gate);
    k_tiles<<<1, 64, 0, stream>>>(cnt, tile_e, tile_r, ntiles, 64);
    { GemmP p{}; p.A = HN; p.B = w_up; p.C = ACT; p.lda = D; p.ldb = 2048; p.ldc = DFF; p.N = DFF; p.K = D;
      p.cnt = cnt; p.tokidx = tokidx; p.tile_e = tile_e; p.tile_r = tile_r; p.ntiles = ntiles; p.bias = b_up; p.gate = gate;
      k_gemm<2><<<dim3(DFF / 64, 1056), 256, 0, stream>>>(p); }
    { GemmP p{}; p.A = ACT; p.B = w_dn; p.C = Y; p.lda = DFF; p.ldb = D; p.ldc = D; p.N = D; p.K = DFF;
      p.cnt = cnt; p.tokidx = tokidx; p.tile_e = tile_e; p.tile_r = tile_r; p.ntiles = ntiles; p.bias = b_dn; p.gate = gate;
      k_gemm<3><<<dim3(D / 64, 1056), 256, 0, stream>>>(p); }
    k_final<<<M / 4, 256, 0, stream>>>(Hh, Y, gf, out);
}
```

```cpp
#include <hip/hip_runtime.h>
#include <cstdio>
#include <cstdint>
#include <cstddef>
#include <cmath>

namespace gold {

constexpr int M = 16384, D = 1024, SEQ = 8192;
constexpr int DPROJ = 3080;
constexpr int NH = 4, DH = 128, CL = 128, NC = SEQ / CL;
constexpr int NE = 32, DFF = 1024;
constexpr int NUNIT = 2 * NH * NC;
constexpr float EPS = 1e-6f;
constexpr int PQ = 0, PK = 512, PV = 1024, PO = 1536, PIG = 2048, PFG = 2052, PU = 2056, PVG = 2568;

__device__ __forceinline__ float wave_sum(float v) {
#pragma unroll
    for (int o = 32; o > 0; o >>= 1) v += __shfl_xor(v, o);
    return v;
}
__device__ __forceinline__ float gelu_tanh(float x) {
    const float c = 0.7978845608028654f;
    float u = c * (x + 0.044715f * x * x * x);
    return 0.5f * x * (1.0f + tanhf(u));
}
__device__ __forceinline__ float sigmoidf_(float x) { return 1.0f / (1.0f + expf(-x)); }
__device__ __forceinline__ float logsigmoid(float x) { return fminf(x, 0.0f) - log1pf(expf(-fabsf(x))); }

__global__ void k_rmsnorm(const float* __restrict__ x, const float* __restrict__ g, float* __restrict__ y, int rows) {
    const int w = (blockIdx.x * blockDim.x + threadIdx.x) >> 6, lane = threadIdx.x & 63;
    if (w >= rows) return;
    const float4* xr = (const float4*)(x + (size_t)w * D);
    float4 v[4]; float s = 0.f;
#pragma unroll
    for (int j = 0; j < 4; ++j) { v[j] = xr[lane + 64 * j]; s += v[j].x * v[j].x + v[j].y * v[j].y + v[j].z * v[j].z + v[j].w * v[j].w; }
    s = wave_sum(s);
    const float r = 1.0f / sqrtf(s * (1.0f / D) + EPS);
    float4* yr = (float4*)(y + (size_t)w * D);
#pragma unroll
    for (int j = 0; j < 4; ++j) { const float4 gg = ((const float4*)g)[lane + 64 * j];
        float4 o; o.x = v[j].x * r * gg.x; o.y = v[j].y * r * gg.y; o.z = v[j].z * r * gg.z; o.w = v[j].w * r * gg.w; yr[lane + 64 * j] = o; }
}

struct GemmP {
    const float* A; const float* B; float* C; const float* R;
    int lda, ldb, ldc, N, K;
    const int* cnt; const int* tokidx; const int* tile_e; const int* tile_r; const int* ntiles; const float* bias; const float* gate;
};
template <int MODE>
__global__ void __launch_bounds__(256) k_gemm(GemmP p) {
    __shared__ float As[16][64 + 4];
    __shared__ float Bs[16][64 + 4];
    __shared__ float Bs2[MODE == 2 ? 16 : 1][64 + 4];
    __shared__ int rowsrc[64];
    const int tid = threadIdx.x, tx = tid & 15, ty = tid >> 4;
    const int n0 = blockIdx.x * 64;
    int m0 = blockIdx.y * 64;
    const float* Bp = p.B;
    int e = 0, rt = 0, cnte = 0;
    if (MODE >= 2) {
        const int tile = blockIdx.y;
        if (tile >= *p.ntiles) return;
        e = p.tile_e[tile]; rt = p.tile_r[tile]; cnte = p.cnt[e];
        if (tid < 64) { const int r = rt * 64 + tid; rowsrc[tid] = p.tokidx[(size_t)e * 65536 + (r < cnte ? r : 0)]; }
        __syncthreads();
        if (MODE == 2) Bp = p.B + (size_t)e * 1024 * 2048; else Bp = p.B + (size_t)e * 1024 * 1024;
    }
    float acc[4][4], acc2[4][4];
#pragma unroll
    for (int i = 0; i < 4; ++i)
#pragma unroll
        for (int j = 0; j < 4; ++j) { acc[i][j] = 0.f; acc2[i][j] = 0.f; }
    const int ar = tid >> 2, ak = (tid & 3) * 4;
    const int bk = tid >> 4, bn = (tid & 15) * 4;
    const float* arow;
    if (MODE == 2) arow = p.A + (size_t)(rowsrc[ar] >> 2) * p.lda;
    else if (MODE == 3) arow = p.A + (size_t)(blockIdx.y * 64 + ar) * p.lda;
    else arow = p.A + (size_t)(m0 + ar) * p.lda;
    for (int k0 = 0; k0 < p.K; k0 += 16) {
        const float4 av = *(const float4*)(arow + k0 + ak);
        As[ak + 0][ar] = av.x; As[ak + 1][ar] = av.y; As[ak + 2][ar] = av.z; As[ak + 3][ar] = av.w;
        float4 bv = make_float4(0.f, 0.f, 0.f, 0.f);
        if (n0 + bn < p.N) bv = *(const float4*)(Bp + (size_t)(k0 + bk) * p.ldb + n0 + bn);
        *(float4*)&Bs[bk][bn] = bv;
        if (MODE == 2) { const float4 b2 = *(const float4*)(Bp + (size_t)(k0 + bk) * p.ldb + 1024 + n0 + bn); *(float4*)&Bs2[bk][bn] = b2; }
        __syncthreads();
#pragma unroll
        for (int kk = 0; kk < 16; ++kk) {
            const float4 a = *(const float4*)&As[kk][ty * 4];
            const float4 b = *(const float4*)&Bs[kk][tx * 4];
            const float aa[4] = {a.x, a.y, a.z, a.w}, bb[4] = {b.x, b.y, b.z, b.w};
#pragma unroll
            for (int i = 0; i < 4; ++i)
#pragma unroll
                for (int j = 0; j < 4; ++j) acc[i][j] += aa[i] * bb[j];
            if (MODE == 2) {
                const float4 c = *(const float4*)&Bs2[kk][tx * 4];
                const float cc[4] = {c.x, c.y, c.z, c.w};
#pragma unroll
                for (int i = 0; i < 4; ++i)
#pragma unroll
                    for (int j = 0; j < 4; ++j) acc2[i][j] += aa[i] * cc[j];
            }
        }
        __syncthreads();
    }
#pragma unroll
    for (int i = 0; i < 4; ++i) {
        const int lr = ty * 4 + i;
#pragma unroll
        for (int j = 0; j < 4; ++j) {
            const int n = n0 + tx * 4 + j;
            if (MODE == 0) { if (n < p.N) p.C[(size_t)(m0 + lr) * p.ldc + n] = acc[i][j]; }
            else if (MODE == 1) { p.C[(size_t)(m0 + lr) * p.ldc + n] = p.R[(size_t)(m0 + lr) * p.ldc + n] + acc[i][j]; }
            else if (MODE == 2) {
                float gl = acc[i][j] + p.bias[(size_t)e * 2048 + n], ln = acc2[i][j] + p.bias[(size_t)e * 2048 + 1024 + n];
                gl = fminf(gl, 7.0f); ln = fminf(fmaxf(ln, -7.0f), 7.0f);
                p.C[(size_t)(blockIdx.y * 64 + lr) * p.ldc + n] = gl * sigmoidf_(1.702f * gl) * (ln + 1.0f);
            } else {
                const int r = rt * 64 + lr;
                if (r < cnte) { const int idx = rowsrc[lr]; p.C[(size_t)idx * p.ldc + n] = (acc[i][j] + p.bias[(size_t)e * 1024 + n]) * p.gate[idx]; }
            }
        }
    }
}

__global__ void k_conv(const float* __restrict__ proj, const float* __restrict__ w, float* __restrict__ qc) {
    const size_t i = (size_t)blockIdx.x * blockDim.x + threadIdx.x;
    if (i >= (size_t)M * 1024) return;
    const int row = (int)(i >> 10), c = (int)(i & 1023), t = row % SEQ;
    float acc = 0.f;
#pragma unroll
    for (int j = 0; j < 4; ++j) { const int tt = t - 3 + j; if (tt >= 0) acc += w[j * 1024 + c] * proj[(size_t)(row - 3 + j) * DPROJ + c]; }
    float y = acc * sigmoidf_(acc);
    if (c >= 512) y *= 0.08838834764831845f;
    qc[i] = y;
}

__global__ void __launch_bounds__(256) k_mlstm_local(const float* __restrict__ proj, const float* __restrict__ qc, const float* __restrict__ GATES,
                                                     float* __restrict__ CLOC, float* __restrict__ NLOC, float* __restrict__ MLOC, float* __restrict__ BLAST) {
    extern __shared__ float sm[];
    float* Vs = sm;
    float* Ks = sm + 16384;
    float* li = sm + 32768;
    float* bc = li + 128;
    float* wl = bc + 128;
    const int u = blockIdx.x, c = u % NC, h = (u / NC) % NH, b = u / (NC * NH);
    const int row0 = b * SEQ + c * CL, tid = threadIdx.x;
    for (int i = tid; i < 16384; i += 256) { const int s = i >> 7, d = i & 127;
        Vs[i] = proj[(size_t)(row0 + s) * DPROJ + PV + h * DH + d];
        Ks[i] = qc[(size_t)(row0 + s) * 1024 + 512 + h * DH + d]; }
    if (tid < 128) { li[tid] = GATES[(size_t)(row0 + tid) * 8 + h]; bc[tid] = GATES[(size_t)(row0 + tid) * 8 + 4 + h]; }
    __syncthreads();
    if (tid == 0) { float a = 0.f; for (int s = 0; s < 128; ++s) { a += bc[s]; bc[s] = a; } }
    __syncthreads();
    if (tid < 128) wl[tid] = bc[127] - bc[tid] + li[tid];
    __syncthreads();
    float mloc = -INFINITY;
    for (int s = 0; s < 128; ++s) mloc = fmaxf(mloc, wl[s]);
    __syncthreads();
    if (tid < 128) wl[tid] = expf(wl[tid] - mloc);
    __syncthreads();
    for (int j = 0; j < 64; ++j) { const int idx = tid + 256 * j, v = idx >> 7, k = idx & 127;
        float a = 0.f;
        for (int s = 0; s < 128; ++s) a += wl[s] * Vs[s * 128 + v] * Ks[s * 128 + k];
        CLOC[(size_t)u * 16384 + idx] = a; }
    if (tid < 128) { float a = 0.f; for (int s = 0; s < 128; ++s) a += wl[s] * Ks[s * 128 + tid]; NLOC[(size_t)u * 128 + tid] = a; }
    if (tid == 0) { MLOC[u] = mloc; BLAST[u] = bc[127]; }
}

__global__ void k_mlstm_scan(const float* __restrict__ CLOC, const float* __restrict__ NLOC, const float* __restrict__ MLOC, const float* __restrict__ BLAST,
                             float* __restrict__ CPREV, float* __restrict__ NPREV, float* __restrict__ MPREV) {
    const int bh = blockIdx.y, e = blockIdx.x * 256 + threadIdx.x;
    if (e >= 16384 + 128) return;
    float m = 0.f, val = 0.f;
    for (int c = 0; c < NC; ++c) {
        const int u = bh * NC + c;
        if (e < 16384) CPREV[(size_t)u * 16384 + e] = val; else NPREV[(size_t)u * 128 + e - 16384] = val;
        if (e == 0) MPREV[u] = m;
        const float ml = MLOC[u], bl = BLAST[u];
        const float mn = fmaxf(bl + m, ml), a = expf(bl + m - mn), cc = expf(ml - mn);
        const float x = (e < 16384) ? CLOC[(size_t)u * 16384 + e] : NLOC[(size_t)u * 128 + e - 16384];
        val = a * val + cc * x; m = mn;
    }
}

__global__ void __launch_bounds__(512) k_mlstm_outA(const float* __restrict__ qc, const float* __restrict__ GATES,
                                                    const float* __restrict__ NPREV, const float* __restrict__ MPREV,
                                                    float* __restrict__ WS, float* __restrict__ ROWS  ) {
    extern __shared__ float sm[];
    float* Qs = sm;
    float* Ks = sm + 128 * 129;
    float* li = Ks + 128 * 129;
    float* bc = li + 128;
    float* mr = bc + 128;
    float* it = mr + 128;
    float* red = it + 128;
    const int u = blockIdx.x, c = u % NC, h = (u / NC) % NH, b = u / (NC * NH);
    const int row0 = b * SEQ + c * CL, tid = threadIdx.x;
    for (int i = tid; i < 16384; i += 512) { const int s = i >> 7, d = i & 127;
        Qs[s * 129 + d] = qc[(size_t)(row0 + s) * 1024 + h * DH + d];
        Ks[s * 129 + d] = qc[(size_t)(row0 + s) * 1024 + 512 + h * DH + d]; }
    if (tid < 128) { li[tid] = GATES[(size_t)(row0 + tid) * 8 + h]; bc[tid] = GATES[(size_t)(row0 + tid) * 8 + 4 + h]; }
    __syncthreads();
    if (tid == 0) { float a = 0.f; for (int s = 0; s < 128; ++s) { a += bc[s]; bc[s] = a; } }
    __syncthreads();
    const float mprev = MPREV[u];
    if (tid < 128) { const int t = tid; const float ai = bc[t] + mprev; float mm = ai;
        for (int s = 0; s <= t; ++s) mm = fmaxf(mm, bc[t] - bc[s] + li[s]);
        mr[t] = mm; it[t] = expf(ai - mm); }
    __syncthreads();
    const int t = tid & 127, qt = tid >> 7;
    float rs = 0.f;
#pragma nounroll
    for (int j = 0; j < 32; ++j) { const int s = qt * 32 + j; float a = 0.f;
        if (s <= t) {
#pragma nounroll
            for (int k = 0; k < 128; ++k) a += Qs[t * 129 + k] * Ks[s * 129 + k];
            a *= expf(bc[t] - bc[s] + li[s] - mr[t]); }
        WS[(size_t)u * 16384 + t * 128 + s] = a; rs += a; }
    red[qt * 128 + t] = rs;
    __syncthreads();
    if (tid < 128) { float q = 0.f;
#pragma nounroll
        for (int k = 0; k < 128; ++k) q += NPREV[(size_t)u * 128 + k] * Qs[tid * 129 + k];
        const float dn = red[tid] + red[128 + tid] + red[256 + tid] + red[384 + tid] + it[tid] * q;
        ROWS[(size_t)u * 384 + tid] = mr[tid]; ROWS[(size_t)u * 384 + 128 + tid] = it[tid]; ROWS[(size_t)u * 384 + 256 + tid] = dn; }
}
__global__ void __launch_bounds__(512) k_mlstm_outB(const float* __restrict__ proj, const float* __restrict__ qc, const float* __restrict__ CPREV,
                                                    const float* __restrict__ WS, const float* __restrict__ ROWS, const float* __restrict__ ngain, float* __restrict__ MIX) {
    extern __shared__ float sm[];
    float* Qs = sm;
    float* Wm = sm + 128 * 129;
    float* red = Wm + 128 * 129;
    const int u = blockIdx.x, c = u % NC, h = (u / NC) % NH, b = u / (NC * NH);
    const int row0 = b * SEQ + c * CL, tid = threadIdx.x;
    for (int i = tid; i < 16384; i += 512) { const int s = i >> 7, d = i & 127;
        Qs[s * 129 + d] = qc[(size_t)(row0 + s) * 1024 + h * DH + d];
        Wm[s * 129 + d] = WS[(size_t)u * 16384 + i]; }
    __syncthreads();
    const int t = tid & 127, qt = tid >> 7;
    const float mrow = ROWS[(size_t)u * 384 + t], inter = ROWS[(size_t)u * 384 + 128 + t], den = fmaxf(fabsf(ROWS[(size_t)u * 384 + 256 + t]), expf(-mrow));
    float s1 = 0.f, s2 = 0.f;
#pragma nounroll
    for (int j = 0; j < 32; ++j) { const int v = qt * 32 + j; float a = 0.f, q = 0.f;
#pragma nounroll
        for (int s = 0; s < 128; ++s) a += Wm[t * 129 + s] * proj[(size_t)(row0 + s) * DPROJ + PV + h * DH + v];
#pragma nounroll
        for (int k = 0; k < 128; ++k) q += CPREV[(size_t)u * 16384 + v * 128 + k] * Qs[t * 129 + k];
        const float x = (a + inter * q) / den; s1 += x; s2 += x * x; }
    red[(qt * 128 + t) * 2] = s1; red[(qt * 128 + t) * 2 + 1] = s2;
    __syncthreads();
    const float mean = (red[t * 2] + red[(128 + t) * 2] + red[(256 + t) * 2] + red[(384 + t) * 2]) * (1.0f / 128.0f);
    const float ex2 = (red[t * 2 + 1] + red[(128 + t) * 2 + 1] + red[(256 + t) * 2 + 1] + red[(384 + t) * 2 + 1]) * (1.0f / 128.0f);
    const float rstd = 1.0f / sqrtf(fmaxf(ex2 - mean * mean, 0.f) + EPS);
#pragma nounroll
    for (int j = 0; j < 32; ++j) { const int v = qt * 32 + j; float a = 0.f, q = 0.f;
#pragma nounroll
        for (int s = 0; s < 128; ++s) a += Wm[t * 129 + s] * proj[(size_t)(row0 + s) * DPROJ + PV + h * DH + v];
#pragma nounroll
        for (int k = 0; k < 128; ++k) q += CPREV[(size_t)u * 16384 + v * 128 + k] * Qs[t * 129 + k];
        const float x = (a + inter * q) / den;
        const float o = proj[(size_t)(row0 + t) * DPROJ + PO + h * DH + v];
        MIX[(size_t)(row0 + t) * 1024 + h * DH + v] = sigmoidf_(o) * (x - mean) * rstd * ngain[h * DH + v]; }
}

__global__ void k_gmlp_ln(const float* __restrict__ proj, const float* __restrict__ g, float* __restrict__ VGN) {
    const int w = (blockIdx.x * blockDim.x + threadIdx.x) >> 6, lane = threadIdx.x & 63;
    if (w >= M) return;
    float v[8]; float s = 0.f;
#pragma unroll
    for (int j = 0; j < 8; ++j) { v[j] = gelu_tanh(proj[(size_t)w * DPROJ + PVG + lane + 64 * j]); s += v[j]; }
    const float mean = wave_sum(s) * (1.0f / 512.0f); float q = 0.f;
#pragma unroll
    for (int j = 0; j < 8; ++j) { v[j] -= mean; q += v[j] * v[j]; }
    const float rstd = 1.0f / sqrtf(wave_sum(q) * (1.0f / 512.0f) + EPS);
#pragma unroll
    for (int j = 0; j < 8; ++j) VGN[(size_t)w * 512 + lane + 64 * j] = v[j] * rstd * g[lane + 64 * j];
}
__global__ void __launch_bounds__(512) k_gmlp_mix(const float* __restrict__ proj, const float* __restrict__ VGN, const float* __restrict__ wsp, const float* __restrict__ bsp,
                                                  const float* __restrict__ og, float* __restrict__ MIX) {
    __shared__ float red[8];
    const int row = blockIdx.x, ch = threadIdx.x, g = ch >> 7, t = row & 127, row0 = row - t;
    float a = bsp[g * 128 + t];
    for (int s = 0; s <= t; ++s) a += wsp[(size_t)(g * 128 + t) * 128 + s] * VGN[(size_t)(row0 + s) * 512 + ch];
    const float val = gelu_tanh(proj[(size_t)row * DPROJ + PU + ch]) * a;
    float q = wave_sum(val * val);
    if ((ch & 63) == 0) red[ch >> 6] = q;
    __syncthreads();
    float tot = 0.f;
#pragma unroll
    for (int i = 0; i < 8; ++i) tot += red[i];
    MIX[(size_t)row * 1024 + 512 + ch] = val / sqrtf(tot * (1.0f / 512.0f) + EPS) * og[ch];
}

__global__ void k_router(const float* __restrict__ Hh, const float* __restrict__ g2, const float* __restrict__ wr, const float* __restrict__ br,
                         float* __restrict__ HN, int* __restrict__ cnt, int* __restrict__ tokidx, float* __restrict__ gate) {
    const int w = (blockIdx.x * blockDim.x + threadIdx.x) >> 6, lane = threadIdx.x & 63;
    if (w >= M) return;
    const float4* xr = (const float4*)(Hh + (size_t)w * D);
    float4 v[4]; float s = 0.f;
#pragma unroll
    for (int j = 0; j < 4; ++j) { v[j] = xr[lane + 64 * j]; s += v[j].x * v[j].x + v[j].y * v[j].y + v[j].z * v[j].z + v[j].w * v[j].w; }
    const float r = 1.0f / sqrtf(wave_sum(s) * (1.0f / D) + EPS);
    float4* yr = (float4*)(HN + (size_t)w * D);
#pragma unroll
    for (int j = 0; j < 4; ++j) { const float4 gg = ((const float4*)g2)[lane + 64 * j];
        v[j].x *= r * gg.x; v[j].y *= r * gg.y; v[j].z *= r * gg.z; v[j].w *= r * gg.w; yr[lane + 64 * j] = v[j]; }
    float lg[NE];
#pragma unroll
    for (int e = 0; e < NE; ++e) lg[e] = 0.f;
#pragma unroll
    for (int j = 0; j < 4; ++j) { const int d0 = (lane + 64 * j) * 4;
        const float xs[4] = {v[j].x, v[j].y, v[j].z, v[j].w};
#pragma unroll
        for (int i = 0; i < 4; ++i) { const float4* wrow = (const float4*)(wr + (size_t)(d0 + i) * NE);
#pragma unroll
            for (int e4 = 0; e4 < 8; ++e4) { const float4 ww = wrow[e4];
                lg[e4 * 4 + 0] += xs[i] * ww.x; lg[e4 * 4 + 1] += xs[i] * ww.y; lg[e4 * 4 + 2] += xs[i] * ww.z; lg[e4 * 4 + 3] += xs[i] * ww.w; } } }
#pragma unroll
    for (int e = 0; e < NE; ++e) lg[e] = wave_sum(lg[e]) + br[e];
    int be[4]; float bv[4];
#pragma unroll
    for (int k = 0; k < 4; ++k) { float best = -INFINITY; int bi = 0;
#pragma unroll
        for (int e = 0; e < NE; ++e) if (lg[e] > best) { best = lg[e]; bi = e; }
        be[k] = bi; bv[k] = best;
#pragma unroll
        for (int e = 0; e < NE; ++e) lg[e] = (e == bi) ? -INFINITY : lg[e]; }
    float den = 0.f, ex[4];
#pragma unroll
    for (int k = 0; k < 4; ++k) { ex[k] = expf(bv[k] - bv[0]); den += ex[k]; }
    if (lane == 0) {
#pragma unroll
        for (int k = 0; k < 4; ++k) { const int rk = atomicAdd(&cnt[be[k]], 1); tokidx[(size_t)be[k] * 65536 + rk] = w * 4 + k; gate[w * 4 + k] = ex[k] / den; } }
}
__global__ void k_tiles(const int* __restrict__ cnt, int* __restrict__ tile_e, int* __restrict__ tile_r, int* __restrict__ ntiles, int TM) {
    if (threadIdx.x == 0) { int n = 0;
        for (int e = 0; e < NE; ++e) { const int nt = (cnt[e] + TM - 1) / TM; for (int r = 0; r < nt; ++r) { tile_e[n] = e; tile_r[n] = r; ++n; } }
        *ntiles = n; }
}
__global__ void k_final(const float* __restrict__ Hh, const float* __restrict__ Y, const float* __restrict__ g, float* __restrict__ out) {
    const int w = (blockIdx.x * blockDim.x + threadIdx.x) >> 6, lane = threadIdx.x & 63;
    if (w >= M) return;
    float4 v[4]; float s = 0.f;
#pragma unroll
    for (int j = 0; j < 4; ++j) { v[j] = ((const float4*)(Hh + (size_t)w * D))[lane + 64 * j];
#pragma unroll
        for (int k = 0; k < 4; ++k) { const float4 y = ((const float4*)(Y + (size_t)(w * 4 + k) * D))[lane + 64 * j]; v[j].x += y.x; v[j].y += y.y; v[j].z += y.z; v[j].w += y.w; }
        s += v[j].x * v[j].x + v[j].y * v[j].y + v[j].z * v[j].z + v[j].w * v[j].w; }
    const float r = 1.0f / sqrtf(wave_sum(s) * (1.0f / D) + EPS);
#pragma unroll
    for (int j = 0; j < 4; ++j) { const float4 gg = ((const float4*)g)[lane + 64 * j];
        float4 o; o.x = v[j].x * r * gg.x; o.y = v[j].y * r * gg.y; o.z = v[j].z * r * gg.z; o.w = v[j].w * r * gg.w; ((float4*)(out + (size_t)w * D))[lane + 64 * j] = o; }
}
}

namespace pg8 {
#define PG8_LAS __attribute__((address_space(3)))
typedef unsigned short bf16_t;
typedef short bf16x8 __attribute__((ext_vector_type(8)));
typedef float f32x4 __attribute__((ext_vector_type(4)));
typedef float f32x2 __attribute__((ext_vector_type(2)));
typedef unsigned u32x4 __attribute__((ext_vector_type(4)));
constexpr int BM = 256, BK = 64, HALF = 128, HTB = HALF * BK * 2, STAGE_BYTES = 8 * HTB, NXCD = 8, WGM = 8;

__host__ __device__ __forceinline__ int lds_byte(int r, int c) { const int st = (r >> 4) * 2 + (c >> 5), rr = r & 15, cc = c & 31, ob = rr * 64 + cc * 2; return st * 1024 + (ob ^ (((ob >> 9) & 1) << 5)); }
__host__ __device__ __forceinline__ void stage_rc(int b, int& R, int& C) { const int st = b / 1024, sb = b % 1024, swz = sb ^ (((sb >> 9) & 1) << 5); R = (st >> 1) * 16 + swz / 64; C = (st & 1) * 32 + (swz % 64) / 2; }
__host__ __device__ __forceinline__ int perm32(int rho) { const int n = rho >> 4, i = rho & 15; return 8 * (i >> 2) + 4 * n + (i & 3); }

struct Unit { int pm, pn, e, rt, nrows; };

struct StaticOrder {
    int nM, nN, nwg, G, c;
    __device__ void init(int nM_, int nN_, int G_, int c_) { nM = nM_; nN = nN_; nwg = nM * nN; G = G_; c = c_; }
    __device__ bool next(int i, Unit& u) const {
        const long L = (long)i * G + c; if (L >= nwg) return false;
        int wgid = (int)L; { const int q = nwg / NXCD, r = nwg % NXCD, xcd = wgid % NXCD, off = wgid / NXCD; wgid = (xcd < r ? xcd * (q + 1) : r * (q + 1) + (xcd - r) * q) + off; }
        const int nig = WGM * nN, gid = wgid / nig, fm = gid * WGM, gsz = (nM - fm) < WGM ? (nM - fm) : WGM;
        u.pm = fm + ((wgid % nig) % gsz); u.pn = (wgid % nig) / gsz; u.e = 0; u.rt = 0; u.nrows = 256; return true;
    }
};
struct MoeOrder : StaticOrder {
    const PG8_LAS unsigned* ttab;
    __device__ bool next(int i, Unit& u) const {
        if (!StaticOrder::next(i, u)) return false;
        const unsigned w = ttab[u.pm]; u.e = (int)(w & 31u); u.rt = (int)((w >> 5) & 511u); u.nrows = (int)((w >> 14) & 255u) + 1; return true;
    }
};

__device__ __forceinline__ unsigned cvt_pk_bf16(float lo, float hi) { unsigned r; asm volatile("v_cvt_pk_bf16_f32 %0, %1, %2" : "=v"(r) : "v"(lo), "v"(hi)); return r; }

struct DenseOps {
    const bf16_t* A; const bf16_t* Bt; int K;
    __device__ __forceinline__ const char* a_base(const Unit& u) const { return (const char*)A + (size_t)u.pm * BM * K * 2; }
    __device__ __forceinline__ const char* b_base(const Unit& u) const { return (const char*)Bt + (size_t)u.pn * BM * K * 2; }
    __device__ __forceinline__ void gather(const Unit&, const int (&)[2], const int (&)[2], unsigned (&)[2][2]) const {}
};
struct UpOps {
    const bf16_t* HN; const bf16_t* WupT; const int* tokidx;
    __device__ __forceinline__ const char* a_base(const Unit&) const { return (const char*)HN; }
    __device__ __forceinline__ const char* b_base(const Unit& u) const { return (const char*)WupT + ((size_t)u.e * 2048 + (size_t)u.pn * BM) * 1024 * 2; }
    __device__ __forceinline__ void gather(const Unit& u, const int (&R)[2], const int (&C)[2], unsigned (&v)[2][2]) const {
        const int* tl = tokidx + (size_t)u.e * 65536 + u.rt * 256;
#pragma unroll
        for (int h = 0; h < 2; ++h)
#pragma unroll
            for (int i = 0; i < 2; ++i) { const int r = R[i] + 128 * h; const int idx = tl[r < u.nrows ? r : 0]; v[h][i] = (unsigned)(idx >> 2) * 2048u + (unsigned)C[i] * 2u; }
    }
};
struct DownOps {
    const bf16_t* ACT; const bf16_t* WdnT;
    __device__ __forceinline__ const char* a_base(const Unit& u) const { return (const char*)ACT + (size_t)u.pm * BM * 1024 * 2; }
    __device__ __forceinline__ const char* b_base(const Unit& u) const { return (const char*)WdnT + ((size_t)u.e * 1024 + (size_t)u.pn * BM) * 1024 * 2; }
    __device__ __forceinline__ void gather(const Unit&, const int (&)[2], const int (&)[2], unsigned (&)[2][2]) const {}
};

struct EpiProj {
    static constexpr bool PERM = true;
    bf16_t* O; int ldc;
    __device__ __forceinline__ void operator()(const f32x4 (&acc)[2][2][4][2], const Unit& u, int wr, int wc, int fr, int fq) const {
        const int row0 = u.pm * BM + wr * 64 + fr, col0 = u.pn * BM + wc * 32 + 8 * fq;
#pragma unroll
        for (int ai = 0; ai < 2; ++ai)
#pragma unroll
            for (int m = 0; m < 4; ++m) { bf16_t* rowp = O + (size_t)(row0 + ai * HALF + m * 16) * ldc + col0;
#pragma unroll
                for (int bj = 0; bj < 2; ++bj) { const f32x4 v0 = acc[ai][bj][m][0], v1 = acc[ai][bj][m][1];
                    u32x4 w; w.x = cvt_pk_bf16(v0[0], v0[1]); w.y = cvt_pk_bf16(v0[2], v0[3]); w.z = cvt_pk_bf16(v1[0], v1[1]); w.w = cvt_pk_bf16(v1[2], v1[3]);
                    *(u32x4*)(rowp + bj * HALF) = w; } }
    }
};
struct EpiRes {
    static constexpr bool PERM = false;
    const float* base; float* C; int ldc;
    __device__ __forceinline__ void operator()(const f32x4 (&acc)[2][2][4][2], const Unit& u, int wr, int wc, int fr, int fq) const {
        const int row0 = u.pm * BM + wr * 64 + fr, col0 = u.pn * BM + wc * 32 + 4 * fq;
#pragma unroll
        for (int ai = 0; ai < 2; ++ai)
#pragma unroll
            for (int m = 0; m < 4; ++m) { const size_t off = (size_t)(row0 + ai * HALF + m * 16) * ldc + col0;
#pragma unroll
                for (int bj = 0; bj < 2; ++bj)
#pragma unroll
                    for (int n = 0; n < 2; ++n) *(f32x4*)(C + off + bj * HALF + n * 16) = *(const f32x4*)(base + off + bj * HALF + n * 16) + acc[ai][bj][m][n]; }
    }
};
struct EpiUp {
    static constexpr bool PERM = true;
    bf16_t* ACT; const float* b_up;
    __device__ __forceinline__ void operator()(const f32x4 (&acc)[2][2][4][2], const Unit& u, int wr, int wc, int fr, int fq) const {
        const int row0 = u.pm * BM + wr * 64 + fr, j0 = wc * 32 + 8 * fq;
        const float* bg = b_up + (size_t)u.e * 2048 + u.pn * 128 + j0;
        f32x4 bgl[2], bln[2];
#pragma unroll
        for (int n = 0; n < 2; ++n) { bgl[n] = *(const f32x4*)(bg + 4 * n); bln[n] = *(const f32x4*)(bg + 1024 + 4 * n); }
#pragma unroll
        for (int ai = 0; ai < 2; ++ai)
#pragma unroll
            for (int m = 0; m < 4; ++m) { bf16_t* rowp = ACT + (size_t)(row0 + ai * HALF + m * 16) * 1024 + u.pn * 128 + j0;
                float o[8];
#pragma unroll
                for (int n = 0; n < 2; ++n) { const f32x4 g = acc[ai][0][m][n] + bgl[n], l = acc[ai][1][m][n] + bln[n];
#pragma unroll
                    for (int i = 0; i < 4; ++i) { const float gl = fminf(g[i], 7.0f), ln = fminf(fmaxf(l[i], -7.0f), 7.0f);
                        o[n * 4 + i] = gl * __builtin_amdgcn_rcpf(1.0f + __builtin_amdgcn_exp2f(-2.4554669595930157f * gl)) * (ln + 1.0f); } }
                u32x4 w; w.x = cvt_pk_bf16(o[0], o[1]); w.y = cvt_pk_bf16(o[2], o[3]); w.z = cvt_pk_bf16(o[4], o[5]); w.w = cvt_pk_bf16(o[6], o[7]);
                *(u32x4*)rowp = w; }
    }
};
struct EpiDown {
    static constexpr bool PERM = true;
    bf16_t* Y; const float* b_dn; const float* gate; const int* tokidx;
    __device__ __forceinline__ void operator()(const f32x4 (&acc)[2][2][4][2], const Unit& u, int wr, int wc, int fr, int fq) const {
        const int r0 = wr * 64 + fr, col0 = u.pn * BM + wc * 32 + 8 * fq;
        const int* tl = tokidx + (size_t)u.e * 65536 + u.rt * 256;
        const float* bb = b_dn + (size_t)u.e * 1024 + col0;
        f32x4 bv[2][2];
#pragma unroll
        for (int bj = 0; bj < 2; ++bj)
#pragma unroll
            for (int n = 0; n < 2; ++n) bv[bj][n] = *(const f32x4*)(bb + bj * HALF + 4 * n);
#pragma unroll
        for (int ai = 0; ai < 2; ++ai)
#pragma unroll
            for (int m = 0; m < 4; ++m) { const int r = r0 + ai * HALF + m * 16;
                if (r < u.nrows) { const int idx = tl[r]; const float gt = gate[idx]; bf16_t* rowp = Y + (size_t)idx * 1024 + col0;
#pragma unroll
                    for (int bj = 0; bj < 2; ++bj) { const f32x4 v0 = (acc[ai][bj][m][0] + bv[bj][0]) * gt, v1 = (acc[ai][bj][m][1] + bv[bj][1]) * gt;
                        u32x4 w; w.x = cvt_pk_bf16(v0[0], v0[1]); w.y = cvt_pk_bf16(v0[2], v0[3]); w.z = cvt_pk_bf16(v1[0], v1[1]); w.w = cvt_pk_bf16(v1[2], v1[3]);
                        *(u32x4*)(rowp + bj * HALF) = w; } } }
    }
};

template <class Epi, class Sched, class Ops, bool GATHER, bool ALIGN_EPI>
__device__ __forceinline__ void gemm_phase(PG8_LAS unsigned char* lds, const int K, const Sched& S, const Ops& O, const Epi& E) {
    const int tid = threadIdx.x, wid = __builtin_amdgcn_readfirstlane(tid >> 6), lane = tid & 63, wr = wid >> 2, wc = wid & 3, fr = lane & 15, fq = lane >> 4;
    const int nt = K / BK;
    unsigned voffA[2], voffB[2]; int sR[2], sC[2];
#pragma unroll
    for (int i = 0; i < 2; ++i) { int R, C; stage_rc(tid * 16 + i * 8192, R, C); const int Rb = Epi::PERM ? ((R & ~31) + perm32(R & 31)) : R; sR[i] = R; sC[i] = C;
        voffA[i] = (unsigned)(R * K + C) * 2u; voffB[i] = (unsigned)(Rb * K + C) * 2u; }
    const size_t kstep = (size_t)(BK * 2);
    const size_t hstep = (size_t)HALF * K * 2;
    const unsigned ldsw = (unsigned)wid * 1024u;
    const int aoff = lds_byte(wr * 64 + fr, fq * 8), boff = lds_byte(wc * 32 + fr, fq * 8);
#define PG8_SA(b, h) (((b) * 2 + (h)) * HTB)
#define PG8_SB(b, h) ((4 + (b) * 2 + (h)) * HTB)
#define PG8_STAGE(bufoff, gbase, voff) do { _Pragma("unroll") for (int _i = 0; _i < 2; ++_i) \
        __builtin_amdgcn_global_load_lds((const unsigned*)((const char*)(gbase) + (voff)[_i]), (PG8_LAS unsigned*)(lds + (bufoff) + ldsw + _i * 8192), 16, 0, 0); } while (0)
#define PG8_STAGE_AC(bufoff, kptr, h) do { if constexpr (GATHER) PG8_STAGE(bufoff, kptr, vC[h]); else PG8_STAGE(bufoff, (kptr) + (h) * hstep, voffA); } while (0)
#define PG8_STAGE_AS(bufoff, kptr, h) do { if constexpr (GATHER) PG8_STAGE(bufoff, kptr, vS[h]); else PG8_STAGE(bufoff, (kptr) + (h) * hstep, voffA); } while (0)
#define PG8_LDA(dst, b, h) do { _Pragma("unroll") for (int m = 0; m < 4; ++m) _Pragma("unroll") for (int k = 0; k < 2; ++k) dst[m][k] = *(const PG8_LAS bf16x8*)(lds + PG8_SA(b, h) + aoff + m * 2048 + k * 1024); } while (0)
#define PG8_LDB(dst, b, h) do { _Pragma("unroll") for (int n = 0; n < 2; ++n) _Pragma("unroll") for (int k = 0; k < 2; ++k) dst[n][k] = *(const PG8_LAS bf16x8*)(lds + PG8_SB(b, h) + boff + n * 2048 + k * 1024); } while (0)
#define PG8_MMA(ai, bj, At, Bt) do { __builtin_amdgcn_s_setprio(1); _Pragma("unroll") for (int m = 0; m < 4; ++m) _Pragma("unroll") for (int n = 0; n < 2; ++n) _Pragma("unroll") for (int k = 0; k < 2; ++k) \
        acc[ai][bj][m][n] = __builtin_amdgcn_mfma_f32_16x16x32_bf16(Bt[n][k], At[m][k], acc[ai][bj][m][n], 0, 0, 0); __builtin_amdgcn_s_setprio(0); } while (0)
#define PG8_WAIT_V(n) asm volatile("s_waitcnt vmcnt(" #n ")" ::: "memory")
#define PG8_WAIT_L(n) asm volatile("s_waitcnt lgkmcnt(" #n ")" ::: "memory")
#define PG8_BAR __builtin_amdgcn_s_barrier()
#define PG8_SCHED __builtin_amdgcn_sched_barrier(0)
    Unit cur, nxt; int ui = 0;
    if (!S.next(0, cur)) return;
    f32x4 acc[2][2][4][2];
#pragma unroll
    for (int a = 0; a < 2; ++a)
#pragma unroll
        for (int b = 0; b < 2; ++b)
#pragma unroll
            for (int m = 0; m < 4; ++m)
#pragma unroll
                for (int n = 0; n < 2; ++n) acc[a][b][m][n] = (f32x4){0.f, 0.f, 0.f, 0.f};
    bf16x8 At[4][2], B0[2][2], B1[2][2];
    unsigned vC[2][2] = {{0u, 0u}, {0u, 0u}}, vN[2][2] = {{0u, 0u}, {0u, 0u}}, vS[2][2] = {{0u, 0u}, {0u, 0u}};
    if constexpr (GATHER) O.gather(cur, sR, sC, vC);
    const char* cA = O.a_base(cur); const char* cB = O.b_base(cur);
    PG8_STAGE(PG8_SB(0, 0), cB, voffB); PG8_STAGE(PG8_SB(0, 1), cB + hstep, voffB); PG8_STAGE_AC(PG8_SA(0, 0), cA, 0); PG8_STAGE_AC(PG8_SA(0, 1), cA, 1);
    if (wr == 1) PG8_BAR;
    PG8_WAIT_V(2); PG8_BAR;
    PG8_STAGE(PG8_SB(1, 0), cB + kstep, voffB); PG8_STAGE_AC(PG8_SA(1, 0), cA + kstep, 0); PG8_STAGE(PG8_SB(1, 1), cB + hstep + kstep, voffB);
    PG8_WAIT_V(6); PG8_BAR;
    for (;;) {
        const bool has_next = S.next(ui + 1, nxt);
        const char* nA = has_next ? O.a_base(nxt) : cA; const char* nB = has_next ? O.b_base(nxt) : cB;
        if constexpr (GATHER) { if (has_next) O.gather(nxt, sR, sC, vN); else {
#pragma unroll
            for (int h = 0; h < 2; ++h)
#pragma unroll
                for (int i = 0; i < 2; ++i) vN[h][i] = vC[h][i]; } }
        for (int t = 0; t < nt; t += 2) {
            const bool last = (t == nt - 2);
            const char* a1 = cA + (size_t)(t + 1) * kstep;
            const char* a2 = last ? nA : cA + (size_t)(t + 2) * kstep; const char* b2 = last ? nB : cB + (size_t)(t + 2) * kstep;
            const char* a3 = a2 + kstep; const char* b3 = b2 + kstep;
            if constexpr (GATHER) {
#pragma unroll
                for (int h = 0; h < 2; ++h)
#pragma unroll
                    for (int i = 0; i < 2; ++i) vS[h][i] = last ? vN[h][i] : vC[h][i]; }
            PG8_LDB(B0, 0, 0); PG8_LDB(B1, 0, 1); PG8_SCHED; PG8_LDA(At, 0, 0); PG8_STAGE_AC(PG8_SA(1, 1), a1, 1);
            PG8_WAIT_V(8); PG8_WAIT_L(0); PG8_BAR; PG8_MMA(0, 0, At, B0); PG8_MMA(0, 1, At, B1); PG8_BAR; PG8_SCHED;
            PG8_LDA(At, 0, 1); PG8_STAGE(PG8_SB(0, 0), b2, voffB); PG8_STAGE(PG8_SB(0, 1), b2 + hstep, voffB); PG8_STAGE_AS(PG8_SA(0, 0), a2, 0);
            PG8_WAIT_V(8); PG8_WAIT_L(0); PG8_BAR; PG8_MMA(1, 0, At, B0); PG8_MMA(1, 1, At, B1); PG8_BAR; PG8_SCHED;
            PG8_LDB(B0, 1, 0); PG8_LDB(B1, 1, 1); PG8_SCHED; PG8_LDA(At, 1, 0); PG8_STAGE_AS(PG8_SA(0, 1), a2, 1);
            PG8_WAIT_V(8); PG8_WAIT_L(0); PG8_BAR; PG8_MMA(0, 0, At, B0); PG8_MMA(0, 1, At, B1); PG8_BAR; PG8_SCHED;
            PG8_LDA(At, 1, 1); PG8_STAGE(PG8_SB(1, 0), b3, voffB); PG8_STAGE(PG8_SB(1, 1), b3 + hstep, voffB); PG8_STAGE_AS(PG8_SA(1, 0), a3, 0);
            PG8_WAIT_V(8); PG8_WAIT_L(0); PG8_BAR; PG8_MMA(1, 0, At, B0); PG8_MMA(1, 1, At, B1); PG8_BAR; PG8_SCHED;
        }
        if constexpr (ALIGN_EPI) { if (wr == 0) PG8_BAR; }
        E(acc, cur, wr, wc, fr, fq);
        if (!has_next) break;
#pragma unroll
        for (int a = 0; a < 2; ++a)
#pragma unroll
            for (int b = 0; b < 2; ++b)
#pragma unroll
                for (int m = 0; m < 4; ++m)
#pragma unroll
                    for (int n = 0; n < 2; ++n) acc[a][b][m][n] = (f32x4){0.f, 0.f, 0.f, 0.f};
        cur = nxt; cA = nA; cB = nB; ++ui;
        if constexpr (GATHER) {
#pragma unroll
            for (int h = 0; h < 2; ++h)
#pragma unroll
                for (int i = 0; i < 2; ++i) vC[h][i] = vN[h][i]; }
        if constexpr (ALIGN_EPI) { if (wr == 1) PG8_BAR; }
    }
    PG8_WAIT_V(0);
    if constexpr (!ALIGN_EPI) { if (wr == 0) PG8_BAR; }
    PG8_BAR;
#undef PG8_SA
#undef PG8_SB
#undef PG8_STAGE
#undef PG8_STAGE_AC
#undef PG8_STAGE_AS
#undef PG8_LDA
#undef PG8_LDB
#undef PG8_MMA
#undef PG8_WAIT_V
#undef PG8_WAIT_L
#undef PG8_BAR
#undef PG8_SCHED
}
}
#define GAS __attribute__((address_space(1)))
#define LAS __attribute__((address_space(3)))
typedef unsigned short bf16;
typedef short bf16x8 __attribute__((ext_vector_type(8)));
typedef short s16x4 __attribute__((ext_vector_type(4)));
typedef float f32x4 __attribute__((ext_vector_type(4)));
typedef unsigned u32x4 __attribute__((ext_vector_type(4)));
typedef unsigned u32x2 __attribute__((ext_vector_type(2)));
typedef LAS unsigned char* lptr;

constexpr int NWAVES = 8, NTHR = 512;
constexpr size_t MiB = 1u << 20;
constexpr size_t WS_CTL = 0, CTL_ZERO_BYTES = 64 * 1024;
constexpr size_t WS_SMALL = 1 * MiB;
constexpr size_t WS_GATES = 2 * MiB;
constexpr size_t WS_RSG = 2 * MiB + 512 * 1024;
constexpr size_t WS_GATE = 3 * MiB;
constexpr size_t WS_TOKIDX = 4 * MiB;
constexpr size_t WS_WRT = 12 * MiB;
constexpr size_t WS_WINT = 16 * MiB, WS_WOUTT = 22 * MiB, WS_WDNT = 24 * MiB, WS_WUPT = 88 * MiB;
constexpr size_t WS_XN = 216 * MiB;
constexpr size_t WS_PROJ = 248 * MiB;
constexpr size_t WS_CLOC = 344 * MiB;
constexpr size_t WS_CPREV = 376 * MiB;
constexpr size_t WS_MIX = 392 * MiB;
constexpr size_t WS_H = 424 * MiB;
constexpr size_t WS_ACT = 488 * MiB;
constexpr size_t WS_Y = 632 * MiB;
constexpr size_t WS_OPT_END = 760 * MiB;
constexpr int CW_CNT = 64;
constexpr int CW_BAR = 4096;
constexpr int PROJ_LD = 3072;
constexpr int QO = 0, KO = 512, VO = 1024, OO = 1536, UO = 2048, VGO = 2560;
constexpr int RING_BYTES = 131072, VEC_OFF = 131072, VEC_BYTES = 16384, CTL_OFF = VEC_OFF + VEC_BYTES, TTAB_OFF = CTL_OFF, MISC_OFF = CTL_OFF + 2048, LDS_BYTES = MISC_OFF + 256;
constexpr int T0 = 0, T1 = 32768, T2 = 65536, T3 = 98304;

#define RLX_AGENT __ATOMIC_RELAXED, __HIP_MEMORY_SCOPE_AGENT
#define XB_TMO      128
#define XB_XCNT(j)  (256  + 64 * (j))
#define XB_XSUB(j)  (1280 + 64 * (j))
#define XB_XGEN(j)  (2304 + 64 * (j))
#define XB_TOP      3328
#define XB_TOPGEN   3392
#define XCD_BAR_WORDS 3456
#define XB_SPIN_CAP (1u << 18)
__device__ __forceinline__ unsigned xb_ld(unsigned* p)              { return __hip_atomic_load(p, __ATOMIC_RELAXED, __HIP_MEMORY_SCOPE_AGENT); }
__device__ __forceinline__ unsigned xb_add(unsigned* p, unsigned v) { return __hip_atomic_fetch_add(p, v, __ATOMIC_RELAXED, __HIP_MEMORY_SCOPE_AGENT); }
__device__ __forceinline__ unsigned xb_xcc_id() { return (unsigned)__builtin_amdgcn_s_getreg((3 << 11) | 20) & 0xFu; }
#define XB_SPIN(cond, bar) do { unsigned _sp = 0; while (cond) { __builtin_amdgcn_s_sleep(1); \
    if ((++_sp & 255u) == 0u) { if (xb_ld(&(bar)[XB_TMO])) break; if (_sp > XB_SPIN_CAP) { atomicAdd(&(bar)[XB_TMO], 1u); break; } } } } while (0)
struct XcdBarrier { unsigned* bar; unsigned x; volatile LAS unsigned* st; };
__device__ __forceinline__ XcdBarrier xcd_barrier_post(unsigned* bar, volatile LAS unsigned* st) {
    XcdBarrier b; b.bar = bar; b.x = xb_xcc_id(); b.st = st;
    if (threadIdx.x == 0) (void)xb_add(&bar[XB_XCNT(b.x)], 1u);
    return b;
}
__device__ __forceinline__ void xcd_barrier_complete(unsigned* bar, unsigned x, unsigned& nloc, unsigned& nx) {
    const unsigned G = gridDim.x * gridDim.y * gridDim.z;
    unsigned sum, cnt, mine, sp = 0u;
    for (;;) {
        sum = 0u; cnt = 0u; mine = 0u;
#pragma unroll
        for (unsigned j = 0; j < 16; ++j) { const unsigned c = xb_ld(&bar[XB_XCNT(j)]); sum += c; cnt += (c > 0u) ? 1u : 0u; mine = (j == x) ? c : mine; }
        if (sum == G) break;
        __builtin_amdgcn_s_sleep(1);
        if ((++sp & 255u) == 0u) { if (xb_ld(&bar[XB_TMO])) break; if (sp > XB_SPIN_CAP) { atomicAdd(&bar[XB_TMO], 1u); break; } }
    }
    nloc = mine > 0u ? mine : 1u; nx = cnt > 0u ? cnt : 1u;
}
__device__ __forceinline__ void xcd_barrier(const XcdBarrier& b) {
    asm volatile("s_waitcnt vmcnt(0)" ::: "memory");
    __syncthreads();
    if (threadIdx.x == 0) {
        unsigned* bar = b.bar;
        __builtin_amdgcn_s_waitcnt(0);
        unsigned nloc = b.st[0], nx = b.st[1];
        if (nloc == 0u) { xcd_barrier_complete(bar, b.x, nloc, nx); b.st[0] = nloc; b.st[1] = nx; }
        const unsigned old = xb_add(&bar[XB_XSUB(b.x)], 1u);
        const unsigned gen = old / nloc;
        if (old + 1u == (gen + 1u) * nloc) {
            __builtin_amdgcn_fence(__ATOMIC_RELEASE, "agent");
            asm volatile("s_waitcnt vmcnt(0)" ::: "memory");
            const unsigned og = xb_add(&bar[XB_TOP], 1u);
            const unsigned tg = og / nx;
            if (og + 1u == (tg + 1u) * nx) xb_add(&bar[XB_TOPGEN], 1u);
            else XB_SPIN(xb_ld(&bar[XB_TOPGEN]) == tg, bar);
            __builtin_amdgcn_fence(__ATOMIC_ACQUIRE, "agent");
            xb_add(&bar[XB_XGEN(b.x)], 1u);
            asm volatile("s_waitcnt vmcnt(0)" ::: "memory");
        } else {
            XB_SPIN(xb_ld(&bar[XB_XGEN(b.x)]) == gen, bar);
            __builtin_amdgcn_fence(__ATOMIC_ACQUIRE, "agent");
            asm volatile("s_waitcnt vmcnt(0)" ::: "memory");
        }
    }
    __syncthreads();
}

__device__ __forceinline__ float bf2f(unsigned short h) { return __builtin_bit_cast(float, (unsigned)h << 16); }
__device__ __forceinline__ unsigned f2bf(float f) { unsigned u = __builtin_bit_cast(unsigned, f); return (u + 0x7fffu + ((u >> 16) & 1u)) >> 16; }
__device__ __forceinline__ unsigned pk2(float lo, float hi) { return pg8::cvt_pk_bf16(lo, hi); }
__device__ __forceinline__ float fexp(float x) { return __builtin_amdgcn_exp2f(x * 1.4426950408889634f); }
__device__ __forceinline__ float fsigmoid(float x) { return __builtin_amdgcn_rcpf(1.0f + fexp(-x)); }
__device__ __forceinline__ float fgelu(float x) {
    const float u = 1.5957691216057308f * (x + 0.044715f * x * x * x);
    return x * fsigmoid(u);
}
__device__ __forceinline__ float wsum_all(float v) {
#pragma unroll
    for (int o = 32; o > 0; o >>= 1) v += __shfl_xor(v, o);
    return v;
}
__device__ __forceinline__ void unpack8(const u32x4 w, float (&f)[8]) {
    f[0] = __builtin_bit_cast(float, w.x << 16); f[1] = __builtin_bit_cast(float, w.x & 0xffff0000u);
    f[2] = __builtin_bit_cast(float, w.y << 16); f[3] = __builtin_bit_cast(float, w.y & 0xffff0000u);
    f[4] = __builtin_bit_cast(float, w.z << 16); f[5] = __builtin_bit_cast(float, w.z & 0xffff0000u);
    f[6] = __builtin_bit_cast(float, w.w << 16); f[7] = __builtin_bit_cast(float, w.w & 0xffff0000u);
}
__device__ __forceinline__ u32x4 pack8(const float (&f)[8]) { u32x4 w; w.x = pk2(f[0], f[1]); w.y = pk2(f[2], f[3]); w.z = pk2(f[4], f[5]); w.w = pk2(f[6], f[7]); return w; }

__device__ __forceinline__ unsigned off_b(unsigned row, unsigned ch) { return 256u * row + 16u * (ch ^ (((row & 3u) << 2) | ((row >> 2) & 3u))); }
__device__ __forceinline__ bf16x8 frag_row(lptr T, int r0, int ks, int lane) { return *(const LAS bf16x8*)(T + off_b((unsigned)(r0 + (lane & 15)), (unsigned)(4 * ks + (lane >> 4)))); }
__device__ __forceinline__ bf16x8 frag_tr(lptr T, int c, int ks, int lane) {
    const unsigned g = lane >> 4, q = (lane & 15) >> 2, p = lane & 3;
    const unsigned a0 = off_b(32u * ks + 8u * g + q, 2u * c + (p >> 1)) + 8u * (p & 1);
    const unsigned a1 = off_b(32u * ks + 8u * g + 4u + q, 2u * c + (p >> 1)) + 8u * (p & 1);
    const s16x4 lo = __builtin_amdgcn_ds_read_tr16_b64_v4i16((LAS s16x4*)(T + a0));
    const s16x4 hi = __builtin_amdgcn_ds_read_tr16_b64_v4i16((LAS s16x4*)(T + a1));
    return __builtin_shufflevector(lo, hi, 0, 1, 2, 3, 4, 5, 6, 7);
}
#define MFMA16(a, b, c) __builtin_amdgcn_mfma_f32_16x16x32_bf16(a, b, c, 0, 0, 0)

struct Frame {
    lptr lds; int tid, lane, wave, G, vcu;
    const float* in[20]; float* out; unsigned char* ws;
};

template <bool SCALE>
__device__ __forceinline__ void stage_tile(const Frame& F, lptr T, const bf16* src, int ld, const LAS float* rowscale) {
#pragma unroll
    for (int j = 0; j < 4; ++j) { const int it = F.tid + NTHR * j, s = it >> 4, cg = it & 15;
        u32x4 w = *(const u32x4*)(src + (size_t)s * ld + 8 * cg);
        if (SCALE) { float f[8]; unpack8(w, f); const float sc = rowscale[s];
#pragma unroll
            for (int i = 0; i < 8; ++i) f[i] *= sc;
            w = pack8(f); }
        *(LAS u32x4*)(T + off_b(s, cg)) = w; }
}
__device__ __forceinline__ void stage_conv(const Frame& F, lptr T, const bf16* src, const LAS float* cw, int tpos, float scale) {
#pragma unroll
    for (int j = 0; j < 4; ++j) { const int it = F.tid + NTHR * j, s = it >> 4, cg = it & 15;
        float a[8];
#pragma unroll
        for (int i = 0; i < 8; ++i) a[i] = 0.f;
#pragma unroll
        for (int tp = 0; tp < 4; ++tp) { if (tpos + s - 3 + tp >= 0) { const u32x4 w = *(const u32x4*)(src + (ptrdiff_t)(s - 3 + tp) * PROJ_LD + 8 * cg); float f[8]; unpack8(w, f);
#pragma unroll
                for (int i = 0; i < 8; ++i) a[i] += cw[tp * 128 + 8 * cg + i] * f[i]; } }
#pragma unroll
        for (int i = 0; i < 8; ++i) a[i] = a[i] * fsigmoid(a[i]) * scale;
        *(LAS u32x4*)(T + off_b(s, cg)) = pack8(a); }
}
__device__ __forceinline__ void p0_item(const float* Wsrc, int ld, bf16* dst, int Kd, LAS float* scr, int lane) {
#pragma unroll 8
    for (int i = 0; i < 32; ++i) { const int kk = 2 * i + (lane >> 5); scr[kk * 33 + (lane & 31)] = Wsrc[(size_t)kk * ld + (lane & 31)]; }
    asm volatile("s_waitcnt lgkmcnt(0)" ::: "memory");
    const int c = lane & 7;
#pragma unroll
    for (int j = 0; j < 4; ++j) { const int n = (lane >> 3) + 8 * j; const LAS float* s = scr + (8 * c) * 33 + n;
        u32x4 o; o.x = pk2(s[0 * 33], s[1 * 33]); o.y = pk2(s[2 * 33], s[3 * 33]); o.z = pk2(s[4 * 33], s[5 * 33]); o.w = pk2(s[6 * 33], s[7 * 33]);
        *(u32x4*)(dst + (size_t)n * Kd + 8 * c) = o; }
    asm volatile("s_waitcnt lgkmcnt(0)" ::: "memory");
}
__device__ __forceinline__ void p0_item_split(const float* Wsrc, int ld, bf16* dhi, bf16* dlo, int Kd, LAS float* scr, int lane) {
#pragma unroll 8
    for (int i = 0; i < 32; ++i) { const int kk = 2 * i + (lane >> 5); scr[kk * 33 + (lane & 31)] = Wsrc[(size_t)kk * ld + (lane & 31)]; }
    asm volatile("s_waitcnt lgkmcnt(0)" ::: "memory");
    const int c = lane & 7;
#pragma unroll
    for (int j = 0; j < 4; ++j) { const int n = (lane >> 3) + 8 * j; const LAS float* s = scr + (8 * c) * 33 + n;
        float v[8], l[8];
#pragma unroll
        for (int i = 0; i < 8; ++i) { v[i] = s[i * 33]; l[i] = v[i] - bf2f((unsigned short)f2bf(v[i])); }
        *(u32x4*)(dhi + (size_t)n * Kd + 8 * c) = pack8(v); *(u32x4*)(dlo + (size_t)n * Kd + 8 * c) = pack8(l); }
    asm volatile("s_waitcnt lgkmcnt(0)" ::: "memory");
}

constexpr int IMG_ROW = 2064;
template <int NF>
__device__ __forceinline__ void row_pass(const float* X, const float* gain, bf16* XNout, lptr img_hi, lptr img_lo, int tok0, int lane, f32x4 (&acc)[NF]) {
    const int r = lane & 7, g = lane >> 4;
    const float* xr = X + (size_t)(tok0 + r) * 1024 + 8 * g;
    float ss = 0.f;
#pragma unroll 8
    for (int ks = 0; ks < 32; ++ks) { const f32x4 a = *(const f32x4*)(xr + 32 * ks), b = *(const f32x4*)(xr + 32 * ks + 4);
        ss += (a[0] * a[0] + a[1] * a[1]) + (a[2] * a[2] + a[3] * a[3]) + (b[0] * b[0] + b[1] * b[1]) + (b[2] * b[2] + b[3] * b[3]); }
    ss += __shfl_xor(ss, 16); ss += __shfl_xor(ss, 32);
    const float rstd = 1.0f / sqrtf(ss * (1.0f / 1024.0f) + 1e-6f);
#pragma unroll
    for (int nf = 0; nf < NF; ++nf) acc[nf] = (f32x4){0.f, 0.f, 0.f, 0.f};
    bf16* orow = XNout + (size_t)(tok0 + r) * 1024 + 8 * g;
#pragma unroll 4
    for (int ks = 0; ks < 32; ++ks) { const f32x4 a = *(const f32x4*)(xr + 32 * ks), b = *(const f32x4*)(xr + 32 * ks + 4);
        const f32x4 ga = *(const f32x4*)(gain + 32 * ks + 8 * g), gb = *(const f32x4*)(gain + 32 * ks + 8 * g + 4);
        float v[8], l[8];
#pragma unroll
        for (int i = 0; i < 4; ++i) { v[i] = a[i] * rstd * ga[i]; v[4 + i] = b[i] * rstd * gb[i]; }
        const u32x4 hi = pack8(v);
        { float h[8]; unpack8(hi, h);
#pragma unroll
          for (int i = 0; i < 8; ++i) l[i] = v[i] - h[i]; }
        const u32x4 lo = pack8(l);
        if ((lane & 8) == 0) *(u32x4*)(orow + 32 * ks) = hi;
        const bf16x8 ahi = __builtin_bit_cast(bf16x8, hi), alo = __builtin_bit_cast(bf16x8, lo);
#pragma unroll
        for (int nf = 0; nf < NF; ++nf) { const unsigned bo = (unsigned)(16 * nf + (lane & 15)) * IMG_ROW + 64u * ks + 16u * g;
            const bf16x8 bhi = *(const LAS bf16x8*)(img_hi + bo), blo = *(const LAS bf16x8*)(img_lo + bo);
            acc[nf] = MFMA16(ahi, bhi, acc[nf]); acc[nf] = MFMA16(ahi, blo, acc[nf]); acc[nf] = MFMA16(alo, bhi, acc[nf]); } }
}

__device__ __forceinline__ void phase0(const Frame& F) {
    const float* x = F.in[0]; const float* g1 = F.in[1]; const float* w_in = F.in[2]; const float* b_i = F.in[4]; const float* b_f = F.in[5];
    const float* w_out = F.in[11]; const float* wr = F.in[13]; const float* w_up = F.in[15]; const float* w_dn = F.in[17];
    bf16* WinT = (bf16*)(F.ws + WS_WINT); bf16* WoutT = (bf16*)(F.ws + WS_WOUTT); bf16* WdnT = (bf16*)(F.ws + WS_WDNT); bf16* WupT = (bf16*)(F.ws + WS_WUPT);
    bf16* WrThi = (bf16*)(F.ws + WS_WRT); bf16* WrTlo = WrThi + 32 * 1024;
    bf16* XN = (bf16*)(F.ws + WS_XN); float* GATES = (float*)(F.ws + WS_GATES);
    lptr ghi = F.lds + T0, glo = F.lds + T0 + 16 * IMG_ROW;
    for (int i = F.tid; i < 16 * 1024; i += NTHR) { const int j = i & 15, k = i >> 4;
        const float v = j < 8 ? w_in[(size_t)k * 3080 + 2048 + j] : 0.f; const unsigned h = f2bf(v); const float l = v - bf2f((unsigned short)h);
        *(LAS unsigned short*)(ghi + j * IMG_ROW + 2 * k) = (unsigned short)h; *(LAS unsigned short*)(glo + j * IMG_ROW + 2 * k) = (unsigned short)f2bf(l); }
    __syncthreads();
    { const int tok0 = F.vcu * 64 + F.wave * 8; f32x4 acc[1];
      row_pass<1>(x, g1, XN, ghi, glo, tok0, F.lane, acc);
      const int j = F.lane & 15, gq = F.lane >> 4;
      if (j < 8 && gq < 2) {
#pragma unroll
          for (int rg = 0; rg < 4; ++rg) { const int tok = tok0 + 4 * gq + rg; float v = acc[0][rg];
              if (j < 4) v += b_i[j]; else { v += b_f[j - 4]; v = fminf(v, 0.f) - log1pf(expf(-fabsf(v))); }
              GATES[(size_t)tok * 8 + j] = v; } } }
    __syncthreads();
    LAS float* scr = (LAS float*)(F.lds + T0 + F.wave * 16384);
    const int gw = F.vcu * NWAVES + F.wave, NGW = F.G * NWAVES;
    constexpr int I_IN = 16 * 96, I_OUT = 16 * 32, I_R = 16, I_DN = 32 * 16 * 32, I_UP = 32 * 16 * 64, NITEMS = I_IN + I_OUT + I_R + I_DN + I_UP;
    for (int it = gw; it < NITEMS; it += NGW) {
        int r = it;
        if (r < I_IN) { const int kb = r / 96, nb = r % 96, nd = 32 * nb, nsrc = nd < 2048 ? nd : nd + 8;
            p0_item(w_in + (size_t)(64 * kb) * 3080 + nsrc, 3080, WinT + (size_t)nd * 1024 + 64 * kb, 1024, scr, F.lane); continue; } r -= I_IN;
        if (r < I_OUT) { const int kb = r / 32, nb = r % 32;
            p0_item(w_out + (size_t)(64 * kb) * 1024 + 32 * nb, 1024, WoutT + (size_t)(32 * nb) * 1024 + 64 * kb, 1024, scr, F.lane); continue; } r -= I_OUT;
        if (r < I_R) { p0_item_split(wr + (size_t)(64 * r) * 32, 32, WrThi + 64 * r, WrTlo + 64 * r, 1024, scr, F.lane); continue; } r -= I_R;
        if (r < I_DN) { const int e = r / 512, q = r % 512, kb = q / 32, nb = q % 32;
            p0_item(w_dn + ((size_t)e * 1024 + 64 * kb) * 1024 + 32 * nb, 1024, WdnT + ((size_t)e * 1024 + 32 * nb) * 1024 + 64 * kb, 1024, scr, F.lane); continue; } r -= I_DN;
        { const int e = r / 1024, q = r % 1024, kb = q / 64, nb = q % 64, n = 32 * nb, half = n >> 10, jj = n & 1023, pn = jj >> 7, j = jj & 127, nd = 256 * pn + 128 * half + j;
          p0_item(w_up + ((size_t)e * 1024 + 64 * kb) * 2048 + n, 2048, WupT + ((size_t)e * 2048 + nd) * 1024 + 64 * kb, 1024, scr, F.lane); }
    }
}

__device__ __forceinline__ float wscan_add(float v, int lane) {
#pragma unroll
    for (int o = 1; o < 64; o <<= 1) { const float t = __shfl_up(v, o); if (lane >= o) v += t; }
    return v;
}
__device__ __forceinline__ float wscan_max(float v, int lane) {
#pragma unroll
    for (int o = 1; o < 64; o <<= 1) { const float t = __shfl_up(v, o); if (lane >= o) v = fmaxf(v, t); }
    return v;
}
__device__ __forceinline__ float wmax_all(float v) {
#pragma unroll
    for (int o = 32; o > 0; o >>= 1) v = fmaxf(v, __shfl_xor(v, o));
    return v;
}

__device__ __forceinline__ void mlstm_local_unit(const Frame& F, int u) {
    const int c = u & 63, h = (u >> 6) & 3, b = u >> 8, row0 = b * 8192 + c * 128;
    const bf16* PROJ = (const bf16*)(F.ws + WS_PROJ); const float* GATES = (const float*)(F.ws + WS_GATES); const float* conv = F.in[3];
    float* CLOC = (float*)(F.ws + WS_CLOC); float* MLOC = (float*)(F.ws + WS_SMALL); float* BLAST = MLOC + 512; float* NLOC = MLOC + 2048;
    LAS float* wv = (LAS float*)(F.lds + VEC_OFF);
    LAS float* cw = wv + 128;
    for (int i = F.tid; i < 512; i += NTHR) cw[i] = conv[(i >> 7) * 1024 + 512 + h * 128 + (i & 127)];
    if (F.wave == 0) { const int l = F.lane, s0 = 2 * l, s1 = s0 + 1;
        const float li0 = GATES[(size_t)(row0 + s0) * 8 + h], li1 = GATES[(size_t)(row0 + s1) * 8 + h], lf0 = GATES[(size_t)(row0 + s0) * 8 + 4 + h], lf1 = GATES[(size_t)(row0 + s1) * 8 + 4 + h];
        const float inc = wscan_add(lf0 + lf1, l), b1 = inc, b0 = inc - lf1, blast = __shfl(inc, 63);
        const float g0 = blast - b0 + li0, g1 = blast - b1 + li1, mloc = wmax_all(fmaxf(g0, g1));
        wv[s0] = fexp(g0 - mloc); wv[s1] = fexp(g1 - mloc);
        if (l == 0) { MLOC[u] = mloc; BLAST[u] = blast; } }
    __syncthreads();
    stage_conv(F, F.lds + T1, PROJ + (size_t)row0 * PROJ_LD + KO + h * 128, cw, c * 128, 0.08838834764831845f);
    stage_tile<true>(F, F.lds + T2, PROJ + (size_t)row0 * PROJ_LD + VO + h * 128, PROJ_LD, wv);
    __syncthreads();
    { const int w = F.wave, lane = F.lane; f32x4 acc[8];
#pragma unroll
      for (int kb = 0; kb < 8; ++kb) acc[kb] = (f32x4){0.f, 0.f, 0.f, 0.f};
#pragma unroll
      for (int ks = 0; ks < 4; ++ks) { const bf16x8 a = frag_tr(F.lds + T2, w, ks, lane);
#pragma unroll
          for (int kb = 0; kb < 8; ++kb) { const bf16x8 bb = frag_tr(F.lds + T1, kb, ks, lane); acc[kb] = MFMA16(a, bb, acc[kb]); } }
      float* cl = CLOC + (size_t)u * 16384 + (size_t)(16 * w + 4 * (lane >> 4)) * 128 + (lane & 15);
#pragma unroll
      for (int kb = 0; kb < 8; ++kb)
#pragma unroll
          for (int rg = 0; rg < 4; ++rg) cl[rg * 128 + 16 * kb] = acc[kb][rg]; }
    if (F.tid < 128) { const int k = F.tid; float a = 0.f;
        for (int s = 0; s < 128; ++s) a += wv[s] * bf2f(*(const LAS unsigned short*)(F.lds + T1 + off_b(s, k >> 3) + 2 * (k & 7)));
        NLOC[(size_t)u * 128 + k] = a; }
    __syncthreads();
}

__device__ __forceinline__ void gmlp_unit(const Frame& F, int uc) {
    const int row0 = uc * 128;
    const bf16* PROJ = (const bf16*)(F.ws + WS_PROJ); bf16* MIX = (bf16*)(F.ws + WS_MIX);
    const float* lng = F.in[7]; const float* wsp = F.in[8]; const float* bsp = F.in[9]; const float* og = F.in[10]; float* RSG = (float*)(F.ws + WS_RSG);
    LAS float* st_mean = (LAS float*)(F.lds + VEC_OFF); LAS float* st_rstd = st_mean + 128;
    const int w = F.wave, lane = F.lane;
    for (int i = 0; i < 16; ++i) { const int t = 16 * w + i; float f[8];
        unpack8(*(const u32x4*)(PROJ + (size_t)(row0 + t) * PROJ_LD + VGO + 8 * lane), f);
        float s = 0.f;
#pragma unroll
        for (int k = 0; k < 8; ++k) { f[k] = fgelu(f[k]); s += f[k]; }
        const float mean = wsum_all(s) * (1.0f / 512.0f); float q = 0.f;
#pragma unroll
        for (int k = 0; k < 8; ++k) { const float d = f[k] - mean; q += d * d; }
        const float rstd = 1.0f / sqrtf(wsum_all(q) * (1.0f / 512.0f) + 1e-6f);
        if (lane == 0) { st_mean[t] = mean; st_rstd[t] = rstd; } }
    __syncthreads();
    float ssq[4] = {0.f, 0.f, 0.f, 0.f};
#pragma unroll 1
    for (int g = 0; g < 4; ++g) {
#pragma unroll 2
        for (int j = 0; j < 4; ++j) { const int it = F.tid + NTHR * j, t = it >> 4, cg = it & 15;
            { const float* wp = wsp + ((size_t)(g * 128 + t)) * 128 + 8 * cg; const f32x4 a = *(const f32x4*)wp, bq = *(const f32x4*)(wp + 4);
              float f[8] = {a[0], a[1], a[2], a[3], bq[0], bq[1], bq[2], bq[3]};
#pragma unroll
              for (int k = 0; k < 8; ++k) if (8 * cg + k > t) f[k] = 0.f;
              *(LAS u32x4*)(F.lds + T0 + off_b(t, cg)) = pack8(f); }
            { float v[8]; unpack8(*(const u32x4*)(PROJ + (size_t)(row0 + t) * PROJ_LD + VGO + g * 128 + 8 * cg), v);
              const float mean = st_mean[t], rstd = st_rstd[t]; const f32x4 l0 = *(const f32x4*)(lng + g * 128 + 8 * cg), l1 = *(const f32x4*)(lng + g * 128 + 8 * cg + 4);
#pragma unroll
              for (int k = 0; k < 8; ++k) v[k] = (fgelu(v[k]) - mean) * rstd * (k < 4 ? l0[k] : l1[k - 4]);
              *(LAS u32x4*)(F.lds + T1 + off_b(t, cg)) = pack8(v); }
            { float uu[8]; unpack8(*(const u32x4*)(PROJ + (size_t)(row0 + t) * PROJ_LD + UO + g * 128 + 8 * cg), uu);
#pragma unroll
              for (int k = 0; k < 8; ++k) uu[k] = fgelu(uu[k]);
              *(LAS u32x4*)(F.lds + T2 + off_b(t, cg)) = pack8(uu); } }
        __syncthreads();
        f32x4 acc[8];
#pragma unroll
        for (int db = 0; db < 8; ++db) acc[db] = (f32x4){0.f, 0.f, 0.f, 0.f};
        for (int ks = 0; ks <= (w >> 1); ++ks) { const bf16x8 a = frag_row(F.lds + T0, 16 * w, ks, lane);
#pragma unroll
            for (int db = 0; db < 8; ++db) { const bf16x8 bb = frag_tr(F.lds + T1, db, ks, lane); acc[db] = MFMA16(a, bb, acc[db]); } }
#pragma unroll
        for (int rg = 0; rg < 4; ++rg) { const int t = 16 * w + 4 * (lane >> 4) + rg; const float bs = bsp[g * 128 + t];
#pragma unroll
            for (int db = 0; db < 8; ++db) { const int d = 16 * db + (lane & 15);
                const float gu = bf2f(*(const LAS unsigned short*)(F.lds + T2 + off_b(t, d >> 3) + 2 * (d & 7)));
                const float val = (acc[db][rg] + bs) * gu; ssq[rg] += val * val;
                *(LAS unsigned short*)(F.lds + T3 + off_b(t, d >> 3) + 2 * (d & 7)) = (unsigned short)(pk2(val * og[g * 128 + d], 0.f) & 0xffffu); } }
#pragma unroll
        for (int i = 0; i < 4; ++i) { const int id = lane + 64 * i, r = id >> 4, ch = id & 15, t = 16 * w + r;
            *(u32x4*)(MIX + (size_t)(row0 + t) * 1024 + 512 + g * 128 + 8 * ch) = *(const LAS u32x4*)(F.lds + T3 + off_b(t, ch)); }
        __syncthreads();
    }
#pragma unroll
    for (int rg = 0; rg < 4; ++rg) { float q = ssq[rg]; q += __shfl_xor(q, 1); q += __shfl_xor(q, 2); q += __shfl_xor(q, 4); q += __shfl_xor(q, 8);
        if ((lane & 15) == 0) RSG[row0 + 16 * w + 4 * (lane >> 4) + rg] = 1.0f / sqrtf(q * (1.0f / 512.0f) + 1e-6f); }
}

__device__ __forceinline__ void phase_scan(const Frame& F) {
    const float* CLOC = (const float*)(F.ws + WS_CLOC); float* MLOC = (float*)(F.ws + WS_SMALL); float* BLAST = MLOC + 512; float* MPREV = MLOC + 1024;
    float* NLOC = MLOC + 2048; float* NPREV = NLOC + 512 * 128; bf16* CPREV = (bf16*)(F.ws + WS_CPREV);
    LAS float* av = (LAS float*)(F.lds + VEC_OFF); LAS float* cv = av + 64;
    const int wg = F.vcu, bh = wg >> 5;
    if (F.wave == 0) { const int l = F.lane; const float ml = MLOC[bh * 64 + l], bl = BLAST[bh * 64 + l];
        float m = 0.f, mym = 0.f, mynext = 0.f;
        for (int c = 0; c < 64; ++c) { const float mlc = __shfl(ml, c), blc = __shfl(bl, c); const float mn = fmaxf(blc + m, mlc); if (l == c) { mym = m; mynext = mn; } m = mn; }
        av[l] = fexp(bl + mym - mynext); cv[l] = fexp(ml - mynext);
        if ((wg & 31) == 0) MPREV[bh * 64 + l] = mym; }
    __syncthreads();
    if (F.tid < 256) { const int p = (wg & 31) * 256 + F.tid; float v0 = 0.f, v1 = 0.f;
        const float* src = CLOC + (size_t)(bh * 64) * 16384 + 2 * p; bf16* dst = CPREV + (size_t)(bh * 64) * 16384 + 2 * p;
#pragma unroll 8
        for (int c = 0; c < 64; ++c) { const float2 x = *(const float2*)(src + (size_t)c * 16384);
            *(unsigned*)(dst + (size_t)c * 16384) = pk2(v0, v1);
            const float a = av[c], cc = cv[c]; v0 = a * v0 + cc * x.x; v1 = a * v1 + cc * x.y; } }
    else if (F.tid < 320 && (wg & 31) == 0) { const int p = F.tid - 256; float v0 = 0.f, v1 = 0.f;
        for (int c = 0; c < 64; ++c) { const float2 x = *(const float2*)(NLOC + (size_t)(bh * 64 + c) * 128 + 2 * p);
            *(float2*)(NPREV + (size_t)(bh * 64 + c) * 128 + 2 * p) = make_float2(v0, v1);
            const float a = av[c], cc = cv[c]; v0 = a * v0 + cc * x.x; v1 = a * v1 + cc * x.y; } }
    __syncthreads();
}

__device__ __forceinline__ void mlstm_out_unit(const Frame& F, int u) {
    const int c = u & 63, h = (u >> 6) & 3, b = u >> 8, row0 = b * 8192 + c * 128;
    const bf16* PROJ = (const bf16*)(F.ws + WS_PROJ); const float* GATES = (const float*)(F.ws + WS_GATES); const float* conv = F.in[3]; const float* ngain = F.in[6];
    const float* MPREV = (const float*)(F.ws + WS_SMALL) + 1024; const float* NPREV = (const float*)(F.ws + WS_SMALL) + 2048 + 512 * 128;
    const bf16* CPREV = (const bf16*)(F.ws + WS_CPREV); bf16* MIX = (bf16*)(F.ws + WS_MIX);
    LAS float* colc = (LAS float*)(F.lds + VEC_OFF); LAS float* rowc = colc + 128; LAS float* inter = rowc + 128; LAS float* emn = inter + 128; LAS float* rdn = emn + 128;
    LAS float* npv = rdn + 128; LAS float* cw = npv + 128;
    const int w = F.wave, lane = F.lane;
    for (int i = F.tid; i < 1024; i += NTHR) { const int qk = i >> 9, tp = (i >> 7) & 3, d = i & 127; cw[i] = conv[tp * 1024 + qk * 512 + h * 128 + d]; }
    if (F.tid < 128) npv[F.tid] = NPREV[(size_t)u * 128 + F.tid];
    if (w == 0) { const int l = lane, s0 = 2 * l, s1 = s0 + 1;
        const float li0 = GATES[(size_t)(row0 + s0) * 8 + h], li1 = GATES[(size_t)(row0 + s1) * 8 + h], lf0 = GATES[(size_t)(row0 + s0) * 8 + 4 + h], lf1 = GATES[(size_t)(row0 + s1) * 8 + 4 + h];
        const float inc = wscan_add(lf0 + lf1, l), b1 = inc, b0 = inc - lf1;
        const float c0 = li0 - b0, c1 = li1 - b1;
        const float pmx = wscan_max(fmaxf(c0, c1), l); float pprev = __shfl_up(pmx, 1); if (l == 0) pprev = -INFINITY;
        const float pm0 = fmaxf(pprev, c0), pm1 = pmx, mprev = MPREV[u];
        const float m0 = b0 + fmaxf(mprev, pm0), m1 = b1 + fmaxf(mprev, pm1);
        colc[s0] = c0; colc[s1] = c1; rowc[s0] = b0 - m0; rowc[s1] = b1 - m1;
        inter[s0] = fexp(b0 + mprev - m0); inter[s1] = fexp(b1 + mprev - m1); emn[s0] = fexp(-m0); emn[s1] = fexp(-m1); }
    __syncthreads();
    stage_conv(F, F.lds + T0, PROJ + (size_t)row0 * PROJ_LD + QO + h * 128, cw, c * 128, 1.0f);
    stage_conv(F, F.lds + T1, PROJ + (size_t)row0 * PROJ_LD + KO + h * 128, cw + 512, c * 128, 0.08838834764831845f);
    stage_tile<false>(F, F.lds + T2, PROJ + (size_t)row0 * PROJ_LD + VO + h * 128, PROJ_LD, nullptr);
    stage_tile<false>(F, F.lds + T3, CPREV + (size_t)u * 16384, 128, nullptr);
    __syncthreads();
    const int t = 16 * w + (lane & 15);
    u32x2 wpk[8]; float rsum = 0.f;
    { const float rc = rowc[t];
#pragma unroll
      for (int sb = 0; sb < 8; ++sb) { wpk[sb] = (u32x2){0u, 0u};
          if (sb <= w) { f32x4 a4 = (f32x4){0.f, 0.f, 0.f, 0.f};
#pragma unroll
              for (int ks = 0; ks < 4; ++ks) { const bf16x8 a = frag_row(F.lds + T1, 16 * sb, ks, lane), bb = frag_row(F.lds + T0, 16 * w, ks, lane); a4 = MFMA16(a, bb, a4); }
              float wv4[4];
#pragma unroll
              for (int rg = 0; rg < 4; ++rg) { const int s = 16 * sb + 4 * (lane >> 4) + rg; const float e = fexp(rc + colc[s]) * a4[rg]; wv4[rg] = (s <= t) ? e : 0.f; }
              wpk[sb].x = pk2(wv4[0], wv4[1]); wpk[sb].y = pk2(wv4[2], wv4[3]);
              rsum += bf2f((unsigned short)(wpk[sb].x & 0xffffu)) + bf2f((unsigned short)(wpk[sb].x >> 16)) + bf2f((unsigned short)(wpk[sb].y & 0xffffu)) + bf2f((unsigned short)(wpk[sb].y >> 16)); } } }
    __syncthreads();
#pragma unroll
    for (int sb = 0; sb < 8; ++sb) if (sb <= (w | 1)) *(LAS u32x2*)(F.lds + T1 + off_b(t, 2 * sb + (lane >> 5)) + 8 * ((lane >> 4) & 1)) = wpk[sb];
    rsum += __shfl_xor(rsum, 16); rsum += __shfl_xor(rsum, 32);
    { float qn = 0.f; const int part = lane >> 4;
#pragma unroll
      for (int i = 0; i < 4; ++i) { float f[8]; unpack8(*(const LAS u32x4*)(F.lds + T0 + off_b(t, 4 * part + i)), f);
#pragma unroll
          for (int k = 0; k < 8; ++k) qn += f[k] * npv[32 * part + 8 * i + k]; }
      qn += __shfl_xor(qn, 16); qn += __shfl_xor(qn, 32);
      const float den = rsum + inter[t] * qn;
      if (lane < 16) rdn[t] = 1.0f / fmaxf(fabsf(den), emn[t]); }
    f32x4 acc[8];
#pragma unroll
    for (int vb = 0; vb < 8; ++vb) acc[vb] = (f32x4){0.f, 0.f, 0.f, 0.f};
#pragma unroll
    for (int ks = 0; ks < 4; ++ks) { const bf16x8 a = frag_row(F.lds + T0, 16 * w, ks, lane);
#pragma unroll
        for (int vb = 0; vb < 8; ++vb) { const bf16x8 bb = frag_row(F.lds + T3, 16 * vb, ks, lane); acc[vb] = MFMA16(a, bb, acc[vb]); } }
    float it4[4], rd4[4];
#pragma unroll
    for (int rg = 0; rg < 4; ++rg) { const int tr = 16 * w + 4 * (lane >> 4) + rg; it4[rg] = inter[tr]; rd4[rg] = rdn[tr]; }
#pragma unroll
    for (int vb = 0; vb < 8; ++vb)
#pragma unroll
        for (int rg = 0; rg < 4; ++rg) acc[vb][rg] *= it4[rg];
    for (int ks = 0; ks <= (w >> 1); ++ks) { const bf16x8 a = frag_row(F.lds + T1, 16 * w, ks, lane);
#pragma unroll
        for (int vb = 0; vb < 8; ++vb) { const bf16x8 bb = frag_tr(F.lds + T2, vb, ks, lane); acc[vb] = MFMA16(a, bb, acc[vb]); } }
#pragma unroll
    for (int rg = 0; rg < 4; ++rg) { float s = 0.f;
#pragma unroll
        for (int vb = 0; vb < 8; ++vb) { acc[vb][rg] *= rd4[rg]; s += acc[vb][rg]; }
        s += __shfl_xor(s, 1); s += __shfl_xor(s, 2); s += __shfl_xor(s, 4); s += __shfl_xor(s, 8);
        const float mean = s * (1.0f / 128.0f); float q = 0.f;
#pragma unroll
        for (int vb = 0; vb < 8; ++vb) { acc[vb][rg] -= mean; q += acc[vb][rg] * acc[vb][rg]; }
        q += __shfl_xor(q, 1); q += __shfl_xor(q, 2); q += __shfl_xor(q, 4); q += __shfl_xor(q, 8);
        const float rstd = 1.0f / sqrtf(q * (1.0f / 128.0f) + 1e-6f);
#pragma unroll
        for (int vb = 0; vb < 8; ++vb) acc[vb][rg] *= rstd; }
#pragma unroll
    for (int vb = 0; vb < 8; ++vb) { const int d = 16 * vb + (lane & 15); const float gg = ngain[h * 128 + d];
#pragma unroll
        for (int rg = 0; rg < 4; ++rg) { const int tr = 16 * w + 4 * (lane >> 4) + rg;
            *(LAS unsigned short*)(F.lds + T1 + off_b(tr, d >> 3) + 2 * (d & 7)) = (unsigned short)f2bf(acc[vb][rg] * gg); } }
#pragma unroll
    for (int i = 0; i < 4; ++i) { const int id = lane + 64 * i, r = id >> 4, ch = id & 15, tr = 16 * w + r;
        float y[8], o[8]; unpack8(*(const LAS u32x4*)(F.lds + T1 + off_b(tr, ch)), y);
        unpack8(*(const u32x4*)(PROJ + (size_t)(row0 + tr) * PROJ_LD + OO + h * 128 + 8 * ch), o);
#pragma unroll
        for (int k = 0; k < 8; ++k) y[k] *= fsigmoid(o[k]);
        *(u32x4*)(MIX + (size_t)(row0 + tr) * 1024 + h * 128 + 8 * ch) = pack8(y); }
    { const float* RSG = (const float*)(F.ws + WS_RSG);
#pragma unroll
      for (int i = 0; i < 4; ++i) { const int id = lane + 64 * i, r = id >> 4, ch = id & 15, tr = 16 * w + r;
          bf16* p = MIX + (size_t)(row0 + tr) * 1024 + 512 + h * 128 + 8 * ch; float y[8]; unpack8(*(const u32x4*)p, y); const float rs = RSG[row0 + tr];
#pragma unroll
          for (int kk = 0; kk < 8; ++kk) y[kk] *= rs;
          *(u32x4*)p = pack8(y); } }
    __syncthreads();
}

__device__ __forceinline__ void phase_router(const Frame& F) {
    const float* H = (const float*)(F.ws + WS_H); const float* g2 = F.in[12]; const float* br = F.in[14];
    const bf16* WrThi = (const bf16*)(F.ws + WS_WRT); const bf16* WrTlo = WrThi + 32 * 1024;
    bf16* HN = (bf16*)(F.ws + WS_XN); int* cnt = (int*)(F.ws + WS_CTL) + CW_CNT; int* tokidx = (int*)(F.ws + WS_TOKIDX); float* gate = (float*)(F.ws + WS_GATE);
    lptr ihi = F.lds, ilo = F.lds + 32 * IMG_ROW;
    LAS float* lg = (LAS float*)(F.lds + 2 * 32 * IMG_ROW);
    LAS int* hist = (LAS int*)(lg + 2048); LAS int* base = hist + 32;
    for (int i = F.tid; i < 32 * 128; i += NTHR) { const int n = i >> 7, ch = i & 127;
        *(LAS u32x4*)(ihi + n * IMG_ROW + 16 * ch) = *(const u32x4*)(WrThi + (size_t)n * 1024 + 8 * ch);
        *(LAS u32x4*)(ilo + n * IMG_ROW + 16 * ch) = *(const u32x4*)(WrTlo + (size_t)n * 1024 + 8 * ch); }
    if (F.tid < 32) hist[F.tid] = 0;
    __syncthreads();
    const int tok0 = F.vcu * 64 + F.wave * 8, lane = F.lane;
    f32x4 acc[2];
    row_pass<2>(H, g2, HN, ihi, ilo, tok0, lane, acc);
    if ((lane >> 4) < 2) {
#pragma unroll
        for (int nf = 0; nf < 2; ++nf)
#pragma unroll
            for (int rg = 0; rg < 4; ++rg) lg[(F.wave * 8 + 4 * (lane >> 4) + rg) * 32 + 16 * nf + (lane & 15)] = acc[nf][rg]; }
    int be[4] = {0, 0, 0, 0}, lr[4] = {0, 0, 0, 0}; float gt[4] = {0.f, 0.f, 0.f, 0.f};
    if (lane < 8) { float v[32];
#pragma unroll
        for (int q4 = 0; q4 < 8; ++q4) { const f32x4 x = *(const LAS f32x4*)(lg + (F.wave * 8 + lane) * 32 + 4 * q4), bb = *(const f32x4*)(br + 4 * q4);
            v[4 * q4] = x[0] + bb[0]; v[4 * q4 + 1] = x[1] + bb[1]; v[4 * q4 + 2] = x[2] + bb[2]; v[4 * q4 + 3] = x[3] + bb[3]; }
        float bv[4];
#pragma unroll
        for (int k = 0; k < 4; ++k) { float best = -INFINITY; int bi = 0;
#pragma unroll
            for (int e = 0; e < 32; ++e) if (v[e] > best) { best = v[e]; bi = e; }
            be[k] = bi; bv[k] = best;
#pragma unroll
            for (int e = 0; e < 32; ++e) v[e] = (e == bi) ? -INFINITY : v[e]; }
        float den = 0.f;
#pragma unroll
        for (int k = 0; k < 4; ++k) { gt[k] = fexp(bv[k] - bv[0]); den += gt[k]; }
        const float rd = 1.0f / den;
#pragma unroll
        for (int k = 0; k < 4; ++k) { gt[k] *= rd; lr[k] = __hip_atomic_fetch_add(hist + be[k], 1, __ATOMIC_RELAXED, __HIP_MEMORY_SCOPE_WORKGROUP); } }
    __syncthreads();
    if (F.tid < 32) base[F.tid] = hist[F.tid] > 0 ? atomicAdd(&cnt[F.tid], hist[F.tid]) : 0;
    __syncthreads();
    if (lane < 8) { const int tok = tok0 + lane;
#pragma unroll
        for (int k = 0; k < 4; ++k) { const int rk = base[be[k]] + lr[k]; tokidx[(size_t)be[k] * 65536 + rk] = tok * 4 + k; gate[tok * 4 + k] = gt[k]; } }
    __syncthreads();
}

__device__ __forceinline__ int build_ttab(const Frame& F) {
    const int* cnt = (const int*)(F.ws + WS_CTL) + CW_CNT; LAS unsigned* ttab = (LAS unsigned*)(F.lds + TTAB_OFF); LAS int* tot = (LAS int*)(F.lds + MISC_OFF + 64);
    if (F.wave == 0) { const int l = F.lane; const int c = l < 32 ? __hip_atomic_load(cnt + l, RLX_AGENT) : 0; const int nt = (c + 255) >> 8;
        int inc = nt;
#pragma unroll
        for (int o = 1; o < 64; o <<= 1) { const int tt = __shfl_up(inc, o); if (l >= o) inc += tt; }
        const int start = inc - nt;
        for (int r = 0; r < nt; ++r) { const int left = c - 256 * r; ttab[start + r] = (unsigned)l | ((unsigned)r << 5) | ((unsigned)((left < 256 ? left : 256) - 1) << 14); }
        if (l == 63) tot[0] = inc; }
    __syncthreads();
    return tot[0];
}

__device__ __forceinline__ void phase_final(const Frame& F) {
    const float* H = (const float*)(F.ws + WS_H); const bf16* Y = (const bf16*)(F.ws + WS_Y); const float* gf = F.in[19];
    const int gw = F.vcu * NWAVES + F.wave, lane = F.lane;
    for (int i = 0; i < 8; ++i) { const int tok = gw * 8 + i;
        f32x4 v[4]; float s = 0.f;
#pragma unroll
        for (int j = 0; j < 4; ++j) { v[j] = *(const f32x4*)(H + (size_t)tok * 1024 + 4 * (lane + 64 * j));
#pragma unroll
            for (int k = 0; k < 4; ++k) { const u32x2 y = *(const u32x2*)(Y + (size_t)(tok * 4 + k) * 1024 + 4 * (lane + 64 * j));
                v[j][0] += __builtin_bit_cast(float, y.x << 16); v[j][1] += __builtin_bit_cast(float, y.x & 0xffff0000u);
                v[j][2] += __builtin_bit_cast(float, y.y << 16); v[j][3] += __builtin_bit_cast(float, y.y & 0xffff0000u); }
            s += (v[j][0] * v[j][0] + v[j][1] * v[j][1]) + (v[j][2] * v[j][2] + v[j][3] * v[j][3]); }
        const float r = 1.0f / sqrtf(wsum_all(s) * (1.0f / 1024.0f) + 1e-6f);
#pragma unroll
        for (int j = 0; j < 4; ++j) { const f32x4 gg = *(const f32x4*)(gf + 4 * (lane + 64 * j)); *(f32x4*)(F.out + (size_t)tok * 1024 + 4 * (lane + 64 * j)) = v[j] * r * gg; } }
}
constexpr int N_PHASES = 10;
struct Args { const float* in[20]; float* out; unsigned char* ws; int ph_lo, ph_hi; };
__global__ void __launch_bounds__(NTHR, 2) mk_fwd(Args args) {
    extern __shared__ __attribute__((aligned(16))) unsigned char lds_raw[];
    Frame F;
    F.lds = (lptr)lds_raw; F.tid = threadIdx.x; F.lane = F.tid & 63; F.wave = __builtin_amdgcn_readfirstlane(F.tid >> 6);
    F.G = gridDim.x; { const int bx = blockIdx.x; F.vcu = (F.G % 8 == 0) ? (bx % 8) * (F.G / 8) + bx / 8 : bx; }
#pragma unroll
    for (int i = 0; i < 20; ++i) F.in[i] = args.in[i];
    F.out = args.out; F.ws = args.ws;
    for (int u = F.tid; u < (LDS_BYTES - CTL_OFF) / 4; u += NTHR) ((LAS unsigned*)(F.lds + CTL_OFF))[u] = 0u;
    __syncthreads();
    XcdBarrier bar = xcd_barrier_post((unsigned*)(F.ws + WS_CTL) + CW_BAR, (volatile LAS unsigned*)(F.lds + MISC_OFF));
    const int lo = args.ph_lo, hi = args.ph_hi;
#define IN(k) (lo <= (k) && (k) < hi)
#define SEAM(k) do { if (IN(k) && IN((k) + 1)) xcd_barrier(bar); } while (0)
    const int bx = blockIdx.x;
    if (IN(0)) { phase0(F); } SEAM(0);
    if (IN(1)) { pg8::DenseOps ops{(const bf16*)(F.ws + WS_XN), (const bf16*)(F.ws + WS_WINT), 1024}; pg8::StaticOrder S; S.init(64, 12, F.G, bx);
        pg8::EpiProj E{(bf16*)(F.ws + WS_PROJ), PROJ_LD};
        pg8::gemm_phase<pg8::EpiProj, pg8::StaticOrder, pg8::DenseOps, false, true>(F.lds, 1024, S, ops, E); } SEAM(1);
    if (IN(2)) { if (F.vcu < 128) gmlp_unit(F, F.vcu); else { for (int j = 0; j < 4; ++j) mlstm_local_unit(F, (F.vcu - 128) * 4 + j); } } SEAM(2);
    if (IN(3)) { phase_scan(F); } SEAM(3);
    if (IN(4)) { for (int j = 0; j < 2; ++j) mlstm_out_unit(F, F.vcu * 2 + j); } SEAM(4);
    if (IN(5)) { pg8::DenseOps ops{(const bf16*)(F.ws + WS_MIX), (const bf16*)(F.ws + WS_WOUTT), 1024}; pg8::StaticOrder S; S.init(64, 4, F.G, bx);
        pg8::EpiRes E{F.in[0], (float*)(F.ws + WS_H), 1024};
        pg8::gemm_phase<pg8::EpiRes, pg8::StaticOrder, pg8::DenseOps, false, false>(F.lds, 1024, S, ops, E); } SEAM(5);
    if (IN(6)) { phase_router(F); } SEAM(6);
    if (IN(7)) { const int nM = build_ttab(F);
        pg8::UpOps ops{(const bf16*)(F.ws + WS_XN), (const bf16*)(F.ws + WS_WUPT), (const int*)(F.ws + WS_TOKIDX)};
        pg8::MoeOrder S; S.init(nM, 8, F.G, bx); S.ttab = (const LAS unsigned*)(F.lds + TTAB_OFF);
        pg8::EpiUp E{(bf16*)(F.ws + WS_ACT), F.in[16]};
        pg8::gemm_phase<pg8::EpiUp, pg8::MoeOrder, pg8::UpOps, true, true>(F.lds, 1024, S, ops, E); } SEAM(7);
    if (IN(8)) { const int nM = build_ttab(F);
        pg8::DownOps ops{(const bf16*)(F.ws + WS_ACT), (const bf16*)(F.ws + WS_WDNT)};
        pg8::MoeOrder S; S.init(nM, 4, F.G, bx); S.ttab = (const LAS unsigned*)(F.lds + TTAB_OFF);
        pg8::EpiDown E{(bf16*)(F.ws + WS_Y), F.in[18], (const float*)(F.ws + WS_GATE), (const int*)(F.ws + WS_TOKIDX)};
        pg8::gemm_phase<pg8::EpiDown, pg8::MoeOrder, pg8::DownOps, false, true>(F.lds, 1024, S, ops, E); } SEAM(8);
    if (IN(9)) { phase_final(F); }
#undef IN
#undef SEAM
}

__global__ void k_cvt_proj(const bf16* __restrict__ P, float* __restrict__ P32) {
    const size_t i = (size_t)blockIdx.x * blockDim.x + threadIdx.x; if (i >= (size_t)16384 * 3072) return;
    const int row = (int)(i / 3072), c = (int)(i % 3072); P32[(size_t)row * 3080 + (c < 2048 ? c : c + 8)] = bf2f(P[i]);
}
__global__ void k_cvt_cols(const bf16* __restrict__ S, float* __restrict__ D, int c0, int c1, const float* __restrict__ rowscale) {
    const size_t i = (size_t)blockIdx.x * blockDim.x + threadIdx.x; const int w = c1 - c0; if (i >= (size_t)16384 * w) return;
    const int row = (int)(i / w), c = c0 + (int)(i % w); D[(size_t)row * 1024 + c] = bf2f(S[(size_t)row * 1024 + c]) * (rowscale ? rowscale[row] : 1.0f);
}
__global__ void k_cvt_flat(const bf16* __restrict__ S, float* __restrict__ D, size_t n) { const size_t i = (size_t)blockIdx.x * blockDim.x + threadIdx.x; if (i < n) D[i] = bf2f(S[i]); }

#ifndef OPT_PHASES
#define OPT_PHASES 10
#endif

extern "C" void kernel_launch(void* const* d_in, const int* in_sizes, int n_in, void* d_out, int out_size, void* d_ws, size_t ws_size, hipStream_t stream) {
    static int ready = 0;
    if (!ready) {
        if (hipFuncSetAttribute((const void*)mk_fwd, hipFuncAttributeMaxDynamicSharedMemorySize, LDS_BYTES) != hipSuccess) { fprintf(stderr, "hipFuncSetAttribute failed\n"); return; }
        ready = 1;
    }
    char* ws = (char*)d_ws;
    if (ws_size < 1024 * MiB) { fprintf(stderr, "ws too small: %zu\n", ws_size); return; }
    (void)hipMemsetAsync(ws + WS_CTL, 0, CTL_ZERO_BYTES, stream);
    Args a{};
    for (int i = 0; i < 20; ++i) a.in[i] = (const float*)d_in[i];
    a.out = (float*)d_out; a.ws = (unsigned char*)d_ws; a.ph_lo = 0; a.ph_hi = OPT_PHASES;
    hipLaunchKernelGGL(mk_fwd, dim3(256), dim3(NTHR), LDS_BYTES, stream, a);
#if OPT_PHASES < 10
    using namespace gold;
    const float* x = (const float*)d_in[0]; const float* conv = (const float*)d_in[3];
    const float* ngain = (const float*)d_in[6]; const float* lng = (const float*)d_in[7];
    const float* wsp = (const float*)d_in[8]; const float* bsp = (const float*)d_in[9]; const float* og = (const float*)d_in[10]; const float* w_out = (const float*)d_in[11];
    const float* g2 = (const float*)d_in[12]; const float* wr = (const float*)d_in[13]; const float* br = (const float*)d_in[14]; const float* w_up = (const float*)d_in[15];
    const float* b_up = (const float*)d_in[16]; const float* w_dn = (const float*)d_in[17]; const float* b_dn = (const float*)d_in[18]; const float* gf = (const float*)d_in[19];
    float* out = (float*)d_out;
    int* cnt = (int*)(ws + WS_CTL) + CW_CNT; float* MLOC = (float*)(ws + WS_SMALL); float* BLAST = MLOC + 512; float* MPREV = MLOC + 1024; float* NLOC = MLOC + 2048; float* NPREV = NLOC + 512 * 128;
    float* GATES = (float*)(ws + WS_GATES); float* gate = (float*)(ws + WS_GATE); int* tokidx = (int*)(ws + WS_TOKIDX); float* CLOC = (float*)(ws + WS_CLOC); float* Hh = (float*)(ws + WS_H);
    int* ntiles = (int*)(ws + 13 * MiB); int* tile_e = (int*)(ws + 13 * MiB + 4096); int* tile_r = (int*)(ws + 13 * MiB + 16384); float* ROWS = (float*)(ws + 14 * MiB);
    float* PROJ32 = (float*)(ws + 488 * MiB); float* QC = (float*)(ws + 684 * MiB); float* CPREV32 = (float*)(ws + 748 * MiB); float* VGN = (float*)(ws + 780 * MiB);
    float* WSCR = (float*)(ws + 812 * MiB); float* MIX32 = (float*)(ws + 844 * MiB); float* HN32 = (float*)(ws + 908 * MiB); float* ACT32 = (float*)(ws + 488 * MiB); float* Y32 = (float*)(ws + 768 * MiB);
    const int lds_local = (32768 + 384) * 4, lds_out = (2 * 128 * 129 + 2048) * 4;
    static bool attr = false;
    if (!attr) { (void)hipFuncSetAttribute((const void*)k_mlstm_local, hipFuncAttributeMaxDynamicSharedMemorySize, lds_local);
                 (void)hipFuncSetAttribute((const void*)k_mlstm_outA, hipFuncAttributeMaxDynamicSharedMemorySize, lds_out);
                 (void)hipFuncSetAttribute((const void*)k_mlstm_outB, hipFuncAttributeMaxDynamicSharedMemorySize, lds_out); attr = true; }
    if (OPT_PHASES <= 4) {
        k_cvt_proj<<<(16384 * 3072) / 256, 256, 0, stream>>>((const bf16*)(ws + WS_PROJ), PROJ32);
        k_conv<<<(M * 1024) / 256, 256, 0, stream>>>(PROJ32, conv, QC);
        if (OPT_PHASES <= 2) k_mlstm_local<<<NUNIT, 256, lds_local, stream>>>(PROJ32, QC, GATES, CLOC, NLOC, MLOC, BLAST);
        if (OPT_PHASES <= 3) k_mlstm_scan<<<dim3((16384 + 128 + 255) / 256, 8), 256, 0, stream>>>(CLOC, NLOC, MLOC, BLAST, CPREV32, NPREV, MPREV);
        else k_cvt_flat<<<(512 * 16384) / 256, 256, 0, stream>>>((const bf16*)(ws + WS_CPREV), CPREV32, (size_t)512 * 16384);
        k_mlstm_outA<<<NUNIT, 512, lds_out, stream>>>(QC, GATES, NPREV, MPREV, WSCR, ROWS);
        k_mlstm_outB<<<NUNIT, 512, lds_out, stream>>>(PROJ32, QC, CPREV32, WSCR, ROWS, ngain, MIX32);
        if (OPT_PHASES <= 2) { k_gmlp_ln<<<M / 4, 256, 0, stream>>>(PROJ32, lng, VGN); k_gmlp_mix<<<M, 512, 0, stream>>>(PROJ32, VGN, wsp, bsp, og, MIX32); }
        else k_cvt_cols<<<(16384 * 512) / 256, 256, 0, stream>>>((const bf16*)(ws + WS_MIX), MIX32, 512, 1024, (const float*)(ws + WS_RSG));
    } else if (OPT_PHASES == 5) k_cvt_cols<<<(16384 * 1024) / 256, 256, 0, stream>>>((const bf16*)(ws + WS_MIX), MIX32, 0, 1024, nullptr);
    if (OPT_PHASES <= 5) { GemmP p{}; p.A = MIX32; p.B = w_out; p.C = Hh; p.R = x; p.lda = D; p.ldb = D; p.ldc = D; p.N = D; p.K = D;
        k_gemm<1><<<dim3(D / 64, M / 64), 256, 0, stream>>>(p); }
    if (OPT_PHASES <= 6) k_router<<<M / 4, 256, 0, stream>>>(Hh, g2, wr, br, HN32, cnt, tokidx, gate);
    else if (OPT_PHASES <= 8) k_cvt_flat<<<(16384 * 1024) / 256, 256, 0, stream>>>((const bf16*)(ws + WS_XN), HN32, (size_t)16384 * 1024);
    if (OPT_PHASES <= 8) {
        k_tiles<<<1, 64, 0, stream>>>(cnt, tile_e, tile_r, ntiles, 64);
        { GemmP p{}; p.A = HN32; p.B = w_up; p.C = ACT32; p.lda = D; p.ldb = 2048; p.ldc = DFF; p.N = DFF; p.K = D;
          p.cnt = cnt; p.tokidx = tokidx; p.tile_e = tile_e; p.tile_r = tile_r; p.ntiles = ntiles; p.bias = b_up; p.gate = gate;
          k_gemm<2><<<dim3(DFF / 64, 1056), 256, 0, stream>>>(p); }
        { GemmP p{}; p.A = ACT32; p.B = w_dn; p.C = Y32; p.lda = DFF; p.ldb = D; p.ldc = D; p.N = D; p.K = DFF;
          p.cnt = cnt; p.tokidx = tokidx; p.tile_e = tile_e; p.tile_r = tile_r; p.ntiles = ntiles; p.bias = b_dn; p.gate = gate;
          k_gemm<3><<<dim3(D / 64, 1056), 256, 0, stream>>>(p); }
    } else k_cvt_flat<<<(65536 * 1024) / 256, 256, 0, stream>>>((const bf16*)(ws + WS_Y), Y32, (size_t)65536 * 1024);
    k_final<<<M / 4, 256, 0, stream>>>(Hh, Y32, gf, out);
#endif
}
```

```cpp
#include <hip/hip_runtime.h>
#include <cstdio>
#include <cstdint>
#include <cstddef>
#include <cmath>


namespace pg8 {
#define PG8_LAS __attribute__((address_space(3)))
typedef unsigned short bf16_t;
typedef short bf16x8 __attribute__((ext_vector_type(8)));
typedef float f32x4 __attribute__((ext_vector_type(4)));
typedef float f32x2 __attribute__((ext_vector_type(2)));
typedef unsigned u32x4 __attribute__((ext_vector_type(4)));
constexpr int BM = 256, BK = 64, HALF = 128, HTB = HALF * BK * 2, STAGE_BYTES = 8 * HTB, NXCD = 8, WGM = 8;

__host__ __device__ __forceinline__ int lds_byte(int r, int c) { const int st = (r >> 4) * 2 + (c >> 5), rr = r & 15, cc = c & 31, ob = rr * 64 + cc * 2; return st * 1024 + (ob ^ (((ob >> 9) & 1) << 5)); }
__host__ __device__ __forceinline__ void stage_rc(int b, int& R, int& C) { const int st = b / 1024, sb = b % 1024, swz = sb ^ (((sb >> 9) & 1) << 5); R = (st >> 1) * 16 + swz / 64; C = (st & 1) * 32 + (swz % 64) / 2; }
__host__ __device__ __forceinline__ int perm32(int rho) { const int n = rho >> 4, i = rho & 15; return 8 * (i >> 2) + 4 * n + (i & 3); }

struct Unit { int pm, pn, e, rt, nrows; };

struct StaticOrder {
    int nM, nN, nwg, G, c;
    __device__ void init(int nM_, int nN_, int G_, int c_) { nM = nM_; nN = nN_; nwg = nM * nN; G = G_; c = c_; }
    __device__ bool next(int i, Unit& u) const {
        const long L = (long)i * G + c; if (L >= nwg) return false;
        int wgid = (int)L; { const int q = nwg / NXCD, r = nwg % NXCD, xcd = wgid % NXCD, off = wgid / NXCD; wgid = (xcd < r ? xcd * (q + 1) : r * (q + 1) + (xcd - r) * q) + off; }
        const int nig = WGM * nN, gid = wgid / nig, fm = gid * WGM, gsz = (nM - fm) < WGM ? (nM - fm) : WGM;
        u.pm = fm + ((wgid % nig) % gsz); u.pn = (wgid % nig) / gsz; u.e = 0; u.rt = 0; u.nrows = 256; return true;
    }
};
struct MoeOrder : StaticOrder {
    const PG8_LAS unsigned* ttab;
    __device__ bool next(int i, Unit& u) const {
        if (!StaticOrder::next(i, u)) return false;
        const unsigned w = ttab[u.pm]; u.e = (int)(w & 31u); u.rt = (int)((w >> 5) & 511u); u.nrows = (int)((w >> 14) & 255u) + 1; return true;
    }
};

__device__ __forceinline__ unsigned cvt_pk_bf16(float lo, float hi) { unsigned r; asm volatile("v_cvt_pk_bf16_f32 %0, %1, %2" : "=v"(r) : "v"(lo), "v"(hi)); return r; }

struct DenseOps {
    const bf16_t* A; const bf16_t* Bt; int K;
    __device__ __forceinline__ const char* a_base(const Unit& u) const { return (const char*)A + (size_t)u.pm * BM * K * 2; }
    __device__ __forceinline__ const char* b_base(const Unit& u) const { return (const char*)Bt + (size_t)u.pn * BM * K * 2; }
    __device__ __forceinline__ void gather(const Unit&, const int (&)[2], const int (&)[2], unsigned (&)[2][2]) const {}
};
struct UpOps {
    const bf16_t* HN; const bf16_t* WupT; const int* tokidx;
    __device__ __forceinline__ const char* a_base(const Unit&) const { return (const char*)HN; }
    __device__ __forceinline__ const char* b_base(const Unit& u) const { return (const char*)WupT + ((size_t)u.e * 2048 + (size_t)u.pn * BM) * 1024 * 2; }
    __device__ __forceinline__ void gather(const Unit& u, const int (&R)[2], const int (&C)[2], unsigned (&v)[2][2]) const {
        const int* tl = tokidx + (size_t)u.e * 65536 + u.rt * 256;
#pragma unroll
        for (int h = 0; h < 2; ++h)
#pragma unroll
            for (int i = 0; i < 2; ++i) { const int r = R[i] + 128 * h; const int idx = tl[r < u.nrows ? r : 0]; v[h][i] = (unsigned)(idx >> 2) * 2048u + (unsigned)C[i] * 2u; }
    }
};
struct DownOps {
    const bf16_t* ACT; const bf16_t* WdnT;
    __device__ __forceinline__ const char* a_base(const Unit& u) const { return (const char*)ACT + (size_t)u.pm * BM * 1024 * 2; }
    __device__ __forceinline__ const char* b_base(const Unit& u) const { return (const char*)WdnT + ((size_t)u.e * 1024 + (size_t)u.pn * BM) * 1024 * 2; }
    __device__ __forceinline__ void gather(const Unit&, const int (&)[2], const int (&)[2], unsigned (&)[2][2]) const {}
};

struct EpiProj {
    static constexpr bool PERM = true;
    bf16_t* O; int ldc; const float* rs;
    static __device__ __forceinline__ float sigm(float x) { return __builtin_amdgcn_rcpf(1.0f + __builtin_amdgcn_exp2f(-1.4426950408889634f * x)); }
    static __device__ __forceinline__ float act(float x, int mode) {
        if (mode == 1) return sigm(x);
        if (mode == 2) return x * sigm(1.5957691216057308f * (x + 0.044715f * x * x * x));
        return x; }
    __device__ __forceinline__ void operator()(const f32x4 (&acc)[2][2][4][2], const Unit& u, int wr, int wc, int fr, int fq) const {
        const int row0 = u.pm * BM + wr * 64 + fr, col0 = u.pn * BM + wc * 32 + 8 * fq;
        const int mode = u.pn >= 8 ? 2 : (u.pn >= 6 ? 1 : 0);
        float sc[2][4];
#pragma unroll
        for (int ai = 0; ai < 2; ++ai)
#pragma unroll
            for (int m = 0; m < 4; ++m) sc[ai][m] = rs[row0 + ai * HALF + m * 16];
#pragma unroll
        for (int ai = 0; ai < 2; ++ai)
#pragma unroll
            for (int m = 0; m < 4; ++m) { bf16_t* rowp = O + (size_t)(row0 + ai * HALF + m * 16) * ldc + col0;
#pragma unroll
                for (int bj = 0; bj < 2; ++bj) { f32x4 v0 = acc[ai][bj][m][0] * sc[ai][m], v1 = acc[ai][bj][m][1] * sc[ai][m];
                    if (mode != 0) {
#pragma unroll
                        for (int i = 0; i < 4; ++i) { v0[i] = act(v0[i], mode); v1[i] = act(v1[i], mode); } }
                    u32x4 w; w.x = cvt_pk_bf16(v0[0], v0[1]); w.y = cvt_pk_bf16(v0[2], v0[3]); w.z = cvt_pk_bf16(v1[0], v1[1]); w.w = cvt_pk_bf16(v1[2], v1[3]);
                    *(u32x4*)(rowp + bj * HALF) = w; } }
    }
};
struct EpiRes {
    static constexpr bool PERM = false;
    const float* base; float* C; int ldc;
    __device__ __forceinline__ void operator()(const f32x4 (&acc)[2][2][4][2], const Unit& u, int wr, int wc, int fr, int fq) const {
        const int row0 = u.pm * BM + wr * 64 + fr, col0 = u.pn * BM + wc * 32 + 4 * fq;
#pragma unroll
        for (int ai = 0; ai < 2; ++ai)
#pragma unroll
            for (int m = 0; m < 4; ++m) { const size_t off = (size_t)(row0 + ai * HALF + m * 16) * ldc + col0;
#pragma unroll
                for (int bj = 0; bj < 2; ++bj)
#pragma unroll
                    for (int n = 0; n < 2; ++n) *(f32x4*)(C + off + bj * HALF + n * 16) = *(const f32x4*)(base + off + bj * HALF + n * 16) + acc[ai][bj][m][n]; }
    }
};
struct EpiUp {
    static constexpr bool PERM = true;
    bf16_t* ACT; const float* b_up; const float* rsx;
    __device__ __forceinline__ void operator()(const f32x4 (&acc)[2][2][4][2], const Unit& u, int wr, int wc, int fr, int fq) const {
        const int r0 = wr * 64 + fr, row0 = u.pm * BM + r0, j0 = wc * 32 + 8 * fq;
        const float* bg = b_up + (size_t)u.e * 2048 + u.pn * 128 + j0;
        const float* rp = rsx + (size_t)u.e * 65536 + u.rt * 256;
        f32x4 bgl[2], bln[2]; float sc[2][4];
#pragma unroll
        for (int n = 0; n < 2; ++n) { bgl[n] = *(const f32x4*)(bg + 4 * n); bln[n] = *(const f32x4*)(bg + 1024 + 4 * n); }
#pragma unroll
        for (int ai = 0; ai < 2; ++ai)
#pragma unroll
            for (int m = 0; m < 4; ++m) { const int r = r0 + ai * HALF + m * 16; sc[ai][m] = rp[r < u.nrows ? r : 0]; }
#pragma unroll
        for (int ai = 0; ai < 2; ++ai)
#pragma unroll
            for (int m = 0; m < 4; ++m) { bf16_t* rowp = ACT + (size_t)(row0 + ai * HALF + m * 16) * 1024 + u.pn * 128 + j0;
                float o[8];
#pragma unroll
                for (int n = 0; n < 2; ++n) { const f32x4 g = acc[ai][0][m][n] * sc[ai][m] + bgl[n], l = acc[ai][1][m][n] * sc[ai][m] + bln[n];
#pragma unroll
                    for (int i = 0; i < 4; ++i) { const float gl = fminf(g[i], 7.0f), ln = fminf(fmaxf(l[i], -7.0f), 7.0f);
                        o[n * 4 + i] = gl * __builtin_amdgcn_rcpf(1.0f + __builtin_amdgcn_exp2f(-2.4554669595930157f * gl)) * (ln + 1.0f); } }
                u32x4 w; w.x = cvt_pk_bf16(o[0], o[1]); w.y = cvt_pk_bf16(o[2], o[3]); w.z = cvt_pk_bf16(o[4], o[5]); w.w = cvt_pk_bf16(o[6], o[7]);
                *(u32x4*)rowp = w; }
    }
};
struct EpiDown {
    static constexpr bool PERM = true;
    bf16_t* Y; const float* b_dn; const float* gatex; const int* tokidx;
    __device__ __forceinline__ void operator()(const f32x4 (&acc)[2][2][4][2], const Unit& u, int wr, int wc, int fr, int fq) const {
        const int r0 = wr * 64 + fr, col0 = u.pn * BM + wc * 32 + 8 * fq;
        const int* tl = tokidx + (size_t)u.e * 65536 + u.rt * 256; const float* gl = gatex + (size_t)u.e * 65536 + u.rt * 256;
        const float* bb = b_dn + (size_t)u.e * 1024 + col0;
        f32x4 bv[2][2]; int idx[2][4]; float gt[2][4];
#pragma unroll
        for (int ai = 0; ai < 2; ++ai)
#pragma unroll
            for (int m = 0; m < 4; ++m) { const int r = r0 + ai * HALF + m * 16, rr = r < u.nrows ? r : 0; idx[ai][m] = tl[rr]; gt[ai][m] = gl[rr]; }
#pragma unroll
        for (int bj = 0; bj < 2; ++bj)
#pragma unroll
            for (int n = 0; n < 2; ++n) bv[bj][n] = *(const f32x4*)(bb + bj * HALF + 4 * n);
#pragma unroll
        for (int ai = 0; ai < 2; ++ai)
#pragma unroll
            for (int m = 0; m < 4; ++m) { const int r = r0 + ai * HALF + m * 16;
                if (r < u.nrows) { bf16_t* rowp = Y + (size_t)idx[ai][m] * 1024 + col0; const float g1 = gt[ai][m];
#pragma unroll
                    for (int bj = 0; bj < 2; ++bj) { const f32x4 v0 = (acc[ai][bj][m][0] + bv[bj][0]) * g1, v1 = (acc[ai][bj][m][1] + bv[bj][1]) * g1;
                        u32x4 w; w.x = cvt_pk_bf16(v0[0], v0[1]); w.y = cvt_pk_bf16(v0[2], v0[3]); w.z = cvt_pk_bf16(v1[0], v1[1]); w.w = cvt_pk_bf16(v1[2], v1[3]);
                        *(u32x4*)(rowp + bj * HALF) = w; } } }
    }
};

template <class Epi, class Sched, class Ops, bool GATHER, bool ALIGN_EPI>
__device__ __forceinline__ void gemm_phase(PG8_LAS unsigned char* lds, const int K, const Sched& S, const Ops& O, const Epi& E) {
    const int tid = threadIdx.x, wid = __builtin_amdgcn_readfirstlane(tid >> 6), lane = tid & 63, wr = wid >> 2, wc = wid & 3, fr = lane & 15, fq = lane >> 4;
    const int nt = K / BK;
    unsigned voffA[2], voffB[2]; int sR[2], sC[2];
#pragma unroll
    for (int i = 0; i < 2; ++i) { int R, C; stage_rc(tid * 16 + i * 8192, R, C); const int Rb = Epi::PERM ? ((R & ~31) + perm32(R & 31)) : R; sR[i] = R; sC[i] = C;
        voffA[i] = (unsigned)(R * K + C) * 2u; voffB[i] = (unsigned)(Rb * K + C) * 2u; }
    const size_t kstep = (size_t)(BK * 2);
    const size_t hstep = (size_t)HALF * K * 2;
    const unsigned ldsw = (unsigned)wid * 1024u;
    const int aoff = lds_byte(wr * 64 + fr, fq * 8), boff = lds_byte(wc * 32 + fr, fq * 8);
#define PG8_SA(b, h) (((b) * 2 + (h)) * HTB)
#define PG8_SB(b, h) ((4 + (b) * 2 + (h)) * HTB)
#define PG8_STAGE(bufoff, gbase, voff) do { _Pragma("unroll") for (int _i = 0; _i < 2; ++_i) \
        __builtin_amdgcn_global_load_lds((const unsigned*)((const char*)(gbase) + (voff)[_i]), (PG8_LAS unsigned*)(lds + (bufoff) + ldsw + _i * 8192), 16, 0, 0); } while (0)
#define PG8_STAGE_AC(bufoff, kptr, h) do { if constexpr (GATHER) PG8_STAGE(bufoff, kptr, vC[h]); else PG8_STAGE(bufoff, (kptr) + (h) * hstep, voffA); } while (0)
#define PG8_STAGE_AS(bufoff, kptr, h) do { if constexpr (GATHER) PG8_STAGE(bufoff, kptr, vS[h]); else PG8_STAGE(bufoff, (kptr) + (h) * hstep, voffA); } while (0)
#define PG8_LDA(dst, b, h) do { _Pragma("unroll") for (int m = 0; m < 4; ++m) _Pragma("unroll") for (int k = 0; k < 2; ++k) dst[m][k] = *(const PG8_LAS bf16x8*)(lds + PG8_SA(b, h) + aoff + m * 2048 + k * 1024); } while (0)
#define PG8_LDB(dst, b, h) do { _Pragma("unroll") for (int n = 0; n < 2; ++n) _Pragma("unroll") for (int k = 0; k < 2; ++k) dst[n][k] = *(const PG8_LAS bf16x8*)(lds + PG8_SB(b, h) + boff + n * 2048 + k * 1024); } while (0)
#define PG8_MMA(ai, bj, At, Bt) do { __builtin_amdgcn_s_setprio(1); _Pragma("unroll") for (int m = 0; m < 4; ++m) _Pragma("unroll") for (int n = 0; n < 2; ++n) _Pragma("unroll") for (int k = 0; k < 2; ++k) \
        acc[ai][bj][m][n] = __builtin_amdgcn_mfma_f32_16x16x32_bf16(Bt[n][k], At[m][k], acc[ai][bj][m][n], 0, 0, 0); __builtin_amdgcn_s_setprio(0); } while (0)
#define PG8_WAIT_V(n) asm volatile("s_waitcnt vmcnt(" #n ")" ::: "memory")
#define PG8_WAIT_L(n) asm volatile("s_waitcnt lgkmcnt(" #n ")" ::: "memory")
#define PG8_BAR __builtin_amdgcn_s_barrier()
#define PG8_SCHED __builtin_amdgcn_sched_barrier(0)
    Unit cur, nxt; int ui = 0;
    if (!S.next(0, cur)) return;
    f32x4 acc[2][2][4][2];
#pragma unroll
    for (int a = 0; a < 2; ++a)
#pragma unroll
        for (int b = 0; b < 2; ++b)
#pragma unroll
            for (int m = 0; m < 4; ++m)
#pragma unroll
                for (int n = 0; n < 2; ++n) acc[a][b][m][n] = (f32x4){0.f, 0.f, 0.f, 0.f};
    bf16x8 At[4][2], B0[2][2], B1[2][2];
    unsigned vC[2][2] = {{0u, 0u}, {0u, 0u}}, vN[2][2] = {{0u, 0u}, {0u, 0u}}, vS[2][2] = {{0u, 0u}, {0u, 0u}};
    if constexpr (GATHER) O.gather(cur, sR, sC, vC);
    const char* cA = O.a_base(cur); const char* cB = O.b_base(cur);
    PG8_STAGE(PG8_SB(0, 0), cB, voffB); PG8_STAGE(PG8_SB(0, 1), cB + hstep, voffB); PG8_STAGE_AC(PG8_SA(0, 0), cA, 0); PG8_STAGE_AC(PG8_SA(0, 1), cA, 1);
    if (wr == 1) PG8_BAR;
    PG8_WAIT_V(2); PG8_BAR;
    PG8_STAGE(PG8_SB(1, 0), cB + kstep, voffB); PG8_STAGE_AC(PG8_SA(1, 0), cA + kstep, 0); PG8_STAGE(PG8_SB(1, 1), cB + hstep + kstep, voffB);
    PG8_WAIT_V(6); PG8_BAR;
    for (;;) {
        const bool has_next = S.next(ui + 1, nxt);
        const char* nA = has_next ? O.a_base(nxt) : cA; const char* nB = has_next ? O.b_base(nxt) : cB;
        if constexpr (GATHER) { if (has_next) O.gather(nxt, sR, sC, vN); else {
#pragma unroll
            for (int h = 0; h < 2; ++h)
#pragma unroll
                for (int i = 0; i < 2; ++i) vN[h][i] = vC[h][i]; } }
        for (int t = 0; t < nt; t += 2) {
            const bool last = (t == nt - 2);
            const char* a1 = cA + (size_t)(t + 1) * kstep;
            const char* a2 = last ? nA : cA + (size_t)(t + 2) * kstep; const char* b2 = last ? nB : cB + (size_t)(t + 2) * kstep;
            const char* a3 = a2 + kstep; const char* b3 = b2 + kstep;
            if constexpr (GATHER) {
#pragma unroll
                for (int h = 0; h < 2; ++h)
#pragma unroll
                    for (int i = 0; i < 2; ++i) vS[h][i] = last ? vN[h][i] : vC[h][i]; }
            PG8_LDB(B0, 0, 0); PG8_LDB(B1, 0, 1); PG8_SCHED; PG8_LDA(At, 0, 0); PG8_STAGE_AC(PG8_SA(1, 1), a1, 1);
            PG8_WAIT_V(8); PG8_WAIT_L(0); PG8_BAR; PG8_MMA(0, 0, At, B0); PG8_MMA(0, 1, At, B1); PG8_BAR; PG8_SCHED;
            PG8_LDA(At, 0, 1); PG8_STAGE(PG8_SB(0, 0), b2, voffB); PG8_STAGE(PG8_SB(0, 1), b2 + hstep, voffB); PG8_STAGE_AS(PG8_SA(0, 0), a2, 0);
            PG8_WAIT_V(8); PG8_WAIT_L(0); PG8_BAR; PG8_MMA(1, 0, At, B0); PG8_MMA(1, 1, At, B1); PG8_BAR; PG8_SCHED;
            PG8_LDB(B0, 1, 0); PG8_LDB(B1, 1, 1); PG8_SCHED; PG8_LDA(At, 1, 0); PG8_STAGE_AS(PG8_SA(0, 1), a2, 1);
            PG8_WAIT_V(8); PG8_WAIT_L(0); PG8_BAR; PG8_MMA(0, 0, At, B0); PG8_MMA(0, 1, At, B1); PG8_BAR; PG8_SCHED;
            PG8_LDA(At, 1, 1); PG8_STAGE(PG8_SB(1, 0), b3, voffB); PG8_STAGE(PG8_SB(1, 1), b3 + hstep, voffB); PG8_STAGE_AS(PG8_SA(1, 0), a3, 0);
            PG8_WAIT_V(8); PG8_WAIT_L(0); PG8_BAR; PG8_MMA(1, 0, At, B0); PG8_MMA(1, 1, At, B1); PG8_BAR; PG8_SCHED;
        }
        if constexpr (ALIGN_EPI) { if (wr == 0) PG8_BAR; }
        E(acc, cur, wr, wc, fr, fq);
        if (!has_next) break;
#pragma unroll
        for (int a = 0; a < 2; ++a)
#pragma unroll
            for (int b = 0; b < 2; ++b)
#pragma unroll
                for (int m = 0; m < 4; ++m)
#pragma unroll
                    for (int n = 0; n < 2; ++n) acc[a][b][m][n] = (f32x4){0.f, 0.f, 0.f, 0.f};
        cur = nxt; cA = nA; cB = nB; ++ui;
        if constexpr (GATHER) {
#pragma unroll
            for (int h = 0; h < 2; ++h)
#pragma unroll
                for (int i = 0; i < 2; ++i) vC[h][i] = vN[h][i]; }
        if constexpr (ALIGN_EPI) { if (wr == 1) PG8_BAR; }
    }
    PG8_WAIT_V(0);
    if constexpr (!ALIGN_EPI) { if (wr == 0) PG8_BAR; }
    PG8_BAR;
#undef PG8_SA
#undef PG8_SB
#undef PG8_STAGE
#undef PG8_STAGE_AC
#undef PG8_STAGE_AS
#undef PG8_LDA
#undef PG8_LDB
#undef PG8_MMA
#undef PG8_WAIT_V
#undef PG8_WAIT_L
#undef PG8_BAR
#undef PG8_SCHED
}
}
#define GAS __attribute__((address_space(1)))
#define LAS __attribute__((address_space(3)))
typedef unsigned short bf16;
typedef short bf16x8 __attribute__((ext_vector_type(8)));
typedef short s16x4 __attribute__((ext_vector_type(4)));
typedef float f32x4 __attribute__((ext_vector_type(4)));
typedef unsigned u32x4 __attribute__((ext_vector_type(4)));
typedef unsigned u32x2 __attribute__((ext_vector_type(2)));
typedef LAS unsigned char* lptr;

constexpr int NWAVES = 8, NTHR = 512;
constexpr size_t MiB = 1u << 20;
constexpr size_t WS_CTL = 0, CTL_ZERO_BYTES = 64 * 1024;
constexpr size_t WS_SMALL = 1 * MiB;
constexpr size_t WS_GATES = 2 * MiB;
constexpr size_t WS_RSG = 2 * MiB + 512 * 1024;
constexpr size_t WS_RS1 = 2 * MiB + 768 * 1024;
constexpr size_t WS_GATE = 3 * MiB;
constexpr size_t WS_TOKIDX = 4 * MiB;
constexpr size_t WS_GATEX = 760 * MiB, WS_RSX = 768 * MiB;
constexpr size_t WS_KC = 776 * MiB;
constexpr size_t WS_WRT = 12 * MiB;
constexpr size_t WS_WINT = 16 * MiB, WS_WOUTT = 22 * MiB, WS_WDNT = 24 * MiB, WS_WUPT = 88 * MiB;
constexpr size_t WS_XN = 216 * MiB;
constexpr size_t WS_PROJ = 248 * MiB;
constexpr size_t WS_CLOC = 344 * MiB;
constexpr size_t WS_CPREV = 376 * MiB;
constexpr size_t WS_MIX = 392 * MiB;
constexpr size_t WS_H = 424 * MiB;
constexpr size_t WS_ACT = 488 * MiB;
constexpr size_t WS_Y = 632 * MiB;
constexpr size_t WS_OPT_END = 760 * MiB;
constexpr int CW_CNT = 64;
constexpr int CW_BAR = 4096;
constexpr int PROJ_LD = 3072;
constexpr int QO = 0, KO = 512, VO = 1024, OO = 1536, UO = 2048, VGO = 2560;
constexpr int RING_BYTES = 131072, VEC_OFF = 131072, VEC_BYTES = 16384, CTL_OFF = VEC_OFF + VEC_BYTES, TTAB_OFF = CTL_OFF, MISC_OFF = CTL_OFF + 2048, LDS_BYTES = MISC_OFF + 256;
constexpr int T0 = 0, T1 = 32768, T2 = 65536, T3 = 98304;

#define RLX_AGENT __ATOMIC_RELAXED, __HIP_MEMORY_SCOPE_AGENT
#define XB_TMO      128
#define XB_XCNT(j)  (256  + 64 * (j))
#define XB_XSUB(j)  (1280 + 64 * (j))
#define XB_XGEN(j)  (2304 + 64 * (j))
#define XB_TOP      3328
#define XB_TOPGEN   3392
#define XCD_BAR_WORDS 3456
#define XB_SPIN_CAP (1u << 18)
__device__ __forceinline__ unsigned xb_ld(unsigned* p)              { return __hip_atomic_load(p, __ATOMIC_RELAXED, __HIP_MEMORY_SCOPE_AGENT); }
__device__ __forceinline__ unsigned xb_add(unsigned* p, unsigned v) { return __hip_atomic_fetch_add(p, v, __ATOMIC_RELAXED, __HIP_MEMORY_SCOPE_AGENT); }
__device__ __forceinline__ unsigned xb_xcc_id() { return (unsigned)__builtin_amdgcn_s_getreg((3 << 11) | 20) & 0xFu; }
#define XB_SPIN(cond, bar) do { unsigned _sp = 0; while (cond) { __builtin_amdgcn_s_sleep(1); \
    if ((++_sp & 255u) == 0u) { if (xb_ld(&(bar)[XB_TMO])) break; if (_sp > XB_SPIN_CAP) { atomicAdd(&(bar)[XB_TMO], 1u); break; } } } } while (0)
struct XcdBarrier { unsigned* bar; unsigned x; volatile LAS unsigned* st; };
__device__ __forceinline__ XcdBarrier xcd_barrier_post(unsigned* bar, volatile LAS unsigned* st) {
    XcdBarrier b; b.bar = bar; b.x = xb_xcc_id(); b.st = st;
    if (threadIdx.x == 0) (void)xb_add(&bar[XB_XCNT(b.x)], 1u);
    return b;
}
__device__ __forceinline__ void xcd_barrier_complete(unsigned* bar, unsigned x, unsigned& nloc, unsigned& nx) {
    const unsigned G = gridDim.x * gridDim.y * gridDim.z;
    unsigned sum, cnt, mine, sp = 0u;
    for (;;) {
        sum = 0u; cnt = 0u; mine = 0u;
#pragma unroll
        for (unsigned j = 0; j < 16; ++j) { const unsigned c = xb_ld(&bar[XB_XCNT(j)]); sum += c; cnt += (c > 0u) ? 1u : 0u; mine = (j == x) ? c : mine; }
        if (sum == G) break;
        __builtin_amdgcn_s_sleep(1);
        if ((++sp & 255u) == 0u) { if (xb_ld(&bar[XB_TMO])) break; if (sp > XB_SPIN_CAP) { atomicAdd(&bar[XB_TMO], 1u); break; } }
    }
    nloc = mine > 0u ? mine : 1u; nx = cnt > 0u ? cnt : 1u;
}
__device__ __forceinline__ void xcd_barrier(const XcdBarrier& b) {
    asm volatile("s_waitcnt vmcnt(0)" ::: "memory");
    __syncthreads();
    if (threadIdx.x == 0) {
        unsigned* bar = b.bar;
        __builtin_amdgcn_s_waitcnt(0);
        unsigned nloc = b.st[0], nx = b.st[1];
        if (nloc == 0u) { xcd_barrier_complete(bar, b.x, nloc, nx); b.st[0] = nloc; b.st[1] = nx; }
        const unsigned old = xb_add(&bar[XB_XSUB(b.x)], 1u);
        const unsigned gen = old / nloc;
        if (old + 1u == (gen + 1u) * nloc) {
            __builtin_amdgcn_fence(__ATOMIC_RELEASE, "agent");
            asm volatile("s_waitcnt vmcnt(0)" ::: "memory");
            const unsigned og = xb_add(&bar[XB_TOP], 1u);
            const unsigned tg = og / nx;
            if (og + 1u == (tg + 1u) * nx) xb_add(&bar[XB_TOPGEN], 1u);
            else XB_SPIN(xb_ld(&bar[XB_TOPGEN]) == tg, bar);
            __builtin_amdgcn_fence(__ATOMIC_ACQUIRE, "agent");
            xb_add(&bar[XB_XGEN(b.x)], 1u);
            asm volatile("s_waitcnt vmcnt(0)" ::: "memory");
        } else {
            XB_SPIN(xb_ld(&bar[XB_XGEN(b.x)]) == gen, bar);
            __builtin_amdgcn_fence(__ATOMIC_ACQUIRE, "agent");
            asm volatile("s_waitcnt vmcnt(0)" ::: "memory");
        }
    }
    __syncthreads();
}

__device__ __forceinline__ float bf2f(unsigned short h) { return __builtin_bit_cast(float, (unsigned)h << 16); }
__device__ __forceinline__ unsigned f2bf(float f) { unsigned u = __builtin_bit_cast(unsigned, f); return (u + 0x7fffu + ((u >> 16) & 1u)) >> 16; }
__device__ __forceinline__ unsigned pk2(float lo, float hi) { return pg8::cvt_pk_bf16(lo, hi); }
__device__ __forceinline__ float fexp(float x) { return __builtin_amdgcn_exp2f(x * 1.4426950408889634f); }
__device__ __forceinline__ float fsigmoid(float x) { return __builtin_amdgcn_rcpf(1.0f + fexp(-x)); }
__device__ __forceinline__ float fgelu(float x) {
    const float u = 1.5957691216057308f * (x + 0.044715f * x * x * x);
    return x * fsigmoid(u);
}
__device__ __forceinline__ float wsum_all(float v) {
#pragma unroll
    for (int o = 32; o > 0; o >>= 1) v += __shfl_xor(v, o);
    return v;
}
__device__ __forceinline__ void unpack8(const u32x4 w, float (&f)[8]) {
    f[0] = __builtin_bit_cast(float, w.x << 16); f[1] = __builtin_bit_cast(float, w.x & 0xffff0000u);
    f[2] = __builtin_bit_cast(float, w.y << 16); f[3] = __builtin_bit_cast(float, w.y & 0xffff0000u);
    f[4] = __builtin_bit_cast(float, w.z << 16); f[5] = __builtin_bit_cast(float, w.z & 0xffff0000u);
    f[6] = __builtin_bit_cast(float, w.w << 16); f[7] = __builtin_bit_cast(float, w.w & 0xffff0000u);
}
__device__ __forceinline__ u32x4 pack8(const float (&f)[8]) { u32x4 w; w.x = pk2(f[0], f[1]); w.y = pk2(f[2], f[3]); w.z = pk2(f[4], f[5]); w.w = pk2(f[6], f[7]); return w; }

__device__ __forceinline__ unsigned off_b(unsigned row, unsigned ch) { return 256u * row + 16u * (ch ^ (((row & 3u) << 2) | ((row >> 2) & 3u))); }
__device__ __forceinline__ bf16x8 frag_row(lptr T, int r0, int ks, int lane) { return *(const LAS bf16x8*)(T + off_b((unsigned)(r0 + (lane & 15)), (unsigned)(4 * ks + (lane >> 4)))); }
__device__ __forceinline__ bf16x8 frag_tr(lptr T, int c, int ks, int lane) {
    const unsigned g = lane >> 4, q = (lane & 15) >> 2, p = lane & 3;
    const unsigned a0 = off_b(32u * ks + 8u * g + q, 2u * c + (p >> 1)) + 8u * (p & 1);
    const unsigned a1 = off_b(32u * ks + 8u * g + 4u + q, 2u * c + (p >> 1)) + 8u * (p & 1);
    const s16x4 lo = __builtin_amdgcn_ds_read_tr16_b64_v4i16((LAS s16x4*)(T + a0));
    const s16x4 hi = __builtin_amdgcn_ds_read_tr16_b64_v4i16((LAS s16x4*)(T + a1));
    return __builtin_shufflevector(lo, hi, 0, 1, 2, 3, 4, 5, 6, 7);
}
#define MFMA16(a, b, c) __builtin_amdgcn_mfma_f32_16x16x32_bf16(a, b, c, 0, 0, 0)

#ifndef PROBE_SEC
#define PROBE_SEC -1
#endif
#define SEC_BEGIN(F, id) do { if (PROBE_SEC == (id)) { __syncthreads(); (F).t0 = __builtin_amdgcn_s_memrealtime(); } } while (0)
#define SEC_END(F, id) do { if (PROBE_SEC == (id)) { __syncthreads(); (F).tsec += __builtin_amdgcn_s_memrealtime() - (F).t0; } } while (0)
struct Frame {
    unsigned long long t0, tsec;
    lptr lds; int tid, lane, wave, G, vcu;
    const float* in[20]; float* out; unsigned char* ws;
};

template <bool SCALE>
__device__ __forceinline__ void stage_tile(const Frame& F, lptr T, const bf16* src, int ld, const LAS float* rowscale) {
    const int cg = F.tid & 15, sb = F.tid >> 4;
    u32x4 w[4];
#pragma unroll
    for (int r = 0; r < 4; ++r) w[r] = *(const u32x4*)(src + (size_t)(4 * sb + r) * ld + 8 * cg);
#pragma unroll
    for (int r = 0; r < 4; ++r) { const int s = 4 * sb + r;
        if (SCALE) { float f[8]; unpack8(w[r], f); const float sc = rowscale[s];
#pragma unroll
            for (int i = 0; i < 8; ++i) f[i] *= sc;
            w[r] = pack8(f); }
        *(LAS u32x4*)(T + off_b(s, cg)) = w[r]; }
}
__device__ __forceinline__ void stage_conv(const Frame& F, lptr T, const bf16* src, const LAS float* cw, int tpos, float scale, u32x4 (&out)[4]) {
    const int cg = F.tid & 15, sb = F.tid >> 4;
    u32x4 w[7];
#pragma unroll
    for (int j = 0; j < 7; ++j) { const int s = 4 * sb - 3 + j; w[j] = (tpos + s >= 0) ? *(const u32x4*)(src + (ptrdiff_t)s * PROJ_LD + 8 * cg) : (u32x4){0u, 0u, 0u, 0u}; }
#pragma unroll
    for (int hf = 0; hf < 2; ++hf) {
        f32x4 tp4[4];
#pragma unroll
        for (int tp = 0; tp < 4; ++tp) tp4[tp] = *(const LAS f32x4*)(cw + tp * 128 + 8 * cg + 4 * hf);
        float a[4][4];
#pragma unroll
        for (int r = 0; r < 4; ++r)
#pragma unroll
            for (int i = 0; i < 4; ++i) a[r][i] = 0.f;
#pragma unroll
        for (int j = 0; j < 7; ++j) { const unsigned u0 = hf ? w[j].z : w[j].x, u1 = hf ? w[j].w : w[j].y;
            const float f[4] = {__builtin_bit_cast(float, u0 << 16), __builtin_bit_cast(float, u0 & 0xffff0000u), __builtin_bit_cast(float, u1 << 16), __builtin_bit_cast(float, u1 & 0xffff0000u)};
#pragma unroll
            for (int r = 0; r < 4; ++r) { const int tp = j - r; if (tp >= 0 && tp < 4) {
#pragma unroll
                for (int i = 0; i < 4; ++i) a[r][i] += tp4[tp][i] * f[i]; } } }
#pragma unroll
        for (int r = 0; r < 4; ++r) {
#pragma unroll
            for (int i = 0; i < 4; ++i) a[r][i] = a[r][i] * fsigmoid(a[r][i]) * scale;
            const unsigned p0 = pk2(a[r][0], a[r][1]), p1 = pk2(a[r][2], a[r][3]);
            if (hf == 0) { out[r].x = p0; out[r].y = p1; } else { out[r].z = p0; out[r].w = p1; } }
        __builtin_amdgcn_sched_barrier(0);
    }
#pragma unroll
    for (int r = 0; r < 4; ++r) *(LAS u32x4*)(T + off_b(4 * sb + r, cg)) = out[r];
}
__device__ __forceinline__ void p0_item(const float* Wsrc, int ld, bf16* dst, int Kd, LAS float* scr, int lane) {
#pragma unroll 8
    for (int i = 0; i < 32; ++i) { const int kk = 2 * i + (lane >> 5); scr[kk * 33 + (lane & 31)] = Wsrc[(size_t)kk * ld + (lane & 31)]; }
    asm volatile("s_waitcnt lgkmcnt(0)" ::: "memory");
    const int c = lane & 7;
#pragma unroll
    for (int j = 0; j < 4; ++j) { const int n = (lane >> 3) + 8 * j; const LAS float* s = scr + (8 * c) * 33 + n;
        u32x4 o; o.x = pk2(s[0 * 33], s[1 * 33]); o.y = pk2(s[2 * 33], s[3 * 33]); o.z = pk2(s[4 * 33], s[5 * 33]); o.w = pk2(s[6 * 33], s[7 * 33]);
        *(u32x4*)(dst + (size_t)n * Kd + 8 * c) = o; }
    asm volatile("s_waitcnt lgkmcnt(0)" ::: "memory");
}
__device__ __forceinline__ void p0_item_split(const float* Wsrc, int ld, bf16* dhi, bf16* dlo, int Kd, LAS float* scr, int lane) {
#pragma unroll 8
    for (int i = 0; i < 32; ++i) { const int kk = 2 * i + (lane >> 5); scr[kk * 33 + (lane & 31)] = Wsrc[(size_t)kk * ld + (lane & 31)]; }
    asm volatile("s_waitcnt lgkmcnt(0)" ::: "memory");
    const int c = lane & 7;
#pragma unroll
    for (int j = 0; j < 4; ++j) { const int n = (lane >> 3) + 8 * j; const LAS float* s = scr + (8 * c) * 33 + n;
        float v[8], l[8];
#pragma unroll
        for (int i = 0; i < 8; ++i) { v[i] = s[i * 33]; l[i] = v[i] - bf2f((unsigned short)f2bf(v[i])); }
        *(u32x4*)(dhi + (size_t)n * Kd + 8 * c) = pack8(v); *(u32x4*)(dlo + (size_t)n * Kd + 8 * c) = pack8(l); }
    asm volatile("s_waitcnt lgkmcnt(0)" ::: "memory");
}

struct P0Item { const float* src; bf16* dst; int ld; };
__device__ __forceinline__ void p0_load(const P0Item& it, int lane, f32x4 (&v)[8]) {
    const float* p = it.src + (size_t)(8 * (lane & 7)) * it.ld + 4 * (lane >> 3);
#pragma unroll
    for (int j = 0; j < 8; ++j) v[j] = __builtin_nontemporal_load((const f32x4*)(p + (size_t)j * it.ld));
}
__device__ __forceinline__ void p0_store(const P0Item& it, int lane, const f32x4 (&v)[8]) {
    bf16* q = it.dst + (size_t)(4 * (lane >> 3)) * 1024 + 8 * (lane & 7);
#pragma unroll
    for (int i = 0; i < 4; ++i) { u32x4 o; o.x = pk2(v[0][i], v[1][i]); o.y = pk2(v[2][i], v[3][i]); o.z = pk2(v[4][i], v[5][i]); o.w = pk2(v[6][i], v[7][i]);
        *(u32x4*)(q + (size_t)i * 1024) = o; }
}
constexpr int IMG_ROW = 2064;
template <int NF>
__device__ __forceinline__ float row_pass(const float* X, const float* gain, bf16* XNout, lptr img_hi, lptr img_lo, int tok0, int lane, f32x4 (&acc)[NF]) {
    const int r = lane & 7, g = lane >> 4;
    const float* xr = X + (size_t)(tok0 + r) * 1024 + 8 * g;
    float ss = 0.f;
#pragma unroll
    for (int nf = 0; nf < NF; ++nf) acc[nf] = (f32x4){0.f, 0.f, 0.f, 0.f};
    bf16* orow = XNout + (size_t)(tok0 + r) * 1024 + 8 * g;
#pragma unroll 8
    for (int ks = 0; ks < 32; ++ks) { const f32x4 a = __builtin_nontemporal_load((const f32x4*)(xr + 32 * ks)), b = __builtin_nontemporal_load((const f32x4*)(xr + 32 * ks + 4));
        ss += (a[0] * a[0] + a[1] * a[1]) + (a[2] * a[2] + a[3] * a[3]) + (b[0] * b[0] + b[1] * b[1]) + (b[2] * b[2] + b[3] * b[3]);
        const f32x4 ga = *(const f32x4*)(gain + 32 * ks + 8 * g), gb = *(const f32x4*)(gain + 32 * ks + 8 * g + 4);
        float v[8], l[8];
#pragma unroll
        for (int i = 0; i < 4; ++i) { v[i] = a[i] * ga[i]; v[4 + i] = b[i] * gb[i]; }
        const u32x4 hi = pack8(v);
        { float h[8]; unpack8(hi, h);
#pragma unroll
          for (int i = 0; i < 8; ++i) l[i] = v[i] - h[i]; }
        const u32x4 lo = pack8(l);
        if ((lane & 8) == 0) *(u32x4*)(orow + 32 * ks) = hi;
        const bf16x8 ahi = __builtin_bit_cast(bf16x8, hi), alo = __builtin_bit_cast(bf16x8, lo);
#pragma unroll
        for (int nf = 0; nf < NF; ++nf) { const unsigned bo = (unsigned)(16 * nf + (lane & 15)) * IMG_ROW + 64u * ks + 16u * g;
            const bf16x8 bhi = *(const LAS bf16x8*)(img_hi + bo), blo = *(const LAS bf16x8*)(img_lo + bo);
            acc[nf] = MFMA16(ahi, bhi, acc[nf]); acc[nf] = MFMA16(ahi, blo, acc[nf]); acc[nf] = MFMA16(alo, bhi, acc[nf]); } }
    ss += __shfl_xor(ss, 16); ss += __shfl_xor(ss, 32);
    return 1.0f / sqrtf(ss * (1.0f / 1024.0f) + 1e-6f);
}

__device__ __forceinline__ void phase0(Frame& F) {
    const float* x = F.in[0]; const float* g1 = F.in[1]; const float* w_in = F.in[2]; const float* b_i = F.in[4]; const float* b_f = F.in[5];
    const float* w_out = F.in[11]; const float* wr = F.in[13]; const float* w_up = F.in[15]; const float* w_dn = F.in[17];
    bf16* WinT = (bf16*)(F.ws + WS_WINT); bf16* WoutT = (bf16*)(F.ws + WS_WOUTT); bf16* WdnT = (bf16*)(F.ws + WS_WDNT); bf16* WupT = (bf16*)(F.ws + WS_WUPT);
    bf16* WrThi = (bf16*)(F.ws + WS_WRT); bf16* WrTlo = WrThi + 32 * 1024;
    bf16* XN = (bf16*)(F.ws + WS_XN); float* GATES = (float*)(F.ws + WS_GATES); float* RS1 = (float*)(F.ws + WS_RS1);
    lptr ghi = F.lds + T0, glo = F.lds + T0 + 16 * IMG_ROW;
    SEC_BEGIN(F, 1);
#pragma unroll
    for (int q = 0; q < 2; ++q) { const int kk = F.tid + NTHR * q; const f32x4 a = *(const f32x4*)(w_in + (size_t)kk * 3080 + 2048), b = *(const f32x4*)(w_in + (size_t)kk * 3080 + 2052);
        const float v[8] = {a[0], a[1], a[2], a[3], b[0], b[1], b[2], b[3]};
#pragma unroll
        for (int j = 0; j < 8; ++j) { const unsigned h = f2bf(v[j]); const float l = v[j] - bf2f((unsigned short)h);
            *(LAS unsigned short*)(ghi + j * IMG_ROW + 2 * kk) = (unsigned short)h; *(LAS unsigned short*)(glo + j * IMG_ROW + 2 * kk) = (unsigned short)f2bf(l); } }
    __syncthreads();
    SEC_END(F, 1); SEC_BEGIN(F, 2);
    { const int tok0 = F.vcu * 64 + F.wave * 8; f32x4 acc[1];
      const float rstd = row_pass<1>(x, g1, XN, ghi, glo, tok0, F.lane, acc);
      if (F.lane < 8) RS1[tok0 + F.lane] = rstd;
      const int j = F.lane & 15, gq = F.lane >> 4;
      float rr[4];
#pragma unroll
      for (int rg = 0; rg < 4; ++rg) rr[rg] = __shfl(rstd, (4 * gq + rg) & 7);
      if (j < 8 && gq < 2) {
#pragma unroll
          for (int rg = 0; rg < 4; ++rg) { const int tok = tok0 + 4 * gq + rg; float v = acc[0][rg] * rr[rg];
              if (j < 4) v += b_i[j]; else { v += b_f[j - 4]; v = fminf(v, 0.f) - log1pf(expf(-fabsf(v))); }
              GATES[(size_t)tok * 8 + j] = v; } } }
    __syncthreads();
    SEC_END(F, 2); SEC_BEGIN(F, 3);
    const float* b_unused = nullptr; (void)b_unused;
    const int gw = F.vcu * NWAVES + F.wave, NGW = F.G * NWAVES;
    if (gw < 16) { LAS float* scr = (LAS float*)(F.lds + T0 + F.wave * 16384); p0_item_split(wr + (size_t)(64 * gw) * 32, 32, WrThi + 64 * gw, WrTlo + 64 * gw, 1024, scr, F.lane); }
    constexpr int I_IN = 16 * 96, I_OUT = 16 * 32, I_DN = 32 * 16 * 32, I_UP = 32 * 16 * 64, NITEMS = I_IN + I_OUT + I_DN + I_UP;
    auto decode = [&](int it) -> P0Item {
        int r = it; P0Item o;
        if (r < I_IN) { const int kb = r / 96, nb = r % 96, nd = 32 * nb, nsrc = nd < 2048 ? nd : nd + 8;
            o.src = w_in + (size_t)(64 * kb) * 3080 + nsrc; o.ld = 3080; o.dst = WinT + (size_t)nd * 1024 + 64 * kb; return o; } r -= I_IN;
        if (r < I_OUT) { const int kb = r / 32, nb = r % 32;
            o.src = w_out + (size_t)(64 * kb) * 1024 + 32 * nb; o.ld = 1024; o.dst = WoutT + (size_t)(32 * nb) * 1024 + 64 * kb; return o; } r -= I_OUT;
        if (r < I_DN) { const int e = r / 512, q = r % 512, kb = q / 32, nb = q % 32;
            o.src = w_dn + ((size_t)e * 1024 + 64 * kb) * 1024 + 32 * nb; o.ld = 1024; o.dst = WdnT + ((size_t)e * 1024 + 32 * nb) * 1024 + 64 * kb; return o; } r -= I_DN;
        { const int e = r / 1024, q = r % 1024, kb = q / 64, nb = q % 64, n = 32 * nb, half = n >> 10, jj = n & 1023, pn = jj >> 7, j = jj & 127, nd = 256 * pn + 128 * half + j;
          o.src = w_up + ((size_t)e * 1024 + 64 * kb) * 2048 + n; o.ld = 2048; o.dst = WupT + ((size_t)e * 2048 + nd) * 1024 + 64 * kb; return o; }
    };
    for (int it = gw; it < NITEMS; it += 2 * NGW) {
        const bool two = it + NGW < NITEMS;
        const P0Item ia = decode(it), ib = decode(two ? it + NGW : it);
        f32x4 va[8], vb[8];
        p0_load(ia, F.lane, va); p0_load(ib, F.lane, vb);
        p0_store(ia, F.lane, va); if (two) p0_store(ib, F.lane, vb);
    }
    SEC_END(F, 3);
}

__device__ __forceinline__ float wscan_add(float v, int lane) {
#pragma unroll
    for (int o = 1; o < 64; o <<= 1) { const float t = __shfl_up(v, o); if (lane >= o) v += t; }
    return v;
}
__device__ __forceinline__ float wscan_max(float v, int lane) {
#pragma unroll
    for (int o = 1; o < 64; o <<= 1) { const float t = __shfl_up(v, o); if (lane >= o) v = fmaxf(v, t); }
    return v;
}
__device__ __forceinline__ float wmax_all(float v) {
#pragma unroll
    for (int o = 32; o > 0; o >>= 1) v = fmaxf(v, __shfl_xor(v, o));
    return v;
}

__device__ __forceinline__ void mlstm_local_unit(Frame& F0, int u) {
    Frame F = F0; asm volatile("" : "+v"(F.tid), "+v"(F.lane));
    const int c = u & 63, h = (u >> 6) & 3, b = u >> 8, row0 = b * 8192 + c * 128;
    const bf16* PROJ = (const bf16*)(F.ws + WS_PROJ); const float* GATES = (const float*)(F.ws + WS_GATES); const float* conv = F.in[3];
    float* CLOC = (float*)(F.ws + WS_CLOC); float* MLOC = (float*)(F.ws + WS_SMALL); float* BLAST = MLOC + 512; float* NLOC = MLOC + 2048; bf16* KC = (bf16*)(F.ws + WS_KC);
    LAS float* wv = (LAS float*)(F.lds + VEC_OFF);
    LAS float* cw = wv + 128;
    LAS float* part = cw + 512;
    const int lane = F.lane, w = F.wave;
    SEC_BEGIN(F, 10);
#pragma unroll
    for (int j = 0; j < 8; ++j) { const int i = lane + 64 * j; cw[i] = conv[(i >> 7) * 1024 + 512 + h * 128 + (i & 127)]; }
    { const int l = lane, s0 = 2 * l, s1 = s0 + 1;
        const float li0 = GATES[(size_t)(row0 + s0) * 8 + h], li1 = GATES[(size_t)(row0 + s1) * 8 + h], lf0 = GATES[(size_t)(row0 + s0) * 8 + 4 + h], lf1 = GATES[(size_t)(row0 + s1) * 8 + 4 + h];
        const float inc = wscan_add(lf0 + lf1, l), b1 = inc, b0 = inc - lf1, blast = __shfl(inc, 63);
        const float g0 = blast - b0 + li0, g1 = blast - b1 + li1, mloc = wmax_all(fmaxf(g0, g1));
        wv[s0] = fexp(g0 - mloc); wv[s1] = fexp(g1 - mloc);
        if (l == 0 && w == 0) { MLOC[u] = mloc; BLAST[u] = blast; } }
    SEC_END(F, 10); SEC_BEGIN(F, 11);
    { u32x4 kv[4]; const int cg = F.tid & 15, sb = F.tid >> 4;
      stage_conv(F, F.lds + T1, PROJ + (size_t)row0 * PROJ_LD + KO + h * 128, cw, c * 128, 0.08838834764831845f, kv);
      float pn[8];
#pragma unroll
      for (int i = 0; i < 8; ++i) pn[i] = 0.f;
#pragma unroll
      for (int r = 0; r < 4; ++r) { *(u32x4*)(KC + (size_t)(row0 + 4 * sb + r) * 512 + h * 128 + 8 * cg) = kv[r];
          float f[8]; unpack8(kv[r], f); const float ws = wv[4 * sb + r];
#pragma unroll
          for (int i = 0; i < 8; ++i) pn[i] += ws * f[i]; }
#pragma unroll
      for (int i = 0; i < 8; ++i) { pn[i] += __shfl_xor(pn[i], 16); pn[i] += __shfl_xor(pn[i], 32); }
      if (lane < 16) { *(LAS f32x4*)(part + w * 128 + 8 * cg) = (f32x4){pn[0], pn[1], pn[2], pn[3]}; *(LAS f32x4*)(part + w * 128 + 8 * cg + 4) = (f32x4){pn[4], pn[5], pn[6], pn[7]}; } }
    stage_tile<true>(F, F.lds + T2, PROJ + (size_t)row0 * PROJ_LD + VO + h * 128, PROJ_LD, wv);
    __syncthreads();
    SEC_END(F, 11); SEC_BEGIN(F, 12);
    { f32x4 acc[8];
#pragma unroll
      for (int kb = 0; kb < 8; ++kb) acc[kb] = (f32x4){0.f, 0.f, 0.f, 0.f};
#pragma unroll
      for (int ks = 0; ks < 4; ++ks) { const bf16x8 a = frag_tr(F.lds + T2, w, ks, lane);
#pragma unroll
          for (int kb = 0; kb < 8; ++kb) { const bf16x8 bb = frag_tr(F.lds + T1, kb, ks, lane); acc[kb] = MFMA16(a, bb, acc[kb]); } }
      float* cl = CLOC + (size_t)u * 16384 + (size_t)(16 * w + 4 * (lane >> 4)) * 128 + (lane & 15);
#pragma unroll
      for (int kb = 0; kb < 8; ++kb)
#pragma unroll
          for (int rg = 0; rg < 4; ++rg) cl[rg * 128 + 16 * kb] = acc[kb][rg]; }
    if (F.tid < 128) { float a = 0.f;
#pragma unroll
        for (int ww = 0; ww < 8; ++ww) a += part[ww * 128 + F.tid];
        NLOC[(size_t)u * 128 + F.tid] = a; }
    __syncthreads();
    SEC_END(F, 12);
    F0.tsec = F.tsec;
}

__device__ __forceinline__ void gmlp_unit(Frame& F0, int ug) {
    Frame F = F0; asm volatile("" : "+v"(F.tid), "+v"(F.lane));
    const int g = ug & 3, row0 = (ug >> 2) * 128;
    const bf16* PROJ = (const bf16*)(F.ws + WS_PROJ); bf16* MIX = (bf16*)(F.ws + WS_MIX);
    const float* lng = F.in[7]; const float* wsp = F.in[8]; const float* bsp = F.in[9]; const float* og = F.in[10]; float* PSSQ = (float*)(F.ws + WS_RSG);
    LAS float* st_mean = (LAS float*)(F.lds + VEC_OFF); LAS float* st_rstd = st_mean + 128;
    const int w = F.wave, lane = F.lane;
    SEC_BEGIN(F, 20);
    { const int t = F.tid >> 2, q = F.tid & 3; const bf16* vp = PROJ + (size_t)(row0 + t) * PROJ_LD + VGO + 128 * q;
      float s = 0.f, s2 = 0.f;
#pragma unroll 8
      for (int j = 0; j < 16; ++j) { float f[8]; unpack8(*(const u32x4*)(vp + 8 * j), f);
#pragma unroll
          for (int i = 0; i < 8; ++i) { s += f[i]; s2 += f[i] * f[i]; } }
      s += __shfl_xor(s, 1); s += __shfl_xor(s, 2); s2 += __shfl_xor(s2, 1); s2 += __shfl_xor(s2, 2);
      const float mean = s * (1.0f / 512.0f), var = fmaxf(s2 * (1.0f / 512.0f) - mean * mean, 0.f);
      if (q == 0) { st_mean[t] = mean; st_rstd[t] = 1.0f / sqrtf(var + 1e-6f); } }
    __syncthreads();
    SEC_END(F, 20); SEC_BEGIN(F, 21);
    { const int cg = F.tid & 15, sb = F.tid >> 4;
      const f32x4 l0 = *(const f32x4*)(lng + g * 128 + 8 * cg), l1 = *(const f32x4*)(lng + g * 128 + 8 * cg + 4);
      u32x4 vv[4], uu[4]; f32x4 wa[4], wb[4];
#pragma unroll
      for (int r = 0; r < 4; ++r) { const int t = 4 * sb + r;
          vv[r] = *(const u32x4*)(PROJ + (size_t)(row0 + t) * PROJ_LD + VGO + g * 128 + 8 * cg); uu[r] = *(const u32x4*)(PROJ + (size_t)(row0 + t) * PROJ_LD + UO + g * 128 + 8 * cg);
          const float* wp = wsp + ((size_t)(g * 128 + t)) * 128 + 8 * cg; wa[r] = *(const f32x4*)wp; wb[r] = *(const f32x4*)(wp + 4); }
#pragma unroll
      for (int r = 0; r < 4; ++r) { const int t = 4 * sb + r;
          float f[8] = {wa[r][0], wa[r][1], wa[r][2], wa[r][3], wb[r][0], wb[r][1], wb[r][2], wb[r][3]};
#pragma unroll
          for (int kk = 0; kk < 8; ++kk) if (8 * cg + kk > t) f[kk] = 0.f;
          *(LAS u32x4*)(F.lds + T0 + off_b(t, cg)) = pack8(f);
          float v[8]; unpack8(vv[r], v); const float mean = st_mean[t], rstd = st_rstd[t];
#pragma unroll
          for (int kk = 0; kk < 8; ++kk) v[kk] = (v[kk] - mean) * rstd * (kk < 4 ? l0[kk] : l1[kk - 4]);
          *(LAS u32x4*)(F.lds + T1 + off_b(t, cg)) = pack8(v);
          *(LAS u32x4*)(F.lds + T2 + off_b(t, cg)) = uu[r]; } }
    __syncthreads();
    SEC_END(F, 21); SEC_BEGIN(F, 22);
    f32x4 acc[8];
#pragma unroll
    for (int db = 0; db < 8; ++db) acc[db] = (f32x4){0.f, 0.f, 0.f, 0.f};
    for (int ks = 0; ks <= (w >> 1); ++ks) { const bf16x8 a = frag_row(F.lds + T0, 16 * w, ks, lane);
#pragma unroll
        for (int db = 0; db < 8; ++db) { const bf16x8 bb = frag_tr(F.lds + T1, db, ks, lane); acc[db] = MFMA16(a, bb, acc[db]); } }
    float ssq[4] = {0.f, 0.f, 0.f, 0.f}; float ogv[8];
#pragma unroll
    for (int db = 0; db < 8; ++db) ogv[db] = og[g * 128 + 16 * db + (lane & 15)];
#pragma unroll
    for (int rg = 0; rg < 4; ++rg) { int t = 16 * w + 4 * (lane >> 4) + rg; const float bs = bsp[g * 128 + t]; asm volatile("" : "+v"(t));
#pragma unroll
        for (int db = 0; db < 8; ++db) { const int d = 16 * db + (lane & 15);
            const float gu = bf2f(*(const LAS unsigned short*)(F.lds + T2 + off_b(t, d >> 3) + 2 * (d & 7)));
            const float val = (acc[db][rg] + bs) * gu; ssq[rg] += val * val;
            *(LAS unsigned short*)(F.lds + T3 + off_b(t, d >> 3) + 2 * (d & 7)) = (unsigned short)(pk2(val * ogv[db], 0.f) & 0xffffu); } }
#pragma unroll
    for (int i = 0; i < 4; ++i) { const int id = lane + 64 * i, r = id >> 4, ch = id & 15, t = 16 * w + r;
        *(u32x4*)(MIX + (size_t)(row0 + t) * 1024 + 512 + g * 128 + 8 * ch) = *(const LAS u32x4*)(F.lds + T3 + off_b(t, ch)); }
#pragma unroll
    for (int rg = 0; rg < 4; ++rg) { float q = ssq[rg]; q += __shfl_xor(q, 1); q += __shfl_xor(q, 2); q += __shfl_xor(q, 4); q += __shfl_xor(q, 8);
        if ((lane & 15) == 0) PSSQ[(size_t)g * 16384 + row0 + 16 * w + 4 * (lane >> 4) + rg] = q; }
    __syncthreads();
    SEC_END(F, 22);
    F0.tsec = F.tsec;
}

__device__ __forceinline__ void phase_scan(const Frame& F) {
    const float* CLOC = (const float*)(F.ws + WS_CLOC); float* MLOC = (float*)(F.ws + WS_SMALL); float* BLAST = MLOC + 512; float* MPREV = MLOC + 1024;
    float* NLOC = MLOC + 2048; float* NPREV = NLOC + 512 * 128; bf16* CPREV = (bf16*)(F.ws + WS_CPREV);
    LAS float* av = (LAS float*)(F.lds + VEC_OFF); LAS float* cv = av + 64;
    const int wg = F.vcu, bh = wg >> 5;
    if (F.wave == 0) { const int l = F.lane; const float ml = MLOC[bh * 64 + l], bl = BLAST[bh * 64 + l];
        float m = 0.f, mym = 0.f, mynext = 0.f;
        for (int c = 0; c < 64; ++c) { const float mlc = __shfl(ml, c), blc = __shfl(bl, c); const float mn = fmaxf(blc + m, mlc); if (l == c) { mym = m; mynext = mn; } m = mn; }
        av[l] = fexp(bl + mym - mynext); cv[l] = fexp(ml - mynext);
        if ((wg & 31) == 0) MPREV[bh * 64 + l] = mym; }
    __syncthreads();
    if (F.tid < 256) { const int p = (wg & 31) * 256 + F.tid; float v0 = 0.f, v1 = 0.f;
        const float* src = CLOC + (size_t)(bh * 64) * 16384 + 2 * p; bf16* dst = CPREV + (size_t)(bh * 64) * 16384 + 2 * p;
#pragma unroll 8
        for (int c = 0; c < 64; ++c) { const float2 x = *(const float2*)(src + (size_t)c * 16384);
            *(unsigned*)(dst + (size_t)c * 16384) = pk2(v0, v1);
            const float a = av[c], cc = cv[c]; v0 = a * v0 + cc * x.x; v1 = a * v1 + cc * x.y; } }
    else if (F.tid < 320 && (wg & 31) == 0) { const int p = F.tid - 256; float v0 = 0.f, v1 = 0.f;
        for (int c = 0; c < 64; ++c) { const float2 x = *(const float2*)(NLOC + (size_t)(bh * 64 + c) * 128 + 2 * p);
            *(float2*)(NPREV + (size_t)(bh * 64 + c) * 128 + 2 * p) = make_float2(v0, v1);
            const float a = av[c], cc = cv[c]; v0 = a * v0 + cc * x.x; v1 = a * v1 + cc * x.y; } }
    __syncthreads();
}

__device__ __forceinline__ void mlstm_out_unit(Frame& F0, int u) {
    Frame F = F0; asm volatile("" : "+v"(F.tid), "+v"(F.lane));
    const int c = u & 63, h = (u >> 6) & 3, b = u >> 8, row0 = b * 8192 + c * 128;
    const bf16* PROJ = (const bf16*)(F.ws + WS_PROJ); const float* GATES = (const float*)(F.ws + WS_GATES); const float* conv = F.in[3]; const float* ngain = F.in[6];
    const float* MPREV = (const float*)(F.ws + WS_SMALL) + 1024; const float* NPREV = (const float*)(F.ws + WS_SMALL) + 2048 + 512 * 128;
    const bf16* CPREV = (const bf16*)(F.ws + WS_CPREV); bf16* MIX = (bf16*)(F.ws + WS_MIX);
    LAS float* colc = (LAS float*)(F.lds + VEC_OFF); LAS float* rowc = colc + 128; LAS float* inter = rowc + 128; LAS float* emn = inter + 128; LAS float* rdn = emn + 128;
    LAS float* npv = rdn + 128; LAS float* cw = npv + 128;
    const int w = F.wave, lane = F.lane;
    SEC_BEGIN(F, 30);
#pragma unroll
    for (int j = 0; j < 8; ++j) { const int i = lane + 64 * j; cw[i] = conv[(i >> 7) * 1024 + h * 128 + (i & 127)]; }
    npv[lane] = NPREV[(size_t)u * 128 + lane]; npv[64 + lane] = NPREV[(size_t)u * 128 + 64 + lane];
    { const int l = lane, s0 = 2 * l, s1 = s0 + 1;
        const float li0 = GATES[(size_t)(row0 + s0) * 8 + h], li1 = GATES[(size_t)(row0 + s1) * 8 + h], lf0 = GATES[(size_t)(row0 + s0) * 8 + 4 + h], lf1 = GATES[(size_t)(row0 + s1) * 8 + 4 + h];
        const float inc = wscan_add(lf0 + lf1, l), b1 = inc, b0 = inc - lf1;
        const float c0 = li0 - b0, c1 = li1 - b1;
        const float pmx = wscan_max(fmaxf(c0, c1), l); float pprev = __shfl_up(pmx, 1); if (l == 0) pprev = -INFINITY;
        const float pm0 = fmaxf(pprev, c0), pm1 = pmx, mprev = MPREV[u];
        const float m0 = b0 + fmaxf(mprev, pm0), m1 = b1 + fmaxf(mprev, pm1);
        colc[s0] = c0; colc[s1] = c1; rowc[s0] = b0 - m0; rowc[s1] = b1 - m1;
        inter[s0] = fexp(b0 + mprev - m0); inter[s1] = fexp(b1 + mprev - m1); emn[s0] = fexp(-m0); emn[s1] = fexp(-m1); }
    SEC_END(F, 30); SEC_BEGIN(F, 31);
    { u32x4 qv[4]; stage_conv(F, F.lds + T0, PROJ + (size_t)row0 * PROJ_LD + QO + h * 128, cw, c * 128, 1.0f, qv); }
    stage_tile<false>(F, F.lds + T1, (const bf16*)(F.ws + WS_KC) + (size_t)row0 * 512 + h * 128, 512, nullptr);
    stage_tile<false>(F, F.lds + T2, PROJ + (size_t)row0 * PROJ_LD + VO + h * 128, PROJ_LD, nullptr);
    stage_tile<false>(F, F.lds + T3, CPREV + (size_t)u * 16384, 128, nullptr);
    __syncthreads();
    SEC_END(F, 31); SEC_BEGIN(F, 32);
    const int t = 16 * w + (lane & 15);
    u32x2 wpk[8]; float rsum = 0.f;
    { const float rc = rowc[t];
#pragma unroll
      for (int sb = 0; sb < 8; ++sb) { wpk[sb] = (u32x2){0u, 0u};
          if (sb <= w) { f32x4 a4 = (f32x4){0.f, 0.f, 0.f, 0.f};
#pragma unroll
              for (int ks = 0; ks < 4; ++ks) { const bf16x8 a = frag_row(F.lds + T1, 16 * sb, ks, lane), bb = frag_row(F.lds + T0, 16 * w, ks, lane); a4 = MFMA16(a, bb, a4); }
              float wv4[4];
#pragma unroll
              for (int rg = 0; rg < 4; ++rg) { const int s = 16 * sb + 4 * (lane >> 4) + rg; const float e = fexp(rc + colc[s]) * a4[rg]; wv4[rg] = (s <= t) ? e : 0.f; }
              wpk[sb].x = pk2(wv4[0], wv4[1]); wpk[sb].y = pk2(wv4[2], wv4[3]);
              rsum += bf2f((unsigned short)(wpk[sb].x & 0xffffu)) + bf2f((unsigned short)(wpk[sb].x >> 16)) + bf2f((unsigned short)(wpk[sb].y & 0xffffu)) + bf2f((unsigned short)(wpk[sb].y >> 16)); } } }
    __syncthreads();
    SEC_END(F, 32); SEC_BEGIN(F, 33);
    { int t2 = t; asm volatile("" : "+v"(t2));
#pragma unroll
    for (int sb = 0; sb < 8; ++sb) if (sb <= (w | 1)) *(LAS u32x2*)(F.lds + T1 + off_b(t2, 2 * sb + (lane >> 5)) + 8 * ((lane >> 4) & 1)) = wpk[sb]; }
    rsum += __shfl_xor(rsum, 16); rsum += __shfl_xor(rsum, 32);
    { float qn = 0.f; const int part = lane >> 4;
#pragma unroll
      for (int i = 0; i < 4; ++i) { float f[8]; unpack8(*(const LAS u32x4*)(F.lds + T0 + off_b(t, 4 * part + i)), f);
#pragma unroll
          for (int k = 0; k < 8; ++k) qn += f[k] * npv[32 * part + 8 * i + k]; }
      qn += __shfl_xor(qn, 16); qn += __shfl_xor(qn, 32);
      const float den = rsum + inter[t] * qn;
      if (lane < 16) rdn[t] = 1.0f / fmaxf(fabsf(den), emn[t]); }
    f32x4 acc[8];
#pragma unroll
    for (int vb = 0; vb < 8; ++vb) acc[vb] = (f32x4){0.f, 0.f, 0.f, 0.f};
#pragma unroll
    for (int ks = 0; ks < 4; ++ks) { const bf16x8 a = frag_row(F.lds + T0, 16 * w, ks, lane);
#pragma unroll
        for (int vb = 0; vb < 8; ++vb) { const bf16x8 bb = frag_row(F.lds + T3, 16 * vb, ks, lane); acc[vb] = MFMA16(a, bb, acc[vb]); } }
    float it4[4], rd4[4];
#pragma unroll
    for (int rg = 0; rg < 4; ++rg) { const int tr = 16 * w + 4 * (lane >> 4) + rg; it4[rg] = inter[tr]; rd4[rg] = rdn[tr]; }
#pragma unroll
    for (int vb = 0; vb < 8; ++vb)
#pragma unroll
        for (int rg = 0; rg < 4; ++rg) acc[vb][rg] *= it4[rg];
    for (int ks = 0; ks <= (w >> 1); ++ks) { const bf16x8 a = frag_row(F.lds + T1, 16 * w, ks, lane);
#pragma unroll
        for (int vb = 0; vb < 8; ++vb) { const bf16x8 bb = frag_tr(F.lds + T2, vb, ks, lane); acc[vb] = MFMA16(a, bb, acc[vb]); } }
    SEC_END(F, 33); SEC_BEGIN(F, 34);
#pragma unroll
    for (int rg = 0; rg < 4; ++rg) { float s = 0.f;
#pragma unroll
        for (int vb = 0; vb < 8; ++vb) { acc[vb][rg] *= rd4[rg]; s += acc[vb][rg]; }
        s += __shfl_xor(s, 1); s += __shfl_xor(s, 2); s += __shfl_xor(s, 4); s += __shfl_xor(s, 8);
        const float mean = s * (1.0f / 128.0f); float q = 0.f;
#pragma unroll
        for (int vb = 0; vb < 8; ++vb) { acc[vb][rg] -= mean; q += acc[vb][rg] * acc[vb][rg]; }
        q += __shfl_xor(q, 1); q += __shfl_xor(q, 2); q += __shfl_xor(q, 4); q += __shfl_xor(q, 8);
        const float rstd = 1.0f / sqrtf(q * (1.0f / 128.0f) + 1e-6f);
#pragma unroll
        for (int vb = 0; vb < 8; ++vb) acc[vb][rg] *= rstd; }
#pragma unroll
    for (int vb = 0; vb < 8; ++vb) { const int d = 16 * vb + (lane & 15); const float gg = ngain[h * 128 + d];
#pragma unroll
        for (int rg = 0; rg < 4; ++rg) { int tr = 16 * w + 4 * (lane >> 4) + rg; asm volatile("" : "+v"(tr));
            *(LAS unsigned short*)(F.lds + T1 + off_b(tr, d >> 3) + 2 * (d & 7)) = (unsigned short)(pk2(acc[vb][rg] * gg, 0.f) & 0xffffu); } }
#pragma unroll
    for (int i = 0; i < 4; ++i) { const int id = lane + 64 * i, r = id >> 4, ch = id & 15, tr = 16 * w + r;
        float y[8], o[8]; unpack8(*(const LAS u32x4*)(F.lds + T1 + off_b(tr, ch)), y);
        unpack8(*(const u32x4*)(PROJ + (size_t)(row0 + tr) * PROJ_LD + OO + h * 128 + 8 * ch), o);
#pragma unroll
        for (int k = 0; k < 8; ++k) y[k] *= o[k];
        *(u32x4*)(MIX + (size_t)(row0 + tr) * 1024 + h * 128 + 8 * ch) = pack8(y); }
    { const float* RSG = (const float*)(F.ws + WS_RSG);
#pragma unroll
      for (int i = 0; i < 4; ++i) { const int id = lane + 64 * i, r = id >> 4, ch = id & 15, tr = 16 * w + r;
          bf16* p = MIX + (size_t)(row0 + tr) * 1024 + 512 + h * 128 + 8 * ch; float y[8]; unpack8(*(const u32x4*)p, y);
          const float rs = 1.0f / sqrtf(((RSG[row0 + tr] + RSG[16384 + row0 + tr]) + (RSG[32768 + row0 + tr] + RSG[49152 + row0 + tr])) * (1.0f / 512.0f) + 1e-6f);
#pragma unroll
          for (int kk = 0; kk < 8; ++kk) y[kk] *= rs;
          *(u32x4*)p = pack8(y); } }
    __syncthreads();
    SEC_END(F, 34);
    F0.tsec = F.tsec;
}

__device__ __forceinline__ void phase_router(Frame& F) {
    const float* H = (const float*)(F.ws + WS_H); const float* g2 = F.in[12]; const float* br = F.in[14];
    const bf16* WrThi = (const bf16*)(F.ws + WS_WRT); const bf16* WrTlo = WrThi + 32 * 1024;
    bf16* HN = (bf16*)(F.ws + WS_XN); int* cnt = (int*)(F.ws + WS_CTL) + CW_CNT; int* tokidx = (int*)(F.ws + WS_TOKIDX); float* gatex = (float*)(F.ws + WS_GATEX); float* rsx = (float*)(F.ws + WS_RSX);
    lptr ihi = F.lds, ilo = F.lds + 32 * IMG_ROW;
    LAS float* lg = (LAS float*)(F.lds + 2 * 32 * IMG_ROW);
    LAS int* hist = (LAS int*)(lg + 2048); LAS int* base = hist + 32;
    SEC_BEGIN(F, 4);
    for (int i = F.tid; i < 32 * 128; i += NTHR) { const int n = i >> 7, ch = i & 127;
        *(LAS u32x4*)(ihi + n * IMG_ROW + 16 * ch) = *(const u32x4*)(WrThi + (size_t)n * 1024 + 8 * ch);
        *(LAS u32x4*)(ilo + n * IMG_ROW + 16 * ch) = *(const u32x4*)(WrTlo + (size_t)n * 1024 + 8 * ch); }
    if (F.tid < 32) hist[F.tid] = 0;
    __syncthreads();
    SEC_END(F, 4); SEC_BEGIN(F, 5);
    const int tok0 = F.vcu * 64 + F.wave * 8, lane = F.lane;
    f32x4 acc[2];
    const float rstd = row_pass<2>(H, g2, HN, ihi, ilo, tok0, lane, acc);
    SEC_END(F, 5); SEC_BEGIN(F, 6);
    { float rr[4];
#pragma unroll
      for (int rg = 0; rg < 4; ++rg) rr[rg] = __shfl(rstd, (4 * (lane >> 4) + rg) & 7);
      if ((lane >> 4) < 2) {
#pragma unroll
        for (int nf = 0; nf < 2; ++nf)
#pragma unroll
            for (int rg = 0; rg < 4; ++rg) lg[(F.wave * 8 + 4 * (lane >> 4) + rg) * 32 + 16 * nf + (lane & 15)] = acc[nf][rg] * rr[rg]; } }
    int be[4] = {0, 0, 0, 0}, lr[4] = {0, 0, 0, 0}; float gt[4] = {0.f, 0.f, 0.f, 0.f};
    if (lane < 8) { float v[32];
#pragma unroll
        for (int q4 = 0; q4 < 8; ++q4) { const f32x4 x = *(const LAS f32x4*)(lg + (F.wave * 8 + lane) * 32 + 4 * q4), bb = *(const f32x4*)(br + 4 * q4);
            v[4 * q4] = x[0] + bb[0]; v[4 * q4 + 1] = x[1] + bb[1]; v[4 * q4 + 2] = x[2] + bb[2]; v[4 * q4 + 3] = x[3] + bb[3]; }
        float bv[4];
#pragma unroll
        for (int k = 0; k < 4; ++k) { float best = -INFINITY; int bi = 0;
#pragma unroll
            for (int e = 0; e < 32; ++e) if (v[e] > best) { best = v[e]; bi = e; }
            be[k] = bi; bv[k] = best;
#pragma unroll
            for (int e = 0; e < 32; ++e) v[e] = (e == bi) ? -INFINITY : v[e]; }
        float den = 0.f;
#pragma unroll
        for (int k = 0; k < 4; ++k) { gt[k] = fexp(bv[k] - bv[0]); den += gt[k]; }
        const float rd = 1.0f / den;
#pragma unroll
        for (int k = 0; k < 4; ++k) { gt[k] *= rd; lr[k] = __hip_atomic_fetch_add(hist + be[k], 1, __ATOMIC_RELAXED, __HIP_MEMORY_SCOPE_WORKGROUP); } }
    __syncthreads();
    if (F.tid < 32) base[F.tid] = hist[F.tid] > 0 ? atomicAdd(&cnt[F.tid], hist[F.tid]) : 0;
    __syncthreads();
    if (lane < 8) { const int tok = tok0 + lane;
#pragma unroll
        for (int k = 0; k < 4; ++k) { const int rk = base[be[k]] + lr[k]; const size_t p = (size_t)be[k] * 65536 + rk; tokidx[p] = tok * 4 + k; gatex[p] = gt[k]; rsx[p] = rstd; } }
    __syncthreads();
    SEC_END(F, 6);
}

__device__ __forceinline__ int build_ttab(const Frame& F) {
    const int* cnt = (const int*)(F.ws + WS_CTL) + CW_CNT; LAS unsigned* ttab = (LAS unsigned*)(F.lds + TTAB_OFF); LAS int* tot = (LAS int*)(F.lds + MISC_OFF + 64);
    if (F.wave == 0) { const int l = F.lane; const int c = l < 32 ? __hip_atomic_load(cnt + l, RLX_AGENT) : 0; const int nt = (c + 255) >> 8;
        int inc = nt;
#pragma unroll
        for (int o = 1; o < 64; o <<= 1) { const int tt = __shfl_up(inc, o); if (l >= o) inc += tt; }
        const int start = inc - nt;
        for (int r = 0; r < nt; ++r) { const int left = c - 256 * r; ttab[start + r] = (unsigned)l | ((unsigned)r << 5) | ((unsigned)((left < 256 ? left : 256) - 1) << 14); }
        if (l == 63) tot[0] = inc; }
    __syncthreads();
    return tot[0];
}

__device__ __forceinline__ void phase_final(const Frame& F) {
    const float* H = (const float*)(F.ws + WS_H); const bf16* Y = (const bf16*)(F.ws + WS_Y); const float* gf = F.in[19];
    const int gw = F.vcu * NWAVES + F.wave, lane = F.lane;
    for (int i = 0; i < 8; ++i) { const int tok = gw * 8 + i;
        f32x4 v[4]; float s = 0.f;
#pragma unroll
        for (int j = 0; j < 4; ++j) { v[j] = *(const f32x4*)(H + (size_t)tok * 1024 + 4 * (lane + 64 * j));
#pragma unroll
            for (int k = 0; k < 4; ++k) { const u32x2 y = *(const u32x2*)(Y + (size_t)(tok * 4 + k) * 1024 + 4 * (lane + 64 * j));
                v[j][0] += __builtin_bit_cast(float, y.x << 16); v[j][1] += __builtin_bit_cast(float, y.x & 0xffff0000u);
                v[j][2] += __builtin_bit_cast(float, y.y << 16); v[j][3] += __builtin_bit_cast(float, y.y & 0xffff0000u); }
            s += (v[j][0] * v[j][0] + v[j][1] * v[j][1]) + (v[j][2] * v[j][2] + v[j][3] * v[j][3]); }
        const float r = 1.0f / sqrtf(wsum_all(s) * (1.0f / 1024.0f) + 1e-6f);
#pragma unroll
        for (int j = 0; j < 4; ++j) { const f32x4 gg = *(const f32x4*)(gf + 4 * (lane + 64 * j)); *(f32x4*)(F.out + (size_t)tok * 1024 + 4 * (lane + 64 * j)) = v[j] * r * gg; } }
}
constexpr int N_PHASES = 10;
struct Args { const float* in[20]; float* out; unsigned char* ws; int ph_lo, ph_hi; };
__global__ void __launch_bounds__(NTHR, 2) mk_fwd(Args args) {
    extern __shared__ __attribute__((aligned(16))) unsigned char lds_raw[];
    Frame F; F.t0 = 0ull; F.tsec = 0ull;
    F.lds = (lptr)lds_raw; F.tid = threadIdx.x; F.lane = F.tid & 63; F.wave = __builtin_amdgcn_readfirstlane(F.tid >> 6);
    F.G = gridDim.x; { const int bx = blockIdx.x; F.vcu = (F.G % 8 == 0) ? (bx % 8) * (F.G / 8) + bx / 8 : bx; }
#pragma unroll
    for (int i = 0; i < 20; ++i) F.in[i] = args.in[i];
    F.out = args.out; F.ws = args.ws;
    for (int u = F.tid; u < (LDS_BYTES - CTL_OFF) / 4; u += NTHR) ((LAS unsigned*)(F.lds + CTL_OFF))[u] = 0u;
    __syncthreads();
    XcdBarrier bar = xcd_barrier_post((unsigned*)(F.ws + WS_CTL) + CW_BAR, (volatile LAS unsigned*)(F.lds + MISC_OFF));
    const int lo = args.ph_lo, hi = args.ph_hi;
#define IN(k) (lo <= (k) && (k) < hi)
#ifndef PROBE_LO
#define PROBE_LO -1
#define PROBE_HI -1
#endif
    unsigned long long tp0 = 0ull;
#define SEAM(k) do { if (IN(k) && IN((k) + 1)) xcd_barrier(bar); \
        if (PROBE_HI == (k) + 1) { const unsigned long long tn = __builtin_amdgcn_s_memrealtime(), dt = tn - tp0; while (__builtin_amdgcn_s_memrealtime() - tn < dt) __builtin_amdgcn_s_sleep(8); __syncthreads(); } \
        if (PROBE_LO == (k) + 1) tp0 = __builtin_amdgcn_s_memrealtime(); } while (0)
    const int bx = blockIdx.x;
    if (PROBE_LO == 0) tp0 = __builtin_amdgcn_s_memrealtime();
    if (IN(0)) { phase0(F); } SEAM(0);
    if (IN(1)) { pg8::DenseOps ops{(const bf16*)(F.ws + WS_XN), (const bf16*)(F.ws + WS_WINT), 1024}; pg8::StaticOrder S; S.init(64, 12, F.G, bx);
        pg8::EpiProj E{(bf16*)(F.ws + WS_PROJ), PROJ_LD, (const float*)(F.ws + WS_RS1)};
        pg8::gemm_phase<pg8::EpiProj, pg8::StaticOrder, pg8::DenseOps, false, true>(F.lds, 1024, S, ops, E); } SEAM(1);
    if (IN(2)) {
#pragma unroll 1
        for (int j = 0; j < 2; ++j) mlstm_local_unit(F, F.vcu * 2 + j);
#pragma unroll 1
        for (int j = 0; j < 2; ++j) gmlp_unit(F, F.vcu * 2 + j); } SEAM(2);
    if (IN(3)) { phase_scan(F); } SEAM(3);
    if (IN(4)) {
#pragma unroll 1
        for (int j = 0; j < 2; ++j) mlstm_out_unit(F, F.vcu * 2 + j); } SEAM(4);
    if (IN(5)) { pg8::DenseOps ops{(const bf16*)(F.ws + WS_MIX), (const bf16*)(F.ws + WS_WOUTT), 1024}; pg8::StaticOrder S; S.init(64, 4, F.G, bx);
        pg8::EpiRes E{F.in[0], (float*)(F.ws + WS_H), 1024};
        pg8::gemm_phase<pg8::EpiRes, pg8::StaticOrder, pg8::DenseOps, false, false>(F.lds, 1024, S, ops, E); } SEAM(5);
    if (IN(6)) { phase_router(F); } SEAM(6);
    if (IN(7)) { const int nM = build_ttab(F);
        pg8::UpOps ops{(const bf16*)(F.ws + WS_XN), (const bf16*)(F.ws + WS_WUPT), (const int*)(F.ws + WS_TOKIDX)};
        pg8::MoeOrder S; S.init(nM, 8, F.G, bx); S.ttab = (const LAS unsigned*)(F.lds + TTAB_OFF);
        pg8::EpiUp E{(bf16*)(F.ws + WS_ACT), F.in[16], (const float*)(F.ws + WS_RSX)};
        pg8::gemm_phase<pg8::EpiUp, pg8::MoeOrder, pg8::UpOps, true, true>(F.lds, 1024, S, ops, E); } SEAM(7);
    if (IN(8)) { const int nM = build_ttab(F);
        pg8::DownOps ops{(const bf16*)(F.ws + WS_ACT), (const bf16*)(F.ws + WS_WDNT)};
        pg8::MoeOrder S; S.init(nM, 4, F.G, bx); S.ttab = (const LAS unsigned*)(F.lds + TTAB_OFF);
        pg8::EpiDown E{(bf16*)(F.ws + WS_Y), F.in[18], (const float*)(F.ws + WS_GATEX), (const int*)(F.ws + WS_TOKIDX)};
        pg8::gemm_phase<pg8::EpiDown, pg8::MoeOrder, pg8::DownOps, false, true>(F.lds, 1024, S, ops, E); } SEAM(8);
    if (IN(9)) { phase_final(F); } SEAM(9);
    if (PROBE_SEC >= 0) { const unsigned long long tn = __builtin_amdgcn_s_memrealtime(); while (__builtin_amdgcn_s_memrealtime() - tn < F.tsec) __builtin_amdgcn_s_sleep(8); }
#undef IN
#undef SEAM
}

extern "C" void kernel_launch(void* const* d_in, const int* in_sizes, int n_in, void* d_out, int out_size, void* d_ws, size_t ws_size, hipStream_t stream) {
    static int ready = 0;
    if (!ready) {
        if (hipFuncSetAttribute((const void*)mk_fwd, hipFuncAttributeMaxDynamicSharedMemorySize, LDS_BYTES) != hipSuccess) { fprintf(stderr, "hipFuncSetAttribute failed\n"); return; }
        ready = 1;
    }
    char* ws = (char*)d_ws;
    if (ws_size < 1024 * MiB) { fprintf(stderr, "ws too small: %zu\n", ws_size); return; }
    (void)hipMemsetAsync(ws + WS_CTL, 0, CTL_ZERO_BYTES, stream);
    Args a{};
    for (int i = 0; i < 20; ++i) a.in[i] = (const float*)d_in[i];
    a.out = (float*)d_out; a.ws = (unsigned char*)d_ws; a.ph_lo = 0; a.ph_hi = N_PHASES;
    hipLaunchKernelGGL(mk_fwd, dim3(256), dim3(NTHR), LDS_BYTES, stream, a);
}
```

```cpp
#include <hip/hip_runtime.h>
#include <cstdio>
#include <cstdint>
#include <cstddef>
#include <cmath>


namespace pg8 {
#define PG8_LAS __attribute__((address_space(3)))
typedef unsigned short bf16_t;
typedef short bf16x8 __attribute__((ext_vector_type(8)));
typedef float f32x4 __attribute__((ext_vector_type(4)));
typedef float f32x2 __attribute__((ext_vector_type(2)));
typedef unsigned u32x4 __attribute__((ext_vector_type(4)));
constexpr int BM = 256, BK = 64, HALF = 128, HTB = HALF * BK * 2, STAGE_BYTES = 8 * HTB, NXCD = 8, WGM = 8;

__host__ __device__ __forceinline__ int lds_byte(int r, int c) { const int st = (r >> 4) * 2 + (c >> 5), rr = r & 15, cc = c & 31, ob = rr * 64 + cc * 2; return st * 1024 + (ob ^ (((ob >> 9) & 1) << 5)); }
__host__ __device__ __forceinline__ void stage_rc(int b, int& R, int& C) { const int st = b / 1024, sb = b % 1024, swz = sb ^ (((sb >> 9) & 1) << 5); R = (st >> 1) * 16 + swz / 64; C = (st & 1) * 32 + (swz % 64) / 2; }
__host__ __device__ __forceinline__ int perm32(int rho) { const int n = rho >> 4, i = rho & 15; return 8 * (i >> 2) + 4 * n + (i & 3); }

struct Unit { int pm, pn, e, rt, nrows; };

struct StaticOrder {
    int nM, nN, nwg, G, c;
    __device__ void init(int nM_, int nN_, int G_, int c_) { nM = nM_; nN = nN_; nwg = nM * nN; G = G_; c = c_; }
    __device__ bool next(int i, Unit& u) const {
        const long L = (long)i * G + c; if (L >= nwg) return false;
        int wgid = (int)L; { const int q = nwg / NXCD, r = nwg % NXCD, xcd = wgid % NXCD, off = wgid / NXCD; wgid = (xcd < r ? xcd * (q + 1) : r * (q + 1) + (xcd - r) * q) + off; }
        const int nig = WGM * nN, gid = wgid / nig, fm = gid * WGM, gsz = (nM - fm) < WGM ? (nM - fm) : WGM;
        u.pm = fm + ((wgid % nig) % gsz); u.pn = (wgid % nig) / gsz; u.e = 0; u.rt = 0; u.nrows = 256; return true;
    }
};
struct MoeOrder : StaticOrder {
    const PG8_LAS unsigned* ttab;
    __device__ bool next(int i, Unit& u) const {
        if (!StaticOrder::next(i, u)) return false;
        const unsigned w = ttab[u.pm]; u.e = (int)(w & 31u); u.rt = (int)((w >> 5) & 511u); u.nrows = (int)((w >> 14) & 255u) + 1; return true;
    }
};

__device__ __forceinline__ unsigned cvt_pk_bf16(float lo, float hi) { unsigned r; asm volatile("v_cvt_pk_bf16_f32 %0, %1, %2" : "=v"(r) : "v"(lo), "v"(hi)); return r; }

struct DenseOps {
    const bf16_t* A; const bf16_t* Bt; int K;
    __device__ __forceinline__ const char* a_base(const Unit& u) const { return (const char*)A + (size_t)u.pm * BM * K * 2; }
    __device__ __forceinline__ const char* b_base(const Unit& u) const { return (const char*)Bt + (size_t)u.pn * BM * K * 2; }
    __device__ __forceinline__ void gather(const Unit&, const int (&)[2], const int (&)[2], unsigned (&)[2][2]) const {}
};
struct UpOps {
    const bf16_t* HN; const bf16_t* WupT; const int* tokidx;
    __device__ __forceinline__ const char* a_base(const Unit&) const { return (const char*)HN; }
    __device__ __forceinline__ const char* b_base(const Unit& u) const { return (const char*)WupT + ((size_t)u.e * 2048 + (size_t)u.pn * BM) * 1024 * 2; }
    __device__ __forceinline__ void gather(const Unit& u, const int (&R)[2], const int (&C)[2], unsigned (&v)[2][2]) const {
        const int* tl = tokidx + (size_t)u.e * 65536 + u.rt * 256;
#pragma unroll
        for (int h = 0; h < 2; ++h)
#pragma unroll
            for (int i = 0; i < 2; ++i) { const int r = R[i] + 128 * h; const int idx = tl[r < u.nrows ? r : 0]; v[h][i] = (unsigned)(idx >> 2) * 2048u + (unsigned)C[i] * 2u; }
    }
};
struct DownOps {
    const bf16_t* ACT; const bf16_t* WdnT;
    __device__ __forceinline__ const char* a_base(const Unit& u) const { return (const char*)ACT + (size_t)u.pm * BM * 1024 * 2; }
    __device__ __forceinline__ const char* b_base(const Unit& u) const { return (const char*)WdnT + ((size_t)u.e * 1024 + (size_t)u.pn * BM) * 1024 * 2; }
    __device__ __forceinline__ void gather(const Unit&, const int (&)[2], const int (&)[2], unsigned (&)[2][2]) const {}
};

struct EpiProj {
    static constexpr bool PERM = true;
    bf16_t* O; int ldc; const float* rs;
    static __device__ __forceinline__ float sigm(float x) { return __builtin_amdgcn_rcpf(1.0f + __builtin_amdgcn_exp2f(-1.4426950408889634f * x)); }
    static __device__ __forceinline__ float act(float x, int mode) {
        if (mode == 1) return sigm(x);
        if (mode == 2) return x * sigm(1.5957691216057308f * (x + 0.044715f * x * x * x));
        return x; }
    __device__ __forceinline__ void operator()(const f32x4 (&acc)[2][2][4][2], const Unit& u, int wr, int wc, int fr, int fq) const {
        const int row0 = u.pm * BM + wr * 64 + fr, col0 = u.pn * BM + wc * 32 + 8 * fq;
        const int mode = u.pn >= 8 ? 2 : (u.pn >= 6 ? 1 : 0);
        float sc[2][4];
#pragma unroll
        for (int ai = 0; ai < 2; ++ai)
#pragma unroll
            for (int m = 0; m < 4; ++m) sc[ai][m] = rs[row0 + ai * HALF + m * 16];
#pragma unroll
        for (int ai = 0; ai < 2; ++ai)
#pragma unroll
            for (int m = 0; m < 4; ++m) { bf16_t* rowp = O + (size_t)(row0 + ai * HALF + m * 16) * ldc + col0;
#pragma unroll
                for (int bj = 0; bj < 2; ++bj) { f32x4 v0 = acc[ai][bj][m][0] * sc[ai][m], v1 = acc[ai][bj][m][1] * sc[ai][m];
                    if (mode != 0) {
#pragma unroll
                        for (int i = 0; i < 4; ++i) { v0[i] = act(v0[i], mode); v1[i] = act(v1[i], mode); } }
                    u32x4 w; w.x = cvt_pk_bf16(v0[0], v0[1]); w.y = cvt_pk_bf16(v0[2], v0[3]); w.z = cvt_pk_bf16(v1[0], v1[1]); w.w = cvt_pk_bf16(v1[2], v1[3]);
                    *(u32x4*)(rowp + bj * HALF) = w; } }
    }
};
struct EpiRes {
    static constexpr bool PERM = false;
    const float* base; float* C; int ldc;
    __device__ __forceinline__ void operator()(const f32x4 (&acc)[2][2][4][2], const Unit& u, int wr, int wc, int fr, int fq) const {
        const int row0 = u.pm * BM + wr * 64 + fr, col0 = u.pn * BM + wc * 32 + 4 * fq;
#pragma unroll
        for (int ai = 0; ai < 2; ++ai)
#pragma unroll
            for (int m = 0; m < 4; ++m) { const size_t off = (size_t)(row0 + ai * HALF + m * 16) * ldc + col0;
#pragma unroll
                for (int bj = 0; bj < 2; ++bj)
#pragma unroll
                    for (int n = 0; n < 2; ++n) *(f32x4*)(C + off + bj * HALF + n * 16) = *(const f32x4*)(base + off + bj * HALF + n * 16) + acc[ai][bj][m][n]; }
    }
};
struct EpiUp {
    static constexpr bool PERM = true;
    bf16_t* ACT; const float* b_up; const float* rsx;
    __device__ __forceinline__ void operator()(const f32x4 (&acc)[2][2][4][2], const Unit& u, int wr, int wc, int fr, int fq) const {
        const int r0 = wr * 64 + fr, row0 = u.pm * BM + r0, j0 = wc * 32 + 8 * fq;
        const float* bg = b_up + (size_t)u.e * 2048 + u.pn * 128 + j0;
        const float* rp = rsx + (size_t)u.e * 65536 + u.rt * 256;
        f32x4 bgl[2], bln[2]; float sc[2][4];
#pragma unroll
        for (int n = 0; n < 2; ++n) { bgl[n] = *(const f32x4*)(bg + 4 * n); bln[n] = *(const f32x4*)(bg + 1024 + 4 * n); }
#pragma unroll
        for (int ai = 0; ai < 2; ++ai)
#pragma unroll
            for (int m = 0; m < 4; ++m) { const int r = r0 + ai * HALF + m * 16; sc[ai][m] = rp[r < u.nrows ? r : 0]; }
#pragma unroll
        for (int ai = 0; ai < 2; ++ai)
#pragma unroll
            for (int m = 0; m < 4; ++m) { bf16_t* rowp = ACT + (size_t)(row0 + ai * HALF + m * 16) * 1024 + u.pn * 128 + j0;
                float o[8];
#pragma unroll
                for (int n = 0; n < 2; ++n) { const f32x4 g = acc[ai][0][m][n] * sc[ai][m] + bgl[n], l = acc[ai][1][m][n] * sc[ai][m] + bln[n];
#pragma unroll
                    for (int i = 0; i < 4; ++i) { const float gl = fminf(g[i], 7.0f), ln = fminf(fmaxf(l[i], -7.0f), 7.0f);
                        o[n * 4 + i] = gl * __builtin_amdgcn_rcpf(1.0f + __builtin_amdgcn_exp2f(-2.4554669595930157f * gl)) * (ln + 1.0f); } }
                u32x4 w; w.x = cvt_pk_bf16(o[0], o[1]); w.y = cvt_pk_bf16(o[2], o[3]); w.z = cvt_pk_bf16(o[4], o[5]); w.w = cvt_pk_bf16(o[6], o[7]);
                *(u32x4*)rowp = w; }
    }
};
struct EpiDown {
    static constexpr bool PERM = true;
    bf16_t* Y; const float* b_dn; const float* gatex; const int* tokidx;
    __device__ __forceinline__ void operator()(const f32x4 (&acc)[2][2][4][2], const Unit& u, int wr, int wc, int fr, int fq) const {
        const int r0 = wr * 64 + fr, col0 = u.pn * BM + wc * 32 + 8 * fq;
        const int* tl = tokidx + (size_t)u.e * 65536 + u.rt * 256; const float* gl = gatex + (size_t)u.e * 65536 + u.rt * 256;
        const float* bb = b_dn + (size_t)u.e * 1024 + col0;
        f32x4 bv[2][2]; int idx[2][4]; float gt[2][4];
#pragma unroll
        for (int ai = 0; ai < 2; ++ai)
#pragma unroll
            for (int m = 0; m < 4; ++m) { const int r = r0 + ai * HALF + m * 16, rr = r < u.nrows ? r : 0; idx[ai][m] = tl[rr]; gt[ai][m] = gl[rr]; }
#pragma unroll
        for (int bj = 0; bj < 2; ++bj)
#pragma unroll
            for (int n = 0; n < 2; ++n) bv[bj][n] = *(const f32x4*)(bb + bj * HALF + 4 * n);
#pragma unroll
        for (int ai = 0; ai < 2; ++ai)
#pragma unroll
            for (int m = 0; m < 4; ++m) { const int r = r0 + ai * HALF + m * 16;
                if (r < u.nrows) { bf16_t* rowp = Y + (size_t)idx[ai][m] * 1024 + col0; const float g1 = gt[ai][m];
#pragma unroll
                    for (int bj = 0; bj < 2; ++bj) { const f32x4 v0 = (acc[ai][bj][m][0] + bv[bj][0]) * g1, v1 = (acc[ai][bj][m][1] + bv[bj][1]) * g1;
                        u32x4 w; w.x = cvt_pk_bf16(v0[0], v0[1]); w.y = cvt_pk_bf16(v0[2], v0[3]); w.z = cvt_pk_bf16(v1[0], v1[1]); w.w = cvt_pk_bf16(v1[2], v1[3]);
                        *(u32x4*)(rowp + bj * HALF) = w; } } }
    }
};

template <class Epi, class Sched, class Ops, bool GATHER, bool ALIGN_EPI>
__device__ __forceinline__ void gemm_phase(PG8_LAS unsigned char* lds, const int K, const Sched& S, const Ops& O, const Epi& E) {
    const int tid = threadIdx.x, wid = __builtin_amdgcn_readfirstlane(tid >> 6), lane = tid & 63, wr = wid >> 2, wc = wid & 3, fr = lane & 15, fq = lane >> 4;
    const int nt = K / BK;
    unsigned voffA[2], voffB[2]; int sR[2], sC[2];
#pragma unroll
    for (int i = 0; i < 2; ++i) { int R, C; stage_rc(tid * 16 + i * 8192, R, C); const int Rb = Epi::PERM ? ((R & ~31) + perm32(R & 31)) : R; sR[i] = R; sC[i] = C;
        voffA[i] = (unsigned)(R * K + C) * 2u; voffB[i] = (unsigned)(Rb * K + C) * 2u; }
    const size_t kstep = (size_t)(BK * 2);
    const size_t hstep = (size_t)HALF * K * 2;
    const unsigned ldsw = (unsigned)wid * 1024u;
    const int aoff = lds_byte(wr * 64 + fr, fq * 8), boff = lds_byte(wc * 32 + fr, fq * 8);
#define PG8_SA(b, h) (((b) * 2 + (h)) * HTB)
#define PG8_SB(b, h) ((4 + (b) * 2 + (h)) * HTB)
#define PG8_STAGE(bufoff, gbase, voff) do { _Pragma("unroll") for (int _i = 0; _i < 2; ++_i) \
        __builtin_amdgcn_global_load_lds((const unsigned*)((const char*)(gbase) + (voff)[_i]), (PG8_LAS unsigned*)(lds + (bufoff) + ldsw + _i * 8192), 16, 0, 0); } while (0)
#define PG8_STAGE_AC(bufoff, kptr, h) do { if constexpr (GATHER) PG8_STAGE(bufoff, kptr, vC[h]); else PG8_STAGE(bufoff, (kptr) + (h) * hstep, voffA); } while (0)
#define PG8_STAGE_AS(bufoff, kptr, h) do { if constexpr (GATHER) PG8_STAGE(bufoff, kptr, vS[h]); else PG8_STAGE(bufoff, (kptr) + (h) * hstep, voffA); } while (0)
#define PG8_LDA(dst, b, h) do { _Pragma("unroll") for (int m = 0; m < 4; ++m) _Pragma("unroll") for (int k = 0; k < 2; ++k) dst[m][k] = *(const PG8_LAS bf16x8*)(lds + PG8_SA(b, h) + aoff + m * 2048 + k * 1024); } while (0)
#define PG8_LDB(dst, b, h) do { _Pragma("unroll") for (int n = 0; n < 2; ++n) _Pragma("unroll") for (int k = 0; k < 2; ++k) dst[n][k] = *(const PG8_LAS bf16x8*)(lds + PG8_SB(b, h) + boff + n * 2048 + k * 1024); } while (0)
#define PG8_MMA(ai, bj, At, Bt) do { __builtin_amdgcn_s_setprio(1); _Pragma("unroll") for (int m = 0; m < 4; ++m) _Pragma("unroll") for (int n = 0; n < 2; ++n) _Pragma("unroll") for (int k = 0; k < 2; ++k) \
        acc[ai][bj][m][n] = __builtin_amdgcn_mfma_f32_16x16x32_bf16(Bt[n][k], At[m][k], acc[ai][bj][m][n], 0, 0, 0); __builtin_amdgcn_s_setprio(0); } while (0)
#define PG8_WAIT_V(n) asm volatile("s_waitcnt vmcnt(" #n ")" ::: "memory")
#define PG8_WAIT_L(n) asm volatile("s_waitcnt lgkmcnt(" #n ")" ::: "memory")
#define PG8_BAR __builtin_amdgcn_s_barrier()
#define PG8_SCHED __builtin_amdgcn_sched_barrier(0)
    Unit cur, nxt; int ui = 0;
    if (!S.next(0, cur)) return;
    f32x4 acc[2][2][4][2];
#pragma unroll
    for (int a = 0; a < 2; ++a)
#pragma unroll
        for (int b = 0; b < 2; ++b)
#pragma unroll
            for (int m = 0; m < 4; ++m)
#pragma unroll
                for (int n = 0; n < 2; ++n) acc[a][b][m][n] = (f32x4){0.f, 0.f, 0.f, 0.f};
    bf16x8 At[4][2], B0[2][2], B1[2][2];
    unsigned vC[2][2] = {{0u, 0u}, {0u, 0u}}, vN[2][2] = {{0u, 0u}, {0u, 0u}}, vS[2][2] = {{0u, 0u}, {0u, 0u}};
    if constexpr (GATHER) O.gather(cur, sR, sC, vC);
    const char* cA = O.a_base(cur); const char* cB = O.b_base(cur);
    PG8_STAGE(PG8_SB(0, 0), cB, voffB); PG8_STAGE(PG8_SB(0, 1), cB + hstep, voffB); PG8_STAGE_AC(PG8_SA(0, 0), cA, 0); PG8_STAGE_AC(PG8_SA(0, 1), cA, 1);
    if (wr == 1) PG8_BAR;
    PG8_WAIT_V(2); PG8_BAR;
    PG8_STAGE(PG8_SB(1, 0), cB + kstep, voffB); PG8_STAGE_AC(PG8_SA(1, 0), cA + kstep, 0); PG8_STAGE(PG8_SB(1, 1), cB + hstep + kstep, voffB);
    PG8_WAIT_V(6); PG8_BAR;
    for (;;) {
        const bool has_next = S.next(ui + 1, nxt);
        const char* nA = has_next ? O.a_base(nxt) : cA; const char* nB = has_next ? O.b_base(nxt) : cB;
        if constexpr (GATHER) { if (has_next) O.gather(nxt, sR, sC, vN); else {
#pragma unroll
            for (int h = 0; h < 2; ++h)
#pragma unroll
                for (int i = 0; i < 2; ++i) vN[h][i] = vC[h][i]; } }
        for (int t = 0; t < nt; t += 2) {
            const bool last = (t == nt - 2);
            const char* a1 = cA + (size_t)(t + 1) * kstep;
            const char* a2 = last ? nA : cA + (size_t)(t + 2) * kstep; const char* b2 = last ? nB : cB + (size_t)(t + 2) * kstep;
            const char* a3 = a2 + kstep; const char* b3 = b2 + kstep;
            if constexpr (GATHER) {
#pragma unroll
                for (int h = 0; h < 2; ++h)
#pragma unroll
                    for (int i = 0; i < 2; ++i) vS[h][i] = last ? vN[h][i] : vC[h][i]; }
            PG8_LDB(B0, 0, 0); PG8_LDB(B1, 0, 1); PG8_SCHED; PG8_LDA(At, 0, 0); PG8_STAGE_AC(PG8_SA(1, 1), a1, 1);
            PG8_WAIT_V(8); PG8_WAIT_L(0); PG8_BAR; PG8_MMA(0, 0, At, B0); PG8_MMA(0, 1, At, B1); PG8_BAR; PG8_SCHED;
            PG8_LDA(At, 0, 1); PG8_STAGE(PG8_SB(0, 0), b2, voffB); PG8_STAGE(PG8_SB(0, 1), b2 + hstep, voffB); PG8_STAGE_AS(PG8_SA(0, 0), a2, 0);
            PG8_WAIT_V(8); PG8_WAIT_L(0); PG8_BAR; PG8_MMA(1, 0, At, B0); PG8_MMA(1, 1, At, B1); PG8_BAR; PG8_SCHED;
            PG8_LDB(B0, 1, 0); PG8_LDB(B1, 1, 1); PG8_SCHED; PG8_LDA(At, 1, 0); PG8_STAGE_AS(PG8_SA(0, 1), a2, 1);
            PG8_WAIT_V(8); PG8_WAIT_L(0); PG8_BAR; PG8_MMA(0, 0, At, B0); PG8_MMA(0, 1, At, B1); PG8_BAR; PG8_SCHED;
            PG8_LDA(At, 1, 1); PG8_STAGE(PG8_SB(1, 0), b3, voffB); PG8_STAGE(PG8_SB(1, 1), b3 + hstep, voffB); PG8_STAGE_AS(PG8_SA(1, 0), a3, 0);
            PG8_WAIT_V(8); PG8_WAIT_L(0); PG8_BAR; PG8_MMA(1, 0, At, B0); PG8_MMA(1, 1, At, B1); PG8_BAR; PG8_SCHED;
        }
        if constexpr (ALIGN_EPI) { if (wr == 0) PG8_BAR; }
        E(acc, cur, wr, wc, fr, fq);
        if (!has_next) break;
#pragma unroll
        for (int a = 0; a < 2; ++a)
#pragma unroll
            for (int b = 0; b < 2; ++b)
#pragma unroll
                for (int m = 0; m < 4; ++m)
#pragma unroll
                    for (int n = 0; n < 2; ++n) acc[a][b][m][n] = (f32x4){0.f, 0.f, 0.f, 0.f};
        cur = nxt; cA = nA; cB = nB; ++ui;
        if constexpr (GATHER) {
#pragma unroll
            for (int h = 0; h < 2; ++h)
#pragma unroll
                for (int i = 0; i < 2; ++i) vC[h][i] = vN[h][i]; }
        if constexpr (ALIGN_EPI) { if (wr == 1) PG8_BAR; }
    }
    PG8_WAIT_V(0);
    if constexpr (!ALIGN_EPI) { if (wr == 0) PG8_BAR; }
    PG8_BAR;
#undef PG8_SA
#undef PG8_SB
#undef PG8_STAGE
#undef PG8_STAGE_AC
#undef PG8_STAGE_AS
#undef PG8_LDA
#undef PG8_LDB
#undef PG8_MMA
#undef PG8_WAIT_V
#undef PG8_WAIT_L
#undef PG8_BAR
#undef PG8_SCHED
}
}
#define GAS __attribute__((address_space(1)))
#define LAS __attribute__((address_space(3)))
typedef unsigned short bf16;
typedef short bf16x8 __attribute__((ext_vector_type(8)));
typedef short s16x4 __attribute__((ext_vector_type(4)));
typedef float f32x4 __attribute__((ext_vector_type(4)));
typedef unsigned u32x4 __attribute__((ext_vector_type(4)));
typedef unsigned u32x2 __attribute__((ext_vector_type(2)));
typedef LAS unsigned char* lptr;

constexpr int NWAVES = 8, NTHR = 512;
constexpr size_t MiB = 1u << 20;
constexpr size_t WS_CTL = 0, CTL_ZERO_BYTES = 64 * 1024;
constexpr size_t WS_SMALL = 1 * MiB;
constexpr size_t WS_GATES = 2 * MiB;
constexpr size_t WS_RSG = 2 * MiB + 512 * 1024;
constexpr size_t WS_RS1 = 2 * MiB + 768 * 1024;
constexpr size_t WS_GATE = 3 * MiB;
constexpr size_t WS_TOKIDX = 4 * MiB;
constexpr size_t WS_GATEX = 760 * MiB, WS_RSX = 768 * MiB;
constexpr size_t WS_KC = 776 * MiB;
constexpr size_t WS_WRT = 12 * MiB;
constexpr size_t WS_WINT = 16 * MiB, WS_WOUTT = 22 * MiB, WS_WDNT = 24 * MiB, WS_WUPT = 88 * MiB;
constexpr size_t WS_XN = 216 * MiB;
constexpr size_t WS_PROJ = 248 * MiB;
constexpr size_t WS_CLOC = 344 * MiB;
constexpr size_t WS_CPREV = 376 * MiB;
constexpr size_t WS_MIX = 392 * MiB;
constexpr size_t WS_H = 424 * MiB;
constexpr size_t WS_ACT = 488 * MiB;
constexpr size_t WS_Y = 632 * MiB;
constexpr size_t WS_OPT_END = 760 * MiB;
constexpr int CW_CNT = 64;
constexpr int CW_BAR = 4096;
constexpr int PROJ_LD = 3072;
constexpr int QO = 0, KO = 512, VO = 1024, OO = 1536, UO = 2048, VGO = 2560;
constexpr int RING_BYTES = 131072, VEC_OFF = 131072, VEC_BYTES = 16384, CTL_OFF = VEC_OFF + VEC_BYTES, TTAB_OFF = CTL_OFF, MISC_OFF = CTL_OFF + 2048, LDS_BYTES = MISC_OFF + 256;
constexpr int T0 = 0, T1 = 32768, T2 = 65536, T3 = 98304;

#define RLX_AGENT __ATOMIC_RELAXED, __HIP_MEMORY_SCOPE_AGENT
#define XB_TMO      128
#define XB_XCNT(j)  (256  + 64 * (j))
#define XB_XSUB(j)  (1280 + 64 * (j))
#define XB_XGEN(j)  (2304 + 64 * (j))
#define XB_TOP      3328
#define XB_TOPGEN   3392
#define XCD_BAR_WORDS 3456
#define XB_SPIN_CAP (1u << 18)
__device__ __forceinline__ unsigned xb_ld(unsigned* p)              { return __hip_atomic_load(p, __ATOMIC_RELAXED, __HIP_MEMORY_SCOPE_AGENT); }
__device__ __forceinline__ unsigned xb_add(unsigned* p, unsigned v) { return __hip_atomic_fetch_add(p, v, __ATOMIC_RELAXED, __HIP_MEMORY_SCOPE_AGENT); }
__device__ __forceinline__ unsigned xb_xcc_id() { return (unsigned)__builtin_amdgcn_s_getreg((3 << 11) | 20) & 0xFu; }
#define XB_SPIN(cond, bar) do { unsigned _sp = 0; while (cond) { __builtin_amdgcn_s_sleep(1); \
    if ((++_sp & 255u) == 0u) { if (xb_ld(&(bar)[XB_TMO])) break; if (_sp > XB_SPIN_CAP) { atomicAdd(&(bar)[XB_TMO], 1u); break; } } } } while (0)
struct XcdBarrier { unsigned* bar; unsigned x; volatile LAS unsigned* st; };
__device__ __forceinline__ XcdBarrier xcd_barrier_post(unsigned* bar, volatile LAS unsigned* st) {
    XcdBarrier b; b.bar = bar; b.x = xb_xcc_id(); b.st = st;
    if (threadIdx.x == 0) (void)xb_add(&bar[XB_XCNT(b.x)], 1u);
    return b;
}
__device__ __forceinline__ void xcd_barrier_complete(unsigned* bar, unsigned x, unsigned& nloc, unsigned& nx) {
    const unsigned G = gridDim.x * gridDim.y * gridDim.z;
    unsigned sum, cnt, mine, sp = 0u;
    for (;;) {
        sum = 0u; cnt = 0u; mine = 0u;
#pragma unroll
        for (unsigned j = 0; j < 16; ++j) { const unsigned c = xb_ld(&bar[XB_XCNT(j)]); sum += c; cnt += (c > 0u) ? 1u : 0u; mine = (j == x) ? c : mine; }
        if (sum == G) break;
        __builtin_amdgcn_s_sleep(1);
        if ((++sp & 255u) == 0u) { if (xb_ld(&bar[XB_TMO])) break; if (sp > XB_SPIN_CAP) { atomicAdd(&bar[XB_TMO], 1u); break; } }
    }
    nloc = mine > 0u ? mine : 1u; nx = cnt > 0u ? cnt : 1u;
}
__device__ __forceinline__ void xcd_barrier(const XcdBarrier& b) {
    asm volatile("s_waitcnt vmcnt(0)" ::: "memory");
    __syncthreads();
    if (threadIdx.x == 0) {
        unsigned* bar = b.bar;
        __builtin_amdgcn_s_waitcnt(0);
        unsigned nloc = b.st[0], nx = b.st[1];
        if (nloc == 0u) { xcd_barrier_complete(bar, b.x, nloc, nx); b.st[0] = nloc; b.st[1] = nx; }
        const unsigned old = xb_add(&bar[XB_XSUB(b.x)], 1u);
        const unsigned gen = old / nloc;
        if (old + 1u == (gen + 1u) * nloc) {
            __builtin_amdgcn_fence(__ATOMIC_RELEASE, "agent");
            asm volatile("s_waitcnt vmcnt(0)" ::: "memory");
            const unsigned og = xb_add(&bar[XB_TOP], 1u);
            const unsigned tg = og / nx;
            if (og + 1u == (tg + 1u) * nx) xb_add(&bar[XB_TOPGEN], 1u);
            else XB_SPIN(xb_ld(&bar[XB_TOPGEN]) == tg, bar);
            __builtin_amdgcn_fence(__ATOMIC_ACQUIRE, "agent");
            xb_add(&bar[XB_XGEN(b.x)], 1u);
            asm volatile("s_waitcnt vmcnt(0)" ::: "memory");
        } else {
            XB_SPIN(xb_ld(&bar[XB_XGEN(b.x)]) == gen, bar);
            __builtin_amdgcn_fence(__ATOMIC_ACQUIRE, "agent");
            asm volatile("s_waitcnt vmcnt(0)" ::: "memory");
        }
    }
    __syncthreads();
}

__device__ __forceinline__ float bf2f(unsigned short h) { return __builtin_bit_cast(float, (unsigned)h << 16); }
__device__ __forceinline__ unsigned f2bf(float f) { unsigned u = __builtin_bit_cast(unsigned, f); return (u + 0x7fffu + ((u >> 16) & 1u)) >> 16; }
__device__ __forceinline__ unsigned pk2(float lo, float hi) { return pg8::cvt_pk_bf16(lo, hi); }
__device__ __forceinline__ float fexp(float x) { return __builtin_amdgcn_exp2f(x * 1.4426950408889634f); }
__device__ __forceinline__ float fsigmoid(float x) { return __builtin_amdgcn_rcpf(1.0f + fexp(-x)); }
__device__ __forceinline__ float fgelu(float x) {
    const float u = 1.5957691216057308f * (x + 0.044715f * x * x * x);
    return x * fsigmoid(u);
}
__device__ __forceinline__ float wsum_all(float v) {
#pragma unroll
    for (int o = 32; o > 0; o >>= 1) v += __shfl_xor(v, o);
    return v;
}
__device__ __forceinline__ void unpack8(const u32x4 w, float (&f)[8]) {
    f[0] = __builtin_bit_cast(float, w.x << 16); f[1] = __builtin_bit_cast(float, w.x & 0xffff0000u);
    f[2] = __builtin_bit_cast(float, w.y << 16); f[3] = __builtin_bit_cast(float, w.y & 0xffff0000u);
    f[4] = __builtin_bit_cast(float, w.z << 16); f[5] = __builtin_bit_cast(float, w.z & 0xffff0000u);
    f[6] = __builtin_bit_cast(float, w.w << 16); f[7] = __builtin_bit_cast(float, w.w & 0xffff0000u);
}
__device__ __forceinline__ u32x4 pack8(const float (&f)[8]) { u32x4 w; w.x = pk2(f[0], f[1]); w.y = pk2(f[2], f[3]); w.z = pk2(f[4], f[5]); w.w = pk2(f[6], f[7]); return w; }

__device__ __forceinline__ unsigned off_b(unsigned row, unsigned ch) { return 256u * row + 16u * (ch ^ (((row & 3u) << 2) | ((row >> 2) & 3u))); }
__device__ __forceinline__ bf16x8 frag_row(lptr T, int r0, int ks, int lane) { return *(const LAS bf16x8*)(T + off_b((unsigned)(r0 + (lane & 15)), (unsigned)(4 * ks + (lane >> 4)))); }
__device__ __forceinline__ bf16x8 frag_tr(lptr T, int c, int ks, int lane) {
    const unsigned g = lane >> 4, q = (lane & 15) >> 2, p = lane & 3;
    const unsigned a0 = off_b(32u * ks + 8u * g + q, 2u * c + (p >> 1)) + 8u * (p & 1);
    const unsigned a1 = off_b(32u * ks + 8u * g + 4u + q, 2u * c + (p >> 1)) + 8u * (p & 1);
    const s16x4 lo = __builtin_amdgcn_ds_read_tr16_b64_v4i16((LAS s16x4*)(T + a0));
    const s16x4 hi = __builtin_amdgcn_ds_read_tr16_b64_v4i16((LAS s16x4*)(T + a1));
    return __builtin_shufflevector(lo, hi, 0, 1, 2, 3, 4, 5, 6, 7);
}
#define MFMA16(a, b, c) __builtin_amdgcn_mfma_f32_16x16x32_bf16(a, b, c, 0, 0, 0)

#ifndef PROBE_SEC
#define PROBE_SEC -1
#endif
#define SEC_BEGIN(F, id) do { if (PROBE_SEC == (id)) { __syncthreads(); (F).t0 = __builtin_amdgcn_s_memrealtime(); } } while (0)
#define SEC_END(F, id) do { if (PROBE_SEC == (id)) { __syncthreads(); (F).tsec += __builtin_amdgcn_s_memrealtime() - (F).t0; } } while (0)
struct Frame {
    unsigned long long t0, tsec;
    lptr lds; int tid, lane, wave, G, vcu;
    const float* in[20]; float* out; unsigned char* ws;
};

template <bool SCALE>
__device__ __forceinline__ void stage_tile(const Frame& F, lptr T, const bf16* src, int ld, const LAS float* rowscale) {
    const int cg = F.tid & 15, sb = F.tid >> 4;
    u32x4 w[4];
#pragma unroll
    for (int r = 0; r < 4; ++r) w[r] = *(const u32x4*)(src + (size_t)(4 * sb + r) * ld + 8 * cg);
#pragma unroll
    for (int r = 0; r < 4; ++r) { const int s = 4 * sb + r;
        if (SCALE) { float f[8]; unpack8(w[r], f); const float sc = rowscale[s];
#pragma unroll
            for (int i = 0; i < 8; ++i) f[i] *= sc;
            w[r] = pack8(f); }
        *(LAS u32x4*)(T + off_b(s, cg)) = w[r]; }
}
__device__ __forceinline__ void stage_conv(const Frame& F, lptr T, const bf16* src, const LAS float* cw, int tpos, float scale, u32x4 (&out)[4]) {
    const int cg = F.tid & 15, sb = F.tid >> 4;
    u32x4 w[7];
#pragma unroll
    for (int j = 0; j < 7; ++j) { const int s = 4 * sb - 3 + j; w[j] = (tpos + s >= 0) ? *(const u32x4*)(src + (ptrdiff_t)s * PROJ_LD + 8 * cg) : (u32x4){0u, 0u, 0u, 0u}; }
#pragma unroll
    for (int hf = 0; hf < 2; ++hf) {
        f32x4 tp4[4];
#pragma unroll
        for (int tp = 0; tp < 4; ++tp) tp4[tp] = *(const LAS f32x4*)(cw + tp * 128 + 8 * cg + 4 * hf);
        float a[4][4];
#pragma unroll
        for (int r = 0; r < 4; ++r)
#pragma unroll
            for (int i = 0; i < 4; ++i) a[r][i] = 0.f;
#pragma unroll
        for (int j = 0; j < 7; ++j) { const unsigned u0 = hf ? w[j].z : w[j].x, u1 = hf ? w[j].w : w[j].y;
            const float f[4] = {__builtin_bit_cast(float, u0 << 16), __builtin_bit_cast(float, u0 & 0xffff0000u), __builtin_bit_cast(float, u1 << 16), __builtin_bit_cast(float, u1 & 0xffff0000u)};
#pragma unroll
            for (int r = 0; r < 4; ++r) { const int tp = j - r; if (tp >= 0 && tp < 4) {
#pragma unroll
                for (int i = 0; i < 4; ++i) a[r][i] += tp4[tp][i] * f[i]; } } }
#pragma unroll
        for (int r = 0; r < 4; ++r) {
#pragma unroll
            for (int i = 0; i < 4; ++i) a[r][i] = a[r][i] * fsigmoid(a[r][i]) * scale;
            const unsigned p0 = pk2(a[r][0], a[r][1]), p1 = pk2(a[r][2], a[r][3]);
            if (hf == 0) { out[r].x = p0; out[r].y = p1; } else { out[r].z = p0; out[r].w = p1; } }
        __builtin_amdgcn_sched_barrier(0);
    }
#pragma unroll
    for (int r = 0; r < 4; ++r) *(LAS u32x4*)(T + off_b(4 * sb + r, cg)) = out[r];
}
__device__ __forceinline__ void p0_item(const float* Wsrc, int ld, bf16* dst, int Kd, LAS float* scr, int lane) {
#pragma unroll 8
    for (int i = 0; i < 32; ++i) { const int kk = 2 * i + (lane >> 5); scr[kk * 33 + (lane & 31)] = Wsrc[(size_t)kk * ld + (lane & 31)]; }
    asm volatile("s_waitcnt lgkmcnt(0)" ::: "memory");
    const int c = lane & 7;
#pragma unroll
    for (int j = 0; j < 4; ++j) { const int n = (lane >> 3) + 8 * j; const LAS float* s = scr + (8 * c) * 33 + n;
        u32x4 o; o.x = pk2(s[0 * 33], s[1 * 33]); o.y = pk2(s[2 * 33], s[3 * 33]); o.z = pk2(s[4 * 33], s[5 * 33]); o.w = pk2(s[6 * 33], s[7 * 33]);
        *(u32x4*)(dst + (size_t)n * Kd + 8 * c) = o; }
    asm volatile("s_waitcnt lgkmcnt(0)" ::: "memory");
}
__device__ __forceinline__ void p0_item_split(const float* Wsrc, int ld, bf16* dhi, bf16* dlo, int Kd, LAS float* scr, int lane) {
#pragma unroll 8
    for (int i = 0; i < 32; ++i) { const int kk = 2 * i + (lane >> 5); scr[kk * 33 + (lane & 31)] = Wsrc[(size_t)kk * ld + (lane & 31)]; }
    asm volatile("s_waitcnt lgkmcnt(0)" ::: "memory");
    const int c = lane & 7;
#pragma unroll
    for (int j = 0; j < 4; ++j) { const int n = (lane >> 3) + 8 * j; const LAS float* s = scr + (8 * c) * 33 + n;
        float v[8], l[8];
#pragma unroll
        for (int i = 0; i < 8; ++i) { v[i] = s[i * 33]; l[i] = v[i] - bf2f((unsigned short)f2bf(v[i])); }
        *(u32x4*)(dhi + (size_t)n * Kd + 8 * c) = pack8(v); *(u32x4*)(dlo + (size_t)n * Kd + 8 * c) = pack8(l); }
    asm volatile("s_waitcnt lgkmcnt(0)" ::: "memory");
}

struct P0Item { const float* src; bf16* dst; int ld; };
__device__ __forceinline__ void p0_load(const P0Item& it, int lane, f32x4 (&v)[8]) {
    const float* p = it.src + (size_t)(8 * (lane & 7)) * it.ld + 4 * (lane >> 3);
#pragma unroll
    for (int j = 0; j < 8; ++j) v[j] = __builtin_nontemporal_load((const f32x4*)(p + (size_t)j * it.ld));
}
__device__ __forceinline__ void p0_store(const P0Item& it, int lane, const f32x4 (&v)[8]) {
    bf16* q = it.dst + (size_t)(4 * (lane >> 3)) * 1024 + 8 * (lane & 7);
#pragma unroll
    for (int i = 0; i < 4; ++i) { u32x4 o; o.x = pk2(v[0][i], v[1][i]); o.y = pk2(v[2][i], v[3][i]); o.z = pk2(v[4][i], v[5][i]); o.w = pk2(v[6][i], v[7][i]);
        *(u32x4*)(q + (size_t)i * 1024) = o; }
}
constexpr int IMG_ROW = 2064;
template <int NF>
__device__ __forceinline__ float row_pass(const float* X, const float* gain, bf16* XNout, lptr img_hi, lptr img_lo, int tok0, int lane, f32x4 (&acc)[NF]) {
    const int r = lane & 15, g = lane >> 4;
    const float* xr = X + (size_t)(tok0 + r) * 1024 + 8 * g;
    float ss = 0.f;
#pragma unroll
    for (int nf = 0; nf < NF; ++nf) acc[nf] = (f32x4){0.f, 0.f, 0.f, 0.f};
    bf16* orow = XNout + (size_t)(tok0 + r) * 1024 + 8 * g;
#pragma unroll 16
    for (int ks = 0; ks < 32; ++ks) { const f32x4 a = __builtin_nontemporal_load((const f32x4*)(xr + 32 * ks)), b = __builtin_nontemporal_load((const f32x4*)(xr + 32 * ks + 4));
        ss += (a[0] * a[0] + a[1] * a[1]) + (a[2] * a[2] + a[3] * a[3]) + (b[0] * b[0] + b[1] * b[1]) + (b[2] * b[2] + b[3] * b[3]);
        const f32x4 ga = *(const f32x4*)(gain + 32 * ks + 8 * g), gb = *(const f32x4*)(gain + 32 * ks + 8 * g + 4);
        float v[8], l[8];
#pragma unroll
        for (int i = 0; i < 4; ++i) { v[i] = a[i] * ga[i]; v[4 + i] = b[i] * gb[i]; }
        const u32x4 hi = pack8(v);
        { float h[8]; unpack8(hi, h);
#pragma unroll
          for (int i = 0; i < 8; ++i) l[i] = v[i] - h[i]; }
        const u32x4 lo = pack8(l);
        *(u32x4*)(orow + 32 * ks) = hi;
        const bf16x8 ahi = __builtin_bit_cast(bf16x8, hi), alo = __builtin_bit_cast(bf16x8, lo);
#pragma unroll
        for (int nf = 0; nf < NF; ++nf) { const unsigned bo = (unsigned)(16 * nf + (lane & 15)) * IMG_ROW + 64u * ks + 16u * g;
            const bf16x8 bhi = *(const LAS bf16x8*)(img_hi + bo), blo = *(const LAS bf16x8*)(img_lo + bo);
            acc[nf] = MFMA16(ahi, bhi, acc[nf]); acc[nf] = MFMA16(ahi, blo, acc[nf]); acc[nf] = MFMA16(alo, bhi, acc[nf]); } }
    ss += __shfl_xor(ss, 16); ss += __shfl_xor(ss, 32);
    return 1.0f / sqrtf(ss * (1.0f / 1024.0f) + 1e-6f);
}

__device__ __forceinline__ void phase0(Frame& F) {
    const float* x = F.in[0]; const float* g1 = F.in[1]; const float* w_in = F.in[2]; const float* b_i = F.in[4]; const float* b_f = F.in[5];
    const float* w_out = F.in[11]; const float* wr = F.in[13]; const float* w_up = F.in[15]; const float* w_dn = F.in[17];
    bf16* WinT = (bf16*)(F.ws + WS_WINT); bf16* WoutT = (bf16*)(F.ws + WS_WOUTT); bf16* WdnT = (bf16*)(F.ws + WS_WDNT); bf16* WupT = (bf16*)(F.ws + WS_WUPT);
    bf16* WrThi = (bf16*)(F.ws + WS_WRT); bf16* WrTlo = WrThi + 32 * 1024;
    bf16* XN = (bf16*)(F.ws + WS_XN); float* GATES = (float*)(F.ws + WS_GATES); float* RS1 = (float*)(F.ws + WS_RS1);
    lptr ghi = F.lds + T0, glo = F.lds + T0 + 16 * IMG_ROW;
    SEC_BEGIN(F, 1);
#pragma unroll
    for (int q = 0; q < 2; ++q) { const int kk = F.tid + NTHR * q; const f32x4 a = *(const f32x4*)(w_in + (size_t)kk * 3080 + 2048), b = *(const f32x4*)(w_in + (size_t)kk * 3080 + 2052);
        const float v[8] = {a[0], a[1], a[2], a[3], b[0], b[1], b[2], b[3]};
#pragma unroll
        for (int j = 0; j < 8; ++j) { const unsigned h = f2bf(v[j]); const float l = v[j] - bf2f((unsigned short)h);
            *(LAS unsigned short*)(ghi + j * IMG_ROW + 2 * kk) = (unsigned short)h; *(LAS unsigned short*)(glo + j * IMG_ROW + 2 * kk) = (unsigned short)f2bf(l); } }
    __syncthreads();
    SEC_END(F, 1); SEC_BEGIN(F, 2);
    if (F.wave < 4) { const int tok0 = F.vcu * 64 + F.wave * 16; f32x4 acc[1];
      const float rstd = row_pass<1>(x, g1, XN, ghi, glo, tok0, F.lane, acc);
      if (F.lane < 16) RS1[tok0 + F.lane] = rstd;
      const int j = F.lane & 15, gq = F.lane >> 4;
      float rr[4];
#pragma unroll
      for (int rg = 0; rg < 4; ++rg) rr[rg] = __shfl(rstd, 4 * gq + rg);
      if (j < 8) {
#pragma unroll
          for (int rg = 0; rg < 4; ++rg) { const int tok = tok0 + 4 * gq + rg; float v = acc[0][rg] * rr[rg];
              if (j < 4) v += b_i[j]; else { v += b_f[j - 4]; v = fminf(v, 0.f) - log1pf(expf(-fabsf(v))); }
              GATES[(size_t)tok * 8 + j] = v; } } }
    SEC_END(F, 2); SEC_BEGIN(F, 3);
    const float* b_unused = nullptr; (void)b_unused;
    const int gw = F.vcu * NWAVES + F.wave, NGW = F.G * NWAVES;
    if (F.vcu < 4 && F.wave >= 4) { const int ri = F.vcu * 4 + F.wave - 4; LAS float* scr = (LAS float*)(F.lds + 66560 + (F.wave - 4) * 8448);
        p0_item_split(wr + (size_t)(64 * ri) * 32, 32, WrThi + 64 * ri, WrTlo + 64 * ri, 1024, scr, F.lane); }
    constexpr int I_IN = 16 * 96, I_OUT = 16 * 32, I_DN = 32 * 16 * 32, I_UP = 32 * 16 * 64, NITEMS = I_IN + I_OUT + I_DN + I_UP;
    auto decode = [&](int it) -> P0Item {
        int r = it; P0Item o;
        if (r < I_IN) { const int kb = r / 96, nb = r % 96, nd = 32 * nb, nsrc = nd < 2048 ? nd : nd + 8;
            o.src = w_in + (size_t)(64 * kb) * 3080 + nsrc; o.ld = 3080; o.dst = WinT + (size_t)nd * 1024 + 64 * kb; return o; } r -= I_IN;
        if (r < I_OUT) { const int kb = r / 32, nb = r % 32;
            o.src = w_out + (size_t)(64 * kb) * 1024 + 32 * nb; o.ld = 1024; o.dst = WoutT + (size_t)(32 * nb) * 1024 + 64 * kb; return o; } r -= I_OUT;
        if (r < I_DN) { const int e = r / 512, q = r % 512, kb = q / 32, nb = q % 32;
            o.src = w_dn + ((size_t)e * 1024 + 64 * kb) * 1024 + 32 * nb; o.ld = 1024; o.dst = WdnT + ((size_t)e * 1024 + 32 * nb) * 1024 + 64 * kb; return o; } r -= I_DN;
        { const int e = r / 1024, q = r % 1024, kb = q / 64, nb = q % 64, n = 32 * nb, half = n >> 10, jj = n & 1023, pn = jj >> 7, j = jj & 127, nd = 256 * pn + 128 * half + j;
          o.src = w_up + ((size_t)e * 1024 + 64 * kb) * 2048 + n; o.ld = 2048; o.dst = WupT + ((size_t)e * 2048 + nd) * 1024 + 64 * kb; return o; }
    };
    constexpr int PER_WAVE = NITEMS / (256 * NWAVES), SHIFT = 4;
    static_assert(NITEMS % (256 * NWAVES) == 0 && SHIFT % 2 == 0, "item split");
    const int nown = F.wave < 4 ? PER_WAVE - SHIFT : PER_WAVE + SHIFT;
    for (int j = 0; j < nown; j += 2) {
        const bool two = j + 1 < nown;
        const int j0 = j, j1 = two ? j + 1 : j;
        const int ita = (j0 < PER_WAVE) ? gw + j0 * NGW : (gw - 4) + (j0 - SHIFT) * NGW;
        const int itb = (j1 < PER_WAVE) ? gw + j1 * NGW : (gw - 4) + (j1 - SHIFT) * NGW;
        const P0Item ia = decode(ita), ib = decode(itb);
        f32x4 va[8], vb[8];
        p0_load(ia, F.lane, va); p0_load(ib, F.lane, vb);
        p0_store(ia, F.lane, va); if (two) p0_store(ib, F.lane, vb);
    }
    SEC_END(F, 3);
}

__device__ __forceinline__ float wscan_add(float v, int lane) {
#pragma unroll
    for (int o = 1; o < 64; o <<= 1) { const float t = __shfl_up(v, o); if (lane >= o) v += t; }
    return v;
}
__device__ __forceinline__ float wscan_max(float v, int lane) {
#pragma unroll
    for (int o = 1; o < 64; o <<= 1) { const float t = __shfl_up(v, o); if (lane >= o) v = fmaxf(v, t); }
    return v;
}
__device__ __forceinline__ float wmax_all(float v) {
#pragma unroll
    for (int o = 32; o > 0; o >>= 1) v = fmaxf(v, __shfl_xor(v, o));
    return v;
}

__device__ __forceinline__ void mlstm_local_unit(Frame& F0, int u) {
    Frame F = F0; asm volatile("" : "+v"(F.tid), "+v"(F.lane));
    const int c = u & 63, h = (u >> 6) & 3, b = u >> 8, row0 = b * 8192 + c * 128;
    const bf16* PROJ = (const bf16*)(F.ws + WS_PROJ); const float* GATES = (const float*)(F.ws + WS_GATES); const float* conv = F.in[3];
    float* CLOC = (float*)(F.ws + WS_CLOC); float* MLOC = (float*)(F.ws + WS_SMALL); float* BLAST = MLOC + 512; float* NLOC = MLOC + 2048; bf16* KC = (bf16*)(F.ws + WS_KC);
    LAS float* wv = (LAS float*)(F.lds + VEC_OFF);
    LAS float* cw = wv + 128;
    LAS float* part = cw + 512;
    const int lane = F.lane, w = F.wave;
    SEC_BEGIN(F, 10);
#pragma unroll
    for (int j = 0; j < 8; ++j) { const int i = lane + 64 * j; cw[i] = conv[(i >> 7) * 1024 + 512 + h * 128 + (i & 127)]; }
    { const int l = lane, s0 = 2 * l, s1 = s0 + 1;
        const float li0 = GATES[(size_t)(row0 + s0) * 8 + h], li1 = GATES[(size_t)(row0 + s1) * 8 + h], lf0 = GATES[(size_t)(row0 + s0) * 8 + 4 + h], lf1 = GATES[(size_t)(row0 + s1) * 8 + 4 + h];
        const float inc = wscan_add(lf0 + lf1, l), b1 = inc, b0 = inc - lf1, blast = __shfl(inc, 63);
        const float g0 = blast - b0 + li0, g1 = blast - b1 + li1, mloc = wmax_all(fmaxf(g0, g1));
        wv[s0] = fexp(g0 - mloc); wv[s1] = fexp(g1 - mloc);
        if (l == 0 && w == 0) { MLOC[u] = mloc; BLAST[u] = blast; } }
    SEC_END(F, 10); SEC_BEGIN(F, 11);
    { u32x4 kv[4]; const int cg = F.tid & 15, sb = F.tid >> 4;
      stage_conv(F, F.lds + T1, PROJ + (size_t)row0 * PROJ_LD + KO + h * 128, cw, c * 128, 0.08838834764831845f, kv);
      float pn[8];
#pragma unroll
      for (int i = 0; i < 8; ++i) pn[i] = 0.f;
#pragma unroll
      for (int r = 0; r < 4; ++r) { *(u32x4*)(KC + (size_t)(row0 + 4 * sb + r) * 512 + h * 128 + 8 * cg) = kv[r];
          float f[8]; unpack8(kv[r], f); const float ws = wv[4 * sb + r];
#pragma unroll
          for (int i = 0; i < 8; ++i) pn[i] += ws * f[i]; }
#pragma unroll
      for (int i = 0; i < 8; ++i) { pn[i] += __shfl_xor(pn[i], 16); pn[i] += __shfl_xor(pn[i], 32); }
      if (lane < 16) { *(LAS f32x4*)(part + w * 128 + 8 * cg) = (f32x4){pn[0], pn[1], pn[2], pn[3]}; *(LAS f32x4*)(part + w * 128 + 8 * cg + 4) = (f32x4){pn[4], pn[5], pn[6], pn[7]}; } }
    stage_tile<true>(F, F.lds + T2, PROJ + (size_t)row0 * PROJ_LD + VO + h * 128, PROJ_LD, wv);
    __syncthreads();
    SEC_END(F, 11); SEC_BEGIN(F, 12);
    { f32x4 acc[8];
#pragma unroll
      for (int kb = 0; kb < 8; ++kb) acc[kb] = (f32x4){0.f, 0.f, 0.f, 0.f};
#pragma unroll
      for (int ks = 0; ks < 4; ++ks) { const bf16x8 a = frag_tr(F.lds + T2, w, ks, lane);
#pragma unroll
          for (int kb = 0; kb < 8; ++kb) { const bf16x8 bb = frag_tr(F.lds + T1, kb, ks, lane); acc[kb] = MFMA16(a, bb, acc[kb]); } }
      float* cl = CLOC + (size_t)u * 16384 + (size_t)(16 * w + 4 * (lane >> 4)) * 128 + (lane & 15);
#pragma unroll
      for (int kb = 0; kb < 8; ++kb)
#pragma unroll
          for (int rg = 0; rg < 4; ++rg) cl[rg * 128 + 16 * kb] = acc[kb][rg]; }
    if (F.tid < 128) { float a = 0.f;
#pragma unroll
        for (int ww = 0; ww < 8; ++ww) a += part[ww * 128 + F.tid];
        NLOC[(size_t)u * 128 + F.tid] = a; }
    __syncthreads();
    SEC_END(F, 12);
    F0.tsec = F.tsec;
}

__device__ __forceinline__ void gmlp_unit(Frame& F0, int ug) {
    Frame F = F0; asm volatile("" : "+v"(F.tid), "+v"(F.lane));
    const int g = ug & 3, row0 = (ug >> 2) * 128;
    const bf16* PROJ = (const bf16*)(F.ws + WS_PROJ); bf16* MIX = (bf16*)(F.ws + WS_MIX);
    const float* lng = F.in[7]; const float* wsp = F.in[8]; const float* bsp = F.in[9]; const float* og = F.in[10]; float* PSSQ = (float*)(F.ws + WS_RSG);
    LAS float* st_mean = (LAS float*)(F.lds + VEC_OFF); LAS float* st_rstd = st_mean + 128;
    const int w = F.wave, lane = F.lane;
    SEC_BEGIN(F, 20);
    { const int t = F.tid >> 2, q = F.tid & 3; const bf16* vp = PROJ + (size_t)(row0 + t) * PROJ_LD + VGO + 128 * q;
      float s = 0.f, s2 = 0.f;
#pragma unroll 8
      for (int j = 0; j < 16; ++j) { float f[8]; unpack8(*(const u32x4*)(vp + 8 * j), f);
#pragma unroll
          for (int i = 0; i < 8; ++i) { s += f[i]; s2 += f[i] * f[i]; } }
      s += __shfl_xor(s, 1); s += __shfl_xor(s, 2); s2 += __shfl_xor(s2, 1); s2 += __shfl_xor(s2, 2);
      const float mean = s * (1.0f / 512.0f), var = fmaxf(s2 * (1.0f / 512.0f) - mean * mean, 0.f);
      if (q == 0) { st_mean[t] = mean; st_rstd[t] = 1.0f / sqrtf(var + 1e-6f); } }
    __syncthreads();
    SEC_END(F, 20); SEC_BEGIN(F, 21);
    { const int cg = F.tid & 15, sb = F.tid >> 4;
      const f32x4 l0 = *(const f32x4*)(lng + g * 128 + 8 * cg), l1 = *(const f32x4*)(lng + g * 128 + 8 * cg + 4);
      u32x4 vv[4], uu[4]; f32x4 wa[4], wb[4];
#pragma unroll
      for (int r = 0; r < 4; ++r) { const int t = 4 * sb + r;
          vv[r] = *(const u32x4*)(PROJ + (size_t)(row0 + t) * PROJ_LD + VGO + g * 128 + 8 * cg); uu[r] = *(const u32x4*)(PROJ + (size_t)(row0 + t) * PROJ_LD + UO + g * 128 + 8 * cg);
          const float* wp = wsp + ((size_t)(g * 128 + t)) * 128 + 8 * cg; wa[r] = *(const f32x4*)wp; wb[r] = *(const f32x4*)(wp + 4); }
#pragma unroll
      for (int r = 0; r < 4; ++r) { const int t = 4 * sb + r;
          float f[8] = {wa[r][0], wa[r][1], wa[r][2], wa[r][3], wb[r][0], wb[r][1], wb[r][2], wb[r][3]};
#pragma unroll
          for (int kk = 0; kk < 8; ++kk) if (8 * cg + kk > t) f[kk] = 0.f;
          *(LAS u32x4*)(F.lds + T0 + off_b(t, cg)) = pack8(f);
          float v[8]; unpack8(vv[r], v); const float mean = st_mean[t], rstd = st_rstd[t];
#pragma unroll
          for (int kk = 0; kk < 8; ++kk) v[kk] = (v[kk] - mean) * rstd * (kk < 4 ? l0[kk] : l1[kk - 4]);
          *(LAS u32x4*)(F.lds + T1 + off_b(t, cg)) = pack8(v);
          *(LAS u32x4*)(F.lds + T2 + off_b(t, cg)) = uu[r]; } }
    __syncthreads();
    SEC_END(F, 21); SEC_BEGIN(F, 22);
    f32x4 acc[8];
#pragma unroll
    for (int db = 0; db < 8; ++db) acc[db] = (f32x4){0.f, 0.f, 0.f, 0.f};
    for (int ks = 0; ks <= (w >> 1); ++ks) { const bf16x8 a = frag_row(F.lds + T0, 16 * w, ks, lane);
#pragma unroll
        for (int db = 0; db < 8; ++db) { const bf16x8 bb = frag_tr(F.lds + T1, db, ks, lane); acc[db] = MFMA16(a, bb, acc[db]); } }
    float ssq[4] = {0.f, 0.f, 0.f, 0.f}; float ogv[8];
#pragma unroll
    for (int db = 0; db < 8; ++db) ogv[db] = og[g * 128 + 16 * db + (lane & 15)];
#pragma unroll
    for (int rg = 0; rg < 4; ++rg) { int t = 16 * w + 4 * (lane >> 4) + rg; const float bs = bsp[g * 128 + t]; asm volatile("" : "+v"(t));
#pragma unroll
        for (int db = 0; db < 8; ++db) { const int d = 16 * db + (lane & 15);
            const float gu = bf2f(*(const LAS unsigned short*)(F.lds + T2 + off_b(t, d >> 3) + 2 * (d & 7)));
            const float val = (acc[db][rg] + bs) * gu; ssq[rg] += val * val;
            *(LAS unsigned short*)(F.lds + T3 + off_b(t, d >> 3) + 2 * (d & 7)) = (unsigned short)(pk2(val * ogv[db], 0.f) & 0xffffu); } }
#pragma unroll
    for (int i = 0; i < 4; ++i) { const int id = lane + 64 * i, r = id >> 4, ch = id & 15, t = 16 * w + r;
        *(u32x4*)(MIX + (size_t)(row0 + t) * 1024 + 512 + g * 128 + 8 * ch) = *(const LAS u32x4*)(F.lds + T3 + off_b(t, ch)); }
#pragma unroll
    for (int rg = 0; rg < 4; ++rg) { float q = ssq[rg]; q += __shfl_xor(q, 1); q += __shfl_xor(q, 2); q += __shfl_xor(q, 4); q += __shfl_xor(q, 8);
        if ((lane & 15) == 0) PSSQ[(size_t)g * 16384 + row0 + 16 * w + 4 * (lane >> 4) + rg] = q; }
    __syncthreads();
    SEC_END(F, 22);
    F0.tsec = F.tsec;
}

__device__ __forceinline__ void phase_scan(const Frame& F) {
    const float* CLOC = (const float*)(F.ws + WS_CLOC); float* MLOC = (float*)(F.ws + WS_SMALL); float* BLAST = MLOC + 512; float* MPREV = MLOC + 1024;
    float* NLOC = MLOC + 2048; float* NPREV = NLOC + 512 * 128; bf16* CPREV = (bf16*)(F.ws + WS_CPREV);
    LAS float* av = (LAS float*)(F.lds + VEC_OFF); LAS float* cv = av + 64;
    const int wg = F.vcu, bh = wg >> 5;
    if (F.wave == 0) { const int l = F.lane; const float ml = MLOC[bh * 64 + l], bl = BLAST[bh * 64 + l];
        float m = 0.f, mym = 0.f, mynext = 0.f;
        for (int c = 0; c < 64; ++c) { const float mlc = __shfl(ml, c), blc = __shfl(bl, c); const float mn = fmaxf(blc + m, mlc); if (l == c) { mym = m; mynext = mn; } m = mn; }
        av[l] = fexp(bl + mym - mynext); cv[l] = fexp(ml - mynext);
        if ((wg & 31) == 0) MPREV[bh * 64 + l] = mym; }
    __syncthreads();
    if (F.tid < 256) { const int p = (wg & 31) * 256 + F.tid; float v0 = 0.f, v1 = 0.f;
        const float* src = CLOC + (size_t)(bh * 64) * 16384 + 2 * p; bf16* dst = CPREV + (size_t)(bh * 64) * 16384 + 2 * p;
#pragma unroll 8
        for (int c = 0; c < 64; ++c) { const float2 x = *(const float2*)(src + (size_t)c * 16384);
            *(unsigned*)(dst + (size_t)c * 16384) = pk2(v0, v1);
            const float a = av[c], cc = cv[c]; v0 = a * v0 + cc * x.x; v1 = a * v1 + cc * x.y; } }
    else if (F.tid < 320 && (wg & 31) == 0) { const int p = F.tid - 256; float v0 = 0.f, v1 = 0.f;
        for (int c = 0; c < 64; ++c) { const float2 x = *(const float2*)(NLOC + (size_t)(bh * 64 + c) * 128 + 2 * p);
            *(float2*)(NPREV + (size_t)(bh * 64 + c) * 128 + 2 * p) = make_float2(v0, v1);
            const float a = av[c], cc = cv[c]; v0 = a * v0 + cc * x.x; v1 = a * v1 + cc * x.y; } }
    __syncthreads();
}

__device__ __forceinline__ void mlstm_out_unit(Frame& F0, int u) {
    Frame F = F0; asm volatile("" : "+v"(F.tid), "+v"(F.lane));
    const int c = u & 63, h = (u >> 6) & 3, b = u >> 8, row0 = b * 8192 + c * 128;
    const bf16* PROJ = (const bf16*)(F.ws + WS_PROJ); const float* GATES = (const float*)(F.ws + WS_GATES); const float* conv = F.in[3]; const float* ngain = F.in[6];
    const float* MPREV = (const float*)(F.ws + WS_SMALL) + 1024; const float* NPREV = (const float*)(F.ws + WS_SMALL) + 2048 + 512 * 128;
    const bf16* CPREV = (const bf16*)(F.ws + WS_CPREV); bf16* MIX = (bf16*)(F.ws + WS_MIX);
    LAS float* colc = (LAS float*)(F.lds + VEC_OFF); LAS float* rowc = colc + 128; LAS float* inter = rowc + 128; LAS float* emn = inter + 128; LAS float* rdn = emn + 128;
    LAS float* npv = rdn + 128; LAS float* cw = npv + 128;
    const int w = F.wave, lane = F.lane;
    SEC_BEGIN(F, 30);
#pragma unroll
    for (int j = 0; j < 8; ++j) { const int i = lane + 64 * j; cw[i] = conv[(i >> 7) * 1024 + h * 128 + (i & 127)]; }
    npv[lane] = NPREV[(size_t)u * 128 + lane]; npv[64 + lane] = NPREV[(size_t)u * 128 + 64 + lane];
    { const int l = lane, s0 = 2 * l, s1 = s0 + 1;
        const float li0 = GATES[(size_t)(row0 + s0) * 8 + h], li1 = GATES[(size_t)(row0 + s1) * 8 + h], lf0 = GATES[(size_t)(row0 + s0) * 8 + 4 + h], lf1 = GATES[(size_t)(row0 + s1) * 8 + 4 + h];
        const float inc = wscan_add(lf0 + lf1, l), b1 = inc, b0 = inc - lf1;
        const float c0 = li0 - b0, c1 = li1 - b1;
        const float pmx = wscan_max(fmaxf(c0, c1), l); float pprev = __shfl_up(pmx, 1); if (l == 0) pprev = -INFINITY;
        const float pm0 = fmaxf(pprev, c0), pm1 = pmx, mprev = MPREV[u];
        const float m0 = b0 + fmaxf(mprev, pm0), m1 = b1 + fmaxf(mprev, pm1);
        colc[s0] = c0; colc[s1] = c1; rowc[s0] = b0 - m0; rowc[s1] = b1 - m1;
        inter[s0] = fexp(b0 + mprev - m0); inter[s1] = fexp(b1 + mprev - m1); emn[s0] = fexp(-m0); emn[s1] = fexp(-m1); }
    SEC_END(F, 30); SEC_BEGIN(F, 31);
    { u32x4 qv[4]; stage_conv(F, F.lds + T0, PROJ + (size_t)row0 * PROJ_LD + QO + h * 128, cw, c * 128, 1.0f, qv); }
    stage_tile<false>(F, F.lds + T1, (const bf16*)(F.ws + WS_KC) + (size_t)row0 * 512 + h * 128, 512, nullptr);
    stage_tile<false>(F, F.lds + T2, PROJ + (size_t)row0 * PROJ_LD + VO + h * 128, PROJ_LD, nullptr);
    stage_tile<false>(F, F.lds + T3, CPREV + (size_t)u * 16384, 128, nullptr);
    __syncthreads();
    SEC_END(F, 31); SEC_BEGIN(F, 32);
    const int t = 16 * w + (lane & 15);
    u32x2 wpk[8]; float rsum = 0.f;
    { const float rc = rowc[t];
#pragma unroll
      for (int sb = 0; sb < 8; ++sb) { wpk[sb] = (u32x2){0u, 0u};
          if (sb <= w) { f32x4 a4 = (f32x4){0.f, 0.f, 0.f, 0.f};
#pragma unroll
              for (int ks = 0; ks < 4; ++ks) { const bf16x8 a = frag_row(F.lds + T1, 16 * sb, ks, lane), bb = frag_row(F.lds + T0, 16 * w, ks, lane); a4 = MFMA16(a, bb, a4); }
              float wv4[4];
#pragma unroll
              for (int rg = 0; rg < 4; ++rg) { const int s = 16 * sb + 4 * (lane >> 4) + rg; const float e = fexp(rc + colc[s]) * a4[rg]; wv4[rg] = (s <= t) ? e : 0.f; }
              wpk[sb].x = pk2(wv4[0], wv4[1]); wpk[sb].y = pk2(wv4[2], wv4[3]);
              rsum += bf2f((unsigned short)(wpk[sb].x & 0xffffu)) + bf2f((unsigned short)(wpk[sb].x >> 16)) + bf2f((unsigned short)(wpk[sb].y & 0xffffu)) + bf2f((unsigned short)(wpk[sb].y >> 16)); } } }
    __syncthreads();
    SEC_END(F, 32); SEC_BEGIN(F, 33);
    { int t2 = t; asm volatile("" : "+v"(t2));
#pragma unroll
    for (int sb = 0; sb < 8; ++sb) if (sb <= (w | 1)) *(LAS u32x2*)(F.lds + T1 + off_b(t2, 2 * sb + (lane >> 5)) + 8 * ((lane >> 4) & 1)) = wpk[sb]; }
    rsum += __shfl_xor(rsum, 16); rsum += __shfl_xor(rsum, 32);
    { float qn = 0.f; const int part = lane >> 4;
#pragma unroll
      for (int i = 0; i < 4; ++i) { float f[8]; unpack8(*(const LAS u32x4*)(F.lds + T0 + off_b(t, 4 * part + i)), f);
#pragma unroll
          for (int k = 0; k < 8; ++k) qn += f[k] * npv[32 * part + 8 * i + k]; }
      qn += __shfl_xor(qn, 16); qn += __shfl_xor(qn, 32);
      const float den = rsum + inter[t] * qn;
      if (lane < 16) rdn[t] = 1.0f / fmaxf(fabsf(den), emn[t]); }
    f32x4 acc[8];
#pragma unroll
    for (int vb = 0; vb < 8; ++vb) acc[vb] = (f32x4){0.f, 0.f, 0.f, 0.f};
#pragma unroll
    for (int ks = 0; ks < 4; ++ks) { const bf16x8 a = frag_row(F.lds + T0, 16 * w, ks, lane);
#pragma unroll
        for (int vb = 0; vb < 8; ++vb) { const bf16x8 bb = frag_row(F.lds + T3, 16 * vb, ks, lane); acc[vb] = MFMA16(a, bb, acc[vb]); } }
    float it4[4], rd4[4];
#pragma unroll
    for (int rg = 0; rg < 4; ++rg) { const int tr = 16 * w + 4 * (lane >> 4) + rg; it4[rg] = inter[tr]; rd4[rg] = rdn[tr]; }
#pragma unroll
    for (int vb = 0; vb < 8; ++vb)
#pragma unroll
        for (int rg = 0; rg < 4; ++rg) acc[vb][rg] *= it4[rg];
    for (int ks = 0; ks <= (w >> 1); ++ks) { const bf16x8 a = frag_row(F.lds + T1, 16 * w, ks, lane);
#pragma unroll
        for (int vb = 0; vb < 8; ++vb) { const bf16x8 bb = frag_tr(F.lds + T2, vb, ks, lane); acc[vb] = MFMA16(a, bb, acc[vb]); } }
    SEC_END(F, 33); SEC_BEGIN(F, 34);
#pragma unroll
    for (int rg = 0; rg < 4; ++rg) { float s = 0.f;
#pragma unroll
        for (int vb = 0; vb < 8; ++vb) { acc[vb][rg] *= rd4[rg]; s += acc[vb][rg]; }
        s += __shfl_xor(s, 1); s += __shfl_xor(s, 2); s += __shfl_xor(s, 4); s += __shfl_xor(s, 8);
        const float mean = s * (1.0f / 128.0f); float q = 0.f;
#pragma unroll
        for (int vb = 0; vb < 8; ++vb) { acc[vb][rg] -= mean; q += acc[vb][rg] * acc[vb][rg]; }
        q += __shfl_xor(q, 1); q += __shfl_xor(q, 2); q += __shfl_xor(q, 4); q += __shfl_xor(q, 8);
        const float rstd = 1.0f / sqrtf(q * (1.0f / 128.0f) + 1e-6f);
#pragma unroll
        for (int vb = 0; vb < 8; ++vb) acc[vb][rg] *= rstd; }
#pragma unroll
    for (int vb = 0; vb < 8; ++vb) { const int d = 16 * vb + (lane & 15); const float gg = ngain[h * 128 + d];
#pragma unroll
        for (int rg = 0; rg < 4; ++rg) { int tr = 16 * w + 4 * (lane >> 4) + rg; asm volatile("" : "+v"(tr));
            *(LAS unsigned short*)(F.lds + T1 + off_b(tr, d >> 3) + 2 * (d & 7)) = (unsigned short)(pk2(acc[vb][rg] * gg, 0.f) & 0xffffu); } }
#pragma unroll
    for (int i = 0; i < 4; ++i) { const int id = lane + 64 * i, r = id >> 4, ch = id & 15, tr = 16 * w + r;
        float y[8], o[8]; unpack8(*(const LAS u32x4*)(F.lds + T1 + off_b(tr, ch)), y);
        unpack8(*(const u32x4*)(PROJ + (size_t)(row0 + tr) * PROJ_LD + OO + h * 128 + 8 * ch), o);
#pragma unroll
        for (int k = 0; k < 8; ++k) y[k] *= o[k];
        *(u32x4*)(MIX + (size_t)(row0 + tr) * 1024 + h * 128 + 8 * ch) = pack8(y); }
    { const float* RSG = (const float*)(F.ws + WS_RSG);
#pragma unroll
      for (int i = 0; i < 4; ++i) { const int id = lane + 64 * i, r = id >> 4, ch = id & 15, tr = 16 * w + r;
          bf16* p = MIX + (size_t)(row0 + tr) * 1024 + 512 + h * 128 + 8 * ch; float y[8]; unpack8(*(const u32x4*)p, y);
          const float rs = 1.0f / sqrtf(((RSG[row0 + tr] + RSG[16384 + row0 + tr]) + (RSG[32768 + row0 + tr] + RSG[49152 + row0 + tr])) * (1.0f / 512.0f) + 1e-6f);
#pragma unroll
          for (int kk = 0; kk < 8; ++kk) y[kk] *= rs;
          *(u32x4*)p = pack8(y); } }
    __syncthreads();
    SEC_END(F, 34);
    F0.tsec = F.tsec;
}

__device__ __forceinline__ void phase_router(Frame& F) {
    const float* H = (const float*)(F.ws + WS_H); const float* g2 = F.in[12]; const float* br = F.in[14];
    const bf16* WrThi = (const bf16*)(F.ws + WS_WRT); const bf16* WrTlo = WrThi + 32 * 1024;
    bf16* HN = (bf16*)(F.ws + WS_XN); int* cnt = (int*)(F.ws + WS_CTL) + CW_CNT; int* tokidx = (int*)(F.ws + WS_TOKIDX); float* gatex = (float*)(F.ws + WS_GATEX); float* rsx = (float*)(F.ws + WS_RSX);
    lptr ihi = F.lds, ilo = F.lds + 32 * IMG_ROW;
    LAS float* lg = (LAS float*)(F.lds + 2 * 32 * IMG_ROW);
    LAS int* hist = (LAS int*)(lg + 2048); LAS int* base = hist + 32;
    SEC_BEGIN(F, 4);
    for (int i = F.tid; i < 32 * 128; i += NTHR) { const int n = i >> 7, ch = i & 127;
        *(LAS u32x4*)(ihi + n * IMG_ROW + 16 * ch) = *(const u32x4*)(WrThi + (size_t)n * 1024 + 8 * ch);
        *(LAS u32x4*)(ilo + n * IMG_ROW + 16 * ch) = *(const u32x4*)(WrTlo + (size_t)n * 1024 + 8 * ch); }
    if (F.tid < 32) hist[F.tid] = 0;
    __syncthreads();
    SEC_END(F, 4); SEC_BEGIN(F, 5);
    const int tok0 = F.vcu * 64 + (F.wave & 3) * 16, lane = F.lane;
    int be[4] = {0, 0, 0, 0}, lr[4] = {0, 0, 0, 0}; float gt[4] = {0.f, 0.f, 0.f, 0.f}; float rstd = 0.f;
    if (F.wave < 4) {
        f32x4 acc[2];
        rstd = row_pass<2>(H, g2, HN, ihi, ilo, tok0, lane, acc);
        { float rr[4];
#pragma unroll
          for (int rg = 0; rg < 4; ++rg) rr[rg] = __shfl(rstd, 4 * (lane >> 4) + rg);
#pragma unroll
          for (int nf = 0; nf < 2; ++nf)
#pragma unroll
              for (int rg = 0; rg < 4; ++rg) lg[(F.wave * 16 + 4 * (lane >> 4) + rg) * 32 + 16 * nf + (lane & 15)] = acc[nf][rg] * rr[rg]; }
        if (lane < 16) { float v[32];
#pragma unroll
            for (int q4 = 0; q4 < 8; ++q4) { const f32x4 x = *(const LAS f32x4*)(lg + (F.wave * 16 + lane) * 32 + 4 * q4), bb = *(const f32x4*)(br + 4 * q4);
                v[4 * q4] = x[0] + bb[0]; v[4 * q4 + 1] = x[1] + bb[1]; v[4 * q4 + 2] = x[2] + bb[2]; v[4 * q4 + 3] = x[3] + bb[3]; }
            float bv[4];
#pragma unroll
            for (int k = 0; k < 4; ++k) { float best = -INFINITY; int bi = 0;
#pragma unroll
                for (int e = 0; e < 32; ++e) if (v[e] > best) { best = v[e]; bi = e; }
                be[k] = bi; bv[k] = best;
#pragma unroll
                for (int e = 0; e < 32; ++e) v[e] = (e == bi) ? -INFINITY : v[e]; }
            float den = 0.f;
#pragma unroll
            for (int k = 0; k < 4; ++k) { gt[k] = fexp(bv[k] - bv[0]); den += gt[k]; }
            const float rd = 1.0f / den;
#pragma unroll
            for (int k = 0; k < 4; ++k) { gt[k] *= rd; lr[k] = __hip_atomic_fetch_add(hist + be[k], 1, __ATOMIC_RELAXED, __HIP_MEMORY_SCOPE_WORKGROUP); } } }
    SEC_END(F, 5); SEC_BEGIN(F, 6);
    __syncthreads();
    if (F.tid < 32) base[F.tid] = hist[F.tid] > 0 ? atomicAdd(&cnt[F.tid], hist[F.tid]) : 0;
    __syncthreads();
    if (F.wave < 4 && lane < 16) { const int tok = tok0 + lane;
#pragma unroll
        for (int k = 0; k < 4; ++k) { const int rk = base[be[k]] + lr[k]; const size_t p = (size_t)be[k] * 65536 + rk; tokidx[p] = tok * 4 + k; gatex[p] = gt[k]; rsx[p] = rstd; } }
    __syncthreads();
    SEC_END(F, 6);
}

__device__ __forceinline__ int build_ttab(const Frame& F) {
    const int* cnt = (const int*)(F.ws + WS_CTL) + CW_CNT; LAS unsigned* ttab = (LAS unsigned*)(F.lds + TTAB_OFF); LAS int* tot = (LAS int*)(F.lds + MISC_OFF + 64);
    if (F.wave == 0) { const int l = F.lane; const int c = l < 32 ? __hip_atomic_load(cnt + l, RLX_AGENT) : 0; const int nt = (c + 255) >> 8;
        int inc = nt;
#pragma unroll
        for (int o = 1; o < 64; o <<= 1) { const int tt = __shfl_up(inc, o); if (l >= o) inc += tt; }
        const int start = inc - nt;
        for (int r = 0; r < nt; ++r) { const int left = c - 256 * r; ttab[start + r] = (unsigned)l | ((unsigned)r << 5) | ((unsigned)((left < 256 ? left : 256) - 1) << 14); }
        if (l == 63) tot[0] = inc; }
    __syncthreads();
    return tot[0];
}

__device__ __forceinline__ void phase_final(const Frame& F) {
    const float* H = (const float*)(F.ws + WS_H); const bf16* Y = (const bf16*)(F.ws + WS_Y); const float* gf = F.in[19];
    const int gw = F.vcu * NWAVES + F.wave, lane = F.lane;
    f32x4 gg[4];
#pragma unroll
    for (int j = 0; j < 4; ++j) gg[j] = *(const f32x4*)(gf + 4 * (lane + 64 * j));
#pragma unroll 1
    for (int i = 0; i < 8; i += 2) { const int tok = gw * 8 + i;
        f32x4 v[2][4]; u32x2 y[2][4][4];
#pragma unroll
        for (int q = 0; q < 2; ++q)
#pragma unroll
            for (int j = 0; j < 4; ++j) { v[q][j] = __builtin_nontemporal_load((const f32x4*)(H + (size_t)(tok + q) * 1024 + 4 * (lane + 64 * j)));
#pragma unroll
                for (int k = 0; k < 4; ++k) y[q][j][k] = __builtin_nontemporal_load((const u32x2*)(Y + (size_t)((tok + q) * 4 + k) * 1024 + 4 * (lane + 64 * j))); }
#pragma unroll
        for (int q = 0; q < 2; ++q) { float s = 0.f;
#pragma unroll
            for (int j = 0; j < 4; ++j) {
#pragma unroll
                for (int k = 0; k < 4; ++k) { const u32x2 yy = y[q][j][k];
                    v[q][j][0] += __builtin_bit_cast(float, yy.x << 16); v[q][j][1] += __builtin_bit_cast(float, yy.x & 0xffff0000u);
                    v[q][j][2] += __builtin_bit_cast(float, yy.y << 16); v[q][j][3] += __builtin_bit_cast(float, yy.y & 0xffff0000u); }
                s += (v[q][j][0] * v[q][j][0] + v[q][j][1] * v[q][j][1]) + (v[q][j][2] * v[q][j][2] + v[q][j][3] * v[q][j][3]); }
            const float r = 1.0f / sqrtf(wsum_all(s) * (1.0f / 1024.0f) + 1e-6f);
#pragma unroll
            for (int j = 0; j < 4; ++j) __builtin_nontemporal_store(v[q][j] * r * gg[j], (f32x4*)(F.out + (size_t)(tok + q) * 1024 + 4 * (lane + 64 * j))); } }
}

constexpr int N_PHASES = 10;
struct Args { const float* in[20]; float* out; unsigned char* ws; int ph_lo, ph_hi; };
__global__ void __launch_bounds__(NTHR, 2) mk_fwd(Args args) {
    extern __shared__ __attribute__((aligned(16))) unsigned char lds_raw[];
    Frame F; F.t0 = 0ull; F.tsec = 0ull;
    F.lds = (lptr)lds_raw; F.tid = threadIdx.x; F.lane = F.tid & 63; F.wave = __builtin_amdgcn_readfirstlane(F.tid >> 6);
    F.G = gridDim.x; { const int bx = blockIdx.x; F.vcu = (F.G % 8 == 0) ? (bx % 8) * (F.G / 8) + bx / 8 : bx; }
#pragma unroll
    for (int i = 0; i < 20; ++i) F.in[i] = args.in[i];
    F.out = args.out; F.ws = args.ws;
    for (int u = F.tid; u < (LDS_BYTES - CTL_OFF) / 4; u += NTHR) ((LAS unsigned*)(F.lds + CTL_OFF))[u] = 0u;
    __syncthreads();
    XcdBarrier bar = xcd_barrier_post((unsigned*)(F.ws + WS_CTL) + CW_BAR, (volatile LAS unsigned*)(F.lds + MISC_OFF));
    const int lo = args.ph_lo, hi = args.ph_hi;
#define IN(k) (lo <= (k) && (k) < hi)
#ifndef PROBE_LO
#define PROBE_LO -1
#define PROBE_HI -1
#endif
    unsigned long long tp0 = 0ull;
#define SEAM(k) do { if (IN(k) && IN((k) + 1)) xcd_barrier(bar); \
        if (PROBE_HI == (k) + 1) { const unsigned long long tn = __builtin_amdgcn_s_memrealtime(), dt = tn - tp0; while (__builtin_amdgcn_s_memrealtime() - tn < dt) __builtin_amdgcn_s_sleep(8); __syncthreads(); } \
        if (PROBE_LO == (k) + 1) tp0 = __builtin_amdgcn_s_memrealtime(); } while (0)
    const int bx = blockIdx.x;
    if (PROBE_LO == 0) tp0 = __builtin_amdgcn_s_memrealtime();
    if (IN(0)) { phase0(F); } SEAM(0);
    if (IN(1)) { pg8::DenseOps ops{(const bf16*)(F.ws + WS_XN), (const bf16*)(F.ws + WS_WINT), 1024}; pg8::StaticOrder S; S.init(64, 12, F.G, bx);
        pg8::EpiProj E{(bf16*)(F.ws + WS_PROJ), PROJ_LD, (const float*)(F.ws + WS_RS1)};
        pg8::gemm_phase<pg8::EpiProj, pg8::StaticOrder, pg8::DenseOps, false, true>(F.lds, 1024, S, ops, E); } SEAM(1);
    if (IN(2)) {
#pragma unroll 1
        for (int j = 0; j < 2; ++j) mlstm_local_unit(F, F.vcu * 2 + j);
#pragma unroll 1
        for (int j = 0; j < 2; ++j) gmlp_unit(F, F.vcu * 2 + j); } SEAM(2);
    if (IN(3)) { phase_scan(F); } SEAM(3);
    if (IN(4)) {
#pragma unroll 1
        for (int j = 0; j < 2; ++j) mlstm_out_unit(F, F.vcu * 2 + j); } SEAM(4);
    if (IN(5)) { pg8::DenseOps ops{(const bf16*)(F.ws + WS_MIX), (const bf16*)(F.ws + WS_WOUTT), 1024}; pg8::StaticOrder S; S.init(64, 4, F.G, bx);
        pg8::EpiRes E{F.in[0], (float*)(F.ws + WS_H), 1024};
        pg8::gemm_phase<pg8::EpiRes, pg8::StaticOrder, pg8::DenseOps, false, false>(F.lds, 1024, S, ops, E); } SEAM(5);
    if (IN(6)) { phase_router(F); } SEAM(6);
    if (IN(7)) { const int nM = build_ttab(F);
        pg8::UpOps ops{(const bf16*)(F.ws + WS_XN), (const bf16*)(F.ws + WS_WUPT), (const int*)(F.ws + WS_TOKIDX)};
        pg8::MoeOrder S; S.init(nM, 8, F.G, bx); S.ttab = (const LAS unsigned*)(F.lds + TTAB_OFF);
        pg8::EpiUp E{(bf16*)(F.ws + WS_ACT), F.in[16], (const float*)(F.ws + WS_RSX)};
        pg8::gemm_phase<pg8::EpiUp, pg8::MoeOrder, pg8::UpOps, true, true>(F.lds, 1024, S, ops, E); } SEAM(7);
    if (IN(8)) { const int nM = build_ttab(F);
        pg8::DownOps ops{(const bf16*)(F.ws + WS_ACT), (const bf16*)(F.ws + WS_WDNT)};
        pg8::MoeOrder S; S.init(nM, 4, F.G, bx); S.ttab = (const LAS unsigned*)(F.lds + TTAB_OFF);
        pg8::EpiDown E{(bf16*)(F.ws + WS_Y), F.in[18], (const float*)(F.ws + WS_GATEX), (const int*)(F.ws + WS_TOKIDX)};
        pg8::gemm_phase<pg8::EpiDown, pg8::MoeOrder, pg8::DownOps, false, true>(F.lds, 1024, S, ops, E); } SEAM(8);
    if (IN(9)) { phase_final(F); } SEAM(9);
    if (PROBE_SEC >= 0) { const unsigned long long tn = __builtin_amdgcn_s_memrealtime(); while (__builtin_amdgcn_s_memrealtime() - tn < F.tsec) __builtin_amdgcn_s_sleep(8); }
#undef IN
#undef SEAM
}

extern "C" void kernel_launch(void* const* d_in, const int* in_sizes, int n_in, void* d_out, int out_size, void* d_ws, size_t ws_size, hipStream_t stream) {
    static int ready = 0;
    if (!ready) {
        if (hipFuncSetAttribute((const void*)mk_fwd, hipFuncAttributeMaxDynamicSharedMemorySize, LDS_BYTES) != hipSuccess) { fprintf(stderr, "hipFuncSetAttribute failed\n"); return; }
        ready = 1;
    }
    char* ws = (char*)d_ws;
    if (ws_size < 800 * MiB) { fprintf(stderr, "ws too small: %zu\n", ws_size); return; }
    (void)hipMemsetAsync(ws + WS_CTL, 0, CTL_ZERO_BYTES, stream);
    Args a{};
    for (int i = 0; i < 20; ++i) a.in[i] = (const float*)d_in[i];
    a.out = (float*)d_out; a.ws = (unsigned char*)d_ws; a.ph_lo = 0; a.ph_hi = N_PHASES;
    hipLaunchKernelGGL(mk_fwd, dim3(256), dim3(NTHR), LDS_BYTES, stream, a);
}
```

```cpp
#include <hip/hip_runtime.h>
#include <cstdio>
#include <cstdint>
#include <cstddef>
#include <cmath>


namespace pg8 {
#define PG8_LAS __attribute__((address_space(3)))
typedef unsigned short bf16_t;
typedef short bf16x8 __attribute__((ext_vector_type(8)));
typedef float f32x4 __attribute__((ext_vector_type(4)));
typedef float f32x2 __attribute__((ext_vector_type(2)));
typedef unsigned u32x4 __attribute__((ext_vector_type(4)));
constexpr int BM = 256, BK = 64, HALF = 128, HTB = HALF * BK * 2, STAGE_BYTES = 8 * HTB, NXCD = 8, WGM = 8;

__host__ __device__ __forceinline__ int lds_byte(int r, int c) { const int st = (r >> 4) * 2 + (c >> 5), rr = r & 15, cc = c & 31, ob = rr * 64 + cc * 2; return st * 1024 + (ob ^ (((ob >> 9) & 1) << 5)); }
__host__ __device__ __forceinline__ void stage_rc(int b, int& R, int& C) { const int st = b / 1024, sb = b % 1024, swz = sb ^ (((sb >> 9) & 1) << 5); R = (st >> 1) * 16 + swz / 64; C = (st & 1) * 32 + (swz % 64) / 2; }
__host__ __device__ __forceinline__ int perm32(int rho) { const int n = rho >> 4, i = rho & 15; return 8 * (i >> 2) + 4 * n + (i & 3); }

struct Unit { int pm, pn, e, rt, nrows; };

struct StaticOrder {
    int nM, nN, nwg, G, c, wgm;
    __device__ void init(int nM_, int nN_, int G_, int c_, int wgm_ = WGM) { nM = nM_; nN = nN_; nwg = nM * nN; G = G_; c = c_; wgm = wgm_; }
    __device__ bool next(int i, Unit& u) const {
        const long L = (long)i * G + c; if (L >= nwg) return false;
        int wgid = (int)L; { const int q = nwg / NXCD, r = nwg % NXCD, xcd = wgid % NXCD, off = wgid / NXCD; wgid = (xcd < r ? xcd * (q + 1) : r * (q + 1) + (xcd - r) * q) + off; }
        const int nig = wgm * nN, gid = wgid / nig, fm = gid * wgm, gsz = (nM - fm) < wgm ? (nM - fm) : wgm;
        u.pm = fm + ((wgid % nig) % gsz); u.pn = (wgid % nig) / gsz; u.e = 0; u.rt = 0; u.nrows = 256; return true;
    }
};
struct MoeOrder : StaticOrder {
    const PG8_LAS unsigned* ttab;
    __device__ bool next(int i, Unit& u) const {
        if (!StaticOrder::next(i, u)) return false;
        const unsigned w = ttab[u.pm]; u.e = (int)(w & 31u); u.rt = (int)((w >> 5) & 511u); u.nrows = (int)((w >> 14) & 255u) + 1; return true;
    }
};

__device__ __forceinline__ unsigned cvt_pk_bf16(float lo, float hi) { unsigned r; asm volatile("v_cvt_pk_bf16_f32 %0, %1, %2" : "=v"(r) : "v"(lo), "v"(hi)); return r; }

struct DenseOps {
    const bf16_t* A; const bf16_t* Bt; int K;
    __device__ __forceinline__ const char* a_base(const Unit& u) const { return (const char*)A + (size_t)u.pm * BM * K * 2; }
    __device__ __forceinline__ const char* b_base(const Unit& u) const { return (const char*)Bt + (size_t)u.pn * BM * K * 2; }
    __device__ __forceinline__ void gather(const Unit&, const int (&)[2], const int (&)[2], unsigned (&)[2][2]) const {}
};
struct UpOps {
    const bf16_t* HN; const bf16_t* WupT; const int* tokidx;
    __device__ __forceinline__ const char* a_base(const Unit&) const { return (const char*)HN; }
    __device__ __forceinline__ const char* b_base(const Unit& u) const { return (const char*)WupT + ((size_t)u.e * 2048 + (size_t)u.pn * BM) * 1024 * 2; }
    __device__ __forceinline__ void gather(const Unit& u, const int (&R)[2], const int (&C)[2], unsigned (&v)[2][2]) const {
        const int* tl = tokidx + (size_t)u.e * 65536 + u.rt * 256;
#pragma unroll
        for (int h = 0; h < 2; ++h)
#pragma unroll
            for (int i = 0; i < 2; ++i) { const int r = R[i] + 128 * h; const int idx = tl[r < u.nrows ? r : 0]; v[h][i] = (unsigned)(idx >> 2) * 2048u + (unsigned)C[i] * 2u; }
    }
};
struct DownOps {
    const bf16_t* ACT; const bf16_t* WdnT;
    __device__ __forceinline__ const char* a_base(const Unit& u) const { return (const char*)ACT + (size_t)u.pm * BM * 1024 * 2; }
    __device__ __forceinline__ const char* b_base(const Unit& u) const { return (const char*)WdnT + ((size_t)u.e * 1024 + (size_t)u.pn * BM) * 1024 * 2; }
    __device__ __forceinline__ void gather(const Unit&, const int (&)[2], const int (&)[2], unsigned (&)[2][2]) const {}
};

struct EpiProj {
    static constexpr bool PERM = true;
    bf16_t* O; int ldc; const float* rs;
    static __device__ __forceinline__ float sigm(float x) { return __builtin_amdgcn_rcpf(1.0f + __builtin_amdgcn_exp2f(-1.4426950408889634f * x)); }
    static __device__ __forceinline__ float act(float x, int mode) {
        if (mode == 1) return sigm(x);
        if (mode == 2) return x * sigm(1.5957691216057308f * (x + 0.044715f * x * x * x));
        return x; }
    __device__ __forceinline__ void operator()(const f32x4 (&acc)[2][2][4][2], const Unit& u, int wr, int wc, int fr, int fq) const {
        const int row0 = u.pm * BM + wr * 64 + fr, col0 = u.pn * BM + wc * 32 + 8 * fq;
        const int mode = u.pn >= 8 ? 2 : (u.pn >= 6 ? 1 : 0);
        float sc[2][4];
#pragma unroll
        for (int ai = 0; ai < 2; ++ai)
#pragma unroll
            for (int m = 0; m < 4; ++m) sc[ai][m] = rs[row0 + ai * HALF + m * 16];
#pragma unroll
        for (int ai = 0; ai < 2; ++ai)
#pragma unroll
            for (int m = 0; m < 4; ++m) { bf16_t* rowp = O + (size_t)(row0 + ai * HALF + m * 16) * ldc + col0;
#pragma unroll
                for (int bj = 0; bj < 2; ++bj) { f32x4 v0 = acc[ai][bj][m][0] * sc[ai][m], v1 = acc[ai][bj][m][1] * sc[ai][m];
                    if (mode != 0) {
#pragma unroll
                        for (int i = 0; i < 4; ++i) { v0[i] = act(v0[i], mode); v1[i] = act(v1[i], mode); } }
                    u32x4 w; w.x = cvt_pk_bf16(v0[0], v0[1]); w.y = cvt_pk_bf16(v0[2], v0[3]); w.z = cvt_pk_bf16(v1[0], v1[1]); w.w = cvt_pk_bf16(v1[2], v1[3]);
                    *(u32x4*)(rowp + bj * HALF) = w; } }
    }
};
struct EpiRes {
    static constexpr bool PERM = false;
    const float* base; float* C; int ldc;
    __device__ __forceinline__ void operator()(const f32x4 (&acc)[2][2][4][2], const Unit& u, int wr, int wc, int fr, int fq) const {
        const int row0 = u.pm * BM + wr * 64 + fr, col0 = u.pn * BM + wc * 32 + 4 * fq;
#pragma unroll
        for (int ai = 0; ai < 2; ++ai)
#pragma unroll
            for (int m = 0; m < 4; ++m) { const size_t off = (size_t)(row0 + ai * HALF + m * 16) * ldc + col0;
#pragma unroll
                for (int bj = 0; bj < 2; ++bj)
#pragma unroll
                    for (int n = 0; n < 2; ++n) *(f32x4*)(C + off + bj * HALF + n * 16) = *(const f32x4*)(base + off + bj * HALF + n * 16) + acc[ai][bj][m][n]; }
    }
};
struct EpiUp {
    static constexpr bool PERM = true;
    bf16_t* ACT; const float* b_up; const float* rsx;
    __device__ __forceinline__ void operator()(const f32x4 (&acc)[2][2][4][2], const Unit& u, int wr, int wc, int fr, int fq) const {
        const int r0 = wr * 64 + fr, row0 = u.pm * BM + r0, j0 = wc * 32 + 8 * fq;
        const float* bg = b_up + (size_t)u.e * 2048 + u.pn * 128 + j0;
        const float* rp = rsx + (size_t)u.e * 65536 + u.rt * 256;
        f32x4 bgl[2], bln[2]; float sc[2][4];
#pragma unroll
        for (int n = 0; n < 2; ++n) { bgl[n] = *(const f32x4*)(bg + 4 * n); bln[n] = *(const f32x4*)(bg + 1024 + 4 * n); }
#pragma unroll
        for (int ai = 0; ai < 2; ++ai)
#pragma unroll
            for (int m = 0; m < 4; ++m) { const int r = r0 + ai * HALF + m * 16; sc[ai][m] = rp[r < u.nrows ? r : 0]; }
#pragma unroll
        for (int ai = 0; ai < 2; ++ai)
#pragma unroll
            for (int m = 0; m < 4; ++m) { bf16_t* rowp = ACT + (size_t)(row0 + ai * HALF + m * 16) * 1024 + u.pn * 128 + j0;
                float o[8];
#pragma unroll
                for (int n = 0; n < 2; ++n) { const f32x4 g = acc[ai][0][m][n] * sc[ai][m] + bgl[n], l = acc[ai][1][m][n] * sc[ai][m] + bln[n];
#pragma unroll
                    for (int i = 0; i < 4; ++i) { const float gl = fminf(g[i], 7.0f), ln = fminf(fmaxf(l[i], -7.0f), 7.0f);
                        o[n * 4 + i] = gl * __builtin_amdgcn_rcpf(1.0f + __builtin_amdgcn_exp2f(-2.4554669595930157f * gl)) * (ln + 1.0f); } }
                u32x4 w; w.x = cvt_pk_bf16(o[0], o[1]); w.y = cvt_pk_bf16(o[2], o[3]); w.z = cvt_pk_bf16(o[4], o[5]); w.w = cvt_pk_bf16(o[6], o[7]);
                *(u32x4*)rowp = w; }
    }
};
struct EpiDown {
    static constexpr bool PERM = true;
    bf16_t* Y; const float* b_dn; const float* gatex; const int* tokidx;
    __device__ __forceinline__ void operator()(const f32x4 (&acc)[2][2][4][2], const Unit& u, int wr, int wc, int fr, int fq) const {
        const int r0 = wr * 64 + fr, col0 = u.pn * BM + wc * 32 + 8 * fq;
        const int* tl = tokidx + (size_t)u.e * 65536 + u.rt * 256; const float* gl = gatex + (size_t)u.e * 65536 + u.rt * 256;
        const float* bb = b_dn + (size_t)u.e * 1024 + col0;
        f32x4 bv[2][2]; int idx[2][4]; float gt[2][4];
#pragma unroll
        for (int ai = 0; ai < 2; ++ai)
#pragma unroll
            for (int m = 0; m < 4; ++m) { const int r = r0 + ai * HALF + m * 16, rr = r < u.nrows ? r : 0; idx[ai][m] = tl[rr]; gt[ai][m] = gl[rr]; }
#pragma unroll
        for (int bj = 0; bj < 2; ++bj)
#pragma unroll
            for (int n = 0; n < 2; ++n) bv[bj][n] = *(const f32x4*)(bb + bj * HALF + 4 * n);
#pragma unroll
        for (int ai = 0; ai < 2; ++ai)
#pragma unroll
            for (int m = 0; m < 4; ++m) { const int r = r0 + ai * HALF + m * 16;
                if (r < u.nrows) { bf16_t* rowp = Y + (size_t)idx[ai][m] * 1024 + col0; const float g1 = gt[ai][m];
#pragma unroll
                    for (int bj = 0; bj < 2; ++bj) { const f32x4 v0 = (acc[ai][bj][m][0] + bv[bj][0]) * g1, v1 = (acc[ai][bj][m][1] + bv[bj][1]) * g1;
                        u32x4 w; w.x = cvt_pk_bf16(v0[0], v0[1]); w.y = cvt_pk_bf16(v0[2], v0[3]); w.z = cvt_pk_bf16(v1[0], v1[1]); w.w = cvt_pk_bf16(v1[2], v1[3]);
                        *(u32x4*)(rowp + bj * HALF) = w; } } }
    }
};

template <class Epi, class Sched, class Ops, bool GATHER, bool ALIGN_EPI>
__device__ __forceinline__ void gemm_phase(PG8_LAS unsigned char* lds, const int K, const Sched& S, const Ops& O, const Epi& E) {
    const int tid = threadIdx.x, wid = __builtin_amdgcn_readfirstlane(tid >> 6), lane = tid & 63, wr = wid >> 2, wc = wid & 3, fr = lane & 15, fq = lane >> 4;
    const int nt = K / BK;
    unsigned voffA[2], voffB[2]; int sR[2], sC[2];
#pragma unroll
    for (int i = 0; i < 2; ++i) { int R, C; stage_rc(tid * 16 + i * 8192, R, C); const int Rb = Epi::PERM ? ((R & ~31) + perm32(R & 31)) : R; sR[i] = R; sC[i] = C;
        voffA[i] = (unsigned)(R * K + C) * 2u; voffB[i] = (unsigned)(Rb * K + C) * 2u; }
    const size_t kstep = (size_t)(BK * 2);
    const size_t hstep = (size_t)HALF * K * 2;
    const unsigned ldsw = (unsigned)wid * 1024u;
    const int aoff = lds_byte(wr * 64 + fr, fq * 8), boff = lds_byte(wc * 32 + fr, fq * 8);
#define PG8_SA(b, h) (((b) * 2 + (h)) * HTB)
#define PG8_SB(b, h) ((4 + (b) * 2 + (h)) * HTB)
#define PG8_STAGE(bufoff, gbase, voff) do { _Pragma("unroll") for (int _i = 0; _i < 2; ++_i) \
        __builtin_amdgcn_global_load_lds((const unsigned*)((const char*)(gbase) + (voff)[_i]), (PG8_LAS unsigned*)(lds + (bufoff) + ldsw + _i * 8192), 16, 0, 0); } while (0)
#define PG8_STAGE_AC(bufoff, kptr, h) do { if constexpr (GATHER) PG8_STAGE(bufoff, kptr, vC[h]); else PG8_STAGE(bufoff, (kptr) + (h) * hstep, voffA); } while (0)
#define PG8_STAGE_AS(bufoff, kptr, h) do { if constexpr (GATHER) PG8_STAGE(bufoff, kptr, vS[h]); else PG8_STAGE(bufoff, (kptr) + (h) * hstep, voffA); } while (0)
#define PG8_LDA(dst, b, h) do { _Pragma("unroll") for (int m = 0; m < 4; ++m) _Pragma("unroll") for (int k = 0; k < 2; ++k) dst[m][k] = *(const PG8_LAS bf16x8*)(lds + PG8_SA(b, h) + aoff + m * 2048 + k * 1024); } while (0)
#define PG8_LDB(dst, b, h) do { _Pragma("unroll") for (int n = 0; n < 2; ++n) _Pragma("unroll") for (int k = 0; k < 2; ++k) dst[n][k] = *(const PG8_LAS bf16x8*)(lds + PG8_SB(b, h) + boff + n * 2048 + k * 1024); } while (0)
#define PG8_MMA(ai, bj, At, Bt) do { __builtin_amdgcn_s_setprio(1); _Pragma("unroll") for (int m = 0; m < 4; ++m) _Pragma("unroll") for (int n = 0; n < 2; ++n) _Pragma("unroll") for (int k = 0; k < 2; ++k) \
        acc[ai][bj][m][n] = __builtin_amdgcn_mfma_f32_16x16x32_bf16(Bt[n][k], At[m][k], acc[ai][bj][m][n], 0, 0, 0); __builtin_amdgcn_s_setprio(0); } while (0)
#define PG8_WAIT_V(n) asm volatile("s_waitcnt vmcnt(" #n ")" ::: "memory")
#define PG8_WAIT_L(n) asm volatile("s_waitcnt lgkmcnt(" #n ")" ::: "memory")
#define PG8_BAR __builtin_amdgcn_s_barrier()
#define PG8_SCHED __builtin_amdgcn_sched_barrier(0)
    Unit cur, nxt; int ui = 0;
    if (!S.next(0, cur)) return;
    f32x4 acc[2][2][4][2];
#pragma unroll
    for (int a = 0; a < 2; ++a)
#pragma unroll
        for (int b = 0; b < 2; ++b)
#pragma unroll
            for (int m = 0; m < 4; ++m)
#pragma unroll
                for (int n = 0; n < 2; ++n) acc[a][b][m][n] = (f32x4){0.f, 0.f, 0.f, 0.f};
    bf16x8 At[4][2], B0[2][2], B1[2][2];
    unsigned vC[2][2] = {{0u, 0u}, {0u, 0u}}, vN[2][2] = {{0u, 0u}, {0u, 0u}}, vS[2][2] = {{0u, 0u}, {0u, 0u}};
    if constexpr (GATHER) O.gather(cur, sR, sC, vC);
    const char* cA = O.a_base(cur); const char* cB = O.b_base(cur);
    PG8_STAGE(PG8_SB(0, 0), cB, voffB); PG8_STAGE(PG8_SB(0, 1), cB + hstep, voffB); PG8_STAGE_AC(PG8_SA(0, 0), cA, 0); PG8_STAGE_AC(PG8_SA(0, 1), cA, 1);
    if (wr == 1) PG8_BAR;
    PG8_WAIT_V(2); PG8_BAR;
    PG8_STAGE(PG8_SB(1, 0), cB + kstep, voffB); PG8_STAGE_AC(PG8_SA(1, 0), cA + kstep, 0); PG8_STAGE(PG8_SB(1, 1), cB + hstep + kstep, voffB);
    PG8_WAIT_V(6); PG8_BAR;
    for (;;) {
        const bool has_next = S.next(ui + 1, nxt);
        const char* nA = has_next ? O.a_base(nxt) : cA; const char* nB = has_next ? O.b_base(nxt) : cB;
        if constexpr (GATHER) { if (has_next) O.gather(nxt, sR, sC, vN); else {
#pragma unroll
            for (int h = 0; h < 2; ++h)
#pragma unroll
                for (int i = 0; i < 2; ++i) vN[h][i] = vC[h][i]; } }
        for (int t = 0; t < nt; t += 2) {
            const bool last = (t == nt - 2);
            const char* a1 = cA + (size_t)(t + 1) * kstep;
            const char* a2 = last ? nA : cA + (size_t)(t + 2) * kstep; const char* b2 = last ? nB : cB + (size_t)(t + 2) * kstep;
            const char* a3 = a2 + kstep; const char* b3 = b2 + kstep;
            if constexpr (GATHER) {
#pragma unroll
                for (int h = 0; h < 2; ++h)
#pragma unroll
                    for (int i = 0; i < 2; ++i) vS[h][i] = last ? vN[h][i] : vC[h][i]; }
            PG8_LDB(B0, 0, 0); PG8_LDB(B1, 0, 1); PG8_SCHED; PG8_LDA(At, 0, 0); PG8_STAGE_AC(PG8_SA(1, 1), a1, 1);
            PG8_WAIT_V(8); PG8_WAIT_L(0); PG8_BAR; PG8_MMA(0, 0, At, B0); PG8_MMA(0, 1, At, B1); PG8_BAR; PG8_SCHED;
            PG8_LDA(At, 0, 1); PG8_STAGE(PG8_SB(0, 0), b2, voffB); PG8_STAGE(PG8_SB(0, 1), b2 + hstep, voffB); PG8_STAGE_AS(PG8_SA(0, 0), a2, 0);
            PG8_WAIT_V(8); PG8_WAIT_L(0); PG8_BAR; PG8_MMA(1, 0, At, B0); PG8_MMA(1, 1, At, B1); PG8_BAR; PG8_SCHED;
            PG8_LDB(B0, 1, 0); PG8_LDB(B1, 1, 1); PG8_SCHED; PG8_LDA(At, 1, 0); PG8_STAGE_AS(PG8_SA(0, 1), a2, 1);
            PG8_WAIT_V(8); PG8_WAIT_L(0); PG8_BAR; PG8_MMA(0, 0, At, B0); PG8_MMA(0, 1, At, B1); PG8_BAR; PG8_SCHED;
            PG8_LDA(At, 1, 1); PG8_STAGE(PG8_SB(1, 0), b3, voffB); PG8_STAGE(PG8_SB(1, 1), b3 + hstep, voffB); PG8_STAGE_AS(PG8_SA(1, 0), a3, 0);
            PG8_WAIT_V(8); PG8_WAIT_L(0); PG8_BAR; PG8_MMA(1, 0, At, B0); PG8_MMA(1, 1, At, B1); PG8_BAR; PG8_SCHED;
        }
        if constexpr (ALIGN_EPI) { if (wr == 0) PG8_BAR; }
        E(acc, cur, wr, wc, fr, fq);
        if (!has_next) break;
#pragma unroll
        for (int a = 0; a < 2; ++a)
#pragma unroll
            for (int b = 0; b < 2; ++b)
#pragma unroll
                for (int m = 0; m < 4; ++m)
#pragma unroll
                    for (int n = 0; n < 2; ++n) acc[a][b][m][n] = (f32x4){0.f, 0.f, 0.f, 0.f};
        cur = nxt; cA = nA; cB = nB; ++ui;
        if constexpr (GATHER) {
#pragma unroll
            for (int h = 0; h < 2; ++h)
#pragma unroll
                for (int i = 0; i < 2; ++i) vC[h][i] = vN[h][i]; }
        if constexpr (ALIGN_EPI) { if (wr == 1) PG8_BAR; }
    }
    PG8_WAIT_V(0);
    if constexpr (!ALIGN_EPI) { if (wr == 0) PG8_BAR; }
    PG8_BAR;
#undef PG8_SA
#undef PG8_SB
#undef PG8_STAGE
#undef PG8_STAGE_AC
#undef PG8_STAGE_AS
#undef PG8_LDA
#undef PG8_LDB
#undef PG8_MMA
#undef PG8_WAIT_V
#undef PG8_WAIT_L
#undef PG8_BAR
#undef PG8_SCHED
}
}
#define GAS __attribute__((address_space(1)))
#define LAS __attribute__((address_space(3)))
typedef unsigned short bf16;
typedef short bf16x8 __attribute__((ext_vector_type(8)));
typedef short s16x4 __attribute__((ext_vector_type(4)));
typedef float f32x4 __attribute__((ext_vector_type(4)));
typedef unsigned u32x4 __attribute__((ext_vector_type(4)));
typedef unsigned u32x2 __attribute__((ext_vector_type(2)));
typedef LAS unsigned char* lptr;

constexpr int NWAVES = 8, NTHR = 512;
constexpr size_t MiB = 1u << 20;
constexpr size_t WS_CTL = 0, CTL_ZERO_BYTES = 64 * 1024;
constexpr size_t WS_SMALL = 1 * MiB;
constexpr size_t WS_GATES = 2 * MiB;
constexpr size_t WS_RSG = 2 * MiB + 512 * 1024;
constexpr size_t WS_RS1 = 2 * MiB + 768 * 1024;
constexpr size_t WS_GATE = 3 * MiB;
constexpr size_t WS_TOKIDX = 4 * MiB;
constexpr size_t WS_GATEX = 760 * MiB, WS_RSX = 768 * MiB;
constexpr size_t WS_KC = 776 * MiB;
constexpr size_t WS_WRT = 12 * MiB;
constexpr size_t WS_WINT = 16 * MiB, WS_WOUTT = 22 * MiB, WS_WDNT = 24 * MiB, WS_WUPT = 88 * MiB;
constexpr size_t WS_XN = 216 * MiB;
constexpr size_t WS_PROJ = 248 * MiB;
constexpr size_t WS_CLOC = 344 * MiB;
constexpr size_t WS_CPREV = 376 * MiB;
constexpr size_t WS_MIX = 392 * MiB;
constexpr size_t WS_H = 424 * MiB;
constexpr size_t WS_ACT = 488 * MiB;
constexpr size_t WS_Y = 632 * MiB;
constexpr size_t WS_OPT_END = 760 * MiB;
constexpr int CW_CNT = 64;
constexpr int CW_BAR = 4096;
constexpr int PROJ_LD = 3072;
constexpr int QO = 0, KO = 512, VO = 1024, OO = 1536, UO = 2048, VGO = 2560;
constexpr int RING_BYTES = 131072, VEC_OFF = 131072, VEC_BYTES = 16384, CTL_OFF = VEC_OFF + VEC_BYTES, TTAB_OFF = CTL_OFF, MISC_OFF = CTL_OFF + 2048, LDS_BYTES = MISC_OFF + 256;
constexpr int T0 = 0, T1 = 32768, T2 = 65536, T3 = 98304;

#define RLX_AGENT __ATOMIC_RELAXED, __HIP_MEMORY_SCOPE_AGENT
#define XB_TMO      128
#define XB_XCNT(j)  (256  + 64 * (j))
#define XB_XSUB(j)  (1280 + 64 * (j))
#define XB_XGEN(j)  (2304 + 64 * (j))
#define XB_TOP      3328
#define XB_TOPGEN   3392
#define XCD_BAR_WORDS 3456
#define XB_SPIN_CAP (1u << 18)
__device__ __forceinline__ unsigned xb_ld(unsigned* p)              { return __hip_atomic_load(p, __ATOMIC_RELAXED, __HIP_MEMORY_SCOPE_AGENT); }
__device__ __forceinline__ unsigned xb_add(unsigned* p, unsigned v) { return __hip_atomic_fetch_add(p, v, __ATOMIC_RELAXED, __HIP_MEMORY_SCOPE_AGENT); }
__device__ __forceinline__ unsigned xb_xcc_id() { return (unsigned)__builtin_amdgcn_s_getreg((3 << 11) | 20) & 0xFu; }
#define XB_SPIN(cond, bar) do { unsigned _sp = 0; while (cond) { __builtin_amdgcn_s_sleep(1); \
    if ((++_sp & 255u) == 0u) { if (xb_ld(&(bar)[XB_TMO])) break; if (_sp > XB_SPIN_CAP) { atomicAdd(&(bar)[XB_TMO], 1u); break; } } } } while (0)
struct XcdBarrier { unsigned* bar; unsigned x; volatile LAS unsigned* st; };
__device__ __forceinline__ XcdBarrier xcd_barrier_post(unsigned* bar, volatile LAS unsigned* st) {
    XcdBarrier b; b.bar = bar; b.x = xb_xcc_id(); b.st = st;
    if (threadIdx.x == 0) (void)xb_add(&bar[XB_XCNT(b.x)], 1u);
    return b;
}
__device__ __forceinline__ void xcd_barrier_complete(unsigned* bar, unsigned x, unsigned& nloc, unsigned& nx) {
    const unsigned G = gridDim.x * gridDim.y * gridDim.z;
    unsigned sum, cnt, mine, sp = 0u;
    for (;;) {
        sum = 0u; cnt = 0u; mine = 0u;
#pragma unroll
        for (unsigned j = 0; j < 16; ++j) { const unsigned c = xb_ld(&bar[XB_XCNT(j)]); sum += c; cnt += (c > 0u) ? 1u : 0u; mine = (j == x) ? c : mine; }
        if (sum == G) break;
        __builtin_amdgcn_s_sleep(1);
        if ((++sp & 255u) == 0u) { if (xb_ld(&bar[XB_TMO])) break; if (sp > XB_SPIN_CAP) { atomicAdd(&bar[XB_TMO], 1u); break; } }
    }
    nloc = mine > 0u ? mine : 1u; nx = cnt > 0u ? cnt : 1u;
}
__device__ __forceinline__ void xcd_barrier(const XcdBarrier& b) {
    asm volatile("s_waitcnt vmcnt(0)" ::: "memory");
    __syncthreads();
    if (threadIdx.x == 0) {
        unsigned* bar = b.bar;
        __builtin_amdgcn_s_waitcnt(0);
        unsigned nloc = b.st[0], nx = b.st[1];
        if (nloc == 0u) { xcd_barrier_complete(bar, b.x, nloc, nx); b.st[0] = nloc; b.st[1] = nx; }
        const unsigned old = xb_add(&bar[XB_XSUB(b.x)], 1u);
        const unsigned gen = old / nloc;
        if (old + 1u == (gen + 1u) * nloc) {
            __builtin_amdgcn_fence(__ATOMIC_RELEASE, "agent");
            asm volatile("s_waitcnt vmcnt(0)" ::: "memory");
            const unsigned og = xb_add(&bar[XB_TOP], 1u);
            const unsigned tg = og / nx;
            if (og + 1u == (tg + 1u) * nx) xb_add(&bar[XB_TOPGEN], 1u);
            else XB_SPIN(xb_ld(&bar[XB_TOPGEN]) == tg, bar);
            __builtin_amdgcn_fence(__ATOMIC_ACQUIRE, "agent");
            xb_add(&bar[XB_XGEN(b.x)], 1u);
            asm volatile("s_waitcnt vmcnt(0)" ::: "memory");
        } else {
            XB_SPIN(xb_ld(&bar[XB_XGEN(b.x)]) == gen, bar);
            __builtin_amdgcn_fence(__ATOMIC_ACQUIRE, "agent");
            asm volatile("s_waitcnt vmcnt(0)" ::: "memory");
        }
    }
    __syncthreads();
}

__device__ __forceinline__ float bf2f(unsigned short h) { return __builtin_bit_cast(float, (unsigned)h << 16); }
__device__ __forceinline__ unsigned f2bf(float f) { unsigned u = __builtin_bit_cast(unsigned, f); return (u + 0x7fffu + ((u >> 16) & 1u)) >> 16; }
__device__ __forceinline__ unsigned pk2(float lo, float hi) { return pg8::cvt_pk_bf16(lo, hi); }
__device__ __forceinline__ float fexp(float x) { return __builtin_amdgcn_exp2f(x * 1.4426950408889634f); }
__device__ __forceinline__ float fsigmoid(float x) { return __builtin_amdgcn_rcpf(1.0f + fexp(-x)); }
__device__ __forceinline__ float fgelu(float x) {
    const float u = 1.5957691216057308f * (x + 0.044715f * x * x * x);
    return x * fsigmoid(u);
}
__device__ __forceinline__ float wsum_all(float v) {
#pragma unroll
    for (int o = 32; o > 0; o >>= 1) v += __shfl_xor(v, o);
    return v;
}
__device__ __forceinline__ void unpack8(const u32x4 w, float (&f)[8]) {
    f[0] = __builtin_bit_cast(float, w.x << 16); f[1] = __builtin_bit_cast(float, w.x & 0xffff0000u);
    f[2] = __builtin_bit_cast(float, w.y << 16); f[3] = __builtin_bit_cast(float, w.y & 0xffff0000u);
    f[4] = __builtin_bit_cast(float, w.z << 16); f[5] = __builtin_bit_cast(float, w.z & 0xffff0000u);
    f[6] = __builtin_bit_cast(float, w.w << 16); f[7] = __builtin_bit_cast(float, w.w & 0xffff0000u);
}
__device__ __forceinline__ u32x4 pack8(const float (&f)[8]) { u32x4 w; w.x = pk2(f[0], f[1]); w.y = pk2(f[2], f[3]); w.z = pk2(f[4], f[5]); w.w = pk2(f[6], f[7]); return w; }

__device__ __forceinline__ unsigned off_b(unsigned row, unsigned ch) { return 256u * row + 16u * (ch ^ (((row & 3u) << 2) | ((row >> 2) & 3u))); }
__device__ __forceinline__ bf16x8 frag_row(lptr T, int r0, int ks, int lane) { return *(const LAS bf16x8*)(T + off_b((unsigned)(r0 + (lane & 15)), (unsigned)(4 * ks + (lane >> 4)))); }
__device__ __forceinline__ bf16x8 frag_tr(lptr T, int c, int ks, int lane) {
    const unsigned g = lane >> 4, q = (lane & 15) >> 2, p = lane & 3;
    const unsigned a0 = off_b(32u * ks + 8u * g + q, 2u * c + (p >> 1)) + 8u * (p & 1);
    const unsigned a1 = off_b(32u * ks + 8u * g + 4u + q, 2u * c + (p >> 1)) + 8u * (p & 1);
    const s16x4 lo = __builtin_amdgcn_ds_read_tr16_b64_v4i16((LAS s16x4*)(T + a0));
    const s16x4 hi = __builtin_amdgcn_ds_read_tr16_b64_v4i16((LAS s16x4*)(T + a1));
    return __builtin_shufflevector(lo, hi, 0, 1, 2, 3, 4, 5, 6, 7);
}
#define MFMA16(a, b, c) __builtin_amdgcn_mfma_f32_16x16x32_bf16(a, b, c, 0, 0, 0)

#ifndef PROBE_SEC
#define PROBE_SEC -1
#endif
#define SEC_BEGIN(F, id) do { if (PROBE_SEC == (id)) { __syncthreads(); (F).t0 = __builtin_amdgcn_s_memrealtime(); } } while (0)
#define SEC_END(F, id) do { if (PROBE_SEC == (id)) { __syncthreads(); (F).tsec += __builtin_amdgcn_s_memrealtime() - (F).t0; } } while (0)
struct Frame {
    unsigned long long t0, tsec;
    lptr lds; int tid, lane, wave, G, vcu;
    const float* in[20]; float* out; unsigned char* ws;
};

template <bool SCALE>
__device__ __forceinline__ void stage_tile(const Frame& F, lptr T, const bf16* src, int ld, const LAS float* rowscale) {
    const int cg = F.tid & 15, sb = F.tid >> 4;
    u32x4 w[4];
#pragma unroll
    for (int r = 0; r < 4; ++r) w[r] = *(const u32x4*)(src + (size_t)(4 * sb + r) * ld + 8 * cg);
#pragma unroll
    for (int r = 0; r < 4; ++r) { const int s = 4 * sb + r;
        if (SCALE) { float f[8]; unpack8(w[r], f); const float sc = rowscale[s];
#pragma unroll
            for (int i = 0; i < 8; ++i) f[i] *= sc;
            w[r] = pack8(f); }
        *(LAS u32x4*)(T + off_b(s, cg)) = w[r]; }
}
__device__ __forceinline__ void stage_conv(const Frame& F, lptr T, const bf16* src, const LAS float* cw, int tpos, float scale, u32x4 (&out)[4]) {
    const int cg = F.tid & 15, sb = F.tid >> 4;
    u32x4 w[7];
#pragma unroll
    for (int j = 0; j < 7; ++j) { const int s = 4 * sb - 3 + j; w[j] = (tpos + s >= 0) ? *(const u32x4*)(src + (ptrdiff_t)s * PROJ_LD + 8 * cg) : (u32x4){0u, 0u, 0u, 0u}; }
#pragma unroll
    for (int hf = 0; hf < 2; ++hf) {
        f32x4 tp4[4];
#pragma unroll
        for (int tp = 0; tp < 4; ++tp) tp4[tp] = *(const LAS f32x4*)(cw + tp * 128 + 8 * cg + 4 * hf);
        float a[4][4];
#pragma unroll
        for (int r = 0; r < 4; ++r)
#pragma unroll
            for (int i = 0; i < 4; ++i) a[r][i] = 0.f;
#pragma unroll
        for (int j = 0; j < 7; ++j) { const unsigned u0 = hf ? w[j].z : w[j].x, u1 = hf ? w[j].w : w[j].y;
            const float f[4] = {__builtin_bit_cast(float, u0 << 16), __builtin_bit_cast(float, u0 & 0xffff0000u), __builtin_bit_cast(float, u1 << 16), __builtin_bit_cast(float, u1 & 0xffff0000u)};
#pragma unroll
            for (int r = 0; r < 4; ++r) { const int tp = j - r; if (tp >= 0 && tp < 4) {
#pragma unroll
                for (int i = 0; i < 4; ++i) a[r][i] += tp4[tp][i] * f[i]; } } }
#pragma unroll
        for (int r = 0; r < 4; ++r) {
#pragma unroll
            for (int i = 0; i < 4; ++i) a[r][i] = a[r][i] * fsigmoid(a[r][i]) * scale;
            const unsigned p0 = pk2(a[r][0], a[r][1]), p1 = pk2(a[r][2], a[r][3]);
            if (hf == 0) { out[r].x = p0; out[r].y = p1; } else { out[r].z = p0; out[r].w = p1; } }
        __builtin_amdgcn_sched_barrier(0);
    }
#pragma unroll
    for (int r = 0; r < 4; ++r) *(LAS u32x4*)(T + off_b(4 * sb + r, cg)) = out[r];
}
__device__ __forceinline__ void p0_item(const float* Wsrc, int ld, bf16* dst, int Kd, LAS float* scr, int lane) {
#pragma unroll 8
    for (int i = 0; i < 32; ++i) { const int kk = 2 * i + (lane >> 5); scr[kk * 33 + (lane & 31)] = Wsrc[(size_t)kk * ld + (lane & 31)]; }
    asm volatile("s_waitcnt lgkmcnt(0)" ::: "memory");
    const int c = lane & 7;
#pragma unroll
    for (int j = 0; j < 4; ++j) { const int n = (lane >> 3) + 8 * j; const LAS float* s = scr + (8 * c) * 33 + n;
        u32x4 o; o.x = pk2(s[0 * 33], s[1 * 33]); o.y = pk2(s[2 * 33], s[3 * 33]); o.z = pk2(s[4 * 33], s[5 * 33]); o.w = pk2(s[6 * 33], s[7 * 33]);
        *(u32x4*)(dst + (size_t)n * Kd + 8 * c) = o; }
    asm volatile("s_waitcnt lgkmcnt(0)" ::: "memory");
}
__device__ __forceinline__ void p0_item_split(const float* Wsrc, int ld, bf16* dhi, bf16* dlo, int Kd, LAS float* scr, int lane) {
#pragma unroll 8
    for (int i = 0; i < 32; ++i) { const int kk = 2 * i + (lane >> 5); scr[kk * 33 + (lane & 31)] = Wsrc[(size_t)kk * ld + (lane & 31)]; }
    asm volatile("s_waitcnt lgkmcnt(0)" ::: "memory");
    const int c = lane & 7;
#pragma unroll
    for (int j = 0; j < 4; ++j) { const int n = (lane >> 3) + 8 * j; const LAS float* s = scr + (8 * c) * 33 + n;
        float v[8], l[8];
#pragma unroll
        for (int i = 0; i < 8; ++i) { v[i] = s[i * 33]; l[i] = v[i] - bf2f((unsigned short)f2bf(v[i])); }
        *(u32x4*)(dhi + (size_t)n * Kd + 8 * c) = pack8(v); *(u32x4*)(dlo + (size_t)n * Kd + 8 * c) = pack8(l); }
    asm volatile("s_waitcnt lgkmcnt(0)" ::: "memory");
}

struct P0Item { const float* src; bf16* dst; int ld; };
__device__ __forceinline__ void p0_load(const P0Item& it, int lane, f32x4 (&v)[8]) {
    const float* p = it.src + (size_t)(8 * (lane & 7)) * it.ld + 4 * (lane >> 3);
#pragma unroll
    for (int j = 0; j < 8; ++j) v[j] = __builtin_nontemporal_load((const f32x4*)(p + (size_t)j * it.ld));
}
__device__ __forceinline__ void p0_store(const P0Item& it, int lane, const f32x4 (&v)[8]) {
    bf16* q = it.dst + (size_t)(4 * (lane >> 3)) * 1024 + 8 * (lane & 7);
#pragma unroll
    for (int i = 0; i < 4; ++i) { u32x4 o; o.x = pk2(v[0][i], v[1][i]); o.y = pk2(v[2][i], v[3][i]); o.z = pk2(v[4][i], v[5][i]); o.w = pk2(v[6][i], v[7][i]);
        *(u32x4*)(q + (size_t)i * 1024) = o; }
}
constexpr int IMG_ROW = 2064;
template <int NF>
__device__ __forceinline__ float row_pass(const float* X, const float* gain, bf16* XNout, lptr img_hi, lptr img_lo, int tok0, int lane, f32x4 (&acc)[NF]) {
    const int r = lane & 15, g = lane >> 4;
    const float* xr = X + (size_t)(tok0 + r) * 1024 + 8 * g;
    float ss = 0.f;
#pragma unroll
    for (int nf = 0; nf < NF; ++nf) acc[nf] = (f32x4){0.f, 0.f, 0.f, 0.f};
    bf16* orow = XNout + (size_t)(tok0 + r) * 1024 + 8 * g;
#pragma unroll 16
    for (int ks = 0; ks < 32; ++ks) { const f32x4 a = __builtin_nontemporal_load((const f32x4*)(xr + 32 * ks)), b = __builtin_nontemporal_load((const f32x4*)(xr + 32 * ks + 4));
        ss += (a[0] * a[0] + a[1] * a[1]) + (a[2] * a[2] + a[3] * a[3]) + (b[0] * b[0] + b[1] * b[1]) + (b[2] * b[2] + b[3] * b[3]);
        const f32x4 ga = *(const f32x4*)(gain + 32 * ks + 8 * g), gb = *(const f32x4*)(gain + 32 * ks + 8 * g + 4);
        float v[8], l[8];
#pragma unroll
        for (int i = 0; i < 4; ++i) { v[i] = a[i] * ga[i]; v[4 + i] = b[i] * gb[i]; }
        const u32x4 hi = pack8(v);
        { float h[8]; unpack8(hi, h);
#pragma unroll
          for (int i = 0; i < 8; ++i) l[i] = v[i] - h[i]; }
        const u32x4 lo = pack8(l);
        *(u32x4*)(orow + 32 * ks) = hi;
        const bf16x8 ahi = __builtin_bit_cast(bf16x8, hi), alo = __builtin_bit_cast(bf16x8, lo);
#pragma unroll
        for (int nf = 0; nf < NF; ++nf) { const unsigned bo = (unsigned)(16 * nf + (lane & 15)) * IMG_ROW + 64u * ks + 16u * g;
            const bf16x8 bhi = *(const LAS bf16x8*)(img_hi + bo), blo = *(const LAS bf16x8*)(img_lo + bo);
            acc[nf] = MFMA16(ahi, bhi, acc[nf]); acc[nf] = MFMA16(ahi, blo, acc[nf]); acc[nf] = MFMA16(alo, bhi, acc[nf]); } }
    ss += __shfl_xor(ss, 16); ss += __shfl_xor(ss, 32);
    return 1.0f / sqrtf(ss * (1.0f / 1024.0f) + 1e-6f);
}

__device__ __forceinline__ void phase0(Frame& F) {
    const float* x = F.in[0]; const float* g1 = F.in[1]; const float* w_in = F.in[2]; const float* b_i = F.in[4]; const float* b_f = F.in[5];
    const float* w_out = F.in[11]; const float* wr = F.in[13]; const float* w_up = F.in[15]; const float* w_dn = F.in[17];
    bf16* WinT = (bf16*)(F.ws + WS_WINT); bf16* WoutT = (bf16*)(F.ws + WS_WOUTT); bf16* WdnT = (bf16*)(F.ws + WS_WDNT); bf16* WupT = (bf16*)(F.ws + WS_WUPT);
    bf16* WrThi = (bf16*)(F.ws + WS_WRT); bf16* WrTlo = WrThi + 32 * 1024;
    bf16* XN = (bf16*)(F.ws + WS_XN); float* GATES = (float*)(F.ws + WS_GATES); float* RS1 = (float*)(F.ws + WS_RS1);
    lptr ghi = F.lds + T0, glo = F.lds + T0 + 16 * IMG_ROW;
    SEC_BEGIN(F, 1);
#pragma unroll
    for (int q = 0; q < 2; ++q) { const int kk = F.tid + NTHR * q; const f32x4 a = *(const f32x4*)(w_in + (size_t)kk * 3080 + 2048), b = *(const f32x4*)(w_in + (size_t)kk * 3080 + 2052);
        const float v[8] = {a[0], a[1], a[2], a[3], b[0], b[1], b[2], b[3]};
#pragma unroll
        for (int j = 0; j < 8; ++j) { const unsigned h = f2bf(v[j]); const float l = v[j] - bf2f((unsigned short)h);
            *(LAS unsigned short*)(ghi + j * IMG_ROW + 2 * kk) = (unsigned short)h; *(LAS unsigned short*)(glo + j * IMG_ROW + 2 * kk) = (unsigned short)f2bf(l); } }
    __syncthreads();
    SEC_END(F, 1); SEC_BEGIN(F, 2);
    if (F.wave < 4) { const int tok0 = F.vcu * 64 + F.wave * 16; f32x4 acc[1];
      const float rstd = row_pass<1>(x, g1, XN, ghi, glo, tok0, F.lane, acc);
      if (F.lane < 16) RS1[tok0 + F.lane] = rstd;
      const int j = F.lane & 15, gq = F.lane >> 4;
      float rr[4];
#pragma unroll
      for (int rg = 0; rg < 4; ++rg) rr[rg] = __shfl(rstd, 4 * gq + rg);
      if (j < 8) {
#pragma unroll
          for (int rg = 0; rg < 4; ++rg) { const int tok = tok0 + 4 * gq + rg; float v = acc[0][rg] * rr[rg];
              if (j < 4) v += b_i[j]; else { v += b_f[j - 4]; v = fminf(v, 0.f) - log1pf(expf(-fabsf(v))); }
              GATES[(size_t)tok * 8 + j] = v; } } }
    SEC_END(F, 2); SEC_BEGIN(F, 3);
    const float* b_unused = nullptr; (void)b_unused;
    const int gw = F.vcu * NWAVES + F.wave, NGW = F.G * NWAVES;
    if (F.vcu < 4 && F.wave >= 4) { const int ri = F.vcu * 4 + F.wave - 4; LAS float* scr = (LAS float*)(F.lds + 66560 + (F.wave - 4) * 8448);
        p0_item_split(wr + (size_t)(64 * ri) * 32, 32, WrThi + 64 * ri, WrTlo + 64 * ri, 1024, scr, F.lane); }
    constexpr int I_IN = 16 * 96, I_OUT = 16 * 32, I_DN = 32 * 16 * 32, I_UP = 32 * 16 * 64, NITEMS = I_IN + I_OUT + I_DN + I_UP;
    auto decode = [&](int it) -> P0Item {
        int r = it; P0Item o;
        if (r < I_IN) { const int kb = r / 96, nb = r % 96, nd = 32 * nb, nsrc = nd < 2048 ? nd : nd + 8;
            o.src = w_in + (size_t)(64 * kb) * 3080 + nsrc; o.ld = 3080; o.dst = WinT + (size_t)nd * 1024 + 64 * kb; return o; } r -= I_IN;
        if (r < I_OUT) { const int kb = r / 32, nb = r % 32;
            o.src = w_out + (size_t)(64 * kb) * 1024 + 32 * nb; o.ld = 1024; o.dst = WoutT + (size_t)(32 * nb) * 1024 + 64 * kb; return o; } r -= I_OUT;
        if (r < I_DN) { const int e = r / 512, q = r % 512, kb = q / 32, nb = q % 32;
            o.src = w_dn + ((size_t)e * 1024 + 64 * kb) * 1024 + 32 * nb; o.ld = 1024; o.dst = WdnT + ((size_t)e * 1024 + 32 * nb) * 1024 + 64 * kb; return o; } r -= I_DN;
        { const int e = r / 1024, q = r % 1024, kb = q / 64, nb = q % 64, n = 32 * nb, half = n >> 10, jj = n & 1023, pn = jj >> 7, j = jj & 127, nd = 256 * pn + 128 * half + j;
          o.src = w_up + ((size_t)e * 1024 + 64 * kb) * 2048 + n; o.ld = 2048; o.dst = WupT + ((size_t)e * 2048 + nd) * 1024 + 64 * kb; return o; }
    };
    constexpr int PER_WAVE = NITEMS / (256 * NWAVES), SHIFT = 4;
    static_assert(NITEMS % (256 * NWAVES) == 0 && SHIFT % 2 == 0, "item split");
    const int nown = F.wave < 4 ? PER_WAVE - SHIFT : PER_WAVE + SHIFT;
    for (int j = 0; j < nown; j += 2) {
        const bool two = j + 1 < nown;
        const int j0 = j, j1 = two ? j + 1 : j;
        const int ita = (j0 < PER_WAVE) ? gw + j0 * NGW : (gw - 4) + (j0 - SHIFT) * NGW;
        const int itb = (j1 < PER_WAVE) ? gw + j1 * NGW : (gw - 4) + (j1 - SHIFT) * NGW;
        const P0Item ia = decode(ita), ib = decode(itb);
        f32x4 va[8], vb[8];
        p0_load(ia, F.lane, va); p0_load(ib, F.lane, vb);
        p0_store(ia, F.lane, va); if (two) p0_store(ib, F.lane, vb);
    }
    SEC_END(F, 3);
}

__device__ __forceinline__ float wscan_add(float v, int lane) {
#pragma unroll
    for (int o = 1; o < 64; o <<= 1) { const float t = __shfl_up(v, o); if (lane >= o) v += t; }
    return v;
}
__device__ __forceinline__ float wscan_max(float v, int lane) {
#pragma unroll
    for (int o = 1; o < 64; o <<= 1) { const float t = __shfl_up(v, o); if (lane >= o) v = fmaxf(v, t); }
    return v;
}
__device__ __forceinline__ float wmax_all(float v) {
#pragma unroll
    for (int o = 32; o > 0; o >>= 1) v = fmaxf(v, __shfl_xor(v, o));
    return v;
}

__device__ __forceinline__ void mlstm_local_unit(Frame& F0, int u) {
    Frame F = F0; asm volatile("" : "+v"(F.tid), "+v"(F.lane));
    const int c = u & 63, h = (u >> 6) & 3, b = u >> 8, row0 = b * 8192 + c * 128;
    const bf16* PROJ = (const bf16*)(F.ws + WS_PROJ); const float* GATES = (const float*)(F.ws + WS_GATES); const float* conv = F.in[3];
    float* CLOC = (float*)(F.ws + WS_CLOC); float* MLOC = (float*)(F.ws + WS_SMALL); float* BLAST = MLOC + 512; float* NLOC = MLOC + 2048; bf16* KC = (bf16*)(F.ws + WS_KC);
    LAS float* wv = (LAS float*)(F.lds + VEC_OFF);
    LAS float* cw = wv + 128;
    LAS float* part = cw + 512;
    const int lane = F.lane, w = F.wave;
    SEC_BEGIN(F, 10);
#pragma unroll
    for (int j = 0; j < 8; ++j) { const int i = lane + 64 * j; cw[i] = conv[(i >> 7) * 1024 + 512 + h * 128 + (i & 127)]; }
    { const int l = lane, s0 = 2 * l, s1 = s0 + 1;
        const float li0 = GATES[(size_t)(row0 + s0) * 8 + h], li1 = GATES[(size_t)(row0 + s1) * 8 + h], lf0 = GATES[(size_t)(row0 + s0) * 8 + 4 + h], lf1 = GATES[(size_t)(row0 + s1) * 8 + 4 + h];
        const float inc = wscan_add(lf0 + lf1, l), b1 = inc, b0 = inc - lf1, blast = __shfl(inc, 63);
        const float g0 = blast - b0 + li0, g1 = blast - b1 + li1, mloc = wmax_all(fmaxf(g0, g1));
        wv[s0] = fexp(g0 - mloc); wv[s1] = fexp(g1 - mloc);
        if (l == 0 && w == 0) { MLOC[u] = mloc; BLAST[u] = blast; } }
    SEC_END(F, 10); SEC_BEGIN(F, 11);
    { u32x4 kv[4]; const int cg = F.tid & 15, sb = F.tid >> 4;
      stage_conv(F, F.lds + T1, PROJ + (size_t)row0 * PROJ_LD + KO + h * 128, cw, c * 128, 0.08838834764831845f, kv);
      float pn[8];
#pragma unroll
      for (int i = 0; i < 8; ++i) pn[i] = 0.f;
#pragma unroll
      for (int r = 0; r < 4; ++r) { *(u32x4*)(KC + (size_t)(row0 + 4 * sb + r) * 512 + h * 128 + 8 * cg) = kv[r];
          float f[8]; unpack8(kv[r], f); const float ws = wv[4 * sb + r];
#pragma unroll
          for (int i = 0; i < 8; ++i) pn[i] += ws * f[i]; }
#pragma unroll
      for (int i = 0; i < 8; ++i) { pn[i] += __shfl_xor(pn[i], 16); pn[i] += __shfl_xor(pn[i], 32); }
      if (lane < 16) { *(LAS f32x4*)(part + w * 128 + 8 * cg) = (f32x4){pn[0], pn[1], pn[2], pn[3]}; *(LAS f32x4*)(part + w * 128 + 8 * cg + 4) = (f32x4){pn[4], pn[5], pn[6], pn[7]}; } }
    stage_tile<true>(F, F.lds + T2, PROJ + (size_t)row0 * PROJ_LD + VO + h * 128, PROJ_LD, wv);
    __syncthreads();
    SEC_END(F, 11); SEC_BEGIN(F, 12);
    { f32x4 acc[8];
#pragma unroll
      for (int kb = 0; kb < 8; ++kb) acc[kb] = (f32x4){0.f, 0.f, 0.f, 0.f};
#pragma unroll
      for (int ks = 0; ks < 4; ++ks) { const bf16x8 a = frag_tr(F.lds + T2, w, ks, lane);
#pragma unroll
          for (int kb = 0; kb < 8; ++kb) { const bf16x8 bb = frag_tr(F.lds + T1, kb, ks, lane); acc[kb] = MFMA16(a, bb, acc[kb]); } }
      float* cl = CLOC + (size_t)u * 16384 + (size_t)(16 * w + 4 * (lane >> 4)) * 128 + (lane & 15);
#pragma unroll
      for (int kb = 0; kb < 8; ++kb)
#pragma unroll
          for (int rg = 0; rg < 4; ++rg) cl[rg * 128 + 16 * kb] = acc[kb][rg]; }
    if (F.tid < 128) { float a = 0.f;
#pragma unroll
        for (int ww = 0; ww < 8; ++ww) a += part[ww * 128 + F.tid];
        NLOC[(size_t)u * 128 + F.tid] = a; }
    __syncthreads();
    SEC_END(F, 12);
    F0.tsec = F.tsec;
}

__device__ __forceinline__ void gmlp_unit(Frame& F0, int ug) {
    Frame F = F0; asm volatile("" : "+v"(F.tid), "+v"(F.lane));
    const int g = ug & 3, row0 = (ug >> 2) * 128;
    const bf16* PROJ = (const bf16*)(F.ws + WS_PROJ); bf16* MIX = (bf16*)(F.ws + WS_MIX);
    const float* lng = F.in[7]; const float* wsp = F.in[8]; const float* bsp = F.in[9]; const float* og = F.in[10]; float* PSSQ = (float*)(F.ws + WS_RSG);
    LAS float* st_mean = (LAS float*)(F.lds + VEC_OFF); LAS float* st_rstd = st_mean + 128;
    const int w = F.wave, lane = F.lane;
    SEC_BEGIN(F, 20);
    { const int t = F.tid >> 2, q = F.tid & 3; const bf16* vp = PROJ + (size_t)(row0 + t) * PROJ_LD + VGO + 128 * q;
      float s = 0.f, s2 = 0.f;
#pragma unroll 8
      for (int j = 0; j < 16; ++j) { float f[8]; unpack8(*(const u32x4*)(vp + 8 * j), f);
#pragma unroll
          for (int i = 0; i < 8; ++i) { s += f[i]; s2 += f[i] * f[i]; } }
      s += __shfl_xor(s, 1); s += __shfl_xor(s, 2); s2 += __shfl_xor(s2, 1); s2 += __shfl_xor(s2, 2);
      const float mean = s * (1.0f / 512.0f), var = fmaxf(s2 * (1.0f / 512.0f) - mean * mean, 0.f);
      if (q == 0) { st_mean[t] = mean; st_rstd[t] = 1.0f / sqrtf(var + 1e-6f); } }
    __syncthreads();
    SEC_END(F, 20); SEC_BEGIN(F, 21);
    { const int cg = F.tid & 15, sb = F.tid >> 4;
      const f32x4 l0 = *(const f32x4*)(lng + g * 128 + 8 * cg), l1 = *(const f32x4*)(lng + g * 128 + 8 * cg + 4);
      u32x4 vv[4], uu[4]; f32x4 wa[4], wb[4];
#pragma unroll
      for (int r = 0; r < 4; ++r) { const int t = 4 * sb + r;
          vv[r] = *(const u32x4*)(PROJ + (size_t)(row0 + t) * PROJ_LD + VGO + g * 128 + 8 * cg); uu[r] = *(const u32x4*)(PROJ + (size_t)(row0 + t) * PROJ_LD + UO + g * 128 + 8 * cg);
          const float* wp = wsp + ((size_t)(g * 128 + t)) * 128 + 8 * cg; wa[r] = *(const f32x4*)wp; wb[r] = *(const f32x4*)(wp + 4); }
#pragma unroll
      for (int r = 0; r < 4; ++r) { const int t = 4 * sb + r;
          float f[8] = {wa[r][0], wa[r][1], wa[r][2], wa[r][3], wb[r][0], wb[r][1], wb[r][2], wb[r][3]};
#pragma unroll
          for (int kk = 0; kk < 8; ++kk) if (8 * cg + kk > t) f[kk] = 0.f;
          *(LAS u32x4*)(F.lds + T0 + off_b(t, cg)) = pack8(f);
          float v[8]; unpack8(vv[r], v); const float mean = st_mean[t], rstd = st_rstd[t];
#pragma unroll
          for (int kk = 0; kk < 8; ++kk) v[kk] = (v[kk] - mean) * rstd * (kk < 4 ? l0[kk] : l1[kk - 4]);
          *(LAS u32x4*)(F.lds + T1 + off_b(t, cg)) = pack8(v);
          *(LAS u32x4*)(F.lds + T2 + off_b(t, cg)) = uu[r]; } }
    __syncthreads();
    SEC_END(F, 21); SEC_BEGIN(F, 22);
    f32x4 acc[8];
#pragma unroll
    for (int db = 0; db < 8; ++db) acc[db] = (f32x4){0.f, 0.f, 0.f, 0.f};
    for (int ks = 0; ks <= (w >> 1); ++ks) { const bf16x8 a = frag_row(F.lds + T0, 16 * w, ks, lane);
#pragma unroll
        for (int db = 0; db < 8; ++db) { const bf16x8 bb = frag_tr(F.lds + T1, db, ks, lane); acc[db] = MFMA16(a, bb, acc[db]); } }
    float ssq[4] = {0.f, 0.f, 0.f, 0.f}; float ogv[8];
#pragma unroll
    for (int db = 0; db < 8; ++db) ogv[db] = og[g * 128 + 16 * db + (lane & 15)];
#pragma unroll
    for (int rg = 0; rg < 4; ++rg) { int t = 16 * w + 4 * (lane >> 4) + rg; const float bs = bsp[g * 128 + t]; asm volatile("" : "+v"(t));
#pragma unroll
        for (int db = 0; db < 8; ++db) { const int d = 16 * db + (lane & 15);
            const float gu = bf2f(*(const LAS unsigned short*)(F.lds + T2 + off_b(t, d >> 3) + 2 * (d & 7)));
            const float val = (acc[db][rg] + bs) * gu; ssq[rg] += val * val;
            *(LAS unsigned short*)(F.lds + T3 + off_b(t, d >> 3) + 2 * (d & 7)) = (unsigned short)(pk2(val * ogv[db], 0.f) & 0xffffu); } }
#pragma unroll
    for (int i = 0; i < 4; ++i) { const int id = lane + 64 * i, r = id >> 4, ch = id & 15, t = 16 * w + r;
        *(u32x4*)(MIX + (size_t)(row0 + t) * 1024 + 512 + g * 128 + 8 * ch) = *(const LAS u32x4*)(F.lds + T3 + off_b(t, ch)); }
#pragma unroll
    for (int rg = 0; rg < 4; ++rg) { float q = ssq[rg]; q += __shfl_xor(q, 1); q += __shfl_xor(q, 2); q += __shfl_xor(q, 4); q += __shfl_xor(q, 8);
        if ((lane & 15) == 0) PSSQ[(size_t)g * 16384 + row0 + 16 * w + 4 * (lane >> 4) + rg] = q; }
    __syncthreads();
    SEC_END(F, 22);
    F0.tsec = F.tsec;
}

__device__ __forceinline__ void phase_scan(const Frame& F) {
    const float* CLOC = (const float*)(F.ws + WS_CLOC); float* MLOC = (float*)(F.ws + WS_SMALL); float* BLAST = MLOC + 512; float* MPREV = MLOC + 1024;
    float* NLOC = MLOC + 2048; float* NPREV = NLOC + 512 * 128; bf16* CPREV = (bf16*)(F.ws + WS_CPREV);
    LAS float* av = (LAS float*)(F.lds + VEC_OFF); LAS float* cv = av + 64;
    const int wg = F.vcu, bh = wg >> 5;
    if (F.wave == 0) { const int l = F.lane; const float ml = MLOC[bh * 64 + l], bl = BLAST[bh * 64 + l];
        float m = 0.f, mym = 0.f, mynext = 0.f;
        for (int c = 0; c < 64; ++c) { const float mlc = __shfl(ml, c), blc = __shfl(bl, c); const float mn = fmaxf(blc + m, mlc); if (l == c) { mym = m; mynext = mn; } m = mn; }
        av[l] = fexp(bl + mym - mynext); cv[l] = fexp(ml - mynext);
        if ((wg & 31) == 0) MPREV[bh * 64 + l] = mym; }
    __syncthreads();
    if (F.tid < 256) { const int p = (wg & 31) * 256 + F.tid; float v0 = 0.f, v1 = 0.f;
        const float* src = CLOC + (size_t)(bh * 64) * 16384 + 2 * p; bf16* dst = CPREV + (size_t)(bh * 64) * 16384 + 2 * p;
#pragma unroll 8
        for (int c = 0; c < 64; ++c) { const float2 x = *(const float2*)(src + (size_t)c * 16384);
            *(unsigned*)(dst + (size_t)c * 16384) = pk2(v0, v1);
            const float a = av[c], cc = cv[c]; v0 = a * v0 + cc * x.x; v1 = a * v1 + cc * x.y; } }
    else if (F.tid < 320 && (wg & 31) == 0) { const int p = F.tid - 256; float v0 = 0.f, v1 = 0.f;
        for (int c = 0; c < 64; ++c) { const float2 x = *(const float2*)(NLOC + (size_t)(bh * 64 + c) * 128 + 2 * p);
            *(float2*)(NPREV + (size_t)(bh * 64 + c) * 128 + 2 * p) = make_float2(v0, v1);
            const float a = av[c], cc = cv[c]; v0 = a * v0 + cc * x.x; v1 = a * v1 + cc * x.y; } }
    __syncthreads();
}

__device__ __forceinline__ void mlstm_out_unit(Frame& F0, int u) {
    Frame F = F0; asm volatile("" : "+v"(F.tid), "+v"(F.lane));
    const int c = u & 63, h = (u >> 6) & 3, b = u >> 8, row0 = b * 8192 + c * 128;
    const bf16* PROJ = (const bf16*)(F.ws + WS_PROJ); const float* GATES = (const float*)(F.ws + WS_GATES); const float* conv = F.in[3]; const float* ngain = F.in[6];
    const float* MPREV = (const float*)(F.ws + WS_SMALL) + 1024; const float* NPREV = (const float*)(F.ws + WS_SMALL) + 2048 + 512 * 128;
    const bf16* CPREV = (const bf16*)(F.ws + WS_CPREV); bf16* MIX = (bf16*)(F.ws + WS_MIX);
    LAS float* colc = (LAS float*)(F.lds + VEC_OFF); LAS float* rowc = colc + 128; LAS float* inter = rowc + 128; LAS float* emn = inter + 128; LAS float* rdn = emn + 128;
    LAS float* npv = rdn + 128; LAS float* cw = npv + 128;
    const int w = F.wave, lane = F.lane;
    SEC_BEGIN(F, 30);
#pragma unroll
    for (int j = 0; j < 8; ++j) { const int i = lane + 64 * j; cw[i] = conv[(i >> 7) * 1024 + h * 128 + (i & 127)]; }
    npv[lane] = NPREV[(size_t)u * 128 + lane]; npv[64 + lane] = NPREV[(size_t)u * 128 + 64 + lane];
    { const int l = lane, s0 = 2 * l, s1 = s0 + 1;
        const float li0 = GATES[(size_t)(row0 + s0) * 8 + h], li1 = GATES[(size_t)(row0 + s1) * 8 + h], lf0 = GATES[(size_t)(row0 + s0) * 8 + 4 + h], lf1 = GATES[(size_t)(row0 + s1) * 8 + 4 + h];
        const float inc = wscan_add(lf0 + lf1, l), b1 = inc, b0 = inc - lf1;
        const float c0 = li0 - b0, c1 = li1 - b1;
        const float pmx = wscan_max(fmaxf(c0, c1), l); float pprev = __shfl_up(pmx, 1); if (l == 0) pprev = -INFINITY;
        const float pm0 = fmaxf(pprev, c0), pm1 = pmx, mprev = MPREV[u];
        const float m0 = b0 + fmaxf(mprev, pm0), m1 = b1 + fmaxf(mprev, pm1);
        colc[s0] = c0; colc[s1] = c1; rowc[s0] = b0 - m0; rowc[s1] = b1 - m1;
        inter[s0] = fexp(b0 + mprev - m0); inter[s1] = fexp(b1 + mprev - m1); emn[s0] = fexp(-m0); emn[s1] = fexp(-m1); }
    SEC_END(F, 30); SEC_BEGIN(F, 31);
    { u32x4 qv[4]; stage_conv(F, F.lds + T0, PROJ + (size_t)row0 * PROJ_LD + QO + h * 128, cw, c * 128, 1.0f, qv); }
    stage_tile<false>(F, F.lds + T1, (const bf16*)(F.ws + WS_KC) + (size_t)row0 * 512 + h * 128, 512, nullptr);
    stage_tile<false>(F, F.lds + T2, PROJ + (size_t)row0 * PROJ_LD + VO + h * 128, PROJ_LD, nullptr);
    stage_tile<false>(F, F.lds + T3, CPREV + (size_t)u * 16384, 128, nullptr);
    __syncthreads();
    SEC_END(F, 31); SEC_BEGIN(F, 32);
    const int t = 16 * w + (lane & 15);
    u32x2 wpk[8]; float rsum = 0.f;
    { const float rc = rowc[t];
#pragma unroll
      for (int sb = 0; sb < 8; ++sb) { wpk[sb] = (u32x2){0u, 0u};
          if (sb <= w) { f32x4 a4 = (f32x4){0.f, 0.f, 0.f, 0.f};
#pragma unroll
              for (int ks = 0; ks < 4; ++ks) { const bf16x8 a = frag_row(F.lds + T1, 16 * sb, ks, lane), bb = frag_row(F.lds + T0, 16 * w, ks, lane); a4 = MFMA16(a, bb, a4); }
              float wv4[4];
#pragma unroll
              for (int rg = 0; rg < 4; ++rg) { const int s = 16 * sb + 4 * (lane >> 4) + rg; const float e = fexp(rc + colc[s]) * a4[rg]; wv4[rg] = (s <= t) ? e : 0.f; }
              wpk[sb].x = pk2(wv4[0], wv4[1]); wpk[sb].y = pk2(wv4[2], wv4[3]);
              rsum += bf2f((unsigned short)(wpk[sb].x & 0xffffu)) + bf2f((unsigned short)(wpk[sb].x >> 16)) + bf2f((unsigned short)(wpk[sb].y & 0xffffu)) + bf2f((unsigned short)(wpk[sb].y >> 16)); } } }
    __syncthreads();
    SEC_END(F, 32); SEC_BEGIN(F, 33);
    { int t2 = t; asm volatile("" : "+v"(t2));
#pragma unroll
    for (int sb = 0; sb < 8; ++sb) if (sb <= (w | 1)) *(LAS u32x2*)(F.lds + T1 + off_b(t2, 2 * sb + (lane >> 5)) + 8 * ((lane >> 4) & 1)) = wpk[sb]; }
    rsum += __shfl_xor(rsum, 16); rsum += __shfl_xor(rsum, 32);
    { float qn = 0.f; const int part = lane >> 4;
#pragma unroll
      for (int i = 0; i < 4; ++i) { float f[8]; unpack8(*(const LAS u32x4*)(F.lds + T0 + off_b(t, 4 * part + i)), f);
#pragma unroll
          for (int k = 0; k < 8; ++k) qn += f[k] * npv[32 * part + 8 * i + k]; }
      qn += __shfl_xor(qn, 16); qn += __shfl_xor(qn, 32);
      const float den = rsum + inter[t] * qn;
      if (lane < 16) rdn[t] = 1.0f / fmaxf(fabsf(den), emn[t]); }
    f32x4 acc[8];
#pragma unroll
    for (int vb = 0; vb < 8; ++vb) acc[vb] = (f32x4){0.f, 0.f, 0.f, 0.f};
#pragma unroll
    for (int ks = 0; ks < 4; ++ks) { const bf16x8 a = frag_row(F.lds + T0, 16 * w, ks, lane);
#pragma unroll
        for (int vb = 0; vb < 8; ++vb) { const bf16x8 bb = frag_row(F.lds + T3, 16 * vb, ks, lane); acc[vb] = MFMA16(a, bb, acc[vb]); } }
    float it4[4], rd4[4];
#pragma unroll
    for (int rg = 0; rg < 4; ++rg) { const int tr = 16 * w + 4 * (lane >> 4) + rg; it4[rg] = inter[tr]; rd4[rg] = rdn[tr]; }
#pragma unroll
    for (int vb = 0; vb < 8; ++vb)
#pragma unroll
        for (int rg = 0; rg < 4; ++rg) acc[vb][rg] *= it4[rg];
    for (int ks = 0; ks <= (w >> 1); ++ks) { const bf16x8 a = frag_row(F.lds + T1, 16 * w, ks, lane);
#pragma unroll
        for (int vb = 0; vb < 8; ++vb) { const bf16x8 bb = frag_tr(F.lds + T2, vb, ks, lane); acc[vb] = MFMA16(a, bb, acc[vb]); } }
    SEC_END(F, 33); SEC_BEGIN(F, 34);
#pragma unroll
    for (int rg = 0; rg < 4; ++rg) { float s = 0.f;
#pragma unroll
        for (int vb = 0; vb < 8; ++vb) { acc[vb][rg] *= rd4[rg]; s += acc[vb][rg]; }
        s += __shfl_xor(s, 1); s += __shfl_xor(s, 2); s += __shfl_xor(s, 4); s += __shfl_xor(s, 8);
        const float mean = s * (1.0f / 128.0f); float q = 0.f;
#pragma unroll
        for (int vb = 0; vb < 8; ++vb) { acc[vb][rg] -= mean; q += acc[vb][rg] * acc[vb][rg]; }
        q += __shfl_xor(q, 1); q += __shfl_xor(q, 2); q += __shfl_xor(q, 4); q += __shfl_xor(q, 8);
        const float rstd = 1.0f / sqrtf(q * (1.0f / 128.0f) + 1e-6f);
#pragma unroll
        for (int vb = 0; vb < 8; ++vb) acc[vb][rg] *= rstd; }
#pragma unroll
    for (int vb = 0; vb < 8; ++vb) { const int d = 16 * vb + (lane & 15); const float gg = ngain[h * 128 + d];
#pragma unroll
        for (int rg = 0; rg < 4; ++rg) { int tr = 16 * w + 4 * (lane >> 4) + rg; asm volatile("" : "+v"(tr));
            *(LAS unsigned short*)(F.lds + T1 + off_b(tr, d >> 3) + 2 * (d & 7)) = (unsigned short)(pk2(acc[vb][rg] * gg, 0.f) & 0xffffu); } }
#pragma unroll
    for (int i = 0; i < 4; ++i) { const int id = lane + 64 * i, r = id >> 4, ch = id & 15, tr = 16 * w + r;
        float y[8], o[8]; unpack8(*(const LAS u32x4*)(F.lds + T1 + off_b(tr, ch)), y);
        unpack8(*(const u32x4*)(PROJ + (size_t)(row0 + tr) * PROJ_LD + OO + h * 128 + 8 * ch), o);
#pragma unroll
        for (int k = 0; k < 8; ++k) y[k] *= o[k];
        *(u32x4*)(MIX + (size_t)(row0 + tr) * 1024 + h * 128 + 8 * ch) = pack8(y); }
    { const float* RSG = (const float*)(F.ws + WS_RSG);
#pragma unroll
      for (int i = 0; i < 4; ++i) { const int id = lane + 64 * i, r = id >> 4, ch = id & 15, tr = 16 * w + r;
          bf16* p = MIX + (size_t)(row0 + tr) * 1024 + 512 + h * 128 + 8 * ch; float y[8]; unpack8(*(const u32x4*)p, y);
          const float rs = 1.0f / sqrtf(((RSG[row0 + tr] + RSG[16384 + row0 + tr]) + (RSG[32768 + row0 + tr] + RSG[49152 + row0 + tr])) * (1.0f / 512.0f) + 1e-6f);
#pragma unroll
          for (int kk = 0; kk < 8; ++kk) y[kk] *= rs;
          *(u32x4*)p = pack8(y); } }
    __syncthreads();
    SEC_END(F, 34);
    F0.tsec = F.tsec;
}

__device__ __forceinline__ void phase_router(Frame& F) {
    const float* H = (const float*)(F.ws + WS_H); const float* g2 = F.in[12]; const float* br = F.in[14];
    const bf16* WrThi = (const bf16*)(F.ws + WS_WRT); const bf16* WrTlo = WrThi + 32 * 1024;
    bf16* HN = (bf16*)(F.ws + WS_XN); int* cnt = (int*)(F.ws + WS_CTL) + CW_CNT; int* tokidx = (int*)(F.ws + WS_TOKIDX); float* gatex = (float*)(F.ws + WS_GATEX); float* rsx = (float*)(F.ws + WS_RSX);
    lptr ihi = F.lds, ilo = F.lds + 32 * IMG_ROW;
    LAS float* lg = (LAS float*)(F.lds + 2 * 32 * IMG_ROW);
    LAS int* hist = (LAS int*)(lg + 2048); LAS int* base = hist + 32;
    SEC_BEGIN(F, 4);
    for (int i = F.tid; i < 32 * 128; i += NTHR) { const int n = i >> 7, ch = i & 127;
        *(LAS u32x4*)(ihi + n * IMG_ROW + 16 * ch) = *(const u32x4*)(WrThi + (size_t)n * 1024 + 8 * ch);
        *(LAS u32x4*)(ilo + n * IMG_ROW + 16 * ch) = *(const u32x4*)(WrTlo + (size_t)n * 1024 + 8 * ch); }
    if (F.tid < 32) hist[F.tid] = 0;
    __syncthreads();
    SEC_END(F, 4); SEC_BEGIN(F, 5);
    const int tok0 = F.vcu * 64 + (F.wave & 3) * 16, lane = F.lane;
    int be[4] = {0, 0, 0, 0}, lr[4] = {0, 0, 0, 0}; float gt[4] = {0.f, 0.f, 0.f, 0.f}; float rstd = 0.f;
    if (F.wave < 4) {
        f32x4 acc[2];
        rstd = row_pass<2>(H, g2, HN, ihi, ilo, tok0, lane, acc);
        { float rr[4];
#pragma unroll
          for (int rg = 0; rg < 4; ++rg) rr[rg] = __shfl(rstd, 4 * (lane >> 4) + rg);
#pragma unroll
          for (int nf = 0; nf < 2; ++nf)
#pragma unroll
              for (int rg = 0; rg < 4; ++rg) lg[(F.wave * 16 + 4 * (lane >> 4) + rg) * 32 + 16 * nf + (lane & 15)] = acc[nf][rg] * rr[rg]; }
        if (lane < 16) { float v[32];
#pragma unroll
            for (int q4 = 0; q4 < 8; ++q4) { const f32x4 x = *(const LAS f32x4*)(lg + (F.wave * 16 + lane) * 32 + 4 * q4), bb = *(const f32x4*)(br + 4 * q4);
                v[4 * q4] = x[0] + bb[0]; v[4 * q4 + 1] = x[1] + bb[1]; v[4 * q4 + 2] = x[2] + bb[2]; v[4 * q4 + 3] = x[3] + bb[3]; }
            float bv[4];
#pragma unroll
            for (int k = 0; k < 4; ++k) { float best = -INFINITY; int bi = 0;
#pragma unroll
                for (int e = 0; e < 32; ++e) if (v[e] > best) { best = v[e]; bi = e; }
                be[k] = bi; bv[k] = best;
#pragma unroll
                for (int e = 0; e < 32; ++e) v[e] = (e == bi) ? -INFINITY : v[e]; }
            float den = 0.f;
#pragma unroll
            for (int k = 0; k < 4; ++k) { gt[k] = fexp(bv[k] - bv[0]); den += gt[k]; }
            const float rd = 1.0f / den;
#pragma unroll
            for (int k = 0; k < 4; ++k) { gt[k] *= rd; lr[k] = __hip_atomic_fetch_add(hist + be[k], 1, __ATOMIC_RELAXED, __HIP_MEMORY_SCOPE_WORKGROUP); } } }
    SEC_END(F, 5); SEC_BEGIN(F, 6);
    __syncthreads();
    if (F.tid < 32) base[F.tid] = hist[F.tid] > 0 ? atomicAdd(&cnt[F.tid], hist[F.tid]) : 0;
    __syncthreads();
    if (F.wave < 4 && lane < 16) { const int tok = tok0 + lane;
#pragma unroll
        for (int k = 0; k < 4; ++k) { const int rk = base[be[k]] + lr[k]; const size_t p = (size_t)be[k] * 65536 + rk; tokidx[p] = tok * 4 + k; gatex[p] = gt[k]; rsx[p] = rstd; } }
    __syncthreads();
    SEC_END(F, 6);
}

__device__ __forceinline__ int build_ttab(const Frame& F) {
    const int* cnt = (const int*)(F.ws + WS_CTL) + CW_CNT; LAS unsigned* ttab = (LAS unsigned*)(F.lds + TTAB_OFF); LAS int* tot = (LAS int*)(F.lds + MISC_OFF + 64);
    if (F.wave == 0) { const int l = F.lane; const int c = l < 32 ? __hip_atomic_load(cnt + l, RLX_AGENT) : 0; const int nt = (c + 255) >> 8;
        int inc = nt;
#pragma unroll
        for (int o = 1; o < 64; o <<= 1) { const int tt = __shfl_up(inc, o); if (l >= o) inc += tt; }
        const int start = inc - nt;
        for (int r = 0; r < nt; ++r) { const int left = c - 256 * r; ttab[start + r] = (unsigned)l | ((unsigned)r << 5) | ((unsigned)((left < 256 ? left : 256) - 1) << 14); }
        if (l == 63) tot[0] = inc; }
    __syncthreads();
    return tot[0];
}

__device__ __forceinline__ void phase_final(const Frame& F) {
    const float* H = (const float*)(F.ws + WS_H); const bf16* Y = (const bf16*)(F.ws + WS_Y); const float* gf = F.in[19];
    const int gw = F.vcu * NWAVES + F.wave, lane = F.lane;
    f32x4 gg[4];
#pragma unroll
    for (int j = 0; j < 4; ++j) gg[j] = *(const f32x4*)(gf + 4 * (lane + 64 * j));
#pragma unroll 1
    for (int i = 0; i < 8; i += 2) { const int tok = gw * 8 + i;
        f32x4 v[2][4]; u32x2 y[2][4][4];
#pragma unroll
        for (int q = 0; q < 2; ++q)
#pragma unroll
            for (int j = 0; j < 4; ++j) { v[q][j] = __builtin_nontemporal_load((const f32x4*)(H + (size_t)(tok + q) * 1024 + 4 * (lane + 64 * j)));
#pragma unroll
                for (int k = 0; k < 4; ++k) y[q][j][k] = __builtin_nontemporal_load((const u32x2*)(Y + (size_t)((tok + q) * 4 + k) * 1024 + 4 * (lane + 64 * j))); }
#pragma unroll
        for (int q = 0; q < 2; ++q) { float s = 0.f;
#pragma unroll
            for (int j = 0; j < 4; ++j) {
#pragma unroll
                for (int k = 0; k < 4; ++k) { const u32x2 yy = y[q][j][k];
                    v[q][j][0] += __builtin_bit_cast(float, yy.x << 16); v[q][j][1] += __builtin_bit_cast(float, yy.x & 0xffff0000u);
                    v[q][j][2] += __builtin_bit_cast(float, yy.y << 16); v[q][j][3] += __builtin_bit_cast(float, yy.y & 0xffff0000u); }
                s += (v[q][j][0] * v[q][j][0] + v[q][j][1] * v[q][j][1]) + (v[q][j][2] * v[q][j][2] + v[q][j][3] * v[q][j][3]); }
            const float r = 1.0f / sqrtf(wsum_all(s) * (1.0f / 1024.0f) + 1e-6f);
#pragma unroll
            for (int j = 0; j < 4; ++j) __builtin_nontemporal_store(v[q][j] * r * gg[j], (f32x4*)(F.out + (size_t)(tok + q) * 1024 + 4 * (lane + 64 * j))); } }
}

constexpr int N_PHASES = 10;
struct Args { const float* in[20]; float* out; unsigned char* ws; int ph_lo, ph_hi; };
__global__ void __launch_bounds__(NTHR, 2) mk_fwd(Args args) {
    extern __shared__ __attribute__((aligned(16))) unsigned char lds_raw[];
    Frame F; F.t0 = 0ull; F.tsec = 0ull;
    F.lds = (lptr)lds_raw; F.tid = threadIdx.x; F.lane = F.tid & 63; F.wave = __builtin_amdgcn_readfirstlane(F.tid >> 6);
    F.G = gridDim.x; { const int bx = blockIdx.x; F.vcu = (F.G % 8 == 0) ? (bx % 8) * (F.G / 8) + bx / 8 : bx; }
#pragma unroll
    for (int i = 0; i < 20; ++i) F.in[i] = args.in[i];
    F.out = args.out; F.ws = args.ws;
    for (int u = F.tid; u < (LDS_BYTES - CTL_OFF) / 4; u += NTHR) ((LAS unsigned*)(F.lds + CTL_OFF))[u] = 0u;
    __syncthreads();
    XcdBarrier bar = xcd_barrier_post((unsigned*)(F.ws + WS_CTL) + CW_BAR, (volatile LAS unsigned*)(F.lds + MISC_OFF));
    const int lo = args.ph_lo, hi = args.ph_hi;
#define IN(k) (lo <= (k) && (k) < hi)
#ifndef PROBE_LO
#define PROBE_LO -1
#define PROBE_HI -1
#endif
    unsigned long long tp0 = 0ull;
#define SEAM(k) do { if (IN(k) && IN((k) + 1)) xcd_barrier(bar); \
        if (PROBE_HI == (k) + 1) { const unsigned long long tn = __builtin_amdgcn_s_memrealtime(), dt = tn - tp0; while (__builtin_amdgcn_s_memrealtime() - tn < dt) __builtin_amdgcn_s_sleep(8); __syncthreads(); } \
        if (PROBE_LO == (k) + 1) tp0 = __builtin_amdgcn_s_memrealtime(); } while (0)
    const int bx = blockIdx.x;
    if (PROBE_LO == 0) tp0 = __builtin_amdgcn_s_memrealtime();
    if (IN(0)) { phase0(F); } SEAM(0);
    if (IN(1)) { pg8::DenseOps ops{(const bf16*)(F.ws + WS_XN), (const bf16*)(F.ws + WS_WINT), 1024}; pg8::StaticOrder S; S.init(64, 12, F.G, bx, 4);
        pg8::EpiProj E{(bf16*)(F.ws + WS_PROJ), PROJ_LD, (const float*)(F.ws + WS_RS1)};
        pg8::gemm_phase<pg8::EpiProj, pg8::StaticOrder, pg8::DenseOps, false, true>(F.lds, 1024, S, ops, E); } SEAM(1);
    if (IN(2)) {
#pragma unroll 1
        for (int j = 0; j < 2; ++j) mlstm_local_unit(F, F.vcu * 2 + j);
#pragma unroll 1
        for (int j = 0; j < 2; ++j) gmlp_unit(F, F.vcu * 2 + j); } SEAM(2);
    if (IN(3)) { phase_scan(F); } SEAM(3);
    if (IN(4)) {
#pragma unroll 1
        for (int j = 0; j < 2; ++j) mlstm_out_unit(F, F.vcu * 2 + j); } SEAM(4);
    if (IN(5)) { pg8::DenseOps ops{(const bf16*)(F.ws + WS_MIX), (const bf16*)(F.ws + WS_WOUTT), 1024}; pg8::StaticOrder S; S.init(64, 4, F.G, bx);
        pg8::EpiRes E{F.in[0], (float*)(F.ws + WS_H), 1024};
        pg8::gemm_phase<pg8::EpiRes, pg8::StaticOrder, pg8::DenseOps, false, false>(F.lds, 1024, S, ops, E); } SEAM(5);
    if (IN(6)) { phase_router(F); } SEAM(6);
    if (IN(7)) { const int nM = build_ttab(F);
        pg8::UpOps ops{(const bf16*)(F.ws + WS_XN), (const bf16*)(F.ws + WS_WUPT), (const int*)(F.ws + WS_TOKIDX)};
        pg8::MoeOrder S; S.init(nM, 8, F.G, bx, 4); S.ttab = (const LAS unsigned*)(F.lds + TTAB_OFF);
        pg8::EpiUp E{(bf16*)(F.ws + WS_ACT), F.in[16], (const float*)(F.ws + WS_RSX)};
        pg8::gemm_phase<pg8::EpiUp, pg8::MoeOrder, pg8::UpOps, true, true>(F.lds, 1024, S, ops, E); } SEAM(7);
    if (IN(8)) { const int nM = build_ttab(F);
        pg8::DownOps ops{(const bf16*)(F.ws + WS_ACT), (const bf16*)(F.ws + WS_WDNT)};
        pg8::MoeOrder S; S.init(nM, 4, F.G, bx); S.ttab = (const LAS unsigned*)(F.lds + TTAB_OFF);
        pg8::EpiDown E{(bf16*)(F.ws + WS_Y), F.in[18], (const float*)(F.ws + WS_GATEX), (const int*)(F.ws + WS_TOKIDX)};
        pg8::gemm_phase<pg8::EpiDown, pg8::MoeOrder, pg8::DownOps, false, true>(F.lds, 1024, S, ops, E); } SEAM(8);
    if (IN(9)) { phase_final(F); } SEAM(9);
    if (PROBE_SEC >= 0) { const unsigned long long tn = __builtin_amdgcn_s_memrealtime(); while (__builtin_amdgcn_s_memrealtime() - tn < F.tsec) __builtin_amdgcn_s_sleep(8); }
#undef IN
#undef SEAM
}

extern "C" void kernel_launch(void* const* d_in, const int* in_sizes, int n_in, void* d_out, int out_size, void* d_ws, size_t ws_size, hipStream_t stream) {
    static int ready = 0;
    if (!ready) {
        if (hipFuncSetAttribute((const void*)mk_fwd, hipFuncAttributeMaxDynamicSharedMemorySize, LDS_BYTES) != hipSuccess) { fprintf(stderr, "hipFuncSetAttribute failed\n"); return; }
        ready = 1;
    }
    char* ws = (char*)d_ws;
    if (ws_size < 800 * MiB) { fprintf(stderr, "ws too small: %zu\n", ws_size); return; }
    (void)hipMemsetAsync(ws + WS_CTL, 0, CTL_ZERO_BYTES, stream);
    Args a{};
    for (int i = 0; i < 20; ++i) a.in[i] = (const float*)d_in[i];
    a.out = (float*)d_out; a.ws = (unsigned char*)d_ws; a.ph_lo = 0; a.ph_hi = N_PHASES;
    hipLaunchKernelGGL(mk_fwd, dim3(256), dim3(NTHR), LDS_BYTES, stream, a);
}
```

```cpp
#include <hip/hip_runtime.h>
#include <cstdio>
#include <cstdint>
#include <cstddef>
#include <cmath>


namespace pg8 {
#define PG8_LAS __attribute__((address_space(3)))
typedef unsigned short bf16_t;
typedef short bf16x8 __attribute__((ext_vector_type(8)));
typedef float f32x4 __attribute__((ext_vector_type(4)));
typedef float f32x2 __attribute__((ext_vector_type(2)));
typedef unsigned u32x4 __attribute__((ext_vector_type(4)));
typedef unsigned u32x2 __attribute__((ext_vector_type(2)));
typedef int i32x4 __attribute__((ext_vector_type(4)));
typedef int i32x8 __attribute__((ext_vector_type(8)));
constexpr int BM = 256, BK = 64, HALF = 128, HTB = HALF * BK * 2, STAGE_BYTES = 8 * HTB, NXCD = 8, WGM = 8;

__host__ __device__ __forceinline__ int lds_byte(int r, int c) { const int st = (r >> 4) * 2 + (c >> 5), rr = r & 15, cc = c & 31, ob = rr * 64 + cc * 2; return st * 1024 + (ob ^ (((ob >> 9) & 1) << 5)); }
__host__ __device__ __forceinline__ void stage_rc(int b, int& R, int& C) { const int st = b / 1024, sb = b % 1024, swz = sb ^ (((sb >> 9) & 1) << 5); R = (st >> 1) * 16 + swz / 64; C = (st & 1) * 32 + (swz % 64) / 2; }
__host__ __device__ __forceinline__ int perm32(int rho) { const int n = rho >> 4, i = rho & 15; return 8 * (i >> 2) + 4 * n + (i & 3); }

struct Unit { int pm, pn, e, rt, nrows; };

struct StaticOrder {
    int nM, nN, nwg, G, c, wgm;
    __device__ void init(int nM_, int nN_, int G_, int c_, int wgm_ = WGM) { nM = nM_; nN = nN_; nwg = nM * nN; G = G_; c = c_; wgm = wgm_; }
    __device__ bool next(int i, Unit& u) const {
        const long L = (long)i * G + c; if (L >= nwg) return false;
        int wgid = (int)L; { const int q = nwg / NXCD, r = nwg % NXCD, xcd = wgid % NXCD, off = wgid / NXCD; wgid = (xcd < r ? xcd * (q + 1) : r * (q + 1) + (xcd - r) * q) + off; }
        const int nig = wgm * nN, gid = wgid / nig, fm = gid * wgm, gsz = (nM - fm) < wgm ? (nM - fm) : wgm;
        u.pm = fm + ((wgid % nig) % gsz); u.pn = (wgid % nig) / gsz; u.e = 0; u.rt = 0; u.nrows = 256; return true;
    }
};
struct MoeOrder : StaticOrder {
    const PG8_LAS unsigned* ttab;
    __device__ bool next(int i, Unit& u) const {
        if (!StaticOrder::next(i, u)) return false;
        const unsigned w = ttab[u.pm]; u.e = (int)(w & 31u); u.rt = (int)((w >> 5) & 511u); u.nrows = (int)((w >> 14) & 255u) + 1; return true;
    }
};

__device__ __forceinline__ unsigned cvt_pk_bf16(float lo, float hi) { unsigned r; asm volatile("v_cvt_pk_bf16_f32 %0, %1, %2" : "=v"(r) : "v"(lo), "v"(hi)); return r; }

struct DenseOps {
    const bf16_t* A; const bf16_t* Bt; int K;
    __device__ __forceinline__ const char* a_base(const Unit& u) const { return (const char*)A + (size_t)u.pm * BM * K * 2; }
    __device__ __forceinline__ const char* b_base(const Unit& u) const { return (const char*)Bt + (size_t)u.pn * BM * K * 2; }
    __device__ __forceinline__ void gather(const Unit&, const int (&)[2], const int (&)[2], unsigned (&)[2][2]) const {}
};
struct UpOps {
    const void* HN; const void* WupT; const int* tokidx; unsigned pitch;
    __device__ __forceinline__ const char* a_base(const Unit&) const { return (const char*)HN; }
    __device__ __forceinline__ const char* b_base(const Unit& u) const { return (const char*)WupT + ((size_t)u.e * 2048 + (size_t)u.pn * BM) * pitch; }
    __device__ __forceinline__ void gather(const Unit& u, const int (&R)[2], const int (&C)[2], unsigned (&v)[2][2]) const {
        const int* tl = tokidx + (size_t)u.e * 65536 + u.rt * 256;
#pragma unroll
        for (int h = 0; h < 2; ++h)
#pragma unroll
            for (int i = 0; i < 2; ++i) { const int r = R[i] + 128 * h; const int idx = tl[r < u.nrows ? r : 0]; v[h][i] = (unsigned)(idx >> 2) * pitch + (unsigned)C[i] * 2u; }
    }
};
struct DownOps {
    const void* ACT; const void* WdnT; unsigned pitch;
    __device__ __forceinline__ const char* a_base(const Unit& u) const { return (const char*)ACT + (size_t)u.pm * BM * pitch; }
    __device__ __forceinline__ const char* b_base(const Unit& u) const { return (const char*)WdnT + ((size_t)u.e * 1024 + (size_t)u.pn * BM) * pitch; }
    __device__ __forceinline__ void gather(const Unit&, const int (&)[2], const int (&)[2], unsigned (&)[2][2]) const {}
};
__device__ __forceinline__ unsigned pk4_fp8(float a, float b, float c, float d) { int r = __builtin_amdgcn_cvt_pk_fp8_f32(a, b, 0, false); r = __builtin_amdgcn_cvt_pk_fp8_f32(c, d, r, true); return (unsigned)r; }

struct EpiProj {
    static constexpr bool PERM = true;
    bf16_t* O; int ldc; const float* rs;
    static __device__ __forceinline__ float sigm(float x) { return __builtin_amdgcn_rcpf(1.0f + __builtin_amdgcn_exp2f(-1.4426950408889634f * x)); }
    static __device__ __forceinline__ float act(float x, int mode) {
        if (mode == 1) return sigm(x);
        if (mode == 2) return x * sigm(1.5957691216057308f * (x + 0.044715f * x * x * x));
        return x; }
    __device__ __forceinline__ void operator()(const f32x4 (&acc)[2][2][4][2], const Unit& u, int wr, int wc, int fr, int fq) const {
        const int row0 = u.pm * BM + wr * 64 + fr, col0 = u.pn * BM + wc * 32 + 8 * fq;
        const int mode = u.pn >= 8 ? 2 : (u.pn >= 6 ? 1 : 0);
        float sc[2][4];
#pragma unroll
        for (int ai = 0; ai < 2; ++ai)
#pragma unroll
            for (int m = 0; m < 4; ++m) sc[ai][m] = rs[row0 + ai * HALF + m * 16];
#pragma unroll
        for (int ai = 0; ai < 2; ++ai)
#pragma unroll
            for (int m = 0; m < 4; ++m) { bf16_t* rowp = O + (size_t)(row0 + ai * HALF + m * 16) * ldc + col0;
#pragma unroll
                for (int bj = 0; bj < 2; ++bj) { f32x4 v0 = acc[ai][bj][m][0] * sc[ai][m], v1 = acc[ai][bj][m][1] * sc[ai][m];
                    if (mode != 0) {
#pragma unroll
                        for (int i = 0; i < 4; ++i) { v0[i] = act(v0[i], mode); v1[i] = act(v1[i], mode); } }
                    u32x4 w; w.x = cvt_pk_bf16(v0[0], v0[1]); w.y = cvt_pk_bf16(v0[2], v0[3]); w.z = cvt_pk_bf16(v1[0], v1[1]); w.w = cvt_pk_bf16(v1[2], v1[3]);
                    *(u32x4*)(rowp + bj * HALF) = w; } }
    }
};
struct EpiRes {
    static constexpr bool PERM = false;
    const float* base; float* C; int ldc;
    __device__ __forceinline__ void operator()(const f32x4 (&acc)[2][2][4][2], const Unit& u, int wr, int wc, int fr, int fq) const {
        const int row0 = u.pm * BM + wr * 64 + fr, col0 = u.pn * BM + wc * 32 + 4 * fq;
#pragma unroll
        for (int ai = 0; ai < 2; ++ai)
#pragma unroll
            for (int m = 0; m < 4; ++m) { const size_t off = (size_t)(row0 + ai * HALF + m * 16) * ldc + col0;
#pragma unroll
                for (int bj = 0; bj < 2; ++bj)
#pragma unroll
                    for (int n = 0; n < 2; ++n) *(f32x4*)(C + off + bj * HALF + n * 16) = *(const f32x4*)(base + off + bj * HALF + n * 16) + acc[ai][bj][m][n]; }
    }
};
template <bool OUT8>
struct EpiUp {
    static constexpr bool PERM = true;
    void* ACT; const float* b_up; const float* rsx; float wsc;
    __device__ __forceinline__ void operator()(const f32x4 (&acc)[2][2][4][2], const Unit& u, int wr, int wc, int fr, int fq) const {
        const int r0 = wr * 64 + fr, row0 = u.pm * BM + r0, j0 = wc * 32 + 8 * fq;
        const float* bg = b_up + (size_t)u.e * 2048 + u.pn * 128 + j0;
        const float* rp = rsx + (size_t)u.e * 65536 + u.rt * 256;
        f32x4 bgl[2], bln[2]; float sc[2][4];
#pragma unroll
        for (int n = 0; n < 2; ++n) { bgl[n] = *(const f32x4*)(bg + 4 * n); bln[n] = *(const f32x4*)(bg + 1024 + 4 * n); }
#pragma unroll
        for (int ai = 0; ai < 2; ++ai)
#pragma unroll
            for (int m = 0; m < 4; ++m) { const int r = r0 + ai * HALF + m * 16; sc[ai][m] = rp[r < u.nrows ? r : 0] * wsc; }
#pragma unroll
        for (int ai = 0; ai < 2; ++ai)
#pragma unroll
            for (int m = 0; m < 4; ++m) { const size_t eoff = (size_t)(row0 + ai * HALF + m * 16) * 1024 + u.pn * 128 + j0;
                float o[8];
#pragma unroll
                for (int n = 0; n < 2; ++n) { const f32x4 g = acc[ai][0][m][n] * sc[ai][m] + bgl[n], l = acc[ai][1][m][n] * sc[ai][m] + bln[n];
#pragma unroll
                    for (int i = 0; i < 4; ++i) { const float gl = fminf(g[i], 7.0f), ln = fminf(fmaxf(l[i], -7.0f), 7.0f);
                        o[n * 4 + i] = gl * __builtin_amdgcn_rcpf(1.0f + __builtin_amdgcn_exp2f(-2.4554669595930157f * gl)) * (ln + 1.0f); } }
                if (OUT8) { u32x2 w; w.x = pk4_fp8(o[0], o[1], o[2], o[3]); w.y = pk4_fp8(o[4], o[5], o[6], o[7]); *(u32x2*)((char*)ACT + eoff) = w; }
                else { u32x4 w; w.x = cvt_pk_bf16(o[0], o[1]); w.y = cvt_pk_bf16(o[2], o[3]); w.z = cvt_pk_bf16(o[4], o[5]); w.w = cvt_pk_bf16(o[6], o[7]); *(u32x4*)((char*)ACT + 2 * eoff) = w; } }
    }
};
struct EpiDown {
    static constexpr bool PERM = true;
    bf16_t* Y; const float* b_dn; const float* gatex; const int* tokidx; float wsc;
    __device__ __forceinline__ void operator()(const f32x4 (&acc)[2][2][4][2], const Unit& u, int wr, int wc, int fr, int fq) const {
        const int r0 = wr * 64 + fr, col0 = u.pn * BM + wc * 32 + 8 * fq;
        const int* tl = tokidx + (size_t)u.e * 65536 + u.rt * 256; const float* gl = gatex + (size_t)u.e * 65536 + u.rt * 256;
        const float* bb = b_dn + (size_t)u.e * 1024 + col0;
        f32x4 bv[2][2]; int idx[2][4]; float gt[2][4];
#pragma unroll
        for (int ai = 0; ai < 2; ++ai)
#pragma unroll
            for (int m = 0; m < 4; ++m) { const int r = r0 + ai * HALF + m * 16, rr = r < u.nrows ? r : 0; idx[ai][m] = tl[rr]; gt[ai][m] = gl[rr]; }
#pragma unroll
        for (int bj = 0; bj < 2; ++bj)
#pragma unroll
            for (int n = 0; n < 2; ++n) bv[bj][n] = *(const f32x4*)(bb + bj * HALF + 4 * n);
#pragma unroll
        for (int ai = 0; ai < 2; ++ai)
#pragma unroll
            for (int m = 0; m < 4; ++m) { const int r = r0 + ai * HALF + m * 16;
                if (r < u.nrows) { bf16_t* rowp = Y + (size_t)idx[ai][m] * 1024 + col0; const float g1 = gt[ai][m];
#pragma unroll
                    for (int bj = 0; bj < 2; ++bj) { const f32x4 v0 = (acc[ai][bj][m][0] * wsc + bv[bj][0]) * g1, v1 = (acc[ai][bj][m][1] * wsc + bv[bj][1]) * g1;
                        u32x4 w; w.x = cvt_pk_bf16(v0[0], v0[1]); w.y = cvt_pk_bf16(v0[2], v0[3]); w.z = cvt_pk_bf16(v1[0], v1[1]); w.w = cvt_pk_bf16(v1[2], v1[3]);
                        *(u32x4*)(rowp + bj * HALF) = w; } } }
    }
};

#ifndef FP8_SCALE
#define FP8_SCALE 0
#endif
template <class Epi, class Sched, class Ops, bool GATHER, bool ALIGN_EPI, bool FP8 = false>
__device__ __forceinline__ void gemm_phase(PG8_LAS unsigned char* lds, const int K, const Sched& S, const Ops& O, const Epi& E) {
    const int tid = threadIdx.x, wid = __builtin_amdgcn_readfirstlane(tid >> 6), lane = tid & 63, wr = wid >> 2, wc = wid & 3, fr = lane & 15, fq = lane >> 4;
    const int nt = K / BK;
    unsigned voffA[2], voffB[2]; int sR[2], sC[2];
#pragma unroll
    for (int i = 0; i < 2; ++i) { int R, C; stage_rc(tid * 16 + i * 8192, R, C); const int Rb = Epi::PERM ? ((R & ~31) + perm32(R & 31)) : R; sR[i] = R; sC[i] = C;
        voffA[i] = (unsigned)(R * K + C) * 2u; voffB[i] = (unsigned)(Rb * K + C) * 2u; }
    const size_t kstep = (size_t)(BK * 2);
    const size_t hstep = (size_t)HALF * K * 2;
    const unsigned ldsw = (unsigned)wid * 1024u;
    const int aoff = lds_byte(wr * 64 + fr, fq * 8), boff = lds_byte(wc * 32 + fr, fq * 8);
#define PG8_SA(b, h) (((b) * 2 + (h)) * HTB)
#define PG8_SB(b, h) ((4 + (b) * 2 + (h)) * HTB)
#define PG8_STAGE(bufoff, gbase, voff) do { _Pragma("unroll") for (int _i = 0; _i < 2; ++_i) \
        __builtin_amdgcn_global_load_lds((const unsigned*)((const char*)(gbase) + (voff)[_i]), (PG8_LAS unsigned*)(lds + (bufoff) + ldsw + _i * 8192), 16, 0, 0); } while (0)
#define PG8_STAGE_AC(bufoff, kptr, h) do { if constexpr (GATHER) PG8_STAGE(bufoff, kptr, vC[h]); else PG8_STAGE(bufoff, (kptr) + (h) * hstep, voffA); } while (0)
#define PG8_STAGE_AS(bufoff, kptr, h) do { if constexpr (GATHER) PG8_STAGE(bufoff, kptr, vS[h]); else PG8_STAGE(bufoff, (kptr) + (h) * hstep, voffA); } while (0)
#define PG8_LDA(dst, b, h) do { _Pragma("unroll") for (int m = 0; m < 4; ++m) _Pragma("unroll") for (int k = 0; k < 2; ++k) dst[m][k] = *(const PG8_LAS bf16x8*)(lds + PG8_SA(b, h) + aoff + m * 2048 + k * 1024); } while (0)
#define PG8_LDB(dst, b, h) do { _Pragma("unroll") for (int n = 0; n < 2; ++n) _Pragma("unroll") for (int k = 0; k < 2; ++k) dst[n][k] = *(const PG8_LAS bf16x8*)(lds + PG8_SB(b, h) + boff + n * 2048 + k * 1024); } while (0)
#define PG8_CAT8(x) __builtin_shufflevector(__builtin_bit_cast(i32x4, (x)[0]), __builtin_bit_cast(i32x4, (x)[1]), 0, 1, 2, 3, 4, 5, 6, 7)
#define PG8_MMA(ai, bj, At, Bt) do { __builtin_amdgcn_s_setprio(1); \
        if constexpr (FP8) { _Pragma("unroll") for (int m = 0; m < 4; ++m) _Pragma("unroll") for (int n = 0; n < 2; ++n) \
            asm volatile("v_mfma_f32_16x16x128_f8f6f4 %0, %1, %2, %0" : "+v"(acc[ai][bj][m][n]) : "v"(PG8_CAT8(Bt[n])), "v"(PG8_CAT8(At[m]))); } \
        else { _Pragma("unroll") for (int m = 0; m < 4; ++m) _Pragma("unroll") for (int n = 0; n < 2; ++n) _Pragma("unroll") for (int k = 0; k < 2; ++k) \
            acc[ai][bj][m][n] = __builtin_amdgcn_mfma_f32_16x16x32_bf16(Bt[n][k], At[m][k], acc[ai][bj][m][n], 0, 0, 0); } \
        __builtin_amdgcn_s_setprio(0); } while (0)
#define PG8_WAIT_V(n) asm volatile("s_waitcnt vmcnt(" #n ")" ::: "memory")
#define PG8_WAIT_L(n) asm volatile("s_waitcnt lgkmcnt(" #n ")" ::: "memory")
#define PG8_BAR __builtin_amdgcn_s_barrier()
#define PG8_SCHED __builtin_amdgcn_sched_barrier(0)
    Unit cur, nxt; int ui = 0;
    if (!S.next(0, cur)) return;
    f32x4 acc[2][2][4][2];
#pragma unroll
    for (int a = 0; a < 2; ++a)
#pragma unroll
        for (int b = 0; b < 2; ++b)
#pragma unroll
            for (int m = 0; m < 4; ++m)
#pragma unroll
                for (int n = 0; n < 2; ++n) acc[a][b][m][n] = (f32x4){0.f, 0.f, 0.f, 0.f};
    bf16x8 At[4][2], B0[2][2], B1[2][2];
    unsigned vC[2][2] = {{0u, 0u}, {0u, 0u}}, vN[2][2] = {{0u, 0u}, {0u, 0u}}, vS[2][2] = {{0u, 0u}, {0u, 0u}};
    if constexpr (GATHER) O.gather(cur, sR, sC, vC);
    const char* cA = O.a_base(cur); const char* cB = O.b_base(cur);
    PG8_STAGE(PG8_SB(0, 0), cB, voffB); PG8_STAGE(PG8_SB(0, 1), cB + hstep, voffB); PG8_STAGE_AC(PG8_SA(0, 0), cA, 0); PG8_STAGE_AC(PG8_SA(0, 1), cA, 1);
    if (wr == 1) PG8_BAR;
    PG8_WAIT_V(2); PG8_BAR;
    PG8_STAGE(PG8_SB(1, 0), cB + kstep, voffB); PG8_STAGE_AC(PG8_SA(1, 0), cA + kstep, 0); PG8_STAGE(PG8_SB(1, 1), cB + hstep + kstep, voffB);
    PG8_WAIT_V(6); PG8_BAR;
    for (;;) {
        const bool has_next = S.next(ui + 1, nxt);
        const char* nA = has_next ? O.a_base(nxt) : cA; const char* nB = has_next ? O.b_base(nxt) : cB;
        if constexpr (GATHER) { if (has_next) O.gather(nxt, sR, sC, vN); else {
#pragma unroll
            for (int h = 0; h < 2; ++h)
#pragma unroll
                for (int i = 0; i < 2; ++i) vN[h][i] = vC[h][i]; } }
#pragma unroll 1
        for (int t = 0; t < nt; t += 2) {
            const bool last = (t == nt - 2);
            const char* a1 = cA + (size_t)(t + 1) * kstep;
            const char* a2 = last ? nA : cA + (size_t)(t + 2) * kstep; const char* b2 = last ? nB : cB + (size_t)(t + 2) * kstep;
            const char* a3 = a2 + kstep; const char* b3 = b2 + kstep;
            if constexpr (GATHER) {
#pragma unroll
                for (int h = 0; h < 2; ++h)
#pragma unroll
                    for (int i = 0; i < 2; ++i) vS[h][i] = last ? vN[h][i] : vC[h][i]; }
            PG8_LDB(B0, 0, 0); PG8_LDB(B1, 0, 1); PG8_SCHED; PG8_LDA(At, 0, 0); PG8_STAGE_AC(PG8_SA(1, 1), a1, 1);
            PG8_WAIT_V(8); PG8_WAIT_L(0); PG8_BAR; PG8_MMA(0, 0, At, B0); PG8_MMA(0, 1, At, B1); PG8_BAR; PG8_SCHED;
            PG8_LDA(At, 0, 1); PG8_STAGE(PG8_SB(0, 0), b2, voffB); PG8_STAGE(PG8_SB(0, 1), b2 + hstep, voffB); PG8_STAGE_AS(PG8_SA(0, 0), a2, 0);
            PG8_WAIT_V(8); PG8_WAIT_L(0); PG8_BAR; PG8_MMA(1, 0, At, B0); PG8_MMA(1, 1, At, B1); PG8_BAR; PG8_SCHED;
            PG8_LDB(B0, 1, 0); PG8_LDB(B1, 1, 1); PG8_SCHED; PG8_LDA(At, 1, 0); PG8_STAGE_AS(PG8_SA(0, 1), a2, 1);
            PG8_WAIT_V(8); PG8_WAIT_L(0); PG8_BAR; PG8_MMA(0, 0, At, B0); PG8_MMA(0, 1, At, B1); PG8_BAR; PG8_SCHED;
            PG8_LDA(At, 1, 1); PG8_STAGE(PG8_SB(1, 0), b3, voffB); PG8_STAGE(PG8_SB(1, 1), b3 + hstep, voffB); PG8_STAGE_AS(PG8_SA(1, 0), a3, 0);
            PG8_WAIT_V(8); PG8_WAIT_L(0); PG8_BAR; PG8_MMA(1, 0, At, B0); PG8_MMA(1, 1, At, B1); PG8_BAR; PG8_SCHED;
        }
        if constexpr (ALIGN_EPI) { if (wr == 0) PG8_BAR; }
        if constexpr (FP8) asm volatile("s_nop 15\n\ts_nop 3" ::: "memory");
        { int fr_e = fr, fq_e = fq; asm volatile("" : "+v"(fr_e), "+v"(fq_e));
          E(acc, cur, wr, wc, fr_e, fq_e); }
        if (!has_next) break;
#pragma unroll
        for (int a = 0; a < 2; ++a)
#pragma unroll
            for (int b = 0; b < 2; ++b)
#pragma unroll
                for (int m = 0; m < 4; ++m)
#pragma unroll
                    for (int n = 0; n < 2; ++n) acc[a][b][m][n] = (f32x4){0.f, 0.f, 0.f, 0.f};
        cur = nxt; cA = nA; cB = nB; ++ui;
        if constexpr (GATHER) {
#pragma unroll
            for (int h = 0; h < 2; ++h)
#pragma unroll
                for (int i = 0; i < 2; ++i) vC[h][i] = vN[h][i]; }
        if constexpr (ALIGN_EPI) { if (wr == 1) PG8_BAR; }
    }
    PG8_WAIT_V(0);
    if constexpr (!ALIGN_EPI) { if (wr == 0) PG8_BAR; }
    PG8_BAR;
#undef PG8_SA
#undef PG8_SB
#undef PG8_STAGE
#undef PG8_STAGE_AC
#undef PG8_STAGE_AS
#undef PG8_LDA
#undef PG8_LDB
#undef PG8_MMA
#undef PG8_CAT8
#undef PG8_WAIT_V
#undef PG8_WAIT_L
#undef PG8_BAR
#undef PG8_SCHED
}
}
#define GAS __attribute__((address_space(1)))
#define LAS __attribute__((address_space(3)))
typedef unsigned short bf16;
typedef short bf16x8 __attribute__((ext_vector_type(8)));
typedef short s16x4 __attribute__((ext_vector_type(4)));
typedef float f32x4 __attribute__((ext_vector_type(4)));
typedef unsigned u32x4 __attribute__((ext_vector_type(4)));
typedef unsigned u32x2 __attribute__((ext_vector_type(2)));
typedef LAS unsigned char* lptr;

constexpr int NWAVES = 8, NTHR = 512;
#ifndef MOE_FP8
#define MOE_FP8 1
#endif
constexpr int MOE_ESZ = MOE_FP8 ? 1 : 2;
constexpr size_t MiB = 1u << 20;
constexpr size_t WS_CTL = 0, CTL_ZERO_BYTES = 64 * 1024;
constexpr size_t WS_SMALL = 1 * MiB;
constexpr size_t WS_GATES = 2 * MiB;
constexpr size_t WS_RSG = 2 * MiB + 512 * 1024;
constexpr size_t WS_RS1 = 2 * MiB + 768 * 1024;
constexpr size_t WS_GATE = 3 * MiB;
constexpr size_t WS_TOKIDX = 4 * MiB;
constexpr size_t WS_GATEX = 760 * MiB, WS_RSX = 768 * MiB;
constexpr size_t WS_KC = 776 * MiB;
constexpr size_t WS_WRT = 12 * MiB;
constexpr size_t WS_WINT = 16 * MiB, WS_WOUTT = 22 * MiB, WS_WDNT = 24 * MiB, WS_WUPT = 88 * MiB;
constexpr size_t WS_XN = 216 * MiB;
constexpr size_t WS_PROJ = 248 * MiB;
constexpr size_t WS_CLOC = 344 * MiB;
constexpr size_t WS_CPREV = 376 * MiB;
constexpr size_t WS_MIX = 392 * MiB;
constexpr size_t WS_H = 424 * MiB;
constexpr size_t WS_ACT = 488 * MiB;
constexpr size_t WS_Y = 632 * MiB;
constexpr size_t WS_OPT_END = 760 * MiB;
constexpr int CW_CNT = 64;
constexpr int CW_BAR = 4096;
constexpr int PROJ_LD = 3072;
constexpr int QO = 0, KO = 512, VO = 1024, OO = 1536, UO = 2048, VGO = 2560;
constexpr int RING_BYTES = 131072, VEC_OFF = 131072, VEC_BYTES = 16384, CTL_OFF = VEC_OFF + VEC_BYTES, TTAB_OFF = CTL_OFF, MISC_OFF = CTL_OFF + 2048, LDS_BYTES = MISC_OFF + 256;
constexpr int T0 = 0, T1 = 32768, T2 = 65536, T3 = 98304;

#define RLX_AGENT __ATOMIC_RELAXED, __HIP_MEMORY_SCOPE_AGENT
#define XB_TMO      128
#define XB_XCNT(j)  (256  + 64 * (j))
#define XB_XSUB(j)  (1280 + 64 * (j))
#define XB_XGEN(j)  (2304 + 64 * (j))
#define XB_TOP      3328
#define XB_TOPGEN   3392
#define XCD_BAR_WORDS 3456
#define XB_SPIN_CAP (1u << 18)
__device__ __forceinline__ unsigned xb_ld(unsigned* p)              { return __hip_atomic_load(p, __ATOMIC_RELAXED, __HIP_MEMORY_SCOPE_AGENT); }
__device__ __forceinline__ unsigned xb_add(unsigned* p, unsigned v) { return __hip_atomic_fetch_add(p, v, __ATOMIC_RELAXED, __HIP_MEMORY_SCOPE_AGENT); }
__device__ __forceinline__ unsigned xb_xcc_id() { return (unsigned)__builtin_amdgcn_s_getreg((3 << 11) | 20) & 0xFu; }
#define XB_SPIN(cond, bar) do { unsigned _sp = 0; while (cond) { __builtin_amdgcn_s_sleep(1); \
    if ((++_sp & 255u) == 0u) { if (xb_ld(&(bar)[XB_TMO])) break; if (_sp > XB_SPIN_CAP) { atomicAdd(&(bar)[XB_TMO], 1u); break; } } } } while (0)
struct XcdBarrier { unsigned* bar; unsigned x; volatile LAS unsigned* st; };
__device__ __forceinline__ XcdBarrier xcd_barrier_post(unsigned* bar, volatile LAS unsigned* st) {
    XcdBarrier b; b.bar = bar; b.x = xb_xcc_id(); b.st = st;
    if (threadIdx.x == 0) (void)xb_add(&bar[XB_XCNT(b.x)], 1u);
    return b;
}
__device__ __forceinline__ void xcd_barrier_complete(unsigned* bar, unsigned x, unsigned& nloc, unsigned& nx) {
    const unsigned G = gridDim.x * gridDim.y * gridDim.z;
    unsigned sum, cnt, mine, sp = 0u;
    for (;;) {
        sum = 0u; cnt = 0u; mine = 0u;
#pragma unroll
        for (unsigned j = 0; j < 16; ++j) { const unsigned c = xb_ld(&bar[XB_XCNT(j)]); sum += c; cnt += (c > 0u) ? 1u : 0u; mine = (j == x) ? c : mine; }
        if (sum == G) break;
        __builtin_amdgcn_s_sleep(1);
        if ((++sp & 255u) == 0u) { if (xb_ld(&bar[XB_TMO])) break; if (sp > XB_SPIN_CAP) { atomicAdd(&bar[XB_TMO], 1u); break; } }
    }
    nloc = mine > 0u ? mine : 1u; nx = cnt > 0u ? cnt : 1u;
}
__device__ __forceinline__ void xcd_barrier(const XcdBarrier& b) {
    asm volatile("s_waitcnt vmcnt(0)" ::: "memory");
    __syncthreads();
    if (threadIdx.x == 0) {
        unsigned* bar = b.bar;
        __builtin_amdgcn_s_waitcnt(0);
        unsigned nloc = b.st[0], nx = b.st[1];
        if (nloc == 0u) { xcd_barrier_complete(bar, b.x, nloc, nx); b.st[0] = nloc; b.st[1] = nx; }
        const unsigned old = xb_add(&bar[XB_XSUB(b.x)], 1u);
        const unsigned gen = old / nloc;
        if (old + 1u == (gen + 1u) * nloc) {
            __builtin_amdgcn_fence(__ATOMIC_RELEASE, "agent");
            asm volatile("s_waitcnt vmcnt(0)" ::: "memory");
            const unsigned og = xb_add(&bar[XB_TOP], 1u);
            const unsigned tg = og / nx;
            if (og + 1u == (tg + 1u) * nx) xb_add(&bar[XB_TOPGEN], 1u);
            else XB_SPIN(xb_ld(&bar[XB_TOPGEN]) == tg, bar);
            __builtin_amdgcn_fence(__ATOMIC_ACQUIRE, "agent");
            xb_add(&bar[XB_XGEN(b.x)], 1u);
            asm volatile("s_waitcnt vmcnt(0)" ::: "memory");
        } else {
            XB_SPIN(xb_ld(&bar[XB_XGEN(b.x)]) == gen, bar);
            __builtin_amdgcn_fence(__ATOMIC_ACQUIRE, "agent");
            asm volatile("s_waitcnt vmcnt(0)" ::: "memory");
        }
    }
    __syncthreads();
}

__device__ __forceinline__ float bf2f(unsigned short h) { return __builtin_bit_cast(float, (unsigned)h << 16); }
__device__ __forceinline__ unsigned f2bf(float f) { unsigned u = __builtin_bit_cast(unsigned, f); return (u + 0x7fffu + ((u >> 16) & 1u)) >> 16; }
__device__ __forceinline__ unsigned pk2(float lo, float hi) { return pg8::cvt_pk_bf16(lo, hi); }
__device__ __forceinline__ float fexp(float x) { return __builtin_amdgcn_exp2f(x * 1.4426950408889634f); }
__device__ __forceinline__ float fsigmoid(float x) { return __builtin_amdgcn_rcpf(1.0f + fexp(-x)); }
__device__ __forceinline__ float fgelu(float x) {
    const float u = 1.5957691216057308f * (x + 0.044715f * x * x * x);
    return x * fsigmoid(u);
}
__device__ __forceinline__ float wsum_all(float v) {
#pragma unroll
    for (int o = 32; o > 0; o >>= 1) v += __shfl_xor(v, o);
    return v;
}
__device__ __forceinline__ void unpack8(const u32x4 w, float (&f)[8]) {
    f[0] = __builtin_bit_cast(float, w.x << 16); f[1] = __builtin_bit_cast(float, w.x & 0xffff0000u);
    f[2] = __builtin_bit_cast(float, w.y << 16); f[3] = __builtin_bit_cast(float, w.y & 0xffff0000u);
    f[4] = __builtin_bit_cast(float, w.z << 16); f[5] = __builtin_bit_cast(float, w.z & 0xffff0000u);
    f[6] = __builtin_bit_cast(float, w.w << 16); f[7] = __builtin_bit_cast(float, w.w & 0xffff0000u);
}
__device__ __forceinline__ u32x4 pack8(const float (&f)[8]) { u32x4 w; w.x = pk2(f[0], f[1]); w.y = pk2(f[2], f[3]); w.z = pk2(f[4], f[5]); w.w = pk2(f[6], f[7]); return w; }

__device__ __forceinline__ unsigned off_b(unsigned row, unsigned ch) { return 256u * row + 16u * (ch ^ (((row & 3u) << 2) | ((row >> 2) & 3u))); }
__device__ __forceinline__ bf16x8 frag_row(lptr T, int r0, int ks, int lane) { return *(const LAS bf16x8*)(T + off_b((unsigned)(r0 + (lane & 15)), (unsigned)(4 * ks + (lane >> 4)))); }
__device__ __forceinline__ bf16x8 frag_tr(lptr T, int c, int ks, int lane) {
    const unsigned g = lane >> 4, q = (lane & 15) >> 2, p = lane & 3;
    const unsigned a0 = off_b(32u * ks + 8u * g + q, 2u * c + (p >> 1)) + 8u * (p & 1);
    const unsigned a1 = off_b(32u * ks + 8u * g + 4u + q, 2u * c + (p >> 1)) + 8u * (p & 1);
    const s16x4 lo = __builtin_amdgcn_ds_read_tr16_b64_v4i16((LAS s16x4*)(T + a0));
    const s16x4 hi = __builtin_amdgcn_ds_read_tr16_b64_v4i16((LAS s16x4*)(T + a1));
    return __builtin_shufflevector(lo, hi, 0, 1, 2, 3, 4, 5, 6, 7);
}
#define MFMA16(a, b, c) __builtin_amdgcn_mfma_f32_16x16x32_bf16(a, b, c, 0, 0, 0)

#ifndef PROBE_SEC
#define PROBE_SEC -1
#endif
#define SEC_BEGIN(F, id) do { if (PROBE_SEC == (id)) { __syncthreads(); (F).t0 = __builtin_amdgcn_s_memrealtime(); } } while (0)
#define SEC_END(F, id) do { if (PROBE_SEC == (id)) { __syncthreads(); (F).tsec += __builtin_amdgcn_s_memrealtime() - (F).t0; } } while (0)
struct Frame {
    unsigned long long t0, tsec;
    lptr lds; int tid, lane, wave, G, vcu;
    const float* in[20]; float* out; unsigned char* ws;
};

template <bool SCALE>
__device__ __forceinline__ void stage_tile(const Frame& F, lptr T, const bf16* src, int ld, const LAS float* rowscale) {
    const int cg = F.tid & 15, sb = F.tid >> 4;
    u32x4 w[4];
#pragma unroll
    for (int r = 0; r < 4; ++r) w[r] = *(const u32x4*)(src + (size_t)(4 * sb + r) * ld + 8 * cg);
#pragma unroll
    for (int r = 0; r < 4; ++r) { const int s = 4 * sb + r;
        if (SCALE) { float f[8]; unpack8(w[r], f); const float sc = rowscale[s];
#pragma unroll
            for (int i = 0; i < 8; ++i) f[i] *= sc;
            w[r] = pack8(f); }
        *(LAS u32x4*)(T + off_b(s, cg)) = w[r]; }
}
__device__ __forceinline__ void stage_conv(const Frame& F, lptr T, const bf16* src, const LAS float* cw, int tpos, float scale, u32x4 (&out)[4]) {
    const int cg = F.tid & 15, sb = F.tid >> 4;
    u32x4 w[7];
#pragma unroll
    for (int j = 0; j < 7; ++j) { const int s = 4 * sb - 3 + j; w[j] = (tpos + s >= 0) ? *(const u32x4*)(src + (ptrdiff_t)s * PROJ_LD + 8 * cg) : (u32x4){0u, 0u, 0u, 0u}; }
#pragma unroll
    for (int hf = 0; hf < 2; ++hf) {
        f32x4 tp4[4];
#pragma unroll
        for (int tp = 0; tp < 4; ++tp) tp4[tp] = *(const LAS f32x4*)(cw + tp * 128 + 8 * cg + 4 * hf);
        float a[4][4];
#pragma unroll
        for (int r = 0; r < 4; ++r)
#pragma unroll
            for (int i = 0; i < 4; ++i) a[r][i] = 0.f;
#pragma unroll
        for (int j = 0; j < 7; ++j) { const unsigned u0 = hf ? w[j].z : w[j].x, u1 = hf ? w[j].w : w[j].y;
            const float f[4] = {__builtin_bit_cast(float, u0 << 16), __builtin_bit_cast(float, u0 & 0xffff0000u), __builtin_bit_cast(float, u1 << 16), __builtin_bit_cast(float, u1 & 0xffff0000u)};
#pragma unroll
            for (int r = 0; r < 4; ++r) { const int tp = j - r; if (tp >= 0 && tp < 4) {
#pragma unroll
                for (int i = 0; i < 4; ++i) a[r][i] += tp4[tp][i] * f[i]; } } }
#pragma unroll
        for (int r = 0; r < 4; ++r) {
#pragma unroll
            for (int i = 0; i < 4; ++i) a[r][i] = a[r][i] * fsigmoid(a[r][i]) * scale;
            const unsigned p0 = pk2(a[r][0], a[r][1]), p1 = pk2(a[r][2], a[r][3]);
            if (hf == 0) { out[r].x = p0; out[r].y = p1; } else { out[r].z = p0; out[r].w = p1; } }
        __builtin_amdgcn_sched_barrier(0);
    }
#pragma unroll
    for (int r = 0; r < 4; ++r) *(LAS u32x4*)(T + off_b(4 * sb + r, cg)) = out[r];
}
__device__ __forceinline__ void p0_item(const float* Wsrc, int ld, bf16* dst, int Kd, LAS float* scr, int lane) {
#pragma unroll 8
    for (int i = 0; i < 32; ++i) { const int kk = 2 * i + (lane >> 5); scr[kk * 33 + (lane & 31)] = Wsrc[(size_t)kk * ld + (lane & 31)]; }
    asm volatile("s_waitcnt lgkmcnt(0)" ::: "memory");
    const int c = lane & 7;
#pragma unroll
    for (int j = 0; j < 4; ++j) { const int n = (lane >> 3) + 8 * j; const LAS float* s = scr + (8 * c) * 33 + n;
        u32x4 o; o.x = pk2(s[0 * 33], s[1 * 33]); o.y = pk2(s[2 * 33], s[3 * 33]); o.z = pk2(s[4 * 33], s[5 * 33]); o.w = pk2(s[6 * 33], s[7 * 33]);
        *(u32x4*)(dst + (size_t)n * Kd + 8 * c) = o; }
    asm volatile("s_waitcnt lgkmcnt(0)" ::: "memory");
}
__device__ __forceinline__ void p0_item_split(const float* Wsrc, int ld, bf16* dhi, bf16* dlo, int Kd, LAS float* scr, int lane) {
#pragma unroll 8
    for (int i = 0; i < 32; ++i) { const int kk = 2 * i + (lane >> 5); scr[kk * 33 + (lane & 31)] = Wsrc[(size_t)kk * ld + (lane & 31)]; }
    asm volatile("s_waitcnt lgkmcnt(0)" ::: "memory");
    const int c = lane & 7;
#pragma unroll
    for (int j = 0; j < 4; ++j) { const int n = (lane >> 3) + 8 * j; const LAS float* s = scr + (8 * c) * 33 + n;
        float v[8], l[8];
#pragma unroll
        for (int i = 0; i < 8; ++i) { v[i] = s[i * 33]; l[i] = v[i] - bf2f((unsigned short)f2bf(v[i])); }
        *(u32x4*)(dhi + (size_t)n * Kd + 8 * c) = pack8(v); *(u32x4*)(dlo + (size_t)n * Kd + 8 * c) = pack8(l); }
    asm volatile("s_waitcnt lgkmcnt(0)" ::: "memory");
}

struct P0Item { const float* src; char* dst; int ld; int esz; };
constexpr float W8_SCALE = 64.0f;
__device__ __forceinline__ void p0_load(const P0Item& it, int lane, f32x4 (&v)[8]) {
    const float* p = it.src + (size_t)(8 * (lane & 7)) * it.ld + 4 * (lane >> 3);
#pragma unroll
    for (int j = 0; j < 8; ++j) v[j] = __builtin_nontemporal_load((const f32x4*)(p + (size_t)j * it.ld));
}
__device__ __forceinline__ void p0_store(const P0Item& it, int lane, const f32x4 (&v)[8]) {
    const size_t eo = (size_t)(4 * (lane >> 3)) * 1024 + 8 * (lane & 7);
    if (it.esz == 2) { char* q = it.dst + 2 * eo;
#pragma unroll
        for (int i = 0; i < 4; ++i) { u32x4 o; o.x = pk2(v[0][i], v[1][i]); o.y = pk2(v[2][i], v[3][i]); o.z = pk2(v[4][i], v[5][i]); o.w = pk2(v[6][i], v[7][i]);
            *(u32x4*)(q + (size_t)i * 2048) = o; } }
    else { char* q = it.dst + eo;
#pragma unroll
        for (int i = 0; i < 4; ++i) { u32x2 o; o.x = pg8::pk4_fp8(v[0][i] * W8_SCALE, v[1][i] * W8_SCALE, v[2][i] * W8_SCALE, v[3][i] * W8_SCALE);
            o.y = pg8::pk4_fp8(v[4][i] * W8_SCALE, v[5][i] * W8_SCALE, v[6][i] * W8_SCALE, v[7][i] * W8_SCALE);
            *(u32x2*)(q + (size_t)i * 1024) = o; } }
}
constexpr int IMG_ROW = 2064;
template <int NF, bool OUT8>
__device__ __forceinline__ float row_pass(const float* X, const float* gain, void* XNout, lptr img_hi, lptr img_lo, int tok0, int lane, f32x4 (&acc)[NF]) {
    const int r = lane & 15, g = lane >> 4;
    const float* xr = X + (size_t)(tok0 + r) * 1024 + 8 * g;
    float ss = 0.f;
#pragma unroll
    for (int nf = 0; nf < NF; ++nf) acc[nf] = (f32x4){0.f, 0.f, 0.f, 0.f};
    char* orow = (char*)XNout + ((size_t)(tok0 + r) * 1024 + 8 * g) * (OUT8 ? 1 : 2);
#pragma unroll 16
    for (int ks = 0; ks < 32; ++ks) { const f32x4 a = __builtin_nontemporal_load((const f32x4*)(xr + 32 * ks)), b = __builtin_nontemporal_load((const f32x4*)(xr + 32 * ks + 4));
        ss += (a[0] * a[0] + a[1] * a[1]) + (a[2] * a[2] + a[3] * a[3]) + (b[0] * b[0] + b[1] * b[1]) + (b[2] * b[2] + b[3] * b[3]);
        const f32x4 ga = *(const f32x4*)(gain + 32 * ks + 8 * g), gb = *(const f32x4*)(gain + 32 * ks + 8 * g + 4);
        float v[8], l[8];
#pragma unroll
        for (int i = 0; i < 4; ++i) { v[i] = a[i] * ga[i]; v[4 + i] = b[i] * gb[i]; }
        const u32x4 hi = pack8(v);
        { float h[8]; unpack8(hi, h);
#pragma unroll
          for (int i = 0; i < 8; ++i) l[i] = v[i] - h[i]; }
        const u32x4 lo = pack8(l);
        if (OUT8) { u32x2 o8; o8.x = pg8::pk4_fp8(v[0], v[1], v[2], v[3]); o8.y = pg8::pk4_fp8(v[4], v[5], v[6], v[7]); *(u32x2*)(orow + 32 * ks) = o8; }
        else *(u32x4*)(orow + 64 * ks) = hi;
        const bf16x8 ahi = __builtin_bit_cast(bf16x8, hi), alo = __builtin_bit_cast(bf16x8, lo);
#pragma unroll
        for (int nf = 0; nf < NF; ++nf) { const unsigned bo = (unsigned)(16 * nf + (lane & 15)) * IMG_ROW + 64u * ks + 16u * g;
            const bf16x8 bhi = *(const LAS bf16x8*)(img_hi + bo), blo = *(const LAS bf16x8*)(img_lo + bo);
            acc[nf] = MFMA16(ahi, bhi, acc[nf]); acc[nf] = MFMA16(ahi, blo, acc[nf]); acc[nf] = MFMA16(alo, bhi, acc[nf]); } }
    ss += __shfl_xor(ss, 16); ss += __shfl_xor(ss, 32);
    return 1.0f / sqrtf(ss * (1.0f / 1024.0f) + 1e-6f);
}

__device__ __forceinline__ void phase0(Frame& F) {
    const float* x = F.in[0]; const float* g1 = F.in[1]; const float* w_in = F.in[2]; const float* b_i = F.in[4]; const float* b_f = F.in[5];
    const float* w_out = F.in[11]; const float* wr = F.in[13]; const float* w_up = F.in[15]; const float* w_dn = F.in[17];
    bf16* WinT = (bf16*)(F.ws + WS_WINT); bf16* WoutT = (bf16*)(F.ws + WS_WOUTT); bf16* WdnT = (bf16*)(F.ws + WS_WDNT); bf16* WupT = (bf16*)(F.ws + WS_WUPT);
    bf16* WrThi = (bf16*)(F.ws + WS_WRT); bf16* WrTlo = WrThi + 32 * 1024;
    bf16* XN = (bf16*)(F.ws + WS_XN); float* GATES = (float*)(F.ws + WS_GATES); float* RS1 = (float*)(F.ws + WS_RS1);
    lptr ghi = F.lds + T0, glo = F.lds + T0 + 16 * IMG_ROW;
    SEC_BEGIN(F, 1);
#pragma unroll
    for (int q = 0; q < 2; ++q) { const int kk = F.tid + NTHR * q; const f32x4 a = *(const f32x4*)(w_in + (size_t)kk * 3080 + 2048), b = *(const f32x4*)(w_in + (size_t)kk * 3080 + 2052);
        const float v[8] = {a[0], a[1], a[2], a[3], b[0], b[1], b[2], b[3]};
#pragma unroll
        for (int j = 0; j < 8; ++j) { const unsigned h = f2bf(v[j]); const float l = v[j] - bf2f((unsigned short)h);
            *(LAS unsigned short*)(ghi + j * IMG_ROW + 2 * kk) = (unsigned short)h; *(LAS unsigned short*)(glo + j * IMG_ROW + 2 * kk) = (unsigned short)f2bf(l); } }
    __syncthreads();
    SEC_END(F, 1); SEC_BEGIN(F, 2);
    if (F.wave < 4) { const int tok0 = F.vcu * 64 + F.wave * 16; f32x4 acc[1];
      const float rstd = row_pass<1, false>(x, g1, XN, ghi, glo, tok0, F.lane, acc);
      if (F.lane < 16) RS1[tok0 + F.lane] = rstd;
      const int j = F.lane & 15, gq = F.lane >> 4;
      float rr[4];
#pragma unroll
      for (int rg = 0; rg < 4; ++rg) rr[rg] = __shfl(rstd, 4 * gq + rg);
      if (j < 8) {
#pragma unroll
          for (int rg = 0; rg < 4; ++rg) { const int tok = tok0 + 4 * gq + rg; float v = acc[0][rg] * rr[rg];
              if (j < 4) v += b_i[j]; else { v += b_f[j - 4]; v = fminf(v, 0.f) - log1pf(expf(-fabsf(v))); }
              GATES[(size_t)tok * 8 + j] = v; } } }
    SEC_END(F, 2); SEC_BEGIN(F, 3);
    const float* b_unused = nullptr; (void)b_unused;
    const int gw = F.vcu * NWAVES + F.wave, NGW = F.G * NWAVES;
    if (F.vcu < 4 && F.wave >= 4) { const int ri = F.vcu * 4 + F.wave - 4; LAS float* scr = (LAS float*)(F.lds + 66560 + (F.wave - 4) * 8448);
        p0_item_split(wr + (size_t)(64 * ri) * 32, 32, WrThi + 64 * ri, WrTlo + 64 * ri, 1024, scr, F.lane); }
    constexpr int I_IN = 16 * 96, I_OUT = 16 * 32, I_DN = 32 * 16 * 32, I_UP = 32 * 16 * 64, NITEMS = I_IN + I_OUT + I_DN + I_UP;
    auto decode = [&](int it) -> P0Item {
        int r = it; P0Item o;
        if (r < I_IN) { const int kb = r / 96, nb = r % 96, nd = 32 * nb, nsrc = nd < 2048 ? nd : nd + 8;
            o.src = w_in + (size_t)(64 * kb) * 3080 + nsrc; o.ld = 3080; o.esz = 2; o.dst = (char*)(WinT + (size_t)nd * 1024 + 64 * kb); return o; } r -= I_IN;
        if (r < I_OUT) { const int kb = r / 32, nb = r % 32;
            o.src = w_out + (size_t)(64 * kb) * 1024 + 32 * nb; o.ld = 1024; o.esz = 2; o.dst = (char*)(WoutT + (size_t)(32 * nb) * 1024 + 64 * kb); return o; } r -= I_OUT;
        if (r < I_DN) { const int e = r / 512, q = r % 512, kb = q / 32, nb = q % 32;
            o.src = w_dn + ((size_t)e * 1024 + 64 * kb) * 1024 + 32 * nb; o.ld = 1024; o.esz = MOE_ESZ; o.dst = (char*)WdnT + (((size_t)e * 1024 + 32 * nb) * 1024 + 64 * kb) * MOE_ESZ; return o; } r -= I_DN;
        { const int e = r / 1024, q = r % 1024, kb = q / 64, nb = q % 64, n = 32 * nb, half = n >> 10, jj = n & 1023, pn = jj >> 7, j = jj & 127, nd = 256 * pn + 128 * half + j;
          o.src = w_up + ((size_t)e * 1024 + 64 * kb) * 2048 + n; o.ld = 2048; o.esz = MOE_ESZ; o.dst = (char*)WupT + (((size_t)e * 2048 + nd) * 1024 + 64 * kb) * MOE_ESZ; return o; }
    };
    constexpr int PER_WAVE = NITEMS / (256 * NWAVES), SHIFT = 4;
    static_assert(NITEMS % (256 * NWAVES) == 0 && SHIFT % 2 == 0, "item split");
    const int nown = F.wave < 4 ? PER_WAVE - SHIFT : PER_WAVE + SHIFT;
    for (int j = 0; j < nown; j += 2) {
        const bool two = j + 1 < nown;
        const int j0 = j, j1 = two ? j + 1 : j;
        const int ita = (j0 < PER_WAVE) ? gw + j0 * NGW : (gw - 4) + (j0 - SHIFT) * NGW;
        const int itb = (j1 < PER_WAVE) ? gw + j1 * NGW : (gw - 4) + (j1 - SHIFT) * NGW;
        const P0Item ia = decode(ita), ib = decode(itb);
        f32x4 va[8], vb[8];
        p0_load(ia, F.lane, va); p0_load(ib, F.lane, vb);
        p0_store(ia, F.lane, va); if (two) p0_store(ib, F.lane, vb);
    }
    SEC_END(F, 3);
}

__device__ __forceinline__ float wscan_add(float v, int lane) {
#pragma unroll
    for (int o = 1; o < 64; o <<= 1) { const float t = __shfl_up(v, o); if (lane >= o) v += t; }
    return v;
}
__device__ __forceinline__ float wscan_max(float v, int lane) {
#pragma unroll
    for (int o = 1; o < 64; o <<= 1) { const float t = __shfl_up(v, o); if (lane >= o) v = fmaxf(v, t); }
    return v;
}
__device__ __forceinline__ float wmax_all(float v) {
#pragma unroll
    for (int o = 32; o > 0; o >>= 1) v = fmaxf(v, __shfl_xor(v, o));
    return v;
}

__device__ __forceinline__ void mlstm_local_unit(Frame& F0, int u) {
    Frame F = F0; asm volatile("" : "+v"(F.tid), "+v"(F.lane));
    const int c = u & 63, h = (u >> 6) & 3, b = u >> 8, row0 = b * 8192 + c * 128;
    const bf16* PROJ = (const bf16*)(F.ws + WS_PROJ); const float* GATES = (const float*)(F.ws + WS_GATES); const float* conv = F.in[3];
    float* CLOC = (float*)(F.ws + WS_CLOC); float* MLOC = (float*)(F.ws + WS_SMALL); float* BLAST = MLOC + 512; float* NLOC = MLOC + 2048; bf16* KC = (bf16*)(F.ws + WS_KC);
    LAS float* wv = (LAS float*)(F.lds + VEC_OFF);
    LAS float* cw = wv + 128;
    LAS float* part = cw + 512;
    const int lane = F.lane, w = F.wave;
    SEC_BEGIN(F, 10);
#pragma unroll
    for (int j = 0; j < 8; ++j) { const int i = lane + 64 * j; cw[i] = conv[(i >> 7) * 1024 + 512 + h * 128 + (i & 127)]; }
    { const int l = lane, s0 = 2 * l, s1 = s0 + 1;
        const float li0 = GATES[(size_t)(row0 + s0) * 8 + h], li1 = GATES[(size_t)(row0 + s1) * 8 + h], lf0 = GATES[(size_t)(row0 + s0) * 8 + 4 + h], lf1 = GATES[(size_t)(row0 + s1) * 8 + 4 + h];
        const float inc = wscan_add(lf0 + lf1, l), b1 = inc, b0 = inc - lf1, blast = __shfl(inc, 63);
        const float g0 = blast - b0 + li0, g1 = blast - b1 + li1, mloc = wmax_all(fmaxf(g0, g1));
        wv[s0] = fexp(g0 - mloc); wv[s1] = fexp(g1 - mloc);
        if (l == 0 && w == 0) { MLOC[u] = mloc; BLAST[u] = blast; } }
    SEC_END(F, 10); SEC_BEGIN(F, 11);
    { u32x4 kv[4]; const int cg = F.tid & 15, sb = F.tid >> 4;
      stage_conv(F, F.lds + T1, PROJ + (size_t)row0 * PROJ_LD + KO + h * 128, cw, c * 128, 0.08838834764831845f, kv);
      float pn[8];
#pragma unroll
      for (int i = 0; i < 8; ++i) pn[i] = 0.f;
#pragma unroll
      for (int r = 0; r < 4; ++r) { *(u32x4*)(KC + (size_t)(row0 + 4 * sb + r) * 512 + h * 128 + 8 * cg) = kv[r];
          float f[8]; unpack8(kv[r], f); const float ws = wv[4 * sb + r];
#pragma unroll
          for (int i = 0; i < 8; ++i) pn[i] += ws * f[i]; }
#pragma unroll
      for (int i = 0; i < 8; ++i) { pn[i] += __shfl_xor(pn[i], 16); pn[i] += __shfl_xor(pn[i], 32); }
      if (lane < 16) { *(LAS f32x4*)(part + w * 128 + 8 * cg) = (f32x4){pn[0], pn[1], pn[2], pn[3]}; *(LAS f32x4*)(part + w * 128 + 8 * cg + 4) = (f32x4){pn[4], pn[5], pn[6], pn[7]}; } }
    stage_tile<true>(F, F.lds + T2, PROJ + (size_t)row0 * PROJ_LD + VO + h * 128, PROJ_LD, wv);
    __syncthreads();
    SEC_END(F, 11); SEC_BEGIN(F, 12);
    { f32x4 acc[8];
#pragma unroll
      for (int kb = 0; kb < 8; ++kb) acc[kb] = (f32x4){0.f, 0.f, 0.f, 0.f};
#pragma unroll
      for (int ks = 0; ks < 4; ++ks) { const bf16x8 a = frag_tr(F.lds + T2, w, ks, lane);
#pragma unroll
          for (int kb = 0; kb < 8; ++kb) { const bf16x8 bb = frag_tr(F.lds + T1, kb, ks, lane); acc[kb] = MFMA16(a, bb, acc[kb]); } }
      float* cl = CLOC + (size_t)u * 16384 + (size_t)(16 * w + 4 * (lane >> 4)) * 128 + (lane & 15);
#pragma unroll
      for (int kb = 0; kb < 8; ++kb)
#pragma unroll
          for (int rg = 0; rg < 4; ++rg) cl[rg * 128 + 16 * kb] = acc[kb][rg]; }
    if (F.tid < 128) { float a = 0.f;
#pragma unroll
        for (int ww = 0; ww < 8; ++ww) a += part[ww * 128 + F.tid];
        NLOC[(size_t)u * 128 + F.tid] = a; }
    __syncthreads();
    SEC_END(F, 12);
    F0.tsec = F.tsec;
}

__device__ __forceinline__ void gmlp_unit(Frame& F0, int ug) {
    Frame F = F0; asm volatile("" : "+v"(F.tid), "+v"(F.lane));
    const int g = ug & 3, row0 = (ug >> 2) * 128;
    const bf16* PROJ = (const bf16*)(F.ws + WS_PROJ); bf16* MIX = (bf16*)(F.ws + WS_MIX);
    const float* lng = F.in[7]; const float* wsp = F.in[8]; const float* bsp = F.in[9]; const float* og = F.in[10]; float* PSSQ = (float*)(F.ws + WS_RSG);
    LAS float* st_mean = (LAS float*)(F.lds + VEC_OFF); LAS float* st_rstd = st_mean + 128;
    const int w = F.wave, lane = F.lane;
    SEC_BEGIN(F, 20);
    { const int t = F.tid >> 2, q = F.tid & 3; const bf16* vp = PROJ + (size_t)(row0 + t) * PROJ_LD + VGO + 128 * q;
      float s = 0.f, s2 = 0.f;
#pragma unroll 8
      for (int j = 0; j < 16; ++j) { float f[8]; unpack8(*(const u32x4*)(vp + 8 * j), f);
#pragma unroll
          for (int i = 0; i < 8; ++i) { s += f[i]; s2 += f[i] * f[i]; } }
      s += __shfl_xor(s, 1); s += __shfl_xor(s, 2); s2 += __shfl_xor(s2, 1); s2 += __shfl_xor(s2, 2);
      const float mean = s * (1.0f / 512.0f), var = fmaxf(s2 * (1.0f / 512.0f) - mean * mean, 0.f);
      if (q == 0) { st_mean[t] = mean; st_rstd[t] = 1.0f / sqrtf(var + 1e-6f); } }
    __syncthreads();
    SEC_END(F, 20); SEC_BEGIN(F, 21);
    { const int cg = F.tid & 15, sb = F.tid >> 4;
      const f32x4 l0 = *(const f32x4*)(lng + g * 128 + 8 * cg), l1 = *(const f32x4*)(lng + g * 128 + 8 * cg + 4);
      u32x4 vv[4], uu[4]; f32x4 wa[4], wb[4];
#pragma unroll
      for (int r = 0; r < 4; ++r) { const int t = 4 * sb + r;
          vv[r] = *(const u32x4*)(PROJ + (size_t)(row0 + t) * PROJ_LD + VGO + g * 128 + 8 * cg); uu[r] = *(const u32x4*)(PROJ + (size_t)(row0 + t) * PROJ_LD + UO + g * 128 + 8 * cg);
          const float* wp = wsp + ((size_t)(g * 128 + t)) * 128 + 8 * cg; wa[r] = *(const f32x4*)wp; wb[r] = *(const f32x4*)(wp + 4); }
#pragma unroll
      for (int r = 0; r < 4; ++r) { const int t = 4 * sb + r;
          float f[8] = {wa[r][0], wa[r][1], wa[r][2], wa[r][3], wb[r][0], wb[r][1], wb[r][2], wb[r][3]};
#pragma unroll
          for (int kk = 0; kk < 8; ++kk) if (8 * cg + kk > t) f[kk] = 0.f;
          *(LAS u32x4*)(F.lds + T0 + off_b(t, cg)) = pack8(f);
          float v[8]; unpack8(vv[r], v); const float mean = st_mean[t], rstd = st_rstd[t];
#pragma unroll
          for (int kk = 0; kk < 8; ++kk) v[kk] = (v[kk] - mean) * rstd * (kk < 4 ? l0[kk] : l1[kk - 4]);
          *(LAS u32x4*)(F.lds + T1 + off_b(t, cg)) = pack8(v);
          *(LAS u32x4*)(F.lds + T2 + off_b(t, cg)) = uu[r]; } }
    __syncthreads();
    SEC_END(F, 21); SEC_BEGIN(F, 22);
    f32x4 acc[8];
#pragma unroll
    for (int db = 0; db < 8; ++db) acc[db] = (f32x4){0.f, 0.f, 0.f, 0.f};
    for (int ks = 0; ks <= (w >> 1); ++ks) { const bf16x8 a = frag_row(F.lds + T0, 16 * w, ks, lane);
#pragma unroll
        for (int db = 0; db < 8; ++db) { const bf16x8 bb = frag_tr(F.lds + T1, db, ks, lane); acc[db] = MFMA16(a, bb, acc[db]); } }
    float ssq[4] = {0.f, 0.f, 0.f, 0.f}; float ogv[8];
#pragma unroll
    for (int db = 0; db < 8; ++db) ogv[db] = og[g * 128 + 16 * db + (lane & 15)];
#pragma unroll
    for (int rg = 0; rg < 4; ++rg) { int t = 16 * w + 4 * (lane >> 4) + rg; const float bs = bsp[g * 128 + t]; asm volatile("" : "+v"(t));
#pragma unroll
        for (int db = 0; db < 8; ++db) { const int d = 16 * db + (lane & 15);
            const float gu = bf2f(*(const LAS unsigned short*)(F.lds + T2 + off_b(t, d >> 3) + 2 * (d & 7)));
            const float val = (acc[db][rg] + bs) * gu; ssq[rg] += val * val;
            *(LAS unsigned short*)(F.lds + T3 + off_b(t, d >> 3) + 2 * (d & 7)) = (unsigned short)(pk2(val * ogv[db], 0.f) & 0xffffu); } }
#pragma unroll
    for (int i = 0; i < 4; ++i) { const int id = lane + 64 * i, r = id >> 4, ch = id & 15, t = 16 * w + r;
        *(u32x4*)(MIX + (size_t)(row0 + t) * 1024 + 512 + g * 128 + 8 * ch) = *(const LAS u32x4*)(F.lds + T3 + off_b(t, ch)); }
#pragma unroll
    for (int rg = 0; rg < 4; ++rg) { float q = ssq[rg]; q += __shfl_xor(q, 1); q += __shfl_xor(q, 2); q += __shfl_xor(q, 4); q += __shfl_xor(q, 8);
        if ((lane & 15) == 0) PSSQ[(size_t)g * 16384 + row0 + 16 * w + 4 * (lane >> 4) + rg] = q; }
    __syncthreads();
    SEC_END(F, 22);
    F0.tsec = F.tsec;
}

__device__ __forceinline__ void phase_scan(const Frame& F) {
    const float* CLOC = (const float*)(F.ws + WS_CLOC); float* MLOC = (float*)(F.ws + WS_SMALL); float* BLAST = MLOC + 512; float* MPREV = MLOC + 1024;
    float* NLOC = MLOC + 2048; float* NPREV = NLOC + 512 * 128; bf16* CPREV = (bf16*)(F.ws + WS_CPREV);
    LAS float* av = (LAS float*)(F.lds + VEC_OFF); LAS float* cv = av + 64;
    const int wg = F.vcu, bh = wg >> 5;
    if (F.wave == 0) { const int l = F.lane; const float ml = MLOC[bh * 64 + l], bl = BLAST[bh * 64 + l];
        float m = 0.f, mym = 0.f, mynext = 0.f;
        for (int c = 0; c < 64; ++c) { const float mlc = __shfl(ml, c), blc = __shfl(bl, c); const float mn = fmaxf(blc + m, mlc); if (l == c) { mym = m; mynext = mn; } m = mn; }
        av[l] = fexp(bl + mym - mynext); cv[l] = fexp(ml - mynext);
        if ((wg & 31) == 0) MPREV[bh * 64 + l] = mym; }
    __syncthreads();
    if (F.tid < 256) { const int p = (wg & 31) * 256 + F.tid; float v0 = 0.f, v1 = 0.f;
        const float* src = CLOC + (size_t)(bh * 64) * 16384 + 2 * p; bf16* dst = CPREV + (size_t)(bh * 64) * 16384 + 2 * p;
#pragma unroll 8
        for (int c = 0; c < 64; ++c) { const float2 x = *(const float2*)(src + (size_t)c * 16384);
            *(unsigned*)(dst + (size_t)c * 16384) = pk2(v0, v1);
            const float a = av[c], cc = cv[c]; v0 = a * v0 + cc * x.x; v1 = a * v1 + cc * x.y; } }
    else if (F.tid < 320 && (wg & 31) == 0) { const int p = F.tid - 256; float v0 = 0.f, v1 = 0.f;
        for (int c = 0; c < 64; ++c) { const float2 x = *(const float2*)(NLOC + (size_t)(bh * 64 + c) * 128 + 2 * p);
            *(float2*)(NPREV + (size_t)(bh * 64 + c) * 128 + 2 * p) = make_float2(v0, v1);
            const float a = av[c], cc = cv[c]; v0 = a * v0 + cc * x.x; v1 = a * v1 + cc * x.y; } }
    __syncthreads();
}

__device__ __forceinline__ void mlstm_out_unit(Frame& F0, int u) {
    Frame F = F0; asm volatile("" : "+v"(F.tid), "+v"(F.lane));
    const int c = u & 63, h = (u >> 6) & 3, b = u >> 8, row0 = b * 8192 + c * 128;
    const bf16* PROJ = (const bf16*)(F.ws + WS_PROJ); const float* GATES = (const float*)(F.ws + WS_GATES); const float* conv = F.in[3]; const float* ngain = F.in[6];
    const float* MPREV = (const float*)(F.ws + WS_SMALL) + 1024; const float* NPREV = (const float*)(F.ws + WS_SMALL) + 2048 + 512 * 128;
    const bf16* CPREV = (const bf16*)(F.ws + WS_CPREV); bf16* MIX = (bf16*)(F.ws + WS_MIX);
    LAS float* colc = (LAS float*)(F.lds + VEC_OFF); LAS float* rowc = colc + 128; LAS float* inter = rowc + 128; LAS float* emn = inter + 128; LAS float* rdn = emn + 128;
    LAS float* npv = rdn + 128; LAS float* cw = npv + 128;
    const int w = F.wave, lane = F.lane;
    SEC_BEGIN(F, 30);
#pragma unroll
    for (int j = 0; j < 8; ++j) { const int i = lane + 64 * j; cw[i] = conv[(i >> 7) * 1024 + h * 128 + (i & 127)]; }
    npv[lane] = NPREV[(size_t)u * 128 + lane]; npv[64 + lane] = NPREV[(size_t)u * 128 + 64 + lane];
    { const int l = lane, s0 = 2 * l, s1 = s0 + 1;
        const float li0 = GATES[(size_t)(row0 + s0) * 8 + h], li1 = GATES[(size_t)(row0 + s1) * 8 + h], lf0 = GATES[(size_t)(row0 + s0) * 8 + 4 + h], lf1 = GATES[(size_t)(row0 + s1) * 8 + 4 + h];
        const float inc = wscan_add(lf0 + lf1, l), b1 = inc, b0 = inc - lf1;
        const float c0 = li0 - b0, c1 = li1 - b1;
        const float pmx = wscan_max(fmaxf(c0, c1), l); float pprev = __shfl_up(pmx, 1); if (l == 0) pprev = -INFINITY;
        const float pm0 = fmaxf(pprev, c0), pm1 = pmx, mprev = MPREV[u];
        const float m0 = b0 + fmaxf(mprev, pm0), m1 = b1 + fmaxf(mprev, pm1);
        colc[s0] = c0; colc[s1] = c1; rowc[s0] = b0 - m0; rowc[s1] = b1 - m1;
        inter[s0] = fexp(b0 + mprev - m0); inter[s1] = fexp(b1 + mprev - m1); emn[s0] = fexp(-m0); emn[s1] = fexp(-m1); }
    SEC_END(F, 30); SEC_BEGIN(F, 31);
    { u32x4 qv[4]; stage_conv(F, F.lds + T0, PROJ + (size_t)row0 * PROJ_LD + QO + h * 128, cw, c * 128, 1.0f, qv); }
    stage_tile<false>(F, F.lds + T1, (const bf16*)(F.ws + WS_KC) + (size_t)row0 * 512 + h * 128, 512, nullptr);
    stage_tile<false>(F, F.lds + T2, PROJ + (size_t)row0 * PROJ_LD + VO + h * 128, PROJ_LD, nullptr);
    stage_tile<false>(F, F.lds + T3, CPREV + (size_t)u * 16384, 128, nullptr);
    __syncthreads();
    SEC_END(F, 31); SEC_BEGIN(F, 32);
    const int t = 16 * w + (lane & 15);
    u32x2 wpk[8]; float rsum = 0.f;
    { const float rc = rowc[t];
#pragma unroll
      for (int sb = 0; sb < 8; ++sb) { wpk[sb] = (u32x2){0u, 0u};
          if (sb <= w) { f32x4 a4 = (f32x4){0.f, 0.f, 0.f, 0.f};
#pragma unroll
              for (int ks = 0; ks < 4; ++ks) { const bf16x8 a = frag_row(F.lds + T1, 16 * sb, ks, lane), bb = frag_row(F.lds + T0, 16 * w, ks, lane); a4 = MFMA16(a, bb, a4); }
              float wv4[4];
#pragma unroll
              for (int rg = 0; rg < 4; ++rg) { const int s = 16 * sb + 4 * (lane >> 4) + rg; const float e = fexp(rc + colc[s]) * a4[rg]; wv4[rg] = (s <= t) ? e : 0.f; }
              wpk[sb].x = pk2(wv4[0], wv4[1]); wpk[sb].y = pk2(wv4[2], wv4[3]);
              rsum += bf2f((unsigned short)(wpk[sb].x & 0xffffu)) + bf2f((unsigned short)(wpk[sb].x >> 16)) + bf2f((unsigned short)(wpk[sb].y & 0xffffu)) + bf2f((unsigned short)(wpk[sb].y >> 16)); } } }
    __syncthreads();
    SEC_END(F, 32); SEC_BEGIN(F, 33);
    { int t2 = t; asm volatile("" : "+v"(t2));
#pragma unroll
    for (int sb = 0; sb < 8; ++sb) if (sb <= (w | 1)) *(LAS u32x2*)(F.lds + T1 + off_b(t2, 2 * sb + (lane >> 5)) + 8 * ((lane >> 4) & 1)) = wpk[sb]; }
    rsum += __shfl_xor(rsum, 16); rsum += __shfl_xor(rsum, 32);
    { float qn = 0.f; const int part = lane >> 4;
#pragma unroll
      for (int i = 0; i < 4; ++i) { float f[8]; unpack8(*(const LAS u32x4*)(F.lds + T0 + off_b(t, 4 * part + i)), f);
#pragma unroll
          for (int k = 0; k < 8; ++k) qn += f[k] * npv[32 * part + 8 * i + k]; }
      qn += __shfl_xor(qn, 16); qn += __shfl_xor(qn, 32);
      const float den = rsum + inter[t] * qn;
      if (lane < 16) rdn[t] = 1.0f / fmaxf(fabsf(den), emn[t]); }
    f32x4 acc[8];
#pragma unroll
    for (int vb = 0; vb < 8; ++vb) acc[vb] = (f32x4){0.f, 0.f, 0.f, 0.f};
#pragma unroll
    for (int ks = 0; ks < 4; ++ks) { const bf16x8 a = frag_row(F.lds + T0, 16 * w, ks, lane);
#pragma unroll
        for (int vb = 0; vb < 8; ++vb) { const bf16x8 bb = frag_row(F.lds + T3, 16 * vb, ks, lane); acc[vb] = MFMA16(a, bb, acc[vb]); } }
    float it4[4], rd4[4];
#pragma unroll
    for (int rg = 0; rg < 4; ++rg) { const int tr = 16 * w + 4 * (lane >> 4) + rg; it4[rg] = inter[tr]; rd4[rg] = rdn[tr]; }
#pragma unroll
    for (int vb = 0; vb < 8; ++vb)
#pragma unroll
        for (int rg = 0; rg < 4; ++rg) acc[vb][rg] *= it4[rg];
    for (int ks = 0; ks <= (w >> 1); ++ks) { const bf16x8 a = frag_row(F.lds + T1, 16 * w, ks, lane);
#pragma unroll
        for (int vb = 0; vb < 8; ++vb) { const bf16x8 bb = frag_tr(F.lds + T2, vb, ks, lane); acc[vb] = MFMA16(a, bb, acc[vb]); } }
    SEC_END(F, 33); SEC_BEGIN(F, 34);
#pragma unroll
    for (int rg = 0; rg < 4; ++rg) { float s = 0.f;
#pragma unroll
        for (int vb = 0; vb < 8; ++vb) { acc[vb][rg] *= rd4[rg]; s += acc[vb][rg]; }
        s += __shfl_xor(s, 1); s += __shfl_xor(s, 2); s += __shfl_xor(s, 4); s += __shfl_xor(s, 8);
        const float mean = s * (1.0f / 128.0f); float q = 0.f;
#pragma unroll
        for (int vb = 0; vb < 8; ++vb) { acc[vb][rg] -= mean; q += acc[vb][rg] * acc[vb][rg]; }
        q += __shfl_xor(q, 1); q += __shfl_xor(q, 2); q += __shfl_xor(q, 4); q += __shfl_xor(q, 8);
        const float rstd = 1.0f / sqrtf(q * (1.0f / 128.0f) + 1e-6f);
#pragma unroll
        for (int vb = 0; vb < 8; ++vb) acc[vb][rg] *= rstd; }
#pragma unroll
    for (int vb = 0; vb < 8; ++vb) { const int d = 16 * vb + (lane & 15); const float gg = ngain[h * 128 + d];
#pragma unroll
        for (int rg = 0; rg < 4; ++rg) { int tr = 16 * w + 4 * (lane >> 4) + rg; asm volatile("" : "+v"(tr));
            *(LAS unsigned short*)(F.lds + T1 + off_b(tr, d >> 3) + 2 * (d & 7)) = (unsigned short)(pk2(acc[vb][rg] * gg, 0.f) & 0xffffu); } }
#pragma unroll
    for (int i = 0; i < 4; ++i) { const int id = lane + 64 * i, r = id >> 4, ch = id & 15, tr = 16 * w + r;
        float y[8], o[8]; unpack8(*(const LAS u32x4*)(F.lds + T1 + off_b(tr, ch)), y);
        unpack8(*(const u32x4*)(PROJ + (size_t)(row0 + tr) * PROJ_LD + OO + h * 128 + 8 * ch), o);
#pragma unroll
        for (int k = 0; k < 8; ++k) y[k] *= o[k];
        *(u32x4*)(MIX + (size_t)(row0 + tr) * 1024 + h * 128 + 8 * ch) = pack8(y); }
    { const float* RSG = (const float*)(F.ws + WS_RSG);
#pragma unroll
      for (int i = 0; i < 4; ++i) { const int id = lane + 64 * i, r = id >> 4, ch = id & 15, tr = 16 * w + r;
          bf16* p = MIX + (size_t)(row0 + tr) * 1024 + 512 + h * 128 + 8 * ch; float y[8]; unpack8(*(const u32x4*)p, y);
          const float rs = 1.0f / sqrtf(((RSG[row0 + tr] + RSG[16384 + row0 + tr]) + (RSG[32768 + row0 + tr] + RSG[49152 + row0 + tr])) * (1.0f / 512.0f) + 1e-6f);
#pragma unroll
          for (int kk = 0; kk < 8; ++kk) y[kk] *= rs;
          *(u32x4*)p = pack8(y); } }
    __syncthreads();
    SEC_END(F, 34);
    F0.tsec = F.tsec;
}

__device__ __forceinline__ void phase_router(Frame& F) {
    const float* H = (const float*)(F.ws + WS_H); const float* g2 = F.in[12]; const float* br = F.in[14];
    const bf16* WrThi = (const bf16*)(F.ws + WS_WRT); const bf16* WrTlo = WrThi + 32 * 1024;
    bf16* HN = (bf16*)(F.ws + WS_XN); int* cnt = (int*)(F.ws + WS_CTL) + CW_CNT; int* tokidx = (int*)(F.ws + WS_TOKIDX); float* gatex = (float*)(F.ws + WS_GATEX); float* rsx = (float*)(F.ws + WS_RSX);
    lptr ihi = F.lds, ilo = F.lds + 32 * IMG_ROW;
    LAS float* lg = (LAS float*)(F.lds + 2 * 32 * IMG_ROW);
    LAS int* hist = (LAS int*)(lg + 2048); LAS int* base = hist + 32;
    SEC_BEGIN(F, 4);
    for (int i = F.tid; i < 32 * 128; i += NTHR) { const int n = i >> 7, ch = i & 127;
        *(LAS u32x4*)(ihi + n * IMG_ROW + 16 * ch) = *(const u32x4*)(WrThi + (size_t)n * 1024 + 8 * ch);
        *(LAS u32x4*)(ilo + n * IMG_ROW + 16 * ch) = *(const u32x4*)(WrTlo + (size_t)n * 1024 + 8 * ch); }
    if (F.tid < 32) hist[F.tid] = 0;
    __syncthreads();
    SEC_END(F, 4); SEC_BEGIN(F, 5);
    const int tok0 = F.vcu * 64 + (F.wave & 3) * 16, lane = F.lane;
    int be[4] = {0, 0, 0, 0}, lr[4] = {0, 0, 0, 0}; float gt[4] = {0.f, 0.f, 0.f, 0.f}; float rstd = 0.f;
    if (F.wave < 4) {
        f32x4 acc[2];
        rstd = row_pass<2, MOE_FP8 != 0>(H, g2, HN, ihi, ilo, tok0, lane, acc);
        { float rr[4];
#pragma unroll
          for (int rg = 0; rg < 4; ++rg) rr[rg] = __shfl(rstd, 4 * (lane >> 4) + rg);
#pragma unroll
          for (int nf = 0; nf < 2; ++nf)
#pragma unroll
              for (int rg = 0; rg < 4; ++rg) lg[(F.wave * 16 + 4 * (lane >> 4) + rg) * 32 + 16 * nf + (lane & 15)] = acc[nf][rg] * rr[rg]; }
        if (lane < 16) { float v[32];
#pragma unroll
            for (int q4 = 0; q4 < 8; ++q4) { const f32x4 x = *(const LAS f32x4*)(lg + (F.wave * 16 + lane) * 32 + 4 * q4), bb = *(const f32x4*)(br + 4 * q4);
                v[4 * q4] = x[0] + bb[0]; v[4 * q4 + 1] = x[1] + bb[1]; v[4 * q4 + 2] = x[2] + bb[2]; v[4 * q4 + 3] = x[3] + bb[3]; }
            float bv[4];
#pragma unroll
            for (int k = 0; k < 4; ++k) { float best = -INFINITY; int bi = 0;
#pragma unroll
                for (int e = 0; e < 32; ++e) if (v[e] > best) { best = v[e]; bi = e; }
                be[k] = bi; bv[k] = best;
#pragma unroll
                for (int e = 0; e < 32; ++e) v[e] = (e == bi) ? -INFINITY : v[e]; }
            float den = 0.f;
#pragma unroll
            for (int k = 0; k < 4; ++k) { gt[k] = fexp(bv[k] - bv[0]); den += gt[k]; }
            const float rd = 1.0f / den;
#pragma unroll
            for (int k = 0; k < 4; ++k) { gt[k] *= rd; lr[k] = __hip_atomic_fetch_add(hist + be[k], 1, __ATOMIC_RELAXED, __HIP_MEMORY_SCOPE_WORKGROUP); } } }
    SEC_END(F, 5); SEC_BEGIN(F, 6);
    __syncthreads();
    if (F.tid < 32) base[F.tid] = hist[F.tid] > 0 ? atomicAdd(&cnt[F.tid], hist[F.tid]) : 0;
    __syncthreads();
    if (F.wave < 4 && lane < 16) { const int tok = tok0 + lane;
#pragma unroll
        for (int k = 0; k < 4; ++k) { const int rk = base[be[k]] + lr[k]; const size_t p = (size_t)be[k] * 65536 + rk; tokidx[p] = tok * 4 + k; gatex[p] = gt[k]; rsx[p] = rstd; } }
    __syncthreads();
    SEC_END(F, 6);
}

__device__ __forceinline__ int build_ttab(const Frame& F) {
    const int* cnt = (const int*)(F.ws + WS_CTL) + CW_CNT; LAS unsigned* ttab = (LAS unsigned*)(F.lds + TTAB_OFF); LAS int* tot = (LAS int*)(F.lds + MISC_OFF + 64);
    if (F.wave == 0) { const int l = F.lane; const int c = l < 32 ? __hip_atomic_load(cnt + l, RLX_AGENT) : 0; const int nt = (c + 255) >> 8;
        int inc = nt;
#pragma unroll
        for (int o = 1; o < 64; o <<= 1) { const int tt = __shfl_up(inc, o); if (l >= o) inc += tt; }
        const int start = inc - nt;
        for (int r = 0; r < nt; ++r) { const int left = c - 256 * r; ttab[start + r] = (unsigned)l | ((unsigned)r << 5) | ((unsigned)((left < 256 ? left : 256) - 1) << 14); }
        if (l == 63) tot[0] = inc; }
    __syncthreads();
    return tot[0];
}

__device__ __forceinline__ void phase_final(const Frame& F) {
    const float* H = (const float*)(F.ws + WS_H); const bf16* Y = (const bf16*)(F.ws + WS_Y); const float* gf = F.in[19];
    const int gw = F.vcu * NWAVES + F.wave, lane = F.lane;
    f32x4 gg[4];
#pragma unroll
    for (int j = 0; j < 4; ++j) gg[j] = *(const f32x4*)(gf + 4 * (lane + 64 * j));
#pragma unroll 1
    for (int i = 0; i < 8; i += 2) { const int tok = gw * 8 + i;
        f32x4 v[2][4]; u32x2 y[2][4][4];
#pragma unroll
        for (int q = 0; q < 2; ++q)
#pragma unroll
            for (int j = 0; j < 4; ++j) { v[q][j] = __builtin_nontemporal_load((const f32x4*)(H + (size_t)(tok + q) * 1024 + 4 * (lane + 64 * j)));
#pragma unroll
                for (int k = 0; k < 4; ++k) y[q][j][k] = __builtin_nontemporal_load((const u32x2*)(Y + (size_t)((tok + q) * 4 + k) * 1024 + 4 * (lane + 64 * j))); }
#pragma unroll
        for (int q = 0; q < 2; ++q) { float s = 0.f;
#pragma unroll
            for (int j = 0; j < 4; ++j) {
#pragma unroll
                for (int k = 0; k < 4; ++k) { const u32x2 yy = y[q][j][k];
                    v[q][j][0] += __builtin_bit_cast(float, yy.x << 16); v[q][j][1] += __builtin_bit_cast(float, yy.x & 0xffff0000u);
                    v[q][j][2] += __builtin_bit_cast(float, yy.y << 16); v[q][j][3] += __builtin_bit_cast(float, yy.y & 0xffff0000u); }
                s += (v[q][j][0] * v[q][j][0] + v[q][j][1] * v[q][j][1]) + (v[q][j][2] * v[q][j][2] + v[q][j][3] * v[q][j][3]); }
            const float r = 1.0f / sqrtf(wsum_all(s) * (1.0f / 1024.0f) + 1e-6f);
#pragma unroll
            for (int j = 0; j < 4; ++j) __builtin_nontemporal_store(v[q][j] * r * gg[j], (f32x4*)(F.out + (size_t)(tok + q) * 1024 + 4 * (lane + 64 * j))); } }
}

constexpr int N_PHASES = 10;
struct Args { const float* in[20]; float* out; unsigned char* ws; int ph_lo, ph_hi; };
__global__ void __launch_bounds__(NTHR, 2) mk_fwd(Args args) {
    extern __shared__ __attribute__((aligned(16))) unsigned char lds_raw[];
    Frame F; F.t0 = 0ull; F.tsec = 0ull;
    F.lds = (lptr)lds_raw; F.tid = threadIdx.x; F.lane = F.tid & 63; F.wave = __builtin_amdgcn_readfirstlane(F.tid >> 6);
    F.G = gridDim.x; { const int bx = blockIdx.x; F.vcu = (F.G % 8 == 0) ? (bx % 8) * (F.G / 8) + bx / 8 : bx; }
#pragma unroll
    for (int i = 0; i < 20; ++i) F.in[i] = args.in[i];
    F.out = args.out; F.ws = args.ws;
    for (int u = F.tid; u < (LDS_BYTES - CTL_OFF) / 4; u += NTHR) ((LAS unsigned*)(F.lds + CTL_OFF))[u] = 0u;
    __syncthreads();
    XcdBarrier bar = xcd_barrier_post((unsigned*)(F.ws + WS_CTL) + CW_BAR, (volatile LAS unsigned*)(F.lds + MISC_OFF));
    const int lo = args.ph_lo, hi = args.ph_hi;
#define IN(k) (lo <= (k) && (k) < hi)
#ifndef PROBE_LO
#define PROBE_LO -1
#define PROBE_HI -1
#endif
    unsigned long long tp0 = 0ull;
#define SEAM(k) do { if (IN(k) && IN((k) + 1)) xcd_barrier(bar); \
        if (PROBE_HI == (k) + 1) { const unsigned long long tn = __builtin_amdgcn_s_memrealtime(), dt = tn - tp0; while (__builtin_amdgcn_s_memrealtime() - tn < dt) __builtin_amdgcn_s_sleep(8); __syncthreads(); } \
        if (PROBE_LO == (k) + 1) tp0 = __builtin_amdgcn_s_memrealtime(); } while (0)
    const int bx = blockIdx.x;
    if (PROBE_LO == 0) tp0 = __builtin_amdgcn_s_memrealtime();
    if (IN(0)) { phase0(F); } SEAM(0);
    if (IN(1)) { pg8::DenseOps ops{(const bf16*)(F.ws + WS_XN), (const bf16*)(F.ws + WS_WINT), 1024}; pg8::StaticOrder S; S.init(64, 12, F.G, bx, 4);
        pg8::EpiProj E{(bf16*)(F.ws + WS_PROJ), PROJ_LD, (const float*)(F.ws + WS_RS1)};
        pg8::gemm_phase<pg8::EpiProj, pg8::StaticOrder, pg8::DenseOps, false, true>(F.lds, 1024, S, ops, E); } SEAM(1);
    if (IN(2)) {
#pragma unroll 1
        for (int j = 0; j < 2; ++j) mlstm_local_unit(F, F.vcu * 2 + j);
#pragma unroll 1
        for (int j = 0; j < 2; ++j) gmlp_unit(F, F.vcu * 2 + j); } SEAM(2);
    if (IN(3)) { phase_scan(F); } SEAM(3);
    if (IN(4)) {
#pragma unroll 1
        for (int j = 0; j < 2; ++j) mlstm_out_unit(F, F.vcu * 2 + j); } SEAM(4);
    if (IN(5)) { pg8::DenseOps ops{(const bf16*)(F.ws + WS_MIX), (const bf16*)(F.ws + WS_WOUTT), 1024}; pg8::StaticOrder S; S.init(64, 4, F.G, bx);
        pg8::EpiRes E{F.in[0], (float*)(F.ws + WS_H), 1024};
        pg8::gemm_phase<pg8::EpiRes, pg8::StaticOrder, pg8::DenseOps, false, false>(F.lds, 1024, S, ops, E); } SEAM(5);
    if (IN(6)) { phase_router(F); } SEAM(6);
    if (IN(7)) { const int nM = build_ttab(F);
        pg8::UpOps ops{F.ws + WS_XN, F.ws + WS_WUPT, (const int*)(F.ws + WS_TOKIDX), 1024u * MOE_ESZ};
        pg8::MoeOrder S; S.init(nM, 8, F.G, bx, 4); S.ttab = (const LAS unsigned*)(F.lds + TTAB_OFF);
        pg8::EpiUp<MOE_FP8 != 0> E{F.ws + WS_ACT, F.in[16], (const float*)(F.ws + WS_RSX), MOE_FP8 ? 1.0f / W8_SCALE : 1.0f};
        pg8::gemm_phase<pg8::EpiUp<MOE_FP8 != 0>, pg8::MoeOrder, pg8::UpOps, true, true, MOE_FP8 != 0>(F.lds, 512 * MOE_ESZ, S, ops, E); } SEAM(7);
    if (IN(8)) { const int nM = build_ttab(F);
        pg8::DownOps ops{F.ws + WS_ACT, F.ws + WS_WDNT, 1024u * MOE_ESZ};
        pg8::MoeOrder S; S.init(nM, 4, F.G, bx); S.ttab = (const LAS unsigned*)(F.lds + TTAB_OFF);
        pg8::EpiDown E{(bf16*)(F.ws + WS_Y), F.in[18], (const float*)(F.ws + WS_GATEX), (const int*)(F.ws + WS_TOKIDX), MOE_FP8 ? 1.0f / W8_SCALE : 1.0f};
        pg8::gemm_phase<pg8::EpiDown, pg8::MoeOrder, pg8::DownOps, false, true, MOE_FP8 != 0>(F.lds, 512 * MOE_ESZ, S, ops, E); } SEAM(8);
    if (IN(9)) { phase_final(F); } SEAM(9);
    if (PROBE_SEC >= 0) { const unsigned long long tn = __builtin_amdgcn_s_memrealtime(); while (__builtin_amdgcn_s_memrealtime() - tn < F.tsec) __builtin_amdgcn_s_sleep(8); }
#undef IN
#undef SEAM
}

extern "C" void kernel_launch(void* const* d_in, const int* in_sizes, int n_in, void* d_out, int out_size, void* d_ws, size_t ws_size, hipStream_t stream) {
    static int ready = 0;
    if (!ready) {
        if (hipFuncSetAttribute((const void*)mk_fwd, hipFuncAttributeMaxDynamicSharedMemorySize, LDS_BYTES) != hipSuccess) { fprintf(stderr, "hipFuncSetAttribute failed\n"); return; }
        ready = 1;
    }
    char* ws = (char*)d_ws;
    if (ws_size < 800 * MiB) { fprintf(stderr, "ws too small: %zu\n", ws_size); return; }
    (void)hipMemsetAsync(ws + WS_CTL, 0, CTL_ZERO_BYTES, stream);
    Args a{};
    for (int i = 0; i < 20; ++i) a.in[i] = (const float*)d_in[i];
    a.out = (float*)d_out; a.ws = (unsigned char*)d_ws; a.ph_lo = 0; a.ph_hi = N_PHASES;
    hipLaunchKernelGGL(mk_fwd, dim3(256), dim3(NTHR), LDS_BYTES, stream, a);
}
```

```cpp
#include <hip/hip_runtime.h>
#include <cstdio>
#include <cstdint>
#include <cstddef>
#include <cmath>


namespace pg8 {
#define PG8_LAS __attribute__((address_space(3)))
typedef unsigned short bf16_t;
typedef short bf16x8 __attribute__((ext_vector_type(8)));
typedef float f32x4 __attribute__((ext_vector_type(4)));
typedef float f32x2 __attribute__((ext_vector_type(2)));
typedef unsigned u32x4 __attribute__((ext_vector_type(4)));
typedef unsigned u32x2 __attribute__((ext_vector_type(2)));
typedef int i32x4 __attribute__((ext_vector_type(4)));
typedef int i32x8 __attribute__((ext_vector_type(8)));
constexpr int BM = 256, BK = 64, HALF = 128, HTB = HALF * BK * 2, STAGE_BYTES = 8 * HTB, NXCD = 8, WGM = 8;

__host__ __device__ __forceinline__ int lds_byte(int r, int c) { const int st = (r >> 4) * 2 + (c >> 5), rr = r & 15, cc = c & 31, ob = rr * 64 + cc * 2; return st * 1024 + (ob ^ (((ob >> 9) & 1) << 5)); }
__host__ __device__ __forceinline__ void stage_rc(int b, int& R, int& C) { const int st = b / 1024, sb = b % 1024, swz = sb ^ (((sb >> 9) & 1) << 5); R = (st >> 1) * 16 + swz / 64; C = (st & 1) * 32 + (swz % 64) / 2; }
__host__ __device__ __forceinline__ int perm32(int rho) { const int n = rho >> 4, i = rho & 15; return 8 * (i >> 2) + 4 * n + (i & 3); }

struct Unit { int pm, pn, e, rt, nrows; };

struct StaticOrder {
    int nM, nN, nwg, G, c, wgm;
    __device__ void init(int nM_, int nN_, int G_, int c_, int wgm_ = WGM) { nM = nM_; nN = nN_; nwg = nM * nN; G = G_; c = c_; wgm = wgm_; }
    __device__ bool next(int i, Unit& u) const {
        const long L = (long)i * G + c; if (L >= nwg) return false;
        int wgid = (int)L; { const int q = nwg / NXCD, r = nwg % NXCD, xcd = wgid % NXCD, off = wgid / NXCD; wgid = (xcd < r ? xcd * (q + 1) : r * (q + 1) + (xcd - r) * q) + off; }
        const int nig = wgm * nN, gid = wgid / nig, fm = gid * wgm, gsz = (nM - fm) < wgm ? (nM - fm) : wgm;
        u.pm = fm + ((wgid % nig) % gsz); u.pn = (wgid % nig) / gsz; u.e = 0; u.rt = 0; u.nrows = 256; return true;
    }
};
struct MoeOrder : StaticOrder {
    const PG8_LAS unsigned* ttab;
    __device__ bool next(int i, Unit& u) const {
        if (!StaticOrder::next(i, u)) return false;
        const unsigned w = ttab[u.pm]; u.e = (int)(w & 31u); u.rt = (int)((w >> 5) & 511u); u.nrows = (int)((w >> 14) & 255u) + 1; return true;
    }
};

__device__ __forceinline__ unsigned cvt_pk_bf16(float lo, float hi) { unsigned r; asm volatile("v_cvt_pk_bf16_f32 %0, %1, %2" : "=v"(r) : "v"(lo), "v"(hi)); return r; }

struct DenseOps {
    const bf16_t* A; const bf16_t* Bt; int K;
    __device__ __forceinline__ const char* a_base(const Unit& u) const { return (const char*)A + (size_t)u.pm * BM * K * 2; }
    __device__ __forceinline__ const char* b_base(const Unit& u) const { return (const char*)Bt + (size_t)u.pn * BM * K * 2; }
    __device__ __forceinline__ void gather(const Unit&, const int (&)[2], const int (&)[2], unsigned (&)[2][2]) const {}
};
struct UpOps {
    const void* HN; const void* WupT; const int* tokidx; unsigned pitch;
    __device__ __forceinline__ const char* a_base(const Unit&) const { return (const char*)HN; }
    __device__ __forceinline__ const char* b_base(const Unit& u) const { return (const char*)WupT + ((size_t)u.e * 2048 + (size_t)u.pn * BM) * pitch; }
    __device__ __forceinline__ void gather(const Unit& u, const int (&R)[2], const int (&C)[2], unsigned (&v)[2][2]) const {
        const int* tl = tokidx + (size_t)u.e * 65536 + u.rt * 256;
#pragma unroll
        for (int h = 0; h < 2; ++h)
#pragma unroll
            for (int i = 0; i < 2; ++i) { const int r = R[i] + 128 * h; const int idx = tl[r < u.nrows ? r : 0]; v[h][i] = (unsigned)(idx >> 2) * pitch + (unsigned)C[i] * 2u; }
    }
};
struct DownOps {
    const void* ACT; const void* WdnT; unsigned pitch;
    __device__ __forceinline__ const char* a_base(const Unit& u) const { return (const char*)ACT + (size_t)u.pm * BM * pitch; }
    __device__ __forceinline__ const char* b_base(const Unit& u) const { return (const char*)WdnT + ((size_t)u.e * 1024 + (size_t)u.pn * BM) * pitch; }
    __device__ __forceinline__ void gather(const Unit&, const int (&)[2], const int (&)[2], unsigned (&)[2][2]) const {}
};
__device__ __forceinline__ unsigned pk4_fp8(float a, float b, float c, float d) { int r = __builtin_amdgcn_cvt_pk_fp8_f32(a, b, 0, false); r = __builtin_amdgcn_cvt_pk_fp8_f32(c, d, r, true); return (unsigned)r; }

struct EpiProj {
    static constexpr bool PERM = true;
    bf16_t* O; int ldc; const float* rs;
    static __device__ __forceinline__ float sigm(float x) { return __builtin_amdgcn_rcpf(1.0f + __builtin_amdgcn_exp2f(-1.4426950408889634f * x)); }
    static __device__ __forceinline__ float act(float x, int mode) {
        if (mode == 1) return sigm(x);
        if (mode == 2) return x * sigm(1.5957691216057308f * (x + 0.044715f * x * x * x));
        return x; }
    __device__ __forceinline__ void operator()(const f32x4 (&acc)[2][2][4][2], const Unit& u, int wr, int wc, int fr, int fq) const {
        const int row0 = u.pm * BM + wr * 64 + fr, col0 = u.pn * BM + wc * 32 + 8 * fq;
        const int mode = u.pn >= 8 ? 2 : (u.pn >= 6 ? 1 : 0);
        float sc[2][4];
#pragma unroll
        for (int ai = 0; ai < 2; ++ai)
#pragma unroll
            for (int m = 0; m < 4; ++m) sc[ai][m] = rs[row0 + ai * HALF + m * 16];
#pragma unroll
        for (int ai = 0; ai < 2; ++ai)
#pragma unroll
            for (int m = 0; m < 4; ++m) { bf16_t* rowp = O + (size_t)(row0 + ai * HALF + m * 16) * ldc + col0;
#pragma unroll
                for (int bj = 0; bj < 2; ++bj) { f32x4 v0 = acc[ai][bj][m][0] * sc[ai][m], v1 = acc[ai][bj][m][1] * sc[ai][m];
                    if (mode != 0) {
#pragma unroll
                        for (int i = 0; i < 4; ++i) { v0[i] = act(v0[i], mode); v1[i] = act(v1[i], mode); } }
                    u32x4 w; w.x = cvt_pk_bf16(v0[0], v0[1]); w.y = cvt_pk_bf16(v0[2], v0[3]); w.z = cvt_pk_bf16(v1[0], v1[1]); w.w = cvt_pk_bf16(v1[2], v1[3]);
                    *(u32x4*)(rowp + bj * HALF) = w; } }
    }
};
struct EpiRes {
    static constexpr bool PERM = false;
    const float* base; float* C; int ldc;
    __device__ __forceinline__ void operator()(const f32x4 (&acc)[2][2][4][2], const Unit& u, int wr, int wc, int fr, int fq) const {
        const int row0 = u.pm * BM + wr * 64 + fr, col0 = u.pn * BM + wc * 32 + 4 * fq;
#pragma unroll
        for (int ai = 0; ai < 2; ++ai)
#pragma unroll
            for (int m = 0; m < 4; ++m) { const size_t off = (size_t)(row0 + ai * HALF + m * 16) * ldc + col0;
#pragma unroll
                for (int bj = 0; bj < 2; ++bj)
#pragma unroll
                    for (int n = 0; n < 2; ++n) *(f32x4*)(C + off + bj * HALF + n * 16) = *(const f32x4*)(base + off + bj * HALF + n * 16) + acc[ai][bj][m][n]; }
    }
};
template <bool OUT8>
struct EpiUp {
    static constexpr bool PERM = true;
    void* ACT; const float* b_up; const float* rsx; float wsc;
    __device__ __forceinline__ void operator()(const f32x4 (&acc)[2][2][4][2], const Unit& u, int wr, int wc, int fr, int fq) const {
        const int r0 = wr * 64 + fr, row0 = u.pm * BM + r0, j0 = wc * 32 + 8 * fq;
        const float* bg = b_up + (size_t)u.e * 2048 + u.pn * 128 + j0;
        const float* rp = rsx + (size_t)u.e * 65536 + u.rt * 256;
        f32x4 bgl[2], bln[2]; float sc[2][4];
#pragma unroll
        for (int n = 0; n < 2; ++n) { bgl[n] = *(const f32x4*)(bg + 4 * n); bln[n] = *(const f32x4*)(bg + 1024 + 4 * n); }
#pragma unroll
        for (int ai = 0; ai < 2; ++ai)
#pragma unroll
            for (int m = 0; m < 4; ++m) { const int r = r0 + ai * HALF + m * 16; sc[ai][m] = rp[r < u.nrows ? r : 0] * wsc; }
#pragma unroll
        for (int ai = 0; ai < 2; ++ai)
#pragma unroll
            for (int m = 0; m < 4; ++m) { const size_t eoff = (size_t)(row0 + ai * HALF + m * 16) * 1024 + u.pn * 128 + j0;
                float o[8];
#pragma unroll
                for (int n = 0; n < 2; ++n) { const f32x4 g = acc[ai][0][m][n] * sc[ai][m] + bgl[n], l = acc[ai][1][m][n] * sc[ai][m] + bln[n];
#pragma unroll
                    for (int i = 0; i < 4; ++i) { const float gl = fminf(g[i], 7.0f), ln = fminf(fmaxf(l[i], -7.0f), 7.0f);
                        o[n * 4 + i] = gl * __builtin_amdgcn_rcpf(1.0f + __builtin_amdgcn_exp2f(-2.4554669595930157f * gl)) * (ln + 1.0f); } }
                if (OUT8) { u32x2 w; w.x = pk4_fp8(o[0], o[1], o[2], o[3]); w.y = pk4_fp8(o[4], o[5], o[6], o[7]); *(u32x2*)((char*)ACT + eoff) = w; }
                else { u32x4 w; w.x = cvt_pk_bf16(o[0], o[1]); w.y = cvt_pk_bf16(o[2], o[3]); w.z = cvt_pk_bf16(o[4], o[5]); w.w = cvt_pk_bf16(o[6], o[7]); *(u32x4*)((char*)ACT + 2 * eoff) = w; } }
    }
};
struct EpiDown {
    static constexpr bool PERM = true;
    bf16_t* Y; const float* b_dn; const float* gatex; const int* tokidx; float wsc;
    __device__ __forceinline__ void operator()(const f32x4 (&acc)[2][2][4][2], const Unit& u, int wr, int wc, int fr, int fq) const {
        const int r0 = wr * 64 + fr, col0 = u.pn * BM + wc * 32 + 8 * fq;
        const int* tl = tokidx + (size_t)u.e * 65536 + u.rt * 256; const float* gl = gatex + (size_t)u.e * 65536 + u.rt * 256;
        const float* bb = b_dn + (size_t)u.e * 1024 + col0;
        f32x4 bv[2][2]; int idx[2][4]; float gt[2][4];
#pragma unroll
        for (int ai = 0; ai < 2; ++ai)
#pragma unroll
            for (int m = 0; m < 4; ++m) { const int r = r0 + ai * HALF + m * 16, rr = r < u.nrows ? r : 0; idx[ai][m] = tl[rr]; gt[ai][m] = gl[rr]; }
#pragma unroll
        for (int bj = 0; bj < 2; ++bj)
#pragma unroll
            for (int n = 0; n < 2; ++n) bv[bj][n] = *(const f32x4*)(bb + bj * HALF + 4 * n);
#pragma unroll
        for (int ai = 0; ai < 2; ++ai)
#pragma unroll
            for (int m = 0; m < 4; ++m) { const int r = r0 + ai * HALF + m * 16;
                if (r < u.nrows) { bf16_t* rowp = Y + (size_t)idx[ai][m] * 1024 + col0; const float g1 = gt[ai][m];
#pragma unroll
                    for (int bj = 0; bj < 2; ++bj) { const f32x4 v0 = (acc[ai][bj][m][0] * wsc + bv[bj][0]) * g1, v1 = (acc[ai][bj][m][1] * wsc + bv[bj][1]) * g1;
                        u32x4 w; w.x = cvt_pk_bf16(v0[0], v0[1]); w.y = cvt_pk_bf16(v0[2], v0[3]); w.z = cvt_pk_bf16(v1[0], v1[1]); w.w = cvt_pk_bf16(v1[2], v1[3]);
                        *(u32x4*)(rowp + bj * HALF) = w; } } }
    }
};

#ifndef FP8_SCALE
#define FP8_SCALE 0
#endif
template <class Epi, class Sched, class Ops, bool GATHER, bool ALIGN_EPI, bool FP8 = false>
__device__ __forceinline__ void gemm_phase(PG8_LAS unsigned char* lds, const int K, const Sched& S, const Ops& O, const Epi& E) {
    const int tid = threadIdx.x, wid = __builtin_amdgcn_readfirstlane(tid >> 6), lane = tid & 63, wr = wid >> 2, wc = wid & 3, fr = lane & 15, fq = lane >> 4;
    const int nt = K / BK;
    unsigned voffA[2], voffB[2]; int sR[2], sC[2];
#pragma unroll
    for (int i = 0; i < 2; ++i) { int R, C; stage_rc(tid * 16 + i * 8192, R, C); const int Rb = Epi::PERM ? ((R & ~31) + perm32(R & 31)) : R; sR[i] = R; sC[i] = C;
        voffA[i] = (unsigned)(R * K + C) * 2u; voffB[i] = (unsigned)(Rb * K + C) * 2u; }
    const size_t kstep = (size_t)(BK * 2);
    const size_t hstep = (size_t)HALF * K * 2;
    const unsigned ldsw = (unsigned)wid * 1024u;
    const int aoff = lds_byte(wr * 64 + fr, fq * 8), boff = lds_byte(wc * 32 + fr, fq * 8);
#define PG8_SA(b, h) (((b) * 2 + (h)) * HTB)
#define PG8_SB(b, h) ((4 + (b) * 2 + (h)) * HTB)
#define PG8_STAGE(bufoff, gbase, voff) do { _Pragma("unroll") for (int _i = 0; _i < 2; ++_i) \
        __builtin_amdgcn_global_load_lds((const unsigned*)((const char*)(gbase) + (voff)[_i]), (PG8_LAS unsigned*)(lds + (bufoff) + ldsw + _i * 8192), 16, 0, 0); } while (0)
#define PG8_STAGE_AC(bufoff, kptr, h) do { if constexpr (GATHER) PG8_STAGE(bufoff, kptr, vC[h]); else PG8_STAGE(bufoff, (kptr) + (h) * hstep, voffA); } while (0)
#define PG8_STAGE_AS(bufoff, kptr, h) do { if constexpr (GATHER) PG8_STAGE(bufoff, kptr, vS[h]); else PG8_STAGE(bufoff, (kptr) + (h) * hstep, voffA); } while (0)
#define PG8_LDA(dst, b, h) do { _Pragma("unroll") for (int m = 0; m < 4; ++m) _Pragma("unroll") for (int k = 0; k < 2; ++k) dst[m][k] = *(const PG8_LAS bf16x8*)(lds + PG8_SA(b, h) + aoff + m * 2048 + k * 1024); } while (0)
#define PG8_LDB(dst, b, h) do { _Pragma("unroll") for (int n = 0; n < 2; ++n) _Pragma("unroll") for (int k = 0; k < 2; ++k) dst[n][k] = *(const PG8_LAS bf16x8*)(lds + PG8_SB(b, h) + boff + n * 2048 + k * 1024); } while (0)
#define PG8_CAT8(x) __builtin_shufflevector(__builtin_bit_cast(i32x4, (x)[0]), __builtin_bit_cast(i32x4, (x)[1]), 0, 1, 2, 3, 4, 5, 6, 7)
#define PG8_MMA(ai, bj, At, Bt) do { __builtin_amdgcn_s_setprio(1); \
        if constexpr (FP8) { _Pragma("unroll") for (int m = 0; m < 4; ++m) _Pragma("unroll") for (int n = 0; n < 2; ++n) \
            asm volatile("v_mfma_f32_16x16x128_f8f6f4 %0, %1, %2, %0" : "+v"(acc[ai][bj][m][n]) : "v"(PG8_CAT8(Bt[n])), "v"(PG8_CAT8(At[m]))); } \
        else { _Pragma("unroll") for (int m = 0; m < 4; ++m) _Pragma("unroll") for (int n = 0; n < 2; ++n) _Pragma("unroll") for (int k = 0; k < 2; ++k) \
            acc[ai][bj][m][n] = __builtin_amdgcn_mfma_f32_16x16x32_bf16(Bt[n][k], At[m][k], acc[ai][bj][m][n], 0, 0, 0); } \
        __builtin_amdgcn_s_setprio(0); } while (0)
#define PG8_WAIT_V(n) asm volatile("s_waitcnt vmcnt(" #n ")" ::: "memory")
#define PG8_WAIT_L(n) asm volatile("s_waitcnt lgkmcnt(" #n ")" ::: "memory")
#define PG8_BAR __builtin_amdgcn_s_barrier()
#define PG8_SCHED __builtin_amdgcn_sched_barrier(0)
    Unit cur, nxt; int ui = 0;
    if (!S.next(0, cur)) return;
    f32x4 acc[2][2][4][2];
#pragma unroll
    for (int a = 0; a < 2; ++a)
#pragma unroll
        for (int b = 0; b < 2; ++b)
#pragma unroll
            for (int m = 0; m < 4; ++m)
#pragma unroll
                for (int n = 0; n < 2; ++n) acc[a][b][m][n] = (f32x4){0.f, 0.f, 0.f, 0.f};
    bf16x8 At[4][2], B0[2][2], B1[2][2];
    unsigned vC[2][2] = {{0u, 0u}, {0u, 0u}}, vN[2][2] = {{0u, 0u}, {0u, 0u}}, vS[2][2] = {{0u, 0u}, {0u, 0u}};
    if constexpr (GATHER) O.gather(cur, sR, sC, vC);
    const char* cA = O.a_base(cur); const char* cB = O.b_base(cur);
    PG8_STAGE(PG8_SB(0, 0), cB, voffB); PG8_STAGE(PG8_SB(0, 1), cB + hstep, voffB); PG8_STAGE_AC(PG8_SA(0, 0), cA, 0); PG8_STAGE_AC(PG8_SA(0, 1), cA, 1);
    if (wr == 1) PG8_BAR;
    PG8_WAIT_V(2); PG8_BAR;
    PG8_STAGE(PG8_SB(1, 0), cB + kstep, voffB); PG8_STAGE_AC(PG8_SA(1, 0), cA + kstep, 0); PG8_STAGE(PG8_SB(1, 1), cB + hstep + kstep, voffB);
    PG8_WAIT_V(6); PG8_BAR;
    for (;;) {
        const bool has_next = S.next(ui + 1, nxt);
        const char* nA = has_next ? O.a_base(nxt) : cA; const char* nB = has_next ? O.b_base(nxt) : cB;
        if constexpr (GATHER) { if (has_next) O.gather(nxt, sR, sC, vN); else {
#pragma unroll
            for (int h = 0; h < 2; ++h)
#pragma unroll
                for (int i = 0; i < 2; ++i) vN[h][i] = vC[h][i]; } }
#pragma unroll 1
        for (int t = 0; t < nt; t += 2) {
            const bool last = (t == nt - 2);
            const char* a1 = cA + (size_t)(t + 1) * kstep;
            const char* a2 = last ? nA : cA + (size_t)(t + 2) * kstep; const char* b2 = last ? nB : cB + (size_t)(t + 2) * kstep;
            const char* a3 = a2 + kstep; const char* b3 = b2 + kstep;
            if constexpr (GATHER) {
#pragma unroll
                for (int h = 0; h < 2; ++h)
#pragma unroll
                    for (int i = 0; i < 2; ++i) vS[h][i] = last ? vN[h][i] : vC[h][i]; }
            PG8_LDB(B0, 0, 0); PG8_LDB(B1, 0, 1); PG8_SCHED; PG8_LDA(At, 0, 0); PG8_STAGE_AC(PG8_SA(1, 1), a1, 1);
            PG8_WAIT_V(8); PG8_WAIT_L(0); PG8_BAR; PG8_MMA(0, 0, At, B0); PG8_MMA(0, 1, At, B1); PG8_BAR; PG8_SCHED;
            PG8_LDA(At, 0, 1); PG8_STAGE(PG8_SB(0, 0), b2, voffB); PG8_STAGE(PG8_SB(0, 1), b2 + hstep, voffB); PG8_STAGE_AS(PG8_SA(0, 0), a2, 0);
            PG8_WAIT_V(8); PG8_WAIT_L(0); PG8_BAR; PG8_MMA(1, 0, At, B0); PG8_MMA(1, 1, At, B1); PG8_BAR; PG8_SCHED;
            PG8_LDB(B0, 1, 0); PG8_LDB(B1, 1, 1); PG8_SCHED; PG8_LDA(At, 1, 0); PG8_STAGE_AS(PG8_SA(0, 1), a2, 1);
            PG8_WAIT_V(8); PG8_WAIT_L(0); PG8_BAR; PG8_MMA(0, 0, At, B0); PG8_MMA(0, 1, At, B1); PG8_BAR; PG8_SCHED;
            PG8_LDA(At, 1, 1); PG8_STAGE(PG8_SB(1, 0), b3, voffB); PG8_STAGE(PG8_SB(1, 1), b3 + hstep, voffB); PG8_STAGE_AS(PG8_SA(1, 0), a3, 0);
            PG8_WAIT_V(8); PG8_WAIT_L(0); PG8_BAR; PG8_MMA(1, 0, At, B0); PG8_MMA(1, 1, At, B1); PG8_BAR; PG8_SCHED;
        }
        if constexpr (ALIGN_EPI) { if (wr == 0) PG8_BAR; }
        if constexpr (FP8) asm volatile("s_nop 15\n\ts_nop 3" ::: "memory");
        { int fr_e = fr, fq_e = fq; asm volatile("" : "+v"(fr_e), "+v"(fq_e));
          E(acc, cur, wr, wc, fr_e, fq_e); }
        if (!has_next) break;
#pragma unroll
        for (int a = 0; a < 2; ++a)
#pragma unroll
            for (int b = 0; b < 2; ++b)
#pragma unroll
                for (int m = 0; m < 4; ++m)
#pragma unroll
                    for (int n = 0; n < 2; ++n) acc[a][b][m][n] = (f32x4){0.f, 0.f, 0.f, 0.f};
        cur = nxt; cA = nA; cB = nB; ++ui;
        if constexpr (GATHER) {
#pragma unroll
            for (int h = 0; h < 2; ++h)
#pragma unroll
                for (int i = 0; i < 2; ++i) vC[h][i] = vN[h][i]; }
        if constexpr (ALIGN_EPI) { if (wr == 1) PG8_BAR; }
    }
    PG8_WAIT_V(0);
    if constexpr (!ALIGN_EPI) { if (wr == 0) PG8_BAR; }
    PG8_BAR;
#undef PG8_SA
#undef PG8_SB
#undef PG8_STAGE
#undef PG8_STAGE_AC
#undef PG8_STAGE_AS
#undef PG8_LDA
#undef PG8_LDB
#undef PG8_MMA
#undef PG8_CAT8
#undef PG8_WAIT_V
#undef PG8_WAIT_L
#undef PG8_BAR
#undef PG8_SCHED
}
}
#define GAS __attribute__((address_space(1)))
#define LAS __attribute__((address_space(3)))
typedef unsigned short bf16;
typedef short bf16x8 __attribute__((ext_vector_type(8)));
typedef short s16x4 __attribute__((ext_vector_type(4)));
typedef float f32x4 __attribute__((ext_vector_type(4)));
typedef unsigned u32x4 __attribute__((ext_vector_type(4)));
typedef unsigned u32x2 __attribute__((ext_vector_type(2)));
typedef LAS unsigned char* lptr;

constexpr int NWAVES = 8, NTHR = 512;
#ifndef MOE_FP8
#define MOE_FP8 1
#endif
constexpr int MOE_ESZ = MOE_FP8 ? 1 : 2;
constexpr size_t MiB = 1u << 20;
constexpr size_t WS_CTL = 0, CTL_ZERO_BYTES = 64 * 1024;
constexpr size_t WS_SMALL = 1 * MiB;
constexpr size_t WS_GATES = 2 * MiB;
constexpr size_t WS_RSG = 2 * MiB + 512 * 1024;
constexpr size_t WS_RS1 = 2 * MiB + 768 * 1024;
constexpr size_t WS_GATE = 3 * MiB;
constexpr size_t WS_TOKIDX = 4 * MiB;
constexpr size_t WS_GATEX = 760 * MiB, WS_RSX = 768 * MiB;
constexpr size_t WS_KC = 776 * MiB;
constexpr size_t WS_WRT = 12 * MiB;
constexpr size_t WS_WINT = 16 * MiB, WS_WOUTT = 22 * MiB, WS_WDNT = 24 * MiB, WS_WUPT = 88 * MiB;
constexpr size_t WS_XN = 216 * MiB;
constexpr size_t WS_PROJ = 248 * MiB;
constexpr size_t WS_CLOC = 344 * MiB;
constexpr size_t WS_CPREV = 376 * MiB;
constexpr size_t WS_MIX = 392 * MiB;
constexpr size_t WS_H = 424 * MiB;
constexpr size_t WS_ACT = 488 * MiB;
constexpr size_t WS_Y = 632 * MiB;
constexpr size_t WS_OPT_END = 760 * MiB;
constexpr int CW_CNT = 64;
constexpr int CW_BAR = 4096;
constexpr int PROJ_LD = 3072;
constexpr int QO = 0, KO = 512, VO = 1024, OO = 1536, UO = 2048, VGO = 2560;
constexpr int RING_BYTES = 131072, VEC_OFF = 131072, VEC_BYTES = 16384, CTL_OFF = VEC_OFF + VEC_BYTES, TTAB_OFF = CTL_OFF, MISC_OFF = CTL_OFF + 2048, LDS_BYTES = MISC_OFF + 256;
constexpr int T0 = 0, T1 = 32768, T2 = 65536, T3 = 98304;

#define RLX_AGENT __ATOMIC_RELAXED, __HIP_MEMORY_SCOPE_AGENT
#define XB_TMO      128
#define XB_XCNT(j)  (256  + 64 * (j))
#define XB_XSUB(j)  (1280 + 64 * (j))
#define XB_XGEN(j)  (2304 + 64 * (j))
#define XB_TOP      3328
#define XB_TOPGEN   3392
#define XCD_BAR_WORDS 3456
#define XB_SPIN_CAP (1u << 18)
__device__ __forceinline__ unsigned xb_ld(unsigned* p)              { return __hip_atomic_load(p, __ATOMIC_RELAXED, __HIP_MEMORY_SCOPE_AGENT); }
__device__ __forceinline__ unsigned xb_add(unsigned* p, unsigned v) { return __hip_atomic_fetch_add(p, v, __ATOMIC_RELAXED, __HIP_MEMORY_SCOPE_AGENT); }
__device__ __forceinline__ unsigned xb_xcc_id() { return (unsigned)__builtin_amdgcn_s_getreg((3 << 11) | 20) & 0xFu; }
#define XB_SPIN(cond, bar) do { unsigned _sp = 0; while (cond) { __builtin_amdgcn_s_sleep(1); \
    if ((++_sp & 255u) == 0u) { if (xb_ld(&(bar)[XB_TMO])) break; if (_sp > XB_SPIN_CAP) { atomicAdd(&(bar)[XB_TMO], 1u); break; } } } } while (0)
struct XcdBarrier { unsigned* bar; unsigned x; volatile LAS unsigned* st; };
__device__ __forceinline__ XcdBarrier xcd_barrier_post(unsigned* bar, volatile LAS unsigned* st) {
    XcdBarrier b; b.bar = bar; b.x = xb_xcc_id(); b.st = st;
    if (threadIdx.x == 0) (void)xb_add(&bar[XB_XCNT(b.x)], 1u);
    return b;
}
__device__ __forceinline__ void xcd_barrier_complete(unsigned* bar, unsigned x, unsigned& nloc, unsigned& nx) {
    const unsigned G = gridDim.x * gridDim.y * gridDim.z;
    unsigned sum, cnt, mine, sp = 0u;
    for (;;) {
        sum = 0u; cnt = 0u; mine = 0u;
#pragma unroll
        for (unsigned j = 0; j < 16; ++j) { const unsigned c = xb_ld(&bar[XB_XCNT(j)]); sum += c; cnt += (c > 0u) ? 1u : 0u; mine = (j == x) ? c : mine; }
        if (sum == G) break;
        __builtin_amdgcn_s_sleep(1);
        if ((++sp & 255u) == 0u) { if (xb_ld(&bar[XB_TMO])) break; if (sp > XB_SPIN_CAP) { atomicAdd(&bar[XB_TMO], 1u); break; } }
    }
    nloc = mine > 0u ? mine : 1u; nx = cnt > 0u ? cnt : 1u;
}
__device__ __forceinline__ void xcd_barrier(const XcdBarrier& b) {
    asm volatile("s_waitcnt vmcnt(0)" ::: "memory");
    __syncthreads();
    if (threadIdx.x == 0) {
        unsigned* bar = b.bar;
        __builtin_amdgcn_s_waitcnt(0);
        unsigned nloc = b.st[0], nx = b.st[1];
        if (nloc == 0u) { xcd_barrier_complete(bar, b.x, nloc, nx); b.st[0] = nloc; b.st[1] = nx; }
        const unsigned old = xb_add(&bar[XB_XSUB(b.x)], 1u);
        const unsigned gen = old / nloc;
        if (old + 1u == (gen + 1u) * nloc) {
            __builtin_amdgcn_fence(__ATOMIC_RELEASE, "agent");
            asm volatile("s_waitcnt vmcnt(0)" ::: "memory");
            const unsigned og = xb_add(&bar[XB_TOP], 1u);
            const unsigned tg = og / nx;
            if (og + 1u == (tg + 1u) * nx) xb_add(&bar[XB_TOPGEN], 1u);
            else XB_SPIN(xb_ld(&bar[XB_TOPGEN]) == tg, bar);
            __builtin_amdgcn_fence(__ATOMIC_ACQUIRE, "agent");
            xb_add(&bar[XB_XGEN(b.x)], 1u);
            asm volatile("s_waitcnt vmcnt(0)" ::: "memory");
        } else {
            XB_SPIN(xb_ld(&bar[XB_XGEN(b.x)]) == gen, bar);
            __builtin_amdgcn_fence(__ATOMIC_ACQUIRE, "agent");
            asm volatile("s_waitcnt vmcnt(0)" ::: "memory");
        }
    }
    __syncthreads();
}

__device__ __forceinline__ float bf2f(unsigned short h) { return __builtin_bit_cast(float, (unsigned)h << 16); }
__device__ __forceinline__ unsigned f2bf(float f) { unsigned u = __builtin_bit_cast(unsigned, f); return (u + 0x7fffu + ((u >> 16) & 1u)) >> 16; }
__device__ __forceinline__ unsigned pk2(float lo, float hi) { return pg8::cvt_pk_bf16(lo, hi); }
__device__ __forceinline__ float fexp(float x) { return __builtin_amdgcn_exp2f(x * 1.4426950408889634f); }
__device__ __forceinline__ float fsigmoid(float x) { return __builtin_amdgcn_rcpf(1.0f + fexp(-x)); }
__device__ __forceinline__ float fgelu(float x) {
    const float u = 1.5957691216057308f * (x + 0.044715f * x * x * x);
    return x * fsigmoid(u);
}
__device__ __forceinline__ float wsum_all(float v) {
#pragma unroll
    for (int o = 32; o > 0; o >>= 1) v += __shfl_xor(v, o);
    return v;
}
__device__ __forceinline__ void unpack8(const u32x4 w, float (&f)[8]) {
    f[0] = __builtin_bit_cast(float, w.x << 16); f[1] = __builtin_bit_cast(float, w.x & 0xffff0000u);
    f[2] = __builtin_bit_cast(float, w.y << 16); f[3] = __builtin_bit_cast(float, w.y & 0xffff0000u);
    f[4] = __builtin_bit_cast(float, w.z << 16); f[5] = __builtin_bit_cast(float, w.z & 0xffff0000u);
    f[6] = __builtin_bit_cast(float, w.w << 16); f[7] = __builtin_bit_cast(float, w.w & 0xffff0000u);
}
__device__ __forceinline__ u32x4 pack8(const float (&f)[8]) { u32x4 w; w.x = pk2(f[0], f[1]); w.y = pk2(f[2], f[3]); w.z = pk2(f[4], f[5]); w.w = pk2(f[6], f[7]); return w; }

__device__ __forceinline__ unsigned off_b(unsigned row, unsigned ch) { return 256u * row + 16u * (ch ^ (((row & 3u) << 2) | ((row >> 2) & 3u))); }
__device__ __forceinline__ bf16x8 frag_row(lptr T, int r0, int ks, int lane) { return *(const LAS bf16x8*)(T + off_b((unsigned)(r0 + (lane & 15)), (unsigned)(4 * ks + (lane >> 4)))); }
__device__ __forceinline__ bf16x8 frag_tr(lptr T, int c, int ks, int lane) {
    const unsigned g = lane >> 4, q = (lane & 15) >> 2, p = lane & 3;
    const unsigned a0 = off_b(32u * ks + 8u * g + q, 2u * c + (p >> 1)) + 8u * (p & 1);
    const unsigned a1 = off_b(32u * ks + 8u * g + 4u + q, 2u * c + (p >> 1)) + 8u * (p & 1);
    const s16x4 lo = __builtin_amdgcn_ds_read_tr16_b64_v4i16((LAS s16x4*)(T + a0));
    const s16x4 hi = __builtin_amdgcn_ds_read_tr16_b64_v4i16((LAS s16x4*)(T + a1));
    return __builtin_shufflevector(lo, hi, 0, 1, 2, 3, 4, 5, 6, 7);
}
#define MFMA16(a, b, c) __builtin_amdgcn_mfma_f32_16x16x32_bf16(a, b, c, 0, 0, 0)

#ifndef PROBE_SEC
#define PROBE_SEC -1
#endif
#define SEC_BEGIN(F, id) do { if (PROBE_SEC == (id)) { __syncthreads(); (F).t0 = __builtin_amdgcn_s_memrealtime(); } } while (0)
#define SEC_END(F, id) do { if (PROBE_SEC == (id)) { __syncthreads(); (F).tsec += __builtin_amdgcn_s_memrealtime() - (F).t0; } } while (0)
struct Frame {
    unsigned long long t0, tsec;
    lptr lds; int tid, lane, wave, G, vcu;
    const float* in[20]; float* out; unsigned char* ws;
};

template <bool SCALE>
__device__ __forceinline__ void stage_tile(const Frame& F, lptr T, const bf16* src, int ld, const LAS float* rowscale) {
    const int cg = F.tid & 15, sb = F.tid >> 4;
    u32x4 w[4];
#pragma unroll
    for (int r = 0; r < 4; ++r) w[r] = *(const u32x4*)(src + (size_t)(4 * sb + r) * ld + 8 * cg);
#pragma unroll
    for (int r = 0; r < 4; ++r) { const int s = 4 * sb + r;
        if (SCALE) { float f[8]; unpack8(w[r], f); const float sc = rowscale[s];
#pragma unroll
            for (int i = 0; i < 8; ++i) f[i] *= sc;
            w[r] = pack8(f); }
        *(LAS u32x4*)(T + off_b(s, cg)) = w[r]; }
}
__device__ __forceinline__ void stage_conv(const Frame& F, lptr T, const bf16* src, const LAS float* cw, int tpos, float scale, u32x4 (&out)[4]) {
    const int cg = F.tid & 15, sb = F.tid >> 4;
    u32x4 w[7];
#pragma unroll
    for (int j = 0; j < 7; ++j) { const int s = 4 * sb - 3 + j; w[j] = (tpos + s >= 0) ? *(const u32x4*)(src + (ptrdiff_t)s * PROJ_LD + 8 * cg) : (u32x4){0u, 0u, 0u, 0u}; }
#pragma unroll
    for (int hf = 0; hf < 2; ++hf) {
        f32x4 tp4[4];
#pragma unroll
        for (int tp = 0; tp < 4; ++tp) tp4[tp] = *(const LAS f32x4*)(cw + tp * 128 + 8 * cg + 4 * hf);
        float a[4][4];
#pragma unroll
        for (int r = 0; r < 4; ++r)
#pragma unroll
            for (int i = 0; i < 4; ++i) a[r][i] = 0.f;
#pragma unroll
        for (int j = 0; j < 7; ++j) { const unsigned u0 = hf ? w[j].z : w[j].x, u1 = hf ? w[j].w : w[j].y;
            const float f[4] = {__builtin_bit_cast(float, u0 << 16), __builtin_bit_cast(float, u0 & 0xffff0000u), __builtin_bit_cast(float, u1 << 16), __builtin_bit_cast(float, u1 & 0xffff0000u)};
#pragma unroll
            for (int r = 0; r < 4; ++r) { const int tp = j - r; if (tp >= 0 && tp < 4) {
#pragma unroll
                for (int i = 0; i < 4; ++i) a[r][i] += tp4[tp][i] * f[i]; } } }
#pragma unroll
        for (int r = 0; r < 4; ++r) {
#pragma unroll
            for (int i = 0; i < 4; ++i) a[r][i] = a[r][i] * fsigmoid(a[r][i]) * scale;
            const unsigned p0 = pk2(a[r][0], a[r][1]), p1 = pk2(a[r][2], a[r][3]);
            if (hf == 0) { out[r].x = p0; out[r].y = p1; } else { out[r].z = p0; out[r].w = p1; } }
        __builtin_amdgcn_sched_barrier(0);
    }
#pragma unroll
    for (int r = 0; r < 4; ++r) *(LAS u32x4*)(T + off_b(4 * sb + r, cg)) = out[r];
}
__device__ __forceinline__ void p0_item(const float* Wsrc, int ld, bf16* dst, int Kd, LAS float* scr, int lane) {
#pragma unroll 8
    for (int i = 0; i < 32; ++i) { const int kk = 2 * i + (lane >> 5); scr[kk * 33 + (lane & 31)] = Wsrc[(size_t)kk * ld + (lane & 31)]; }
    asm volatile("s_waitcnt lgkmcnt(0)" ::: "memory");
    const int c = lane & 7;
#pragma unroll
    for (int j = 0; j < 4; ++j) { const int n = (lane >> 3) + 8 * j; const LAS float* s = scr + (8 * c) * 33 + n;
        u32x4 o; o.x = pk2(s[0 * 33], s[1 * 33]); o.y = pk2(s[2 * 33], s[3 * 33]); o.z = pk2(s[4 * 33], s[5 * 33]); o.w = pk2(s[6 * 33], s[7 * 33]);
        *(u32x4*)(dst + (size_t)n * Kd + 8 * c) = o; }
    asm volatile("s_waitcnt lgkmcnt(0)" ::: "memory");
}
__device__ __forceinline__ void p0_item_split(const float* Wsrc, int ld, bf16* dhi, bf16* dlo, int Kd, LAS float* scr, int lane) {
#pragma unroll 8
    for (int i = 0; i < 32; ++i) { const int kk = 2 * i + (lane >> 5); scr[kk * 33 + (lane & 31)] = Wsrc[(size_t)kk * ld + (lane & 31)]; }
    asm volatile("s_waitcnt lgkmcnt(0)" ::: "memory");
    const int c = lane & 7;
#pragma unroll
    for (int j = 0; j < 4; ++j) { const int n = (lane >> 3) + 8 * j; const LAS float* s = scr + (8 * c) * 33 + n;
        float v[8], l[8];
#pragma unroll
        for (int i = 0; i < 8; ++i) { v[i] = s[i * 33]; l[i] = v[i] - bf2f((unsigned short)f2bf(v[i])); }
        *(u32x4*)(dhi + (size_t)n * Kd + 8 * c) = pack8(v); *(u32x4*)(dlo + (size_t)n * Kd + 8 * c) = pack8(l); }
    asm volatile("s_waitcnt lgkmcnt(0)" ::: "memory");
}

struct P0Item { const float* src; char* dst; int ld; int esz; };
constexpr float W8_SCALE = 64.0f;
__device__ __forceinline__ void p0_load(const P0Item& it, int lane, f32x4 (&v)[8]) {
    const float* p = it.src + (size_t)(8 * (lane & 7)) * it.ld + 4 * (lane >> 3);
#pragma unroll
    for (int j = 0; j < 8; ++j) v[j] = __builtin_nontemporal_load((const f32x4*)(p + (size_t)j * it.ld));
}
__device__ __forceinline__ void p0_store(const P0Item& it, int lane, const f32x4 (&v)[8]) {
    const size_t eo = (size_t)(4 * (lane >> 3)) * 1024 + 8 * (lane & 7);
    if (it.esz == 2) { char* q = it.dst + 2 * eo;
#pragma unroll
        for (int i = 0; i < 4; ++i) { u32x4 o; o.x = pk2(v[0][i], v[1][i]); o.y = pk2(v[2][i], v[3][i]); o.z = pk2(v[4][i], v[5][i]); o.w = pk2(v[6][i], v[7][i]);
            *(u32x4*)(q + (size_t)i * 2048) = o; } }
    else { char* q = it.dst + eo;
#pragma unroll
        for (int i = 0; i < 4; ++i) { u32x2 o; o.x = pg8::pk4_fp8(v[0][i] * W8_SCALE, v[1][i] * W8_SCALE, v[2][i] * W8_SCALE, v[3][i] * W8_SCALE);
            o.y = pg8::pk4_fp8(v[4][i] * W8_SCALE, v[5][i] * W8_SCALE, v[6][i] * W8_SCALE, v[7][i] * W8_SCALE);
            *(u32x2*)(q + (size_t)i * 1024) = o; } }
}
constexpr int IMG_ROW = 2064;
template <int NF, bool OUT8>
__device__ __forceinline__ float row_pass(const float* X, const float* gain, void* XNout, lptr img_hi, lptr img_lo, int tok0, int lane, f32x4 (&acc)[NF]) {
    const int r = lane & 15, g = lane >> 4;
    const float* xr = X + (size_t)(tok0 + r) * 1024 + 8 * g;
    float ss = 0.f;
#pragma unroll
    for (int nf = 0; nf < NF; ++nf) acc[nf] = (f32x4){0.f, 0.f, 0.f, 0.f};
    char* orow = (char*)XNout + ((size_t)(tok0 + r) * 1024 + 8 * g) * (OUT8 ? 1 : 2);
#pragma unroll 16
    for (int ks = 0; ks < 32; ++ks) { const f32x4 a = __builtin_nontemporal_load((const f32x4*)(xr + 32 * ks)), b = __builtin_nontemporal_load((const f32x4*)(xr + 32 * ks + 4));
        ss += (a[0] * a[0] + a[1] * a[1]) + (a[2] * a[2] + a[3] * a[3]) + (b[0] * b[0] + b[1] * b[1]) + (b[2] * b[2] + b[3] * b[3]);
        const f32x4 ga = *(const f32x4*)(gain + 32 * ks + 8 * g), gb = *(const f32x4*)(gain + 32 * ks + 8 * g + 4);
        float v[8], l[8];
#pragma unroll
        for (int i = 0; i < 4; ++i) { v[i] = a[i] * ga[i]; v[4 + i] = b[i] * gb[i]; }
        const u32x4 hi = pack8(v);
        { float h[8]; unpack8(hi, h);
#pragma unroll
          for (int i = 0; i < 8; ++i) l[i] = v[i] - h[i]; }
        const u32x4 lo = pack8(l);
        if (OUT8) { u32x2 o8; o8.x = pg8::pk4_fp8(v[0], v[1], v[2], v[3]); o8.y = pg8::pk4_fp8(v[4], v[5], v[6], v[7]); *(u32x2*)(orow + 32 * ks) = o8; }
        else *(u32x4*)(orow + 64 * ks) = hi;
        const bf16x8 ahi = __builtin_bit_cast(bf16x8, hi), alo = __builtin_bit_cast(bf16x8, lo);
#pragma unroll
        for (int nf = 0; nf < NF; ++nf) { const unsigned bo = (unsigned)(16 * nf + (lane & 15)) * IMG_ROW + 64u * ks + 16u * g;
            const bf16x8 bhi = *(const LAS bf16x8*)(img_hi + bo), blo = *(const LAS bf16x8*)(img_lo + bo);
            acc[nf] = MFMA16(ahi, bhi, acc[nf]); acc[nf] = MFMA16(ahi, blo, acc[nf]); acc[nf] = MFMA16(alo, bhi, acc[nf]); } }
    ss += __shfl_xor(ss, 16); ss += __shfl_xor(ss, 32);
    return 1.0f / sqrtf(ss * (1.0f / 1024.0f) + 1e-6f);
}

__device__ __forceinline__ void phase0(Frame& F) {
    const float* x = F.in[0]; const float* g1 = F.in[1]; const float* w_in = F.in[2]; const float* b_i = F.in[4]; const float* b_f = F.in[5];
    const float* w_out = F.in[11]; const float* wr = F.in[13]; const float* w_up = F.in[15]; const float* w_dn = F.in[17];
    bf16* WinT = (bf16*)(F.ws + WS_WINT); bf16* WoutT = (bf16*)(F.ws + WS_WOUTT); bf16* WdnT = (bf16*)(F.ws + WS_WDNT); bf16* WupT = (bf16*)(F.ws + WS_WUPT);
    bf16* WrThi = (bf16*)(F.ws + WS_WRT); bf16* WrTlo = WrThi + 32 * 1024;
    bf16* XN = (bf16*)(F.ws + WS_XN); float* GATES = (float*)(F.ws + WS_GATES); float* RS1 = (float*)(F.ws + WS_RS1);
    lptr ghi = F.lds + T0, glo = F.lds + T0 + 16 * IMG_ROW;
    SEC_BEGIN(F, 1);
#pragma unroll
    for (int q = 0; q < 2; ++q) { const int kk = F.tid + NTHR * q; const f32x4 a = *(const f32x4*)(w_in + (size_t)kk * 3080 + 2048), b = *(const f32x4*)(w_in + (size_t)kk * 3080 + 2052);
        const float v[8] = {a[0], a[1], a[2], a[3], b[0], b[1], b[2], b[3]};
#pragma unroll
        for (int j = 0; j < 8; ++j) { const unsigned h = f2bf(v[j]); const float l = v[j] - bf2f((unsigned short)h);
            *(LAS unsigned short*)(ghi + j * IMG_ROW + 2 * kk) = (unsigned short)h; *(LAS unsigned short*)(glo + j * IMG_ROW + 2 * kk) = (unsigned short)f2bf(l); } }
    __syncthreads();
    SEC_END(F, 1); SEC_BEGIN(F, 2);
    if (F.wave < 4) { const int tok0 = F.vcu * 64 + F.wave * 16; f32x4 acc[1];
      const float rstd = row_pass<1, false>(x, g1, XN, ghi, glo, tok0, F.lane, acc);
      if (F.lane < 16) RS1[tok0 + F.lane] = rstd;
      const int j = F.lane & 15, gq = F.lane >> 4;
      float rr[4];
#pragma unroll
      for (int rg = 0; rg < 4; ++rg) rr[rg] = __shfl(rstd, 4 * gq + rg);
      if (j < 8) {
#pragma unroll
          for (int rg = 0; rg < 4; ++rg) { const int tok = tok0 + 4 * gq + rg; float v = acc[0][rg] * rr[rg];
              if (j < 4) v += b_i[j]; else { v += b_f[j - 4]; v = fminf(v, 0.f) - log1pf(expf(-fabsf(v))); }
              GATES[(size_t)tok * 8 + j] = v; } } }
    SEC_END(F, 2); SEC_BEGIN(F, 3);
    const float* b_unused = nullptr; (void)b_unused;
    const int gw = F.vcu * NWAVES + F.wave, NGW = F.G * NWAVES;
    if (F.vcu < 4 && F.wave >= 4) { const int ri = F.vcu * 4 + F.wave - 4; LAS float* scr = (LAS float*)(F.lds + 66560 + (F.wave - 4) * 8448);
        p0_item_split(wr + (size_t)(64 * ri) * 32, 32, WrThi + 64 * ri, WrTlo + 64 * ri, 1024, scr, F.lane); }
    constexpr int I_IN = 16 * 96, I_OUT = 16 * 32, I_UP = 32 * 16 * 64, NITEMS = I_IN + I_OUT + I_UP;
    auto decode = [&](int it) -> P0Item {
        int r = it; P0Item o;
        if (r < I_IN) { const int kb = r / 96, nb = r % 96, nd = 32 * nb, nsrc = nd < 2048 ? nd : nd + 8;
            o.src = w_in + (size_t)(64 * kb) * 3080 + nsrc; o.ld = 3080; o.esz = 2; o.dst = (char*)(WinT + (size_t)nd * 1024 + 64 * kb); return o; } r -= I_IN;
        if (r < I_OUT) { const int kb = r / 32, nb = r % 32;
            o.src = w_out + (size_t)(64 * kb) * 1024 + 32 * nb; o.ld = 1024; o.esz = 2; o.dst = (char*)(WoutT + (size_t)(32 * nb) * 1024 + 64 * kb); return o; } r -= I_OUT;
        { const int e = r / 1024, q = r % 1024, kb = q / 64, nb = q % 64, n = 32 * nb, half = n >> 10, jj = n & 1023, pn = jj >> 7, j = jj & 127, nd = 256 * pn + 128 * half + j;
          o.src = w_up + ((size_t)e * 1024 + 64 * kb) * 2048 + n; o.ld = 2048; o.esz = MOE_ESZ; o.dst = (char*)WupT + (((size_t)e * 2048 + nd) * 1024 + 64 * kb) * MOE_ESZ; return o; }
    };
    constexpr int PER_WAVE = NITEMS / (256 * NWAVES), SHIFT = 3;
    static_assert(NITEMS % (256 * NWAVES) == 0, "item split");
    const int nown = F.wave < 4 ? PER_WAVE - SHIFT : PER_WAVE + SHIFT;
    for (int j = 0; j < nown; j += 2) {
        const bool two = j + 1 < nown;
        const int j0 = j, j1 = two ? j + 1 : j;
        const int ita = (j0 < PER_WAVE) ? gw + j0 * NGW : (gw - 4) + (j0 - SHIFT) * NGW;
        const int itb = (j1 < PER_WAVE) ? gw + j1 * NGW : (gw - 4) + (j1 - SHIFT) * NGW;
        const P0Item ia = decode(ita), ib = decode(itb);
        f32x4 va[8], vb[8];
        p0_load(ia, F.lane, va); p0_load(ib, F.lane, vb);
        p0_store(ia, F.lane, va); if (two) p0_store(ib, F.lane, vb);
    }
    SEC_END(F, 3);
}

__device__ __forceinline__ float wscan_add(float v, int lane) {
#pragma unroll
    for (int o = 1; o < 64; o <<= 1) { const float t = __shfl_up(v, o); if (lane >= o) v += t; }
    return v;
}
__device__ __forceinline__ float wscan_max(float v, int lane) {
#pragma unroll
    for (int o = 1; o < 64; o <<= 1) { const float t = __shfl_up(v, o); if (lane >= o) v = fmaxf(v, t); }
    return v;
}
__device__ __forceinline__ float wmax_all(float v) {
#pragma unroll
    for (int o = 32; o > 0; o >>= 1) v = fmaxf(v, __shfl_xor(v, o));
    return v;
}

__device__ __forceinline__ void mlstm_local_unit(Frame& F0, int u) {
    Frame F = F0; asm volatile("" : "+v"(F.tid), "+v"(F.lane));
    const int c = u & 63, h = (u >> 6) & 3, b = u >> 8, row0 = b * 8192 + c * 128;
    const bf16* PROJ = (const bf16*)(F.ws + WS_PROJ); const float* GATES = (const float*)(F.ws + WS_GATES); const float* conv = F.in[3];
    float* CLOC = (float*)(F.ws + WS_CLOC); float* MLOC = (float*)(F.ws + WS_SMALL); float* BLAST = MLOC + 512; float* NLOC = MLOC + 2048; bf16* KC = (bf16*)(F.ws + WS_KC);
    LAS float* wv = (LAS float*)(F.lds + VEC_OFF);
    LAS float* cw = wv + 128;
    LAS float* part = cw + 512;
    const int lane = F.lane, w = F.wave;
    SEC_BEGIN(F, 10);
#pragma unroll
    for (int j = 0; j < 8; ++j) { const int i = lane + 64 * j; cw[i] = conv[(i >> 7) * 1024 + 512 + h * 128 + (i & 127)]; }
    { const int l = lane, s0 = 2 * l, s1 = s0 + 1;
        const float li0 = GATES[(size_t)(row0 + s0) * 8 + h], li1 = GATES[(size_t)(row0 + s1) * 8 + h], lf0 = GATES[(size_t)(row0 + s0) * 8 + 4 + h], lf1 = GATES[(size_t)(row0 + s1) * 8 + 4 + h];
        const float inc = wscan_add(lf0 + lf1, l), b1 = inc, b0 = inc - lf1, blast = __shfl(inc, 63);
        const float g0 = blast - b0 + li0, g1 = blast - b1 + li1, mloc = wmax_all(fmaxf(g0, g1));
        wv[s0] = fexp(g0 - mloc); wv[s1] = fexp(g1 - mloc);
        if (l == 0 && w == 0) { MLOC[u] = mloc; BLAST[u] = blast; } }
    SEC_END(F, 10); SEC_BEGIN(F, 11);
    { u32x4 kv[4]; const int cg = F.tid & 15, sb = F.tid >> 4;
      stage_conv(F, F.lds + T1, PROJ + (size_t)row0 * PROJ_LD + KO + h * 128, cw, c * 128, 0.08838834764831845f, kv);
      float pn[8];
#pragma unroll
      for (int i = 0; i < 8; ++i) pn[i] = 0.f;
#pragma unroll
      for (int r = 0; r < 4; ++r) { *(u32x4*)(KC + (size_t)(row0 + 4 * sb + r) * 512 + h * 128 + 8 * cg) = kv[r];
          float f[8]; unpack8(kv[r], f); const float ws = wv[4 * sb + r];
#pragma unroll
          for (int i = 0; i < 8; ++i) pn[i] += ws * f[i]; }
#pragma unroll
      for (int i = 0; i < 8; ++i) { pn[i] += __shfl_xor(pn[i], 16); pn[i] += __shfl_xor(pn[i], 32); }
      if (lane < 16) { *(LAS f32x4*)(part + w * 128 + 8 * cg) = (f32x4){pn[0], pn[1], pn[2], pn[3]}; *(LAS f32x4*)(part + w * 128 + 8 * cg + 4) = (f32x4){pn[4], pn[5], pn[6], pn[7]}; } }
    stage_tile<true>(F, F.lds + T2, PROJ + (size_t)row0 * PROJ_LD + VO + h * 128, PROJ_LD, wv);
    __syncthreads();
    SEC_END(F, 11); SEC_BEGIN(F, 12);
    { f32x4 acc[8];
#pragma unroll
      for (int kb = 0; kb < 8; ++kb) acc[kb] = (f32x4){0.f, 0.f, 0.f, 0.f};
#pragma unroll
      for (int ks = 0; ks < 4; ++ks) { const bf16x8 a = frag_tr(F.lds + T2, w, ks, lane);
#pragma unroll
          for (int kb = 0; kb < 8; ++kb) { const bf16x8 bb = frag_tr(F.lds + T1, kb, ks, lane); acc[kb] = MFMA16(a, bb, acc[kb]); } }
      float* cl = CLOC + (size_t)u * 16384 + (size_t)(16 * w + 4 * (lane >> 4)) * 128 + (lane & 15);
#pragma unroll
      for (int kb = 0; kb < 8; ++kb)
#pragma unroll
          for (int rg = 0; rg < 4; ++rg) cl[rg * 128 + 16 * kb] = acc[kb][rg]; }
    if (F.tid < 128) { float a = 0.f;
#pragma unroll
        for (int ww = 0; ww < 8; ++ww) a += part[ww * 128 + F.tid];
        NLOC[(size_t)u * 128 + F.tid] = a; }
    __syncthreads();
    SEC_END(F, 12);
    F0.tsec = F.tsec;
}

__device__ __forceinline__ void gmlp_unit(Frame& F0, int ug) {
    Frame F = F0; asm volatile("" : "+v"(F.tid), "+v"(F.lane));
    const int g = ug & 3, row0 = (ug >> 2) * 128;
    const bf16* PROJ = (const bf16*)(F.ws + WS_PROJ); bf16* MIX = (bf16*)(F.ws + WS_MIX);
    const float* lng = F.in[7]; const float* wsp = F.in[8]; const float* bsp = F.in[9]; const float* og = F.in[10]; float* PSSQ = (float*)(F.ws + WS_RSG);
    LAS float* st_mean = (LAS float*)(F.lds + VEC_OFF); LAS float* st_rstd = st_mean + 128;
    const int w = F.wave, lane = F.lane;
    SEC_BEGIN(F, 20);
    { const int t = F.tid >> 2, q = F.tid & 3; const bf16* vp = PROJ + (size_t)(row0 + t) * PROJ_LD + VGO + 128 * q;
      float s = 0.f, s2 = 0.f;
#pragma unroll 8
      for (int j = 0; j < 16; ++j) { float f[8]; unpack8(*(const u32x4*)(vp + 8 * j), f);
#pragma unroll
          for (int i = 0; i < 8; ++i) { s += f[i]; s2 += f[i] * f[i]; } }
      s += __shfl_xor(s, 1); s += __shfl_xor(s, 2); s2 += __shfl_xor(s2, 1); s2 += __shfl_xor(s2, 2);
      const float mean = s * (1.0f / 512.0f), var = fmaxf(s2 * (1.0f / 512.0f) - mean * mean, 0.f);
      if (q == 0) { st_mean[t] = mean; st_rstd[t] = 1.0f / sqrtf(var + 1e-6f); } }
    __syncthreads();
    SEC_END(F, 20); SEC_BEGIN(F, 21);
    { const int cg = F.tid & 15, sb = F.tid >> 4;
      const f32x4 l0 = *(const f32x4*)(lng + g * 128 + 8 * cg), l1 = *(const f32x4*)(lng + g * 128 + 8 * cg + 4);
      u32x4 vv[4], uu[4]; f32x4 wa[4], wb[4];
#pragma unroll
      for (int r = 0; r < 4; ++r) { const int t = 4 * sb + r;
          vv[r] = *(const u32x4*)(PROJ + (size_t)(row0 + t) * PROJ_LD + VGO + g * 128 + 8 * cg); uu[r] = *(const u32x4*)(PROJ + (size_t)(row0 + t) * PROJ_LD + UO + g * 128 + 8 * cg);
          const float* wp = wsp + ((size_t)(g * 128 + t)) * 128 + 8 * cg; wa[r] = *(const f32x4*)wp; wb[r] = *(const f32x4*)(wp + 4); }
#pragma unroll
      for (int r = 0; r < 4; ++r) { const int t = 4 * sb + r;
          float f[8] = {wa[r][0], wa[r][1], wa[r][2], wa[r][3], wb[r][0], wb[r][1], wb[r][2], wb[r][3]};
#pragma unroll
          for (int kk = 0; kk < 8; ++kk) if (8 * cg + kk > t) f[kk] = 0.f;
          *(LAS u32x4*)(F.lds + T0 + off_b(t, cg)) = pack8(f);
          float v[8]; unpack8(vv[r], v); const float mean = st_mean[t], rstd = st_rstd[t];
#pragma unroll
          for (int kk = 0; kk < 8; ++kk) v[kk] = (v[kk] - mean) * rstd * (kk < 4 ? l0[kk] : l1[kk - 4]);
          *(LAS u32x4*)(F.lds + T1 + off_b(t, cg)) = pack8(v);
          *(LAS u32x4*)(F.lds + T2 + off_b(t, cg)) = uu[r]; } }
    __syncthreads();
    SEC_END(F, 21); SEC_BEGIN(F, 22);
    f32x4 acc[8];
#pragma unroll
    for (int db = 0; db < 8; ++db) acc[db] = (f32x4){0.f, 0.f, 0.f, 0.f};
    for (int ks = 0; ks <= (w >> 1); ++ks) { const bf16x8 a = frag_row(F.lds + T0, 16 * w, ks, lane);
#pragma unroll
        for (int db = 0; db < 8; ++db) { const bf16x8 bb = frag_tr(F.lds + T1, db, ks, lane); acc[db] = MFMA16(a, bb, acc[db]); } }
    float ssq[4] = {0.f, 0.f, 0.f, 0.f}; float ogv[8];
#pragma unroll
    for (int db = 0; db < 8; ++db) ogv[db] = og[g * 128 + 16 * db + (lane & 15)];
#pragma unroll
    for (int rg = 0; rg < 4; ++rg) { int t = 16 * w + 4 * (lane >> 4) + rg; const float bs = bsp[g * 128 + t]; asm volatile("" : "+v"(t));
#pragma unroll
        for (int db = 0; db < 8; ++db) { const int d = 16 * db + (lane & 15);
            const float gu = bf2f(*(const LAS unsigned short*)(F.lds + T2 + off_b(t, d >> 3) + 2 * (d & 7)));
            const float val = (acc[db][rg] + bs) * gu; ssq[rg] += val * val;
            *(LAS unsigned short*)(F.lds + T3 + off_b(t, d >> 3) + 2 * (d & 7)) = (unsigned short)(pk2(val * ogv[db], 0.f) & 0xffffu); } }
#pragma unroll
    for (int i = 0; i < 4; ++i) { const int id = lane + 64 * i, r = id >> 4, ch = id & 15, t = 16 * w + r;
        *(u32x4*)(MIX + (size_t)(row0 + t) * 1024 + 512 + g * 128 + 8 * ch) = *(const LAS u32x4*)(F.lds + T3 + off_b(t, ch)); }
#pragma unroll
    for (int rg = 0; rg < 4; ++rg) { float q = ssq[rg]; q += __shfl_xor(q, 1); q += __shfl_xor(q, 2); q += __shfl_xor(q, 4); q += __shfl_xor(q, 8);
        if ((lane & 15) == 0) PSSQ[(size_t)g * 16384 + row0 + 16 * w + 4 * (lane >> 4) + rg] = q; }
    __syncthreads();
    SEC_END(F, 22);
    F0.tsec = F.tsec;
}

__device__ __forceinline__ void phase_scan(const Frame& F) {
    const float* CLOC = (const float*)(F.ws + WS_CLOC); float* MLOC = (float*)(F.ws + WS_SMALL); float* BLAST = MLOC + 512; float* MPREV = MLOC + 1024;
    float* NLOC = MLOC + 2048; float* NPREV = NLOC + 512 * 128; bf16* CPREV = (bf16*)(F.ws + WS_CPREV);
    LAS float* av = (LAS float*)(F.lds + VEC_OFF); LAS float* cv = av + 64;
    const int wg = F.vcu, bh = wg >> 5;
    if (F.wave == 0) { const int l = F.lane; const float ml = MLOC[bh * 64 + l], bl = BLAST[bh * 64 + l];
        float m = 0.f, mym = 0.f, mynext = 0.f;
        for (int c = 0; c < 64; ++c) { const float mlc = __shfl(ml, c), blc = __shfl(bl, c); const float mn = fmaxf(blc + m, mlc); if (l == c) { mym = m; mynext = mn; } m = mn; }
        av[l] = fexp(bl + mym - mynext); cv[l] = fexp(ml - mynext);
        if ((wg & 31) == 0) MPREV[bh * 64 + l] = mym; }
    __syncthreads();
    if (F.tid < 256) { const int p = (wg & 31) * 256 + F.tid; float v0 = 0.f, v1 = 0.f;
        const float* src = CLOC + (size_t)(bh * 64) * 16384 + 2 * p; bf16* dst = CPREV + (size_t)(bh * 64) * 16384 + 2 * p;
#pragma unroll 8
        for (int c = 0; c < 64; ++c) { const float2 x = *(const float2*)(src + (size_t)c * 16384);
            *(unsigned*)(dst + (size_t)c * 16384) = pk2(v0, v1);
            const float a = av[c], cc = cv[c]; v0 = a * v0 + cc * x.x; v1 = a * v1 + cc * x.y; } }
    else if (F.tid < 320 && (wg & 31) == 0) { const int p = F.tid - 256; float v0 = 0.f, v1 = 0.f;
        for (int c = 0; c < 64; ++c) { const float2 x = *(const float2*)(NLOC + (size_t)(bh * 64 + c) * 128 + 2 * p);
            *(float2*)(NPREV + (size_t)(bh * 64 + c) * 128 + 2 * p) = make_float2(v0, v1);
            const float a = av[c], cc = cv[c]; v0 = a * v0 + cc * x.x; v1 = a * v1 + cc * x.y; } }
    __syncthreads();
}

__device__ __forceinline__ void mlstm_out_unit(Frame& F0, int u) {
    Frame F = F0; asm volatile("" : "+v"(F.tid), "+v"(F.lane));
    const int c = u & 63, h = (u >> 6) & 3, b = u >> 8, row0 = b * 8192 + c * 128;
    const bf16* PROJ = (const bf16*)(F.ws + WS_PROJ); const float* GATES = (const float*)(F.ws + WS_GATES); const float* conv = F.in[3]; const float* ngain = F.in[6];
    const float* MPREV = (const float*)(F.ws + WS_SMALL) + 1024; const float* NPREV = (const float*)(F.ws + WS_SMALL) + 2048 + 512 * 128;
    const bf16* CPREV = (const bf16*)(F.ws + WS_CPREV); bf16* MIX = (bf16*)(F.ws + WS_MIX);
    LAS float* colc = (LAS float*)(F.lds + VEC_OFF); LAS float* rowc = colc + 128; LAS float* inter = rowc + 128; LAS float* emn = inter + 128; LAS float* rdn = emn + 128;
    LAS float* npv = rdn + 128; LAS float* cw = npv + 128;
    const int w = F.wave, lane = F.lane;
    SEC_BEGIN(F, 30);
#pragma unroll
    for (int j = 0; j < 8; ++j) { const int i = lane + 64 * j; cw[i] = conv[(i >> 7) * 1024 + h * 128 + (i & 127)]; }
    npv[lane] = NPREV[(size_t)u * 128 + lane]; npv[64 + lane] = NPREV[(size_t)u * 128 + 64 + lane];
    { const int l = lane, s0 = 2 * l, s1 = s0 + 1;
        const float li0 = GATES[(size_t)(row0 + s0) * 8 + h], li1 = GATES[(size_t)(row0 + s1) * 8 + h], lf0 = GATES[(size_t)(row0 + s0) * 8 + 4 + h], lf1 = GATES[(size_t)(row0 + s1) * 8 + 4 + h];
        const float inc = wscan_add(lf0 + lf1, l), b1 = inc, b0 = inc - lf1;
        const float c0 = li0 - b0, c1 = li1 - b1;
        const float pmx = wscan_max(fmaxf(c0, c1), l); float pprev = __shfl_up(pmx, 1); if (l == 0) pprev = -INFINITY;
        const float pm0 = fmaxf(pprev, c0), pm1 = pmx, mprev = MPREV[u];
        const float m0 = b0 + fmaxf(mprev, pm0), m1 = b1 + fmaxf(mprev, pm1);
        colc[s0] = c0; colc[s1] = c1; rowc[s0] = b0 - m0; rowc[s1] = b1 - m1;
        inter[s0] = fexp(b0 + mprev - m0); inter[s1] = fexp(b1 + mprev - m1); emn[s0] = fexp(-m0); emn[s1] = fexp(-m1); }
    SEC_END(F, 30); SEC_BEGIN(F, 31);
    { u32x4 qv[4]; stage_conv(F, F.lds + T0, PROJ + (size_t)row0 * PROJ_LD + QO + h * 128, cw, c * 128, 1.0f, qv); }
    stage_tile<false>(F, F.lds + T1, (const bf16*)(F.ws + WS_KC) + (size_t)row0 * 512 + h * 128, 512, nullptr);
    stage_tile<false>(F, F.lds + T2, PROJ + (size_t)row0 * PROJ_LD + VO + h * 128, PROJ_LD, nullptr);
    stage_tile<false>(F, F.lds + T3, CPREV + (size_t)u * 16384, 128, nullptr);
    __syncthreads();
    SEC_END(F, 31); SEC_BEGIN(F, 32);
    const int t = 16 * w + (lane & 15);
    u32x2 wpk[8]; float rsum = 0.f;
    { const float rc = rowc[t];
#pragma unroll
      for (int sb = 0; sb < 8; ++sb) { wpk[sb] = (u32x2){0u, 0u};
          if (sb <= w) { f32x4 a4 = (f32x4){0.f, 0.f, 0.f, 0.f};
#pragma unroll
              for (int ks = 0; ks < 4; ++ks) { const bf16x8 a = frag_row(F.lds + T1, 16 * sb, ks, lane), bb = frag_row(F.lds + T0, 16 * w, ks, lane); a4 = MFMA16(a, bb, a4); }
              float wv4[4];
#pragma unroll
              for (int rg = 0; rg < 4; ++rg) { const int s = 16 * sb + 4 * (lane >> 4) + rg; const float e = fexp(rc + colc[s]) * a4[rg]; wv4[rg] = (s <= t) ? e : 0.f; }
              wpk[sb].x = pk2(wv4[0], wv4[1]); wpk[sb].y = pk2(wv4[2], wv4[3]);
              rsum += bf2f((unsigned short)(wpk[sb].x & 0xffffu)) + bf2f((unsigned short)(wpk[sb].x >> 16)) + bf2f((unsigned short)(wpk[sb].y & 0xffffu)) + bf2f((unsigned short)(wpk[sb].y >> 16)); } } }
    __syncthreads();
    SEC_END(F, 32); SEC_BEGIN(F, 33);
    { int t2 = t; asm volatile("" : "+v"(t2));
#pragma unroll
    for (int sb = 0; sb < 8; ++sb) if (sb <= (w | 1)) *(LAS u32x2*)(F.lds + T1 + off_b(t2, 2 * sb + (lane >> 5)) + 8 * ((lane >> 4) & 1)) = wpk[sb]; }
    rsum += __shfl_xor(rsum, 16); rsum += __shfl_xor(rsum, 32);
    { float qn = 0.f; const int part = lane >> 4;
#pragma unroll
      for (int i = 0; i < 4; ++i) { float f[8]; unpack8(*(const LAS u32x4*)(F.lds + T0 + off_b(t, 4 * part + i)), f);
#pragma unroll
          for (int k = 0; k < 8; ++k) qn += f[k] * npv[32 * part + 8 * i + k]; }
      qn += __shfl_xor(qn, 16); qn += __shfl_xor(qn, 32);
      const float den = rsum + inter[t] * qn;
      if (lane < 16) rdn[t] = 1.0f / fmaxf(fabsf(den), emn[t]); }
    f32x4 acc[8];
#pragma unroll
    for (int vb = 0; vb < 8; ++vb) acc[vb] = (f32x4){0.f, 0.f, 0.f, 0.f};
#pragma unroll
    for (int ks = 0; ks < 4; ++ks) { const bf16x8 a = frag_row(F.lds + T0, 16 * w, ks, lane);
#pragma unroll
        for (int vb = 0; vb < 8; ++vb) { const bf16x8 bb = frag_row(F.lds + T3, 16 * vb, ks, lane); acc[vb] = MFMA16(a, bb, acc[vb]); } }
    float it4[4], rd4[4];
#pragma unroll
    for (int rg = 0; rg < 4; ++rg) { const int tr = 16 * w + 4 * (lane >> 4) + rg; it4[rg] = inter[tr]; rd4[rg] = rdn[tr]; }
#pragma unroll
    for (int vb = 0; vb < 8; ++vb)
#pragma unroll
        for (int rg = 0; rg < 4; ++rg) acc[vb][rg] *= it4[rg];
    for (int ks = 0; ks <= (w >> 1); ++ks) { const bf16x8 a = frag_row(F.lds + T1, 16 * w, ks, lane);
#pragma unroll
        for (int vb = 0; vb < 8; ++vb) { const bf16x8 bb = frag_tr(F.lds + T2, vb, ks, lane); acc[vb] = MFMA16(a, bb, acc[vb]); } }
    SEC_END(F, 33); SEC_BEGIN(F, 34);
#pragma unroll
    for (int rg = 0; rg < 4; ++rg) { float s = 0.f;
#pragma unroll
        for (int vb = 0; vb < 8; ++vb) { acc[vb][rg] *= rd4[rg]; s += acc[vb][rg]; }
        s += __shfl_xor(s, 1); s += __shfl_xor(s, 2); s += __shfl_xor(s, 4); s += __shfl_xor(s, 8);
        const float mean = s * (1.0f / 128.0f); float q = 0.f;
#pragma unroll
        for (int vb = 0; vb < 8; ++vb) { acc[vb][rg] -= mean; q += acc[vb][rg] * acc[vb][rg]; }
        q += __shfl_xor(q, 1); q += __shfl_xor(q, 2); q += __shfl_xor(q, 4); q += __shfl_xor(q, 8);
        const float rstd = 1.0f / sqrtf(q * (1.0f / 128.0f) + 1e-6f);
#pragma unroll
        for (int vb = 0; vb < 8; ++vb) acc[vb][rg] *= rstd; }
#pragma unroll
    for (int vb = 0; vb < 8; ++vb) { const int d = 16 * vb + (lane & 15); const float gg = ngain[h * 128 + d];
#pragma unroll
        for (int rg = 0; rg < 4; ++rg) { int tr = 16 * w + 4 * (lane >> 4) + rg; asm volatile("" : "+v"(tr));
            *(LAS unsigned short*)(F.lds + T1 + off_b(tr, d >> 3) + 2 * (d & 7)) = (unsigned short)(pk2(acc[vb][rg] * gg, 0.f) & 0xffffu); } }
#pragma unroll
    for (int i = 0; i < 4; ++i) { const int id = lane + 64 * i, r = id >> 4, ch = id & 15, tr = 16 * w + r;
        float y[8], o[8]; unpack8(*(const LAS u32x4*)(F.lds + T1 + off_b(tr, ch)), y);
        unpack8(*(const u32x4*)(PROJ + (size_t)(row0 + tr) * PROJ_LD + OO + h * 128 + 8 * ch), o);
#pragma unroll
        for (int k = 0; k < 8; ++k) y[k] *= o[k];
        *(u32x4*)(MIX + (size_t)(row0 + tr) * 1024 + h * 128 + 8 * ch) = pack8(y); }
    { const float* RSG = (const float*)(F.ws + WS_RSG);
#pragma unroll
      for (int i = 0; i < 4; ++i) { const int id = lane + 64 * i, r = id >> 4, ch = id & 15, tr = 16 * w + r;
          bf16* p = MIX + (size_t)(row0 + tr) * 1024 + 512 + h * 128 + 8 * ch; float y[8]; unpack8(*(const u32x4*)p, y);
          const float rs = 1.0f / sqrtf(((RSG[row0 + tr] + RSG[16384 + row0 + tr]) + (RSG[32768 + row0 + tr] + RSG[49152 + row0 + tr])) * (1.0f / 512.0f) + 1e-6f);
#pragma unroll
          for (int kk = 0; kk < 8; ++kk) y[kk] *= rs;
          *(u32x4*)p = pack8(y); } }
    __syncthreads();
    SEC_END(F, 34);
    F0.tsec = F.tsec;
}

__device__ __forceinline__ void phase_router(Frame& F) {
    const float* H = (const float*)(F.ws + WS_H); const float* g2 = F.in[12]; const float* br = F.in[14];
    const bf16* WrThi = (const bf16*)(F.ws + WS_WRT); const bf16* WrTlo = WrThi + 32 * 1024;
    bf16* HN = (bf16*)(F.ws + WS_XN); int* cnt = (int*)(F.ws + WS_CTL) + CW_CNT; int* tokidx = (int*)(F.ws + WS_TOKIDX); float* gatex = (float*)(F.ws + WS_GATEX); float* rsx = (float*)(F.ws + WS_RSX);
    lptr ihi = F.lds, ilo = F.lds + 32 * IMG_ROW;
    LAS float* lg = (LAS float*)(F.lds + 2 * 32 * IMG_ROW);
    LAS int* hist = (LAS int*)(lg + 2048); LAS int* base = hist + 32;
    SEC_BEGIN(F, 4);
    for (int i = F.tid; i < 32 * 128; i += NTHR) { const int n = i >> 7, ch = i & 127;
        *(LAS u32x4*)(ihi + n * IMG_ROW + 16 * ch) = *(const u32x4*)(WrThi + (size_t)n * 1024 + 8 * ch);
        *(LAS u32x4*)(ilo + n * IMG_ROW + 16 * ch) = *(const u32x4*)(WrTlo + (size_t)n * 1024 + 8 * ch); }
    if (F.tid < 32) hist[F.tid] = 0;
    __syncthreads();
    SEC_END(F, 4); SEC_BEGIN(F, 5);
    const int tok0 = F.vcu * 64 + (F.wave & 3) * 16, lane = F.lane;
    int be[4] = {0, 0, 0, 0}, lr[4] = {0, 0, 0, 0}; float gt[4] = {0.f, 0.f, 0.f, 0.f}; float rstd = 0.f;
    if (F.wave >= 4) {
        const float* w_dn = F.in[17]; char* WdnT = (char*)(F.ws + WS_WDNT);
        const int cw = F.vcu * 4 + (F.wave - 4), NCW = F.G * 4;
#pragma unroll 1
        for (int j = 0; j < (32 * 16 * 32) / 1024; j += 2) { P0Item it[2]; f32x4 v[2][8];
#pragma unroll
            for (int q = 0; q < 2; ++q) { const int r = cw + (j + q) * NCW, e = r / 512, qq = r % 512, kb = qq / 32, nb = qq % 32;
                it[q].src = w_dn + ((size_t)e * 1024 + 64 * kb) * 1024 + 32 * nb; it[q].ld = 1024; it[q].esz = MOE_ESZ; it[q].dst = WdnT + (((size_t)e * 1024 + 32 * nb) * 1024 + 64 * kb) * MOE_ESZ;
                p0_load(it[q], lane, v[q]); }
#pragma unroll
            for (int q = 0; q < 2; ++q) p0_store(it[q], lane, v[q]); } }
    if (F.wave < 4) {
        f32x4 acc[2];
        rstd = row_pass<2, MOE_FP8 != 0>(H, g2, HN, ihi, ilo, tok0, lane, acc);
        { float rr[4];
#pragma unroll
          for (int rg = 0; rg < 4; ++rg) rr[rg] = __shfl(rstd, 4 * (lane >> 4) + rg);
#pragma unroll
          for (int nf = 0; nf < 2; ++nf)
#pragma unroll
              for (int rg = 0; rg < 4; ++rg) lg[(F.wave * 16 + 4 * (lane >> 4) + rg) * 32 + 16 * nf + (lane & 15)] = acc[nf][rg] * rr[rg]; }
        if (lane < 16) { float v[32];
#pragma unroll
            for (int q4 = 0; q4 < 8; ++q4) { const f32x4 x = *(const LAS f32x4*)(lg + (F.wave * 16 + lane) * 32 + 4 * q4), bb = *(const f32x4*)(br + 4 * q4);
                v[4 * q4] = x[0] + bb[0]; v[4 * q4 + 1] = x[1] + bb[1]; v[4 * q4 + 2] = x[2] + bb[2]; v[4 * q4 + 3] = x[3] + bb[3]; }
            float bv[4];
#pragma unroll
            for (int k = 0; k < 4; ++k) { float best = -INFINITY; int bi = 0;
#pragma unroll
                for (int e = 0; e < 32; ++e) if (v[e] > best) { best = v[e]; bi = e; }
                be[k] = bi; bv[k] = best;
#pragma unroll
                for (int e = 0; e < 32; ++e) v[e] = (e == bi) ? -INFINITY : v[e]; }
            float den = 0.f;
#pragma unroll
            for (int k = 0; k < 4; ++k) { gt[k] = fexp(bv[k] - bv[0]); den += gt[k]; }
            const float rd = 1.0f / den;
#pragma unroll
            for (int k = 0; k < 4; ++k) { gt[k] *= rd; lr[k] = __hip_atomic_fetch_add(hist + be[k], 1, __ATOMIC_RELAXED, __HIP_MEMORY_SCOPE_WORKGROUP); } } }
    SEC_END(F, 5); SEC_BEGIN(F, 6);
    __syncthreads();
    if (F.tid < 32) base[F.tid] = hist[F.tid] > 0 ? atomicAdd(&cnt[F.tid], hist[F.tid]) : 0;
    __syncthreads();
    if (F.wave < 4 && lane < 16) { const int tok = tok0 + lane;
#pragma unroll
        for (int k = 0; k < 4; ++k) { const int rk = base[be[k]] + lr[k]; const size_t p = (size_t)be[k] * 65536 + rk; tokidx[p] = tok * 4 + k; gatex[p] = gt[k]; rsx[p] = rstd; } }
    __syncthreads();
    SEC_END(F, 6);
}

__device__ __forceinline__ int build_ttab(const Frame& F) {
    const int* cnt = (const int*)(F.ws + WS_CTL) + CW_CNT; LAS unsigned* ttab = (LAS unsigned*)(F.lds + TTAB_OFF); LAS int* tot = (LAS int*)(F.lds + MISC_OFF + 64);
    if (F.wave == 0) { const int l = F.lane; const int c = l < 32 ? __hip_atomic_load(cnt + l, RLX_AGENT) : 0; const int nt = (c + 255) >> 8;
        int inc = nt;
#pragma unroll
        for (int o = 1; o < 64; o <<= 1) { const int tt = __shfl_up(inc, o); if (l >= o) inc += tt; }
        const int start = inc - nt;
        for (int r = 0; r < nt; ++r) { const int left = c - 256 * r; ttab[start + r] = (unsigned)l | ((unsigned)r << 5) | ((unsigned)((left < 256 ? left : 256) - 1) << 14); }
        if (l == 63) tot[0] = inc; }
    __syncthreads();
    return tot[0];
}

__device__ __forceinline__ void phase_final(const Frame& F) {
    const float* H = (const float*)(F.ws + WS_H); const bf16* Y = (const bf16*)(F.ws + WS_Y); const float* gf = F.in[19];
    const int gw = F.vcu * NWAVES + F.wave, lane = F.lane;
    f32x4 gg[4];
#pragma unroll
    for (int j = 0; j < 4; ++j) gg[j] = *(const f32x4*)(gf + 4 * (lane + 64 * j));
#pragma unroll 1
    for (int i = 0; i < 8; i += 2) { const int tok = gw * 8 + i;
        f32x4 v[2][4]; u32x2 y[2][4][4];
#pragma unroll
        for (int q = 0; q < 2; ++q)
#pragma unroll
            for (int j = 0; j < 4; ++j) { v[q][j] = __builtin_nontemporal_load((const f32x4*)(H + (size_t)(tok + q) * 1024 + 4 * (lane + 64 * j)));
#pragma unroll
                for (int k = 0; k < 4; ++k) y[q][j][k] = __builtin_nontemporal_load((const u32x2*)(Y + (size_t)((tok + q) * 4 + k) * 1024 + 4 * (lane + 64 * j))); }
#pragma unroll
        for (int q = 0; q < 2; ++q) { float s = 0.f;
#pragma unroll
            for (int j = 0; j < 4; ++j) {
#pragma unroll
                for (int k = 0; k < 4; ++k) { const u32x2 yy = y[q][j][k];
                    v[q][j][0] += __builtin_bit_cast(float, yy.x << 16); v[q][j][1] += __builtin_bit_cast(float, yy.x & 0xffff0000u);
                    v[q][j][2] += __builtin_bit_cast(float, yy.y << 16); v[q][j][3] += __builtin_bit_cast(float, yy.y & 0xffff0000u); }
                s += (v[q][j][0] * v[q][j][0] + v[q][j][1] * v[q][j][1]) + (v[q][j][2] * v[q][j][2] + v[q][j][3] * v[q][j][3]); }
            const float r = 1.0f / sqrtf(wsum_all(s) * (1.0f / 1024.0f) + 1e-6f);
#pragma unroll
            for (int j = 0; j < 4; ++j) __builtin_nontemporal_store(v[q][j] * r * gg[j], (f32x4*)(F.out + (size_t)(tok + q) * 1024 + 4 * (lane + 64 * j))); } }
}

constexpr int N_PHASES = 10;
struct Args { const float* in[20]; float* out; unsigned char* ws; int ph_lo, ph_hi; };
__global__ void __launch_bounds__(NTHR, 2) mk_fwd(Args args) {
    extern __shared__ __attribute__((aligned(16))) unsigned char lds_raw[];
    Frame F; F.t0 = 0ull; F.tsec = 0ull;
    F.lds = (lptr)lds_raw; F.tid = threadIdx.x; F.lane = F.tid & 63; F.wave = __builtin_amdgcn_readfirstlane(F.tid >> 6);
    F.G = gridDim.x; { const int bx = blockIdx.x; F.vcu = (F.G % 8 == 0) ? (bx % 8) * (F.G / 8) + bx / 8 : bx; }
#pragma unroll
    for (int i = 0; i < 20; ++i) F.in[i] = args.in[i];
    F.out = args.out; F.ws = args.ws;
    for (int u = F.tid; u < (LDS_BYTES - CTL_OFF) / 4; u += NTHR) ((LAS unsigned*)(F.lds + CTL_OFF))[u] = 0u;
    __syncthreads();
    XcdBarrier bar = xcd_barrier_post((unsigned*)(F.ws + WS_CTL) + CW_BAR, (volatile LAS unsigned*)(F.lds + MISC_OFF));
    const int lo = args.ph_lo, hi = args.ph_hi;
#define IN(k) (lo <= (k) && (k) < hi)
#ifndef PROBE_LO
#define PROBE_LO -1
#define PROBE_HI -1
#endif
    unsigned long long tp0 = 0ull;
#define SEAM(k) do { if (IN(k) && IN((k) + 1)) xcd_barrier(bar); \
        if (PROBE_HI == (k) + 1) { const unsigned long long tn = __builtin_amdgcn_s_memrealtime(), dt = tn - tp0; while (__builtin_amdgcn_s_memrealtime() - tn < dt) __builtin_amdgcn_s_sleep(8); __syncthreads(); } \
        if (PROBE_LO == (k) + 1) tp0 = __builtin_amdgcn_s_memrealtime(); } while (0)
    const int bx = blockIdx.x;
    if (PROBE_LO == 0) tp0 = __builtin_amdgcn_s_memrealtime();
    if (IN(0)) { phase0(F); } SEAM(0);
    if (IN(1)) { pg8::DenseOps ops{(const bf16*)(F.ws + WS_XN), (const bf16*)(F.ws + WS_WINT), 1024}; pg8::StaticOrder S; S.init(64, 12, F.G, bx, 4);
        pg8::EpiProj E{(bf16*)(F.ws + WS_PROJ), PROJ_LD, (const float*)(F.ws + WS_RS1)};
        pg8::gemm_phase<pg8::EpiProj, pg8::StaticOrder, pg8::DenseOps, false, true>(F.lds, 1024, S, ops, E); } SEAM(1);
    if (IN(2)) {
#pragma unroll 1
        for (int j = 0; j < 2; ++j) mlstm_local_unit(F, F.vcu * 2 + j);
#pragma unroll 1
        for (int j = 0; j < 2; ++j) gmlp_unit(F, F.vcu * 2 + j); } SEAM(2);
    if (IN(3)) { phase_scan(F); } SEAM(3);
    if (IN(4)) {
#pragma unroll 1
        for (int j = 0; j < 2; ++j) mlstm_out_unit(F, F.vcu * 2 + j); } SEAM(4);
    if (IN(5)) { pg8::DenseOps ops{(const bf16*)(F.ws + WS_MIX), (const bf16*)(F.ws + WS_WOUTT), 1024}; pg8::StaticOrder S; S.init(64, 4, F.G, bx);
        pg8::EpiRes E{F.in[0], (float*)(F.ws + WS_H), 1024};
        pg8::gemm_phase<pg8::EpiRes, pg8::StaticOrder, pg8::DenseOps, false, false>(F.lds, 1024, S, ops, E); } SEAM(5);
    if (IN(6)) { phase_router(F); } SEAM(6);
    if (IN(7)) { const int nM = build_ttab(F);
        pg8::UpOps ops{F.ws + WS_XN, F.ws + WS_WUPT, (const int*)(F.ws + WS_TOKIDX), 1024u * MOE_ESZ};
        pg8::MoeOrder S; S.init(nM, 8, F.G, bx, 4); S.ttab = (const LAS unsigned*)(F.lds + TTAB_OFF);
        pg8::EpiUp<MOE_FP8 != 0> E{F.ws + WS_ACT, F.in[16], (const float*)(F.ws + WS_RSX), MOE_FP8 ? 1.0f / W8_SCALE : 1.0f};
        pg8::gemm_phase<pg8::EpiUp<MOE_FP8 != 0>, pg8::MoeOrder, pg8::UpOps, true, true, MOE_FP8 != 0>(F.lds, 512 * MOE_ESZ, S, ops, E); } SEAM(7);
    if (IN(8)) { const int nM = build_ttab(F);
        pg8::DownOps ops{F.ws + WS_ACT, F.ws + WS_WDNT, 1024u * MOE_ESZ};
        pg8::MoeOrder S; S.init(nM, 4, F.G, bx); S.ttab = (const LAS unsigned*)(F.lds + TTAB_OFF);
        pg8::EpiDown E{(bf16*)(F.ws + WS_Y), F.in[18], (const float*)(F.ws + WS_GATEX), (const int*)(F.ws + WS_TOKIDX), MOE_FP8 ? 1.0f / W8_SCALE : 1.0f};
        pg8::gemm_phase<pg8::EpiDown, pg8::MoeOrder, pg8::DownOps, false, true, MOE_FP8 != 0>(F.lds, 512 * MOE_ESZ, S, ops, E); } SEAM(8);
    if (IN(9)) { phase_final(F); } SEAM(9);
    if (PROBE_SEC >= 0) { const unsigned long long tn = __builtin_amdgcn_s_memrealtime(); while (__builtin_amdgcn_s_memrealtime() - tn < F.tsec) __builtin_amdgcn_s_sleep(8); }
#undef IN
#undef SEAM
}

extern "C" void kernel_launch(void* const* d_in, const int* in_sizes, int n_in, void* d_out, int out_size, void* d_ws, size_t ws_size, hipStream_t stream) {
    static int ready = 0;
    if (!ready) {
        if (hipFuncSetAttribute((const void*)mk_fwd, hipFuncAttributeMaxDynamicSharedMemorySize, LDS_BYTES) != hipSuccess) { fprintf(stderr, "hipFuncSetAttribute failed\n"); return; }
        ready = 1;
    }
    char* ws = (char*)d_ws;
    if (ws_size < 800 * MiB) { fprintf(stderr, "ws too small: %zu\n", ws_size); return; }
    (void)hipMemsetAsync(ws + WS_CTL, 0, CTL_ZERO_BYTES, stream);
    Args a{};
    for (int i = 0; i < 20; ++i) a.in[i] = (const float*)d_in[i];
    a.out = (float*)d_out; a.ws = (unsigned char*)d_ws; a.ph_lo = 0; a.ph_hi = N_PHASES;
    hipLaunchKernelGGL(mk_fwd, dim3(256), dim3(NTHR), LDS_BYTES, stream, a);
}
```

```cpp
#include <hip/hip_runtime.h>
#include <cstdio>
#include <cstdint>
#include <cstddef>
#include <cmath>


namespace pg8 {
#define PG8_LAS __attribute__((address_space(3)))
typedef unsigned short bf16_t;
typedef short bf16x8 __attribute__((ext_vector_type(8)));
typedef float f32x4 __attribute__((ext_vector_type(4)));
typedef float f32x2 __attribute__((ext_vector_type(2)));
typedef unsigned u32x4 __attribute__((ext_vector_type(4)));
typedef unsigned u32x2 __attribute__((ext_vector_type(2)));
typedef int i32x4 __attribute__((ext_vector_type(4)));
typedef int i32x8 __attribute__((ext_vector_type(8)));
constexpr int BM = 256, BK = 64, HALF = 128, HTB = HALF * BK * 2, STAGE_BYTES = 8 * HTB, NXCD = 8, WGM = 8;

__host__ __device__ __forceinline__ int lds_byte(int r, int c) { const int st = (r >> 4) * 2 + (c >> 5), rr = r & 15, cc = c & 31, ob = rr * 64 + cc * 2; return st * 1024 + (ob ^ (((ob >> 9) & 1) << 5)); }
__host__ __device__ __forceinline__ void stage_rc(int b, int& R, int& C) { const int st = b / 1024, sb = b % 1024, swz = sb ^ (((sb >> 9) & 1) << 5); R = (st >> 1) * 16 + swz / 64; C = (st & 1) * 32 + (swz % 64) / 2; }
__host__ __device__ __forceinline__ int perm32(int rho) { const int n = rho >> 4, i = rho & 15; return 8 * (i >> 2) + 4 * n + (i & 3); }

struct Unit { int pm, pn, e, rt, nrows; };

struct StaticOrder {
    int nM, nN, nwg, G, c, wgm;
    __device__ void init(int nM_, int nN_, int G_, int c_, int wgm_ = WGM) { nM = nM_; nN = nN_; nwg = nM * nN; G = G_; c = c_; wgm = wgm_; }
    __device__ bool next(int i, Unit& u) const {
        const long L = (long)i * G + c; if (L >= nwg) return false;
        int wgid = (int)L; { const int q = nwg / NXCD, r = nwg % NXCD, xcd = wgid % NXCD, off = wgid / NXCD; wgid = (xcd < r ? xcd * (q + 1) : r * (q + 1) + (xcd - r) * q) + off; }
        const int nig = wgm * nN, gid = wgid / nig, fm = gid * wgm, gsz = (nM - fm) < wgm ? (nM - fm) : wgm;
        u.pm = fm + ((wgid % nig) % gsz); u.pn = (wgid % nig) / gsz; u.e = 0; u.rt = 0; u.nrows = 256; return true;
    }
};
struct MoeOrder : StaticOrder {
    const PG8_LAS unsigned* ttab;
    __device__ bool next(int i, Unit& u) const {
        if (!StaticOrder::next(i, u)) return false;
        const unsigned w = ttab[u.pm]; u.e = (int)(w & 31u); u.rt = (int)((w >> 5) & 511u); u.nrows = (int)((w >> 14) & 255u) + 1; return true;
    }
};

__device__ __forceinline__ unsigned cvt_pk_bf16(float lo, float hi) { unsigned r; asm volatile("v_cvt_pk_bf16_f32 %0, %1, %2" : "=v"(r) : "v"(lo), "v"(hi)); return r; }

struct DenseOps {
    const bf16_t* A; const bf16_t* Bt; int K;
    __device__ __forceinline__ const char* a_base(const Unit& u) const { return (const char*)A + (size_t)u.pm * BM * K * 2; }
    __device__ __forceinline__ const char* b_base(const Unit& u) const { return (const char*)Bt + (size_t)u.pn * BM * K * 2; }
    __device__ __forceinline__ void gather(const Unit&, const int (&)[2], const int (&)[2], unsigned (&)[2][2]) const {}
};
struct UpOps {
    const void* HN; const void* WupT; const int* tokidx; unsigned pitch;
    __device__ __forceinline__ const char* a_base(const Unit&) const { return (const char*)HN; }
    __device__ __forceinline__ const char* b_base(const Unit& u) const { return (const char*)WupT + ((size_t)u.e * 2048 + (size_t)u.pn * BM) * pitch; }
    __device__ __forceinline__ void gather(const Unit& u, const int (&R)[2], const int (&C)[2], unsigned (&v)[2][2]) const {
        const int* tl = tokidx + (size_t)u.e * 65536 + u.rt * 256;
#pragma unroll
        for (int h = 0; h < 2; ++h)
#pragma unroll
            for (int i = 0; i < 2; ++i) { const int r = R[i] + 128 * h; const int idx = tl[r < u.nrows ? r : 0]; v[h][i] = (unsigned)(idx >> 2) * pitch + (unsigned)C[i] * 2u; }
    }
};
struct DownOps {
    const void* ACT; const void* WdnT; unsigned pitch;
    __device__ __forceinline__ const char* a_base(const Unit& u) const { return (const char*)ACT + (size_t)u.pm * BM * pitch; }
    __device__ __forceinline__ const char* b_base(const Unit& u) const { return (const char*)WdnT + ((size_t)u.e * 1024 + (size_t)u.pn * BM) * pitch; }
    __device__ __forceinline__ void gather(const Unit&, const int (&)[2], const int (&)[2], unsigned (&)[2][2]) const {}
};
__device__ __forceinline__ unsigned pk4_fp8(float a, float b, float c, float d) { int r = __builtin_amdgcn_cvt_pk_fp8_f32(a, b, 0, false); r = __builtin_amdgcn_cvt_pk_fp8_f32(c, d, r, true); return (unsigned)r; }

struct EpiProj {
    static constexpr bool PERM = true;
    bf16_t* O; int ldc; const float* rs;
    static __device__ __forceinline__ float sigm(float x) { return __builtin_amdgcn_rcpf(1.0f + __builtin_amdgcn_exp2f(-1.4426950408889634f * x)); }
    static __device__ __forceinline__ float act(float x, int mode) {
        if (mode == 1) return sigm(x);
        if (mode == 2) return x * sigm(1.5957691216057308f * (x + 0.044715f * x * x * x));
        return x; }
    __device__ __forceinline__ void operator()(const f32x4 (&acc)[2][2][4][2], const Unit& u, int wr, int wc, int fr, int fq) const {
        const int row0 = u.pm * BM + wr * 64 + fr, col0 = u.pn * BM + wc * 32 + 8 * fq;
        const int mode = u.pn >= 8 ? 2 : (u.pn >= 6 ? 1 : 0);
        float sc[2][4];
#pragma unroll
        for (int ai = 0; ai < 2; ++ai)
#pragma unroll
            for (int m = 0; m < 4; ++m) sc[ai][m] = rs[row0 + ai * HALF + m * 16];
#pragma unroll
        for (int ai = 0; ai < 2; ++ai)
#pragma unroll
            for (int m = 0; m < 4; ++m) { bf16_t* rowp = O + (size_t)(row0 + ai * HALF + m * 16) * ldc + col0;
#pragma unroll
                for (int bj = 0; bj < 2; ++bj) { f32x4 v0 = acc[ai][bj][m][0] * sc[ai][m], v1 = acc[ai][bj][m][1] * sc[ai][m];
                    if (mode != 0) {
#pragma unroll
                        for (int i = 0; i < 4; ++i) { v0[i] = act(v0[i], mode); v1[i] = act(v1[i], mode); } }
                    u32x4 w; w.x = cvt_pk_bf16(v0[0], v0[1]); w.y = cvt_pk_bf16(v0[2], v0[3]); w.z = cvt_pk_bf16(v1[0], v1[1]); w.w = cvt_pk_bf16(v1[2], v1[3]);
                    *(u32x4*)(rowp + bj * HALF) = w; } }
    }
};
struct EpiRes {
    static constexpr bool PERM = false;
    const float* base; float* C; int ldc;
    __device__ __forceinline__ void operator()(const f32x4 (&acc)[2][2][4][2], const Unit& u, int wr, int wc, int fr, int fq) const {
        const int row0 = u.pm * BM + wr * 64 + fr, col0 = u.pn * BM + wc * 32 + 4 * fq;
#pragma unroll
        for (int ai = 0; ai < 2; ++ai)
#pragma unroll
            for (int m = 0; m < 4; ++m) { const size_t off = (size_t)(row0 + ai * HALF + m * 16) * ldc + col0;
#pragma unroll
                for (int bj = 0; bj < 2; ++bj)
#pragma unroll
                    for (int n = 0; n < 2; ++n) *(f32x4*)(C + off + bj * HALF + n * 16) = *(const f32x4*)(base + off + bj * HALF + n * 16) + acc[ai][bj][m][n]; }
    }
};
template <bool OUT8>
struct EpiUp {
    static constexpr bool PERM = true;
    void* ACT; const float* b_up; const float* rsx; float wsc;
    __device__ __forceinline__ void operator()(const f32x4 (&acc)[2][2][4][2], const Unit& u, int wr, int wc, int fr, int fq) const {
        const int r0 = wr * 64 + fr, row0 = u.pm * BM + r0, j0 = wc * 32 + 8 * fq;
        const float* bg = b_up + (size_t)u.e * 2048 + u.pn * 128 + j0;
        const float* rp = rsx + (size_t)u.e * 65536 + u.rt * 256;
        f32x4 bgl[2], bln[2]; float sc[2][4];
#pragma unroll
        for (int n = 0; n < 2; ++n) { bgl[n] = *(const f32x4*)(bg + 4 * n); bln[n] = *(const f32x4*)(bg + 1024 + 4 * n); }
#pragma unroll
        for (int ai = 0; ai < 2; ++ai)
#pragma unroll
            for (int m = 0; m < 4; ++m) { const int r = r0 + ai * HALF + m * 16; sc[ai][m] = rp[r < u.nrows ? r : 0] * wsc; }
#pragma unroll
        for (int ai = 0; ai < 2; ++ai)
#pragma unroll
            for (int m = 0; m < 4; ++m) { const size_t eoff = (size_t)(row0 + ai * HALF + m * 16) * 1024 + u.pn * 128 + j0;
                float o[8];
#pragma unroll
                for (int n = 0; n < 2; ++n) { const f32x4 g = acc[ai][0][m][n] * sc[ai][m] + bgl[n], l = acc[ai][1][m][n] * sc[ai][m] + bln[n];
#pragma unroll
                    for (int i = 0; i < 4; ++i) { const float gl = fminf(g[i], 7.0f), ln = fminf(fmaxf(l[i], -7.0f), 7.0f);
                        o[n * 4 + i] = gl * __builtin_amdgcn_rcpf(1.0f + __builtin_amdgcn_exp2f(-2.4554669595930157f * gl)) * (ln + 1.0f); } }
                if (OUT8) { u32x2 w; w.x = pk4_fp8(o[0], o[1], o[2], o[3]); w.y = pk4_fp8(o[4], o[5], o[6], o[7]); *(u32x2*)((char*)ACT + eoff) = w; }
                else { u32x4 w; w.x = cvt_pk_bf16(o[0], o[1]); w.y = cvt_pk_bf16(o[2], o[3]); w.z = cvt_pk_bf16(o[4], o[5]); w.w = cvt_pk_bf16(o[6], o[7]); *(u32x4*)((char*)ACT + 2 * eoff) = w; } }
    }
};
struct EpiDown {
    static constexpr bool PERM = true;
    bf16_t* Y; const float* b_dn; const float* gatex; const int* tokidx; float wsc;
    __device__ __forceinline__ void operator()(const f32x4 (&acc)[2][2][4][2], const Unit& u, int wr, int wc, int fr, int fq) const {
        const int r0 = wr * 64 + fr, col0 = u.pn * BM + wc * 32 + 8 * fq;
        const int* tl = tokidx + (size_t)u.e * 65536 + u.rt * 256; const float* gl = gatex + (size_t)u.e * 65536 + u.rt * 256;
        const float* bb = b_dn + (size_t)u.e * 1024 + col0;
        f32x4 bv[2][2]; int idx[2][4]; float gt[2][4];
#pragma unroll
        for (int ai = 0; ai < 2; ++ai)
#pragma unroll
            for (int m = 0; m < 4; ++m) { const int r = r0 + ai * HALF + m * 16, rr = r < u.nrows ? r : 0; idx[ai][m] = tl[rr]; gt[ai][m] = gl[rr]; }
#pragma unroll
        for (int bj = 0; bj < 2; ++bj)
#pragma unroll
            for (int n = 0; n < 2; ++n) bv[bj][n] = *(const f32x4*)(bb + bj * HALF + 4 * n);
#pragma unroll
        for (int ai = 0; ai < 2; ++ai)
#pragma unroll
            for (int m = 0; m < 4; ++m) { const int r = r0 + ai * HALF + m * 16;
                if (r < u.nrows) { bf16_t* rowp = Y + (size_t)idx[ai][m] * 1024 + col0; const float g1 = gt[ai][m];
#pragma unroll
                    for (int bj = 0; bj < 2; ++bj) { const f32x4 v0 = (acc[ai][bj][m][0] * wsc + bv[bj][0]) * g1, v1 = (acc[ai][bj][m][1] * wsc + bv[bj][1]) * g1;
                        u32x4 w; w.x = cvt_pk_bf16(v0[0], v0[1]); w.y = cvt_pk_bf16(v0[2], v0[3]); w.z = cvt_pk_bf16(v1[0], v1[1]); w.w = cvt_pk_bf16(v1[2], v1[3]);
                        *(u32x4*)(rowp + bj * HALF) = w; } } }
    }
};

#ifndef FP8_SCALE
#define FP8_SCALE 0
#endif
template <class Epi, class Sched, class Ops, bool GATHER, bool ALIGN_EPI, bool FP8 = false>
__device__ __forceinline__ void gemm_phase(PG8_LAS unsigned char* lds, const int K, const Sched& S, const Ops& O, const Epi& E) {
    const int tid = threadIdx.x, wid = __builtin_amdgcn_readfirstlane(tid >> 6), lane = tid & 63, wr = wid >> 2, wc = wid & 3, fr = lane & 15, fq = lane >> 4;
    const int nt = K / BK;
    unsigned voffA[2], voffB[2]; int sR[2], sC[2];
#pragma unroll
    for (int i = 0; i < 2; ++i) { int R, C; stage_rc(tid * 16 + i * 8192, R, C); const int Rb = Epi::PERM ? ((R & ~31) + perm32(R & 31)) : R; sR[i] = R; sC[i] = C;
        voffA[i] = (unsigned)(R * K + C) * 2u; voffB[i] = (unsigned)(Rb * K + C) * 2u; }
    const size_t kstep = (size_t)(BK * 2);
    const size_t hstep = (size_t)HALF * K * 2;
    const unsigned ldsw = (unsigned)wid * 1024u;
    const int aoff = lds_byte(wr * 64 + fr, fq * 8), boff = lds_byte(wc * 32 + fr, fq * 8);
#define PG8_SA(b, h) (((b) * 2 + (h)) * HTB)
#define PG8_SB(b, h) ((4 + (b) * 2 + (h)) * HTB)
#define PG8_STAGE(bufoff, gbase, voff) do { _Pragma("unroll") for (int _i = 0; _i < 2; ++_i) \
        __builtin_amdgcn_global_load_lds((const unsigned*)((const char*)(gbase) + (voff)[_i]), (PG8_LAS unsigned*)(lds + (bufoff) + ldsw + _i * 8192), 16, 0, 0); } while (0)
#define PG8_STAGE_AC(bufoff, kptr, h) do { if constexpr (GATHER) PG8_STAGE(bufoff, kptr, vC[h]); else PG8_STAGE(bufoff, (kptr) + (h) * hstep, voffA); } while (0)
#define PG8_STAGE_AS(bufoff, kptr, h) do { if constexpr (GATHER) PG8_STAGE(bufoff, kptr, vS[h]); else PG8_STAGE(bufoff, (kptr) + (h) * hstep, voffA); } while (0)
#define PG8_LDA(dst, b, h) do { _Pragma("unroll") for (int m = 0; m < 4; ++m) _Pragma("unroll") for (int k = 0; k < 2; ++k) dst[m][k] = *(const PG8_LAS bf16x8*)(lds + PG8_SA(b, h) + aoff + m * 2048 + k * 1024); } while (0)
#define PG8_LDB(dst, b, h) do { _Pragma("unroll") for (int n = 0; n < 2; ++n) _Pragma("unroll") for (int k = 0; k < 2; ++k) dst[n][k] = *(const PG8_LAS bf16x8*)(lds + PG8_SB(b, h) + boff + n * 2048 + k * 1024); } while (0)
#define PG8_CAT8(x) __builtin_shufflevector(__builtin_bit_cast(i32x4, (x)[0]), __builtin_bit_cast(i32x4, (x)[1]), 0, 1, 2, 3, 4, 5, 6, 7)
#define PG8_MMA(ai, bj, At, Bt) do { __builtin_amdgcn_s_setprio(1); \
        if constexpr (FP8) { _Pragma("unroll") for (int m = 0; m < 4; ++m) _Pragma("unroll") for (int n = 0; n < 2; ++n) \
            asm volatile("v_mfma_f32_16x16x128_f8f6f4 %0, %1, %2, %0" : "+v"(acc[ai][bj][m][n]) : "v"(PG8_CAT8(Bt[n])), "v"(PG8_CAT8(At[m]))); } \
        else { _Pragma("unroll") for (int m = 0; m < 4; ++m) _Pragma("unroll") for (int n = 0; n < 2; ++n) _Pragma("unroll") for (int k = 0; k < 2; ++k) \
            acc[ai][bj][m][n] = __builtin_amdgcn_mfma_f32_16x16x32_bf16(Bt[n][k], At[m][k], acc[ai][bj][m][n], 0, 0, 0); } \
        __builtin_amdgcn_s_setprio(0); } while (0)
#define PG8_WAIT_V(n) asm volatile("s_waitcnt vmcnt(" #n ")" ::: "memory")
#define PG8_WAIT_L(n) asm volatile("s_waitcnt lgkmcnt(" #n ")" ::: "memory")
#define PG8_BAR __builtin_amdgcn_s_barrier()
#define PG8_SCHED __builtin_amdgcn_sched_barrier(0)
    Unit cur, nxt; int ui = 0;
    if (!S.next(0, cur)) return;
    f32x4 acc[2][2][4][2];
#pragma unroll
    for (int a = 0; a < 2; ++a)
#pragma unroll
        for (int b = 0; b < 2; ++b)
#pragma unroll
            for (int m = 0; m < 4; ++m)
#pragma unroll
                for (int n = 0; n < 2; ++n) acc[a][b][m][n] = (f32x4){0.f, 0.f, 0.f, 0.f};
    bf16x8 At[4][2], B0[2][2], B1[2][2];
    unsigned vC[2][2] = {{0u, 0u}, {0u, 0u}}, vN[2][2] = {{0u, 0u}, {0u, 0u}}, vS[2][2] = {{0u, 0u}, {0u, 0u}};
    if constexpr (GATHER) O.gather(cur, sR, sC, vC);
    const char* cA = O.a_base(cur); const char* cB = O.b_base(cur);
    PG8_STAGE(PG8_SB(0, 0), cB, voffB); PG8_STAGE(PG8_SB(0, 1), cB + hstep, voffB); PG8_STAGE_AC(PG8_SA(0, 0), cA, 0); PG8_STAGE_AC(PG8_SA(0, 1), cA, 1);
    if (wr == 1) PG8_BAR;
    PG8_WAIT_V(2); PG8_BAR;
    PG8_STAGE(PG8_SB(1, 0), cB + kstep, voffB); PG8_STAGE_AC(PG8_SA(1, 0), cA + kstep, 0); PG8_STAGE(PG8_SB(1, 1), cB + hstep + kstep, voffB);
    PG8_WAIT_V(6); PG8_BAR;
    for (;;) {
        const bool has_next = S.next(ui + 1, nxt);
        const char* nA = has_next ? O.a_base(nxt) : cA; const char* nB = has_next ? O.b_base(nxt) : cB;
        if constexpr (GATHER) { if (has_next) O.gather(nxt, sR, sC, vN); else {
#pragma unroll
            for (int h = 0; h < 2; ++h)
#pragma unroll
                for (int i = 0; i < 2; ++i) vN[h][i] = vC[h][i]; } }
#pragma unroll 1
        for (int t = 0; t < nt; t += 2) {
            const bool last = (t == nt - 2);
            const char* a1 = cA + (size_t)(t + 1) * kstep;
            const char* a2 = last ? nA : cA + (size_t)(t + 2) * kstep; const char* b2 = last ? nB : cB + (size_t)(t + 2) * kstep;
            const char* a3 = a2 + kstep; const char* b3 = b2 + kstep;
            if constexpr (GATHER) {
#pragma unroll
                for (int h = 0; h < 2; ++h)
#pragma unroll
                    for (int i = 0; i < 2; ++i) vS[h][i] = last ? vN[h][i] : vC[h][i]; }
            PG8_LDB(B0, 0, 0); PG8_LDB(B1, 0, 1); PG8_SCHED; PG8_LDA(At, 0, 0); PG8_STAGE_AC(PG8_SA(1, 1), a1, 1);
            PG8_WAIT_V(8); PG8_WAIT_L(0); PG8_BAR; PG8_MMA(0, 0, At, B0); PG8_MMA(0, 1, At, B1); PG8_BAR; PG8_SCHED;
            PG8_LDA(At, 0, 1); PG8_STAGE(PG8_SB(0, 0), b2, voffB); PG8_STAGE(PG8_SB(0, 1), b2 + hstep, voffB); PG8_STAGE_AS(PG8_SA(0, 0), a2, 0);
            PG8_WAIT_V(8); PG8_WAIT_L(0); PG8_BAR; PG8_MMA(1, 0, At, B0); PG8_MMA(1, 1, At, B1); PG8_BAR; PG8_SCHED;
            PG8_LDB(B0, 1, 0); PG8_LDB(B1, 1, 1); PG8_SCHED; PG8_LDA(At, 1, 0); PG8_STAGE_AS(PG8_SA(0, 1), a2, 1);
            PG8_WAIT_V(8); PG8_WAIT_L(0); PG8_BAR; PG8_MMA(0, 0, At, B0); PG8_MMA(0, 1, At, B1); PG8_BAR; PG8_SCHED;
            PG8_LDA(At, 1, 1); PG8_STAGE(PG8_SB(1, 0), b3, voffB); PG8_STAGE(PG8_SB(1, 1), b3 + hstep, voffB); PG8_STAGE_AS(PG8_SA(1, 0), a3, 0);
            PG8_WAIT_V(8); PG8_WAIT_L(0); PG8_BAR; PG8_MMA(1, 0, At, B0); PG8_MMA(1, 1, At, B1); PG8_BAR; PG8_SCHED;
        }
        if constexpr (ALIGN_EPI) { if (wr == 0) PG8_BAR; }
        if constexpr (FP8) asm volatile("s_nop 15\n\ts_nop 3" ::: "memory");
        { int fr_e = fr, fq_e = fq; asm volatile("" : "+v"(fr_e), "+v"(fq_e));
          E(acc, cur, wr, wc, fr_e, fq_e); }
        if (!has_next) break;
#pragma unroll
        for (int a = 0; a < 2; ++a)
#pragma unroll
            for (int b = 0; b < 2; ++b)
#pragma unroll
                for (int m = 0; m < 4; ++m)
#pragma unroll
                    for (int n = 0; n < 2; ++n) acc[a][b][m][n] = (f32x4){0.f, 0.f, 0.f, 0.f};
        cur = nxt; cA = nA; cB = nB; ++ui;
        if constexpr (GATHER) {
#pragma unroll
            for (int h = 0; h < 2; ++h)
#pragma unroll
                for (int i = 0; i < 2; ++i) vC[h][i] = vN[h][i]; }
        if constexpr (ALIGN_EPI) { if (wr == 1) PG8_BAR; }
    }
    PG8_WAIT_V(0);
    if constexpr (!ALIGN_EPI) { if (wr == 0) PG8_BAR; }
    PG8_BAR;
#undef PG8_SA
#undef PG8_SB
#undef PG8_STAGE
#undef PG8_STAGE_AC
#undef PG8_STAGE_AS
#undef PG8_LDA
#undef PG8_LDB
#undef PG8_MMA
#undef PG8_CAT8
#undef PG8_WAIT_V
#undef PG8_WAIT_L
#undef PG8_BAR
#undef PG8_SCHED
}
}
#define GAS __attribute__((address_space(1)))
#define LAS __attribute__((address_space(3)))
typedef unsigned short bf16;
typedef short bf16x8 __attribute__((ext_vector_type(8)));
typedef short s16x4 __attribute__((ext_vector_type(4)));
typedef float f32x4 __attribute__((ext_vector_type(4)));
typedef unsigned u32x4 __attribute__((ext_vector_type(4)));
typedef unsigned u32x2 __attribute__((ext_vector_type(2)));
typedef LAS unsigned char* lptr;

constexpr int NWAVES = 8, NTHR = 512;
#ifndef MOE_FP8
#define MOE_FP8 1
#endif
constexpr int MOE_ESZ = MOE_FP8 ? 1 : 2;
constexpr size_t MiB = 1u << 20;
constexpr size_t WS_CTL = 0, CTL_ZERO_BYTES = 64 * 1024;
constexpr size_t WS_SMALL = 1 * MiB;
constexpr size_t WS_GATES = 2 * MiB;
constexpr size_t WS_RSG = 2 * MiB + 512 * 1024;
constexpr size_t WS_RS1 = 2 * MiB + 768 * 1024;
constexpr size_t WS_GATE = 3 * MiB;
constexpr size_t WS_TOKIDX = 4 * MiB;
constexpr size_t WS_GATEX = 760 * MiB, WS_RSX = 768 * MiB;
constexpr size_t WS_KC = 776 * MiB;
constexpr size_t WS_WRT = 12 * MiB;
constexpr size_t WS_WINT = 16 * MiB, WS_WOUTT = 22 * MiB, WS_WDNT = 24 * MiB, WS_WUPT = 88 * MiB;
constexpr size_t WS_XN = 216 * MiB;
constexpr size_t WS_PROJ = 248 * MiB;
constexpr size_t WS_CLOC = 344 * MiB;
constexpr size_t WS_CPREV = 376 * MiB;
constexpr size_t WS_MIX = 392 * MiB;
constexpr size_t WS_H = 424 * MiB;
constexpr size_t WS_ACT = 488 * MiB;
constexpr size_t WS_Y = 632 * MiB;
constexpr size_t WS_OPT_END = 760 * MiB;
constexpr int CW_CNT = 64;
constexpr int CW_BAR = 4096;
constexpr int PROJ_LD = 3072;
constexpr int QO = 0, KO = 512, VO = 1024, OO = 1536, UO = 2048, VGO = 2560;
constexpr int RING_BYTES = 131072, VEC_OFF = 131072, VEC_BYTES = 16384, CTL_OFF = VEC_OFF + VEC_BYTES, TTAB_OFF = CTL_OFF, MISC_OFF = CTL_OFF + 2048, LDS_BYTES = MISC_OFF + 256;
constexpr int T0 = 0, T1 = 32768, T2 = 65536, T3 = 98304;

#define RLX_AGENT __ATOMIC_RELAXED, __HIP_MEMORY_SCOPE_AGENT
#define XB_TMO      128
#define XB_XCNT(j)  (256  + 64 * (j))
#define XB_XSUB(j)  (1280 + 64 * (j))
#define XB_XGEN(j)  (2304 + 64 * (j))
#define XB_TOP      3328
#define XB_TOPGEN   3392
#define XCD_BAR_WORDS 3456
#define XB_SPIN_CAP (1u << 18)
__device__ __forceinline__ unsigned xb_ld(unsigned* p)              { return __hip_atomic_load(p, __ATOMIC_RELAXED, __HIP_MEMORY_SCOPE_AGENT); }
__device__ __forceinline__ unsigned xb_add(unsigned* p, unsigned v) { return __hip_atomic_fetch_add(p, v, __ATOMIC_RELAXED, __HIP_MEMORY_SCOPE_AGENT); }
__device__ __forceinline__ unsigned xb_xcc_id() { return (unsigned)__builtin_amdgcn_s_getreg((3 << 11) | 20) & 0xFu; }
#define XB_SPIN(cond, bar) do { unsigned _sp = 0; while (cond) { __builtin_amdgcn_s_sleep(1); \
    if ((++_sp & 255u) == 0u) { if (xb_ld(&(bar)[XB_TMO])) break; if (_sp > XB_SPIN_CAP) { atomicAdd(&(bar)[XB_TMO], 1u); break; } } } } while (0)
struct XcdBarrier { unsigned* bar; unsigned x; volatile LAS unsigned* st; };
__device__ __forceinline__ XcdBarrier xcd_barrier_post(unsigned* bar, volatile LAS unsigned* st) {
    XcdBarrier b; b.bar = bar; b.x = xb_xcc_id(); b.st = st;
    if (threadIdx.x == 0) (void)xb_add(&bar[XB_XCNT(b.x)], 1u);
    return b;
}
__device__ __forceinline__ void xcd_barrier_complete(unsigned* bar, unsigned x, unsigned& nloc, unsigned& nx) {
    const unsigned G = gridDim.x * gridDim.y * gridDim.z;
    unsigned sum, cnt, mine, sp = 0u;
    for (;;) {
        sum = 0u; cnt = 0u; mine = 0u;
#pragma unroll
        for (unsigned j = 0; j < 16; ++j) { const unsigned c = xb_ld(&bar[XB_XCNT(j)]); sum += c; cnt += (c > 0u) ? 1u : 0u; mine = (j == x) ? c : mine; }
        if (sum == G) break;
        __builtin_amdgcn_s_sleep(1);
        if ((++sp & 255u) == 0u) { if (xb_ld(&bar[XB_TMO])) break; if (sp > XB_SPIN_CAP) { atomicAdd(&bar[XB_TMO], 1u); break; } }
    }
    nloc = mine > 0u ? mine : 1u; nx = cnt > 0u ? cnt : 1u;
}
__device__ __forceinline__ void xcd_barrier(const XcdBarrier& b) {
    asm volatile("s_waitcnt vmcnt(0)" ::: "memory");
    __syncthreads();
    if (threadIdx.x == 0) {
        unsigned* bar = b.bar;
        __builtin_amdgcn_s_waitcnt(0);
        unsigned nloc = b.st[0], nx = b.st[1];
        if (nloc == 0u) { xcd_barrier_complete(bar, b.x, nloc, nx); b.st[0] = nloc; b.st[1] = nx; }
        const unsigned old = xb_add(&bar[XB_XSUB(b.x)], 1u);
        const unsigned gen = old / nloc;
        if (old + 1u == (gen + 1u) * nloc) {
            __builtin_amdgcn_fence(__ATOMIC_RELEASE, "agent");
            asm volatile("s_waitcnt vmcnt(0)" ::: "memory");
            const unsigned og = xb_add(&bar[XB_TOP], 1u);
            const unsigned tg = og / nx;
            if (og + 1u == (tg + 1u) * nx) xb_add(&bar[XB_TOPGEN], 1u);
            else XB_SPIN(xb_ld(&bar[XB_TOPGEN]) == tg, bar);
            __builtin_amdgcn_fence(__ATOMIC_ACQUIRE, "agent");
            xb_add(&bar[XB_XGEN(b.x)], 1u);
            asm volatile("s_waitcnt vmcnt(0)" ::: "memory");
        } else {
            XB_SPIN(xb_ld(&bar[XB_XGEN(b.x)]) == gen, bar);
            __builtin_amdgcn_fence(__ATOMIC_ACQUIRE, "agent");
            asm volatile("s_waitcnt vmcnt(0)" ::: "memory");
        }
    }
    __syncthreads();
}

__device__ __forceinline__ float bf2f(unsigned short h) { return __builtin_bit_cast(float, (unsigned)h << 16); }
__device__ __forceinline__ unsigned f2bf(float f) { unsigned u = __builtin_bit_cast(unsigned, f); return (u + 0x7fffu + ((u >> 16) & 1u)) >> 16; }
__device__ __forceinline__ unsigned pk2(float lo, float hi) { return pg8::cvt_pk_bf16(lo, hi); }
__device__ __forceinline__ float fexp(float x) { return __builtin_amdgcn_exp2f(x * 1.4426950408889634f); }
__device__ __forceinline__ float fsigmoid(float x) { return __builtin_amdgcn_rcpf(1.0f + fexp(-x)); }
__device__ __forceinline__ float fgelu(float x) {
    const float u = 1.5957691216057308f * (x + 0.044715f * x * x * x);
    return x * fsigmoid(u);
}
__device__ __forceinline__ float wsum_all(float v) {
#pragma unroll
    for (int o = 32; o > 0; o >>= 1) v += __shfl_xor(v, o);
    return v;
}
__device__ __forceinline__ void unpack8(const u32x4 w, float (&f)[8]) {
    f[0] = __builtin_bit_cast(float, w.x << 16); f[1] = __builtin_bit_cast(float, w.x & 0xffff0000u);
    f[2] = __builtin_bit_cast(float, w.y << 16); f[3] = __builtin_bit_cast(float, w.y & 0xffff0000u);
    f[4] = __builtin_bit_cast(float, w.z << 16); f[5] = __builtin_bit_cast(float, w.z & 0xffff0000u);
    f[6] = __builtin_bit_cast(float, w.w << 16); f[7] = __builtin_bit_cast(float, w.w & 0xffff0000u);
}
__device__ __forceinline__ u32x4 pack8(const float (&f)[8]) { u32x4 w; w.x = pk2(f[0], f[1]); w.y = pk2(f[2], f[3]); w.z = pk2(f[4], f[5]); w.w = pk2(f[6], f[7]); return w; }

__device__ __forceinline__ unsigned off_b(unsigned row, unsigned ch) { return 256u * row + 16u * (ch ^ (((row & 3u) << 2) | ((row >> 2) & 3u))); }
__device__ __forceinline__ bf16x8 frag_row(lptr T, int r0, int ks, int lane) { return *(const LAS bf16x8*)(T + off_b((unsigned)(r0 + (lane & 15)), (unsigned)(4 * ks + (lane >> 4)))); }
__device__ __forceinline__ bf16x8 frag_tr(lptr T, int c, int ks, int lane) {
    const unsigned g = lane >> 4, q = (lane & 15) >> 2, p = lane & 3;
    const unsigned a0 = off_b(32u * ks + 8u * g + q, 2u * c + (p >> 1)) + 8u * (p & 1);
    const unsigned a1 = off_b(32u * ks + 8u * g + 4u + q, 2u * c + (p >> 1)) + 8u * (p & 1);
    const s16x4 lo = __builtin_amdgcn_ds_read_tr16_b64_v4i16((LAS s16x4*)(T + a0));
    const s16x4 hi = __builtin_amdgcn_ds_read_tr16_b64_v4i16((LAS s16x4*)(T + a1));
    return __builtin_shufflevector(lo, hi, 0, 1, 2, 3, 4, 5, 6, 7);
}
#define MFMA16(a, b, c) __builtin_amdgcn_mfma_f32_16x16x32_bf16(a, b, c, 0, 0, 0)

#ifndef PROBE_SEC
#define PROBE_SEC -1
#endif
#define SEC_BEGIN(F, id) do { if (PROBE_SEC == (id)) { __syncthreads(); (F).t0 = __builtin_amdgcn_s_memrealtime(); } } while (0)
#define SEC_END(F, id) do { if (PROBE_SEC == (id)) { __syncthreads(); (F).tsec += __builtin_amdgcn_s_memrealtime() - (F).t0; } } while (0)
struct Frame {
    unsigned long long t0, tsec;
    lptr lds; int tid, lane, wave, G, vcu;
    const float* in[20]; float* out; unsigned char* ws;
};

template <bool SCALE>
__device__ __forceinline__ void stage_tile(const Frame& F, lptr T, const bf16* src, int ld, const LAS float* rowscale) {
    const int cg = F.tid & 15, sb = F.tid >> 4;
    u32x4 w[4];
#pragma unroll
    for (int r = 0; r < 4; ++r) w[r] = *(const u32x4*)(src + (size_t)(4 * sb + r) * ld + 8 * cg);
#pragma unroll
    for (int r = 0; r < 4; ++r) { const int s = 4 * sb + r;
        if (SCALE) { float f[8]; unpack8(w[r], f); const float sc = rowscale[s];
#pragma unroll
            for (int i = 0; i < 8; ++i) f[i] *= sc;
            w[r] = pack8(f); }
        *(LAS u32x4*)(T + off_b(s, cg)) = w[r]; }
}
__device__ __forceinline__ void stage_conv(const Frame& F, lptr T, const bf16* src, const LAS float* cw, int tpos, float scale, u32x4 (&out)[4]) {
    const int cg = F.tid & 15, sb = F.tid >> 4;
    u32x4 w[7];
#pragma unroll
    for (int j = 0; j < 7; ++j) { const int s = 4 * sb - 3 + j; w[j] = (tpos + s >= 0) ? *(const u32x4*)(src + (ptrdiff_t)s * PROJ_LD + 8 * cg) : (u32x4){0u, 0u, 0u, 0u}; }
#pragma unroll
    for (int hf = 0; hf < 2; ++hf) {
        f32x4 tp4[4];
#pragma unroll
        for (int tp = 0; tp < 4; ++tp) tp4[tp] = *(const LAS f32x4*)(cw + tp * 128 + 8 * cg + 4 * hf);
        float a[4][4];
#pragma unroll
        for (int r = 0; r < 4; ++r)
#pragma unroll
            for (int i = 0; i < 4; ++i) a[r][i] = 0.f;
#pragma unroll
        for (int j = 0; j < 7; ++j) { const unsigned u0 = hf ? w[j].z : w[j].x, u1 = hf ? w[j].w : w[j].y;
            const float f[4] = {__builtin_bit_cast(float, u0 << 16), __builtin_bit_cast(float, u0 & 0xffff0000u), __builtin_bit_cast(float, u1 << 16), __builtin_bit_cast(float, u1 & 0xffff0000u)};
#pragma unroll
            for (int r = 0; r < 4; ++r) { const int tp = j - r; if (tp >= 0 && tp < 4) {
#pragma unroll
                for (int i = 0; i < 4; ++i) a[r][i] += tp4[tp][i] * f[i]; } } }
#pragma unroll
        for (int r = 0; r < 4; ++r) {
#pragma unroll
            for (int i = 0; i < 4; ++i) a[r][i] = a[r][i] * fsigmoid(a[r][i]) * scale;
            const unsigned p0 = pk2(a[r][0], a[r][1]), p1 = pk2(a[r][2], a[r][3]);
            if (hf == 0) { out[r].x = p0; out[r].y = p1; } else { out[r].z = p0; out[r].w = p1; } }
        __builtin_amdgcn_sched_barrier(0);
    }
#pragma unroll
    for (int r = 0; r < 4; ++r) *(LAS u32x4*)(T + off_b(4 * sb + r, cg)) = out[r];
}
__device__ __forceinline__ void p0_item(const float* Wsrc, int ld, bf16* dst, int Kd, LAS float* scr, int lane) {
#pragma unroll 8
    for (int i = 0; i < 32; ++i) { const int kk = 2 * i + (lane >> 5); scr[kk * 33 + (lane & 31)] = Wsrc[(size_t)kk * ld + (lane & 31)]; }
    asm volatile("s_waitcnt lgkmcnt(0)" ::: "memory");
    const int c = lane & 7;
#pragma unroll
    for (int j = 0; j < 4; ++j) { const int n = (lane >> 3) + 8 * j; const LAS float* s = scr + (8 * c) * 33 + n;
        u32x4 o; o.x = pk2(s[0 * 33], s[1 * 33]); o.y = pk2(s[2 * 33], s[3 * 33]); o.z = pk2(s[4 * 33], s[5 * 33]); o.w = pk2(s[6 * 33], s[7 * 33]);
        *(u32x4*)(dst + (size_t)n * Kd + 8 * c) = o; }
    asm volatile("s_waitcnt lgkmcnt(0)" ::: "memory");
}
__device__ __forceinline__ void p0_item_split(const float* Wsrc, int ld, bf16* dhi, bf16* dlo, int Kd, LAS float* scr, int lane) {
#pragma unroll 8
    for (int i = 0; i < 32; ++i) { const int kk = 2 * i + (lane >> 5); scr[kk * 33 + (lane & 31)] = Wsrc[(size_t)kk * ld + (lane & 31)]; }
    asm volatile("s_waitcnt lgkmcnt(0)" ::: "memory");
    const int c = lane & 7;
#pragma unroll
    for (int j = 0; j < 4; ++j) { const int n = (lane >> 3) + 8 * j; const LAS float* s = scr + (8 * c) * 33 + n;
        float v[8], l[8];
#pragma unroll
        for (int i = 0; i < 8; ++i) { v[i] = s[i * 33]; l[i] = v[i] - bf2f((unsigned short)f2bf(v[i])); }
        *(u32x4*)(dhi + (size_t)n * Kd + 8 * c) = pack8(v); *(u32x4*)(dlo + (size_t)n * Kd + 8 * c) = pack8(l); }
    asm volatile("s_waitcnt lgkmcnt(0)" ::: "memory");
}

struct P0Item { const float* src; char* dst; int ld; int esz; };
constexpr float W8_SCALE = 64.0f;
__device__ __forceinline__ void p0_load(const P0Item& it, int lane, f32x4 (&v)[8]) {
    const float* p = it.src + (size_t)(8 * (lane & 7)) * it.ld + 4 * (lane >> 3);
#pragma unroll
    for (int j = 0; j < 8; ++j) v[j] = __builtin_nontemporal_load((const f32x4*)(p + (size_t)j * it.ld));
}
__device__ __forceinline__ void p0_store(const P0Item& it, int lane, const f32x4 (&v)[8]) {
    const size_t eo = (size_t)(4 * (lane >> 3)) * 1024 + 8 * (lane & 7);
    if (it.esz == 2) { char* q = it.dst + 2 * eo;
#pragma unroll
        for (int i = 0; i < 4; ++i) { u32x4 o; o.x = pk2(v[0][i], v[1][i]); o.y = pk2(v[2][i], v[3][i]); o.z = pk2(v[4][i], v[5][i]); o.w = pk2(v[6][i], v[7][i]);
            *(u32x4*)(q + (size_t)i * 2048) = o; } }
    else { char* q = it.dst + eo;
#pragma unroll
        for (int i = 0; i < 4; ++i) { u32x2 o; o.x = pg8::pk4_fp8(v[0][i] * W8_SCALE, v[1][i] * W8_SCALE, v[2][i] * W8_SCALE, v[3][i] * W8_SCALE);
            o.y = pg8::pk4_fp8(v[4][i] * W8_SCALE, v[5][i] * W8_SCALE, v[6][i] * W8_SCALE, v[7][i] * W8_SCALE);
            *(u32x2*)(q + (size_t)i * 1024) = o; } }
}
constexpr int IMG_ROW = 2064;
template <int NF, bool OUT8>
__device__ __forceinline__ float row_pass(const float* X, const float* gain, void* XNout, lptr img_hi, lptr img_lo, int tok0, int lane, f32x4 (&acc)[NF]) {
    const int r = lane & 15, g = lane >> 4;
    const float* xr = X + (size_t)(tok0 + r) * 1024 + 8 * g;
    float ss = 0.f;
#pragma unroll
    for (int nf = 0; nf < NF; ++nf) acc[nf] = (f32x4){0.f, 0.f, 0.f, 0.f};
    char* orow = (char*)XNout + ((size_t)(tok0 + r) * 1024 + 8 * g) * (OUT8 ? 1 : 2);
#pragma unroll 16
    for (int ks = 0; ks < 32; ++ks) { const f32x4 a = __builtin_nontemporal_load((const f32x4*)(xr + 32 * ks)), b = __builtin_nontemporal_load((const f32x4*)(xr + 32 * ks + 4));
        ss += (a[0] * a[0] + a[1] * a[1]) + (a[2] * a[2] + a[3] * a[3]) + (b[0] * b[0] + b[1] * b[1]) + (b[2] * b[2] + b[3] * b[3]);
        const f32x4 ga = *(const f32x4*)(gain + 32 * ks + 8 * g), gb = *(const f32x4*)(gain + 32 * ks + 8 * g + 4);
        float v[8], l[8];
#pragma unroll
        for (int i = 0; i < 4; ++i) { v[i] = a[i] * ga[i]; v[4 + i] = b[i] * gb[i]; }
        const u32x4 hi = pack8(v);
        { float h[8]; unpack8(hi, h);
#pragma unroll
          for (int i = 0; i < 8; ++i) l[i] = v[i] - h[i]; }
        const u32x4 lo = pack8(l);
        if (OUT8) { u32x2 o8; o8.x = pg8::pk4_fp8(v[0], v[1], v[2], v[3]); o8.y = pg8::pk4_fp8(v[4], v[5], v[6], v[7]); *(u32x2*)(orow + 32 * ks) = o8; }
        else *(u32x4*)(orow + 64 * ks) = hi;
        const bf16x8 ahi = __builtin_bit_cast(bf16x8, hi), alo = __builtin_bit_cast(bf16x8, lo);
#pragma unroll
        for (int nf = 0; nf < NF; ++nf) { const unsigned bo = (unsigned)(16 * nf + (lane & 15)) * IMG_ROW + 64u * ks + 16u * g;
            const bf16x8 bhi = *(const LAS bf16x8*)(img_hi + bo), blo = *(const LAS bf16x8*)(img_lo + bo);
            acc[nf] = MFMA16(ahi, bhi, acc[nf]); acc[nf] = MFMA16(ahi, blo, acc[nf]); acc[nf] = MFMA16(alo, bhi, acc[nf]); } }
    ss += __shfl_xor(ss, 16); ss += __shfl_xor(ss, 32);
    return 1.0f / sqrtf(ss * (1.0f / 1024.0f) + 1e-6f);
}

__device__ __forceinline__ void phase0(Frame& F) {
    const float* x = F.in[0]; const float* g1 = F.in[1]; const float* w_in = F.in[2]; const float* b_i = F.in[4]; const float* b_f = F.in[5];
    const float* w_out = F.in[11]; const float* wr = F.in[13]; const float* w_up = F.in[15]; const float* w_dn = F.in[17];
    bf16* WinT = (bf16*)(F.ws + WS_WINT); bf16* WoutT = (bf16*)(F.ws + WS_WOUTT); bf16* WdnT = (bf16*)(F.ws + WS_WDNT); bf16* WupT = (bf16*)(F.ws + WS_WUPT);
    bf16* WrThi = (bf16*)(F.ws + WS_WRT); bf16* WrTlo = WrThi + 32 * 1024;
    bf16* XN = (bf16*)(F.ws + WS_XN); float* GATES = (float*)(F.ws + WS_GATES); float* RS1 = (float*)(F.ws + WS_RS1);
    lptr ghi = F.lds + T0, glo = F.lds + T0 + 16 * IMG_ROW;
    SEC_BEGIN(F, 1);
#pragma unroll
    for (int q = 0; q < 2; ++q) { const int kk = F.tid + NTHR * q; const f32x4 a = *(const f32x4*)(w_in + (size_t)kk * 3080 + 2048), b = *(const f32x4*)(w_in + (size_t)kk * 3080 + 2052);
        const float v[8] = {a[0], a[1], a[2], a[3], b[0], b[1], b[2], b[3]};
#pragma unroll
        for (int j = 0; j < 8; ++j) { const unsigned h = f2bf(v[j]); const float l = v[j] - bf2f((unsigned short)h);
            *(LAS unsigned short*)(ghi + j * IMG_ROW + 2 * kk) = (unsigned short)h; *(LAS unsigned short*)(glo + j * IMG_ROW + 2 * kk) = (unsigned short)f2bf(l); } }
    __syncthreads();
    SEC_END(F, 1); SEC_BEGIN(F, 2);
    if (F.wave < 4) { const int tok0 = F.vcu * 64 + F.wave * 16; f32x4 acc[1];
      const float rstd = row_pass<1, false>(x, g1, XN, ghi, glo, tok0, F.lane, acc);
      if (F.lane < 16) RS1[tok0 + F.lane] = rstd;
      const int j = F.lane & 15, gq = F.lane >> 4;
      float rr[4];
#pragma unroll
      for (int rg = 0; rg < 4; ++rg) rr[rg] = __shfl(rstd, 4 * gq + rg);
      if (j < 8) {
#pragma unroll
          for (int rg = 0; rg < 4; ++rg) { const int tok = tok0 + 4 * gq + rg; float v = acc[0][rg] * rr[rg];
              if (j < 4) v += b_i[j]; else { v += b_f[j - 4]; v = fminf(v, 0.f) - log1pf(expf(-fabsf(v))); }
              GATES[(size_t)tok * 8 + j] = v; } } }
    SEC_END(F, 2); SEC_BEGIN(F, 3);
    const float* b_unused = nullptr; (void)b_unused;
    const int gw = F.vcu * NWAVES + F.wave, NGW = F.G * NWAVES;
    if (F.vcu < 4 && F.wave >= 4) { const int ri = F.vcu * 4 + F.wave - 4; LAS float* scr = (LAS float*)(F.lds + 66560 + (F.wave - 4) * 8448);
        p0_item_split(wr + (size_t)(64 * ri) * 32, 32, WrThi + 64 * ri, WrTlo + 64 * ri, 1024, scr, F.lane); }
    constexpr int I_IN = 16 * 96, I_OUT = 16 * 32, I_UP = 24 * 16 * 64, NITEMS = I_IN + I_OUT + I_UP;
    auto decode = [&](int it) -> P0Item {
        int r = it; P0Item o;
        if (r < I_IN) { const int kb = r / 96, nb = r % 96, nd = 32 * nb, nsrc = nd < 2048 ? nd : nd + 8;
            o.src = w_in + (size_t)(64 * kb) * 3080 + nsrc; o.ld = 3080; o.esz = 2; o.dst = (char*)(WinT + (size_t)nd * 1024 + 64 * kb); return o; } r -= I_IN;
        if (r < I_OUT) { const int kb = r / 32, nb = r % 32;
            o.src = w_out + (size_t)(64 * kb) * 1024 + 32 * nb; o.ld = 1024; o.esz = 2; o.dst = (char*)(WoutT + (size_t)(32 * nb) * 1024 + 64 * kb); return o; } r -= I_OUT;
        { const int e = r / 1024, q = r % 1024, kb = q / 64, nb = q % 64, n = 32 * nb, half = n >> 10, jj = n & 1023, pn = jj >> 7, j = jj & 127, nd = 256 * pn + 128 * half + j;
          o.src = w_up + ((size_t)e * 1024 + 64 * kb) * 2048 + n; o.ld = 2048; o.esz = MOE_ESZ; o.dst = (char*)WupT + (((size_t)e * 2048 + nd) * 1024 + 64 * kb) * MOE_ESZ; return o; }
    };
    constexpr int PER_WAVE = NITEMS / (256 * NWAVES), SHIFT = 3;
    static_assert(NITEMS % (256 * NWAVES) == 0, "item split");
    const int nown = F.wave < 4 ? PER_WAVE - SHIFT : PER_WAVE + SHIFT;
    for (int j = 0; j < nown; j += 2) {
        const bool two = j + 1 < nown;
        const int j0 = j, j1 = two ? j + 1 : j;
        const int ita = (j0 < PER_WAVE) ? gw + j0 * NGW : (gw - 4) + (j0 - SHIFT) * NGW;
        const int itb = (j1 < PER_WAVE) ? gw + j1 * NGW : (gw - 4) + (j1 - SHIFT) * NGW;
        const P0Item ia = decode(ita), ib = decode(itb);
        f32x4 va[8], vb[8];
        p0_load(ia, F.lane, va); p0_load(ib, F.lane, vb);
        p0_store(ia, F.lane, va); if (two) p0_store(ib, F.lane, vb);
    }
    SEC_END(F, 3);
}

__device__ __forceinline__ float wscan_add(float v, int lane) {
#pragma unroll
    for (int o = 1; o < 64; o <<= 1) { const float t = __shfl_up(v, o); if (lane >= o) v += t; }
    return v;
}
__device__ __forceinline__ float wscan_max(float v, int lane) {
#pragma unroll
    for (int o = 1; o < 64; o <<= 1) { const float t = __shfl_up(v, o); if (lane >= o) v = fmaxf(v, t); }
    return v;
}
__device__ __forceinline__ float wmax_all(float v) {
#pragma unroll
    for (int o = 32; o > 0; o >>= 1) v = fmaxf(v, __shfl_xor(v, o));
    return v;
}

__device__ __forceinline__ void mlstm_local_unit(Frame& F0, int u) {
    Frame F = F0; asm volatile("" : "+v"(F.tid), "+v"(F.lane));
    const int c = u & 63, h = (u >> 6) & 3, b = u >> 8, row0 = b * 8192 + c * 128;
    const bf16* PROJ = (const bf16*)(F.ws + WS_PROJ); const float* GATES = (const float*)(F.ws + WS_GATES); const float* conv = F.in[3];
    float* CLOC = (float*)(F.ws + WS_CLOC); float* MLOC = (float*)(F.ws + WS_SMALL); float* BLAST = MLOC + 512; float* NLOC = MLOC + 2048; bf16* KC = (bf16*)(F.ws + WS_KC);
    LAS float* wv = (LAS float*)(F.lds + VEC_OFF);
    LAS float* cw = wv + 128;
    LAS float* part = cw + 512;
    const int lane = F.lane, w = F.wave;
    SEC_BEGIN(F, 10);
#pragma unroll
    for (int j = 0; j < 8; ++j) { const int i = lane + 64 * j; cw[i] = conv[(i >> 7) * 1024 + 512 + h * 128 + (i & 127)]; }
    { const int l = lane, s0 = 2 * l, s1 = s0 + 1;
        const float li0 = GATES[(size_t)(row0 + s0) * 8 + h], li1 = GATES[(size_t)(row0 + s1) * 8 + h], lf0 = GATES[(size_t)(row0 + s0) * 8 + 4 + h], lf1 = GATES[(size_t)(row0 + s1) * 8 + 4 + h];
        const float inc = wscan_add(lf0 + lf1, l), b1 = inc, b0 = inc - lf1, blast = __shfl(inc, 63);
        const float g0 = blast - b0 + li0, g1 = blast - b1 + li1, mloc = wmax_all(fmaxf(g0, g1));
        wv[s0] = fexp(g0 - mloc); wv[s1] = fexp(g1 - mloc);
        if (l == 0 && w == 0) { MLOC[u] = mloc; BLAST[u] = blast; } }
    SEC_END(F, 10); SEC_BEGIN(F, 11);
    { u32x4 kv[4]; const int cg = F.tid & 15, sb = F.tid >> 4;
      stage_conv(F, F.lds + T1, PROJ + (size_t)row0 * PROJ_LD + KO + h * 128, cw, c * 128, 0.08838834764831845f, kv);
      float pn[8];
#pragma unroll
      for (int i = 0; i < 8; ++i) pn[i] = 0.f;
#pragma unroll
      for (int r = 0; r < 4; ++r) { *(u32x4*)(KC + (size_t)(row0 + 4 * sb + r) * 512 + h * 128 + 8 * cg) = kv[r];
          float f[8]; unpack8(kv[r], f); const float ws = wv[4 * sb + r];
#pragma unroll
          for (int i = 0; i < 8; ++i) pn[i] += ws * f[i]; }
#pragma unroll
      for (int i = 0; i < 8; ++i) { pn[i] += __shfl_xor(pn[i], 16); pn[i] += __shfl_xor(pn[i], 32); }
      if (lane < 16) { *(LAS f32x4*)(part + w * 128 + 8 * cg) = (f32x4){pn[0], pn[1], pn[2], pn[3]}; *(LAS f32x4*)(part + w * 128 + 8 * cg + 4) = (f32x4){pn[4], pn[5], pn[6], pn[7]}; } }
    stage_tile<true>(F, F.lds + T2, PROJ + (size_t)row0 * PROJ_LD + VO + h * 128, PROJ_LD, wv);
    __syncthreads();
    SEC_END(F, 11); SEC_BEGIN(F, 12);
    { f32x4 acc[8];
#pragma unroll
      for (int kb = 0; kb < 8; ++kb) acc[kb] = (f32x4){0.f, 0.f, 0.f, 0.f};
#pragma unroll
      for (int ks = 0; ks < 4; ++ks) { const bf16x8 a = frag_tr(F.lds + T2, w, ks, lane);
#pragma unroll
          for (int kb = 0; kb < 8; ++kb) { const bf16x8 bb = frag_tr(F.lds + T1, kb, ks, lane); acc[kb] = MFMA16(a, bb, acc[kb]); } }
      float* cl = CLOC + (size_t)u * 16384 + (size_t)(16 * w + 4 * (lane >> 4)) * 128 + (lane & 15);
#pragma unroll
      for (int kb = 0; kb < 8; ++kb)
#pragma unroll
          for (int rg = 0; rg < 4; ++rg) cl[rg * 128 + 16 * kb] = acc[kb][rg]; }
    if (F.tid < 128) { float a = 0.f;
#pragma unroll
        for (int ww = 0; ww < 8; ++ww) a += part[ww * 128 + F.tid];
        NLOC[(size_t)u * 128 + F.tid] = a; }
    __syncthreads();
    SEC_END(F, 12);
    F0.tsec = F.tsec;
}

__device__ __forceinline__ void gmlp_unit(Frame& F0, int ug) {
    Frame F = F0; asm volatile("" : "+v"(F.tid), "+v"(F.lane));
    const int g = ug & 3, row0 = (ug >> 2) * 128;
    const bf16* PROJ = (const bf16*)(F.ws + WS_PROJ); bf16* MIX = (bf16*)(F.ws + WS_MIX);
    const float* lng = F.in[7]; const float* wsp = F.in[8]; const float* bsp = F.in[9]; const float* og = F.in[10]; float* PSSQ = (float*)(F.ws + WS_RSG);
    LAS float* st_mean = (LAS float*)(F.lds + VEC_OFF); LAS float* st_rstd = st_mean + 128;
    const int w = F.wave, lane = F.lane;
    SEC_BEGIN(F, 20);
    { const int t = F.tid >> 2, q = F.tid & 3; const bf16* vp = PROJ + (size_t)(row0 + t) * PROJ_LD + VGO + 128 * q;
      float s = 0.f, s2 = 0.f;
#pragma unroll 8
      for (int j = 0; j < 16; ++j) { float f[8]; unpack8(*(const u32x4*)(vp + 8 * j), f);
#pragma unroll
          for (int i = 0; i < 8; ++i) { s += f[i]; s2 += f[i] * f[i]; } }
      s += __shfl_xor(s, 1); s += __shfl_xor(s, 2); s2 += __shfl_xor(s2, 1); s2 += __shfl_xor(s2, 2);
      const float mean = s * (1.0f / 512.0f), var = fmaxf(s2 * (1.0f / 512.0f) - mean * mean, 0.f);
      if (q == 0) { st_mean[t] = mean; st_rstd[t] = 1.0f / sqrtf(var + 1e-6f); } }
    __syncthreads();
    SEC_END(F, 20); SEC_BEGIN(F, 21);
    { const int cg = F.tid & 15, sb = F.tid >> 4;
      const f32x4 l0 = *(const f32x4*)(lng + g * 128 + 8 * cg), l1 = *(const f32x4*)(lng + g * 128 + 8 * cg + 4);
      u32x4 vv[4], uu[4]; f32x4 wa[4], wb[4];
#pragma unroll
      for (int r = 0; r < 4; ++r) { const int t = 4 * sb + r;
          vv[r] = *(const u32x4*)(PROJ + (size_t)(row0 + t) * PROJ_LD + VGO + g * 128 + 8 * cg); uu[r] = *(const u32x4*)(PROJ + (size_t)(row0 + t) * PROJ_LD + UO + g * 128 + 8 * cg);
          const float* wp = wsp + ((size_t)(g * 128 + t)) * 128 + 8 * cg; wa[r] = *(const f32x4*)wp; wb[r] = *(const f32x4*)(wp + 4); }
#pragma unroll
      for (int r = 0; r < 4; ++r) { const int t = 4 * sb + r;
          float f[8] = {wa[r][0], wa[r][1], wa[r][2], wa[r][3], wb[r][0], wb[r][1], wb[r][2], wb[r][3]};
#pragma unroll
          for (int kk = 0; kk < 8; ++kk) if (8 * cg + kk > t) f[kk] = 0.f;
          *(LAS u32x4*)(F.lds + T0 + off_b(t, cg)) = pack8(f);
          float v[8]; unpack8(vv[r], v); const float mean = st_mean[t], rstd = st_rstd[t];
#pragma unroll
          for (int kk = 0; kk < 8; ++kk) v[kk] = (v[kk] - mean) * rstd * (kk < 4 ? l0[kk] : l1[kk - 4]);
          *(LAS u32x4*)(F.lds + T1 + off_b(t, cg)) = pack8(v);
          *(LAS u32x4*)(F.lds + T2 + off_b(t, cg)) = uu[r]; } }
    __syncthreads();
    SEC_END(F, 21); SEC_BEGIN(F, 22);
    f32x4 acc[8];
#pragma unroll
    for (int db = 0; db < 8; ++db) acc[db] = (f32x4){0.f, 0.f, 0.f, 0.f};
    for (int ks = 0; ks <= (w >> 1); ++ks) { const bf16x8 a = frag_row(F.lds + T0, 16 * w, ks, lane);
#pragma unroll
        for (int db = 0; db < 8; ++db) { const bf16x8 bb = frag_tr(F.lds + T1, db, ks, lane); acc[db] = MFMA16(a, bb, acc[db]); } }
    float ssq[4] = {0.f, 0.f, 0.f, 0.f}; float ogv[8];
#pragma unroll
    for (int db = 0; db < 8; ++db) ogv[db] = og[g * 128 + 16 * db + (lane & 15)];
#pragma unroll
    for (int rg = 0; rg < 4; ++rg) { int t = 16 * w + 4 * (lane >> 4) + rg; const float bs = bsp[g * 128 + t]; asm volatile("" : "+v"(t));
#pragma unroll
        for (int db = 0; db < 8; ++db) { const int d = 16 * db + (lane & 15);
            const float gu = bf2f(*(const LAS unsigned short*)(F.lds + T2 + off_b(t, d >> 3) + 2 * (d & 7)));
            const float val = (acc[db][rg] + bs) * gu; ssq[rg] += val * val;
            *(LAS unsigned short*)(F.lds + T3 + off_b(t, d >> 3) + 2 * (d & 7)) = (unsigned short)(pk2(val * ogv[db], 0.f) & 0xffffu); } }
#pragma unroll
    for (int i = 0; i < 4; ++i) { const int id = lane + 64 * i, r = id >> 4, ch = id & 15, t = 16 * w + r;
        *(u32x4*)(MIX + (size_t)(row0 + t) * 1024 + 512 + g * 128 + 8 * ch) = *(const LAS u32x4*)(F.lds + T3 + off_b(t, ch)); }
#pragma unroll
    for (int rg = 0; rg < 4; ++rg) { float q = ssq[rg]; q += __shfl_xor(q, 1); q += __shfl_xor(q, 2); q += __shfl_xor(q, 4); q += __shfl_xor(q, 8);
        if ((lane & 15) == 0) PSSQ[(size_t)g * 16384 + row0 + 16 * w + 4 * (lane >> 4) + rg] = q; }
    __syncthreads();
    SEC_END(F, 22);
    F0.tsec = F.tsec;
}

__device__ __forceinline__ void phase_scan(const Frame& F) {
    const float* CLOC = (const float*)(F.ws + WS_CLOC); float* MLOC = (float*)(F.ws + WS_SMALL); float* BLAST = MLOC + 512; float* MPREV = MLOC + 1024;
    float* NLOC = MLOC + 2048; float* NPREV = NLOC + 512 * 128; bf16* CPREV = (bf16*)(F.ws + WS_CPREV);
    LAS float* av = (LAS float*)(F.lds + VEC_OFF); LAS float* cv = av + 64;
    const int wg = F.vcu, bh = wg >> 5;
    if (F.wave == 0) { const int l = F.lane; const float ml = MLOC[bh * 64 + l], bl = BLAST[bh * 64 + l];
        float m = 0.f, mym = 0.f, mynext = 0.f;
        for (int c = 0; c < 64; ++c) { const float mlc = __shfl(ml, c), blc = __shfl(bl, c); const float mn = fmaxf(blc + m, mlc); if (l == c) { mym = m; mynext = mn; } m = mn; }
        av[l] = fexp(bl + mym - mynext); cv[l] = fexp(ml - mynext);
        if ((wg & 31) == 0) MPREV[bh * 64 + l] = mym; }
    __syncthreads();
    if (F.tid < 256) { const int p = (wg & 31) * 256 + F.tid; float v0 = 0.f, v1 = 0.f;
        const float* src = CLOC + (size_t)(bh * 64) * 16384 + 2 * p; bf16* dst = CPREV + (size_t)(bh * 64) * 16384 + 2 * p;
#pragma unroll 8
        for (int c = 0; c < 64; ++c) { const float2 x = *(const float2*)(src + (size_t)c * 16384);
            *(unsigned*)(dst + (size_t)c * 16384) = pk2(v0, v1);
            const float a = av[c], cc = cv[c]; v0 = a * v0 + cc * x.x; v1 = a * v1 + cc * x.y; } }
    else if (F.tid < 320 && (wg & 31) == 0) { const int p = F.tid - 256; float v0 = 0.f, v1 = 0.f;
        for (int c = 0; c < 64; ++c) { const float2 x = *(const float2*)(NLOC + (size_t)(bh * 64 + c) * 128 + 2 * p);
            *(float2*)(NPREV + (size_t)(bh * 64 + c) * 128 + 2 * p) = make_float2(v0, v1);
            const float a = av[c], cc = cv[c]; v0 = a * v0 + cc * x.x; v1 = a * v1 + cc * x.y; } }
    __syncthreads();
}

__device__ __forceinline__ void mlstm_out_unit(Frame& F0, int u) {
    Frame F = F0; asm volatile("" : "+v"(F.tid), "+v"(F.lane));
    const int c = u & 63, h = (u >> 6) & 3, b = u >> 8, row0 = b * 8192 + c * 128;
    const bf16* PROJ = (const bf16*)(F.ws + WS_PROJ); const float* GATES = (const float*)(F.ws + WS_GATES); const float* conv = F.in[3]; const float* ngain = F.in[6];
    const float* MPREV = (const float*)(F.ws + WS_SMALL) + 1024; const float* NPREV = (const float*)(F.ws + WS_SMALL) + 2048 + 512 * 128;
    const bf16* CPREV = (const bf16*)(F.ws + WS_CPREV); bf16* MIX = (bf16*)(F.ws + WS_MIX);
    LAS float* colc = (LAS float*)(F.lds + VEC_OFF); LAS float* rowc = colc + 128; LAS float* inter = rowc + 128; LAS float* emn = inter + 128; LAS float* rdn = emn + 128;
    LAS float* npv = rdn + 128; LAS float* cw = npv + 128;
    const int w = F.wave, lane = F.lane;
    SEC_BEGIN(F, 30);
#pragma unroll
    for (int j = 0; j < 8; ++j) { const int i = lane + 64 * j; cw[i] = conv[(i >> 7) * 1024 + h * 128 + (i & 127)]; }
    npv[lane] = NPREV[(size_t)u * 128 + lane]; npv[64 + lane] = NPREV[(size_t)u * 128 + 64 + lane];
    { const int l = lane, s0 = 2 * l, s1 = s0 + 1;
        const float li0 = GATES[(size_t)(row0 + s0) * 8 + h], li1 = GATES[(size_t)(row0 + s1) * 8 + h], lf0 = GATES[(size_t)(row0 + s0) * 8 + 4 + h], lf1 = GATES[(size_t)(row0 + s1) * 8 + 4 + h];
        const float inc = wscan_add(lf0 + lf1, l), b1 = inc, b0 = inc - lf1;
        const float c0 = li0 - b0, c1 = li1 - b1;
        const float pmx = wscan_max(fmaxf(c0, c1), l); float pprev = __shfl_up(pmx, 1); if (l == 0) pprev = -INFINITY;
        const float pm0 = fmaxf(pprev, c0), pm1 = pmx, mprev = MPREV[u];
        const float m0 = b0 + fmaxf(mprev, pm0), m1 = b1 + fmaxf(mprev, pm1);
        colc[s0] = c0; colc[s1] = c1; rowc[s0] = b0 - m0; rowc[s1] = b1 - m1;
        inter[s0] = fexp(b0 + mprev - m0); inter[s1] = fexp(b1 + mprev - m1); emn[s0] = fexp(-m0); emn[s1] = fexp(-m1); }
    SEC_END(F, 30); SEC_BEGIN(F, 31);
    { u32x4 qv[4]; stage_conv(F, F.lds + T0, PROJ + (size_t)row0 * PROJ_LD + QO + h * 128, cw, c * 128, 1.0f, qv); }
    stage_tile<false>(F, F.lds + T1, (const bf16*)(F.ws + WS_KC) + (size_t)row0 * 512 + h * 128, 512, nullptr);
    stage_tile<false>(F, F.lds + T2, PROJ + (size_t)row0 * PROJ_LD + VO + h * 128, PROJ_LD, nullptr);
    stage_tile<false>(F, F.lds + T3, CPREV + (size_t)u * 16384, 128, nullptr);
    __syncthreads();
    SEC_END(F, 31); SEC_BEGIN(F, 32);
    const int t = 16 * w + (lane & 15);
    u32x2 wpk[8]; float rsum = 0.f;
    { const float rc = rowc[t];
#pragma unroll
      for (int sb = 0; sb < 8; ++sb) { wpk[sb] = (u32x2){0u, 0u};
          if (sb <= w) { f32x4 a4 = (f32x4){0.f, 0.f, 0.f, 0.f};
#pragma unroll
              for (int ks = 0; ks < 4; ++ks) { const bf16x8 a = frag_row(F.lds + T1, 16 * sb, ks, lane), bb = frag_row(F.lds + T0, 16 * w, ks, lane); a4 = MFMA16(a, bb, a4); }
              float wv4[4];
#pragma unroll
              for (int rg = 0; rg < 4; ++rg) { const int s = 16 * sb + 4 * (lane >> 4) + rg; const float e = fexp(rc + colc[s]) * a4[rg]; wv4[rg] = (s <= t) ? e : 0.f; }
              wpk[sb].x = pk2(wv4[0], wv4[1]); wpk[sb].y = pk2(wv4[2], wv4[3]);
              rsum += bf2f((unsigned short)(wpk[sb].x & 0xffffu)) + bf2f((unsigned short)(wpk[sb].x >> 16)) + bf2f((unsigned short)(wpk[sb].y & 0xffffu)) + bf2f((unsigned short)(wpk[sb].y >> 16)); } } }
    __syncthreads();
    SEC_END(F, 32); SEC_BEGIN(F, 33);
    { int t2 = t; asm volatile("" : "+v"(t2));
#pragma unroll
    for (int sb = 0; sb < 8; ++sb) if (sb <= (w | 1)) *(LAS u32x2*)(F.lds + T1 + off_b(t2, 2 * sb + (lane >> 5)) + 8 * ((lane >> 4) & 1)) = wpk[sb]; }
    rsum += __shfl_xor(rsum, 16); rsum += __shfl_xor(rsum, 32);
    { float qn = 0.f; const int part = lane >> 4;
#pragma unroll
      for (int i = 0; i < 4; ++i) { float f[8]; unpack8(*(const LAS u32x4*)(F.lds + T0 + off_b(t, 4 * part + i)), f);
#pragma unroll
          for (int k = 0; k < 8; ++k) qn += f[k] * npv[32 * part + 8 * i + k]; }
      qn += __shfl_xor(qn, 16); qn += __shfl_xor(qn, 32);
      const float den = rsum + inter[t] * qn;
      if (lane < 16) rdn[t] = 1.0f / fmaxf(fabsf(den), emn[t]); }
    f32x4 acc[8];
#pragma unroll
    for (int vb = 0; vb < 8; ++vb) acc[vb] = (f32x4){0.f, 0.f, 0.f, 0.f};
#pragma unroll
    for (int ks = 0; ks < 4; ++ks) { const bf16x8 a = frag_row(F.lds + T0, 16 * w, ks, lane);
#pragma unroll
        for (int vb = 0; vb < 8; ++vb) { const bf16x8 bb = frag_row(F.lds + T3, 16 * vb, ks, lane); acc[vb] = MFMA16(a, bb, acc[vb]); } }
    float it4[4], rd4[4];
#pragma unroll
    for (int rg = 0; rg < 4; ++rg) { const int tr = 16 * w + 4 * (lane >> 4) + rg; it4[rg] = inter[tr]; rd4[rg] = rdn[tr]; }
#pragma unroll
    for (int vb = 0; vb < 8; ++vb)
#pragma unroll
        for (int rg = 0; rg < 4; ++rg) acc[vb][rg] *= it4[rg];
    for (int ks = 0; ks <= (w >> 1); ++ks) { const bf16x8 a = frag_row(F.lds + T1, 16 * w, ks, lane);
#pragma unroll
        for (int vb = 0; vb < 8; ++vb) { const bf16x8 bb = frag_tr(F.lds + T2, vb, ks, lane); acc[vb] = MFMA16(a, bb, acc[vb]); } }
    SEC_END(F, 33); SEC_BEGIN(F, 34);
#pragma unroll
    for (int rg = 0; rg < 4; ++rg) { float s = 0.f;
#pragma unroll
        for (int vb = 0; vb < 8; ++vb) { acc[vb][rg] *= rd4[rg]; s += acc[vb][rg]; }
        s += __shfl_xor(s, 1); s += __shfl_xor(s, 2); s += __shfl_xor(s, 4); s += __shfl_xor(s, 8);
        const float mean = s * (1.0f / 128.0f); float q = 0.f;
#pragma unroll
        for (int vb = 0; vb < 8; ++vb) { acc[vb][rg] -= mean; q += acc[vb][rg] * acc[vb][rg]; }
        q += __shfl_xor(q, 1); q += __shfl_xor(q, 2); q += __shfl_xor(q, 4); q += __shfl_xor(q, 8);
        const float rstd = 1.0f / sqrtf(q * (1.0f / 128.0f) + 1e-6f);
#pragma unroll
        for (int vb = 0; vb < 8; ++vb) acc[vb][rg] *= rstd; }
#pragma unroll
    for (int vb = 0; vb < 8; ++vb) { const int d = 16 * vb + (lane & 15); const float gg = ngain[h * 128 + d];
#pragma unroll
        for (int rg = 0; rg < 4; ++rg) { int tr = 16 * w + 4 * (lane >> 4) + rg; asm volatile("" : "+v"(tr));
            *(LAS unsigned short*)(F.lds + T1 + off_b(tr, d >> 3) + 2 * (d & 7)) = (unsigned short)(pk2(acc[vb][rg] * gg, 0.f) & 0xffffu); } }
#pragma unroll
    for (int i = 0; i < 4; ++i) { const int id = lane + 64 * i, r = id >> 4, ch = id & 15, tr = 16 * w + r;
        float y[8], o[8]; unpack8(*(const LAS u32x4*)(F.lds + T1 + off_b(tr, ch)), y);
        unpack8(*(const u32x4*)(PROJ + (size_t)(row0 + tr) * PROJ_LD + OO + h * 128 + 8 * ch), o);
#pragma unroll
        for (int k = 0; k < 8; ++k) y[k] *= o[k];
        *(u32x4*)(MIX + (size_t)(row0 + tr) * 1024 + h * 128 + 8 * ch) = pack8(y); }
    { const float* RSG = (const float*)(F.ws + WS_RSG);
#pragma unroll
      for (int i = 0; i < 4; ++i) { const int id = lane + 64 * i, r = id >> 4, ch = id & 15, tr = 16 * w + r;
          bf16* p = MIX + (size_t)(row0 + tr) * 1024 + 512 + h * 128 + 8 * ch; float y[8]; unpack8(*(const u32x4*)p, y);
          const float rs = 1.0f / sqrtf(((RSG[row0 + tr] + RSG[16384 + row0 + tr]) + (RSG[32768 + row0 + tr] + RSG[49152 + row0 + tr])) * (1.0f / 512.0f) + 1e-6f);
#pragma unroll
          for (int kk = 0; kk < 8; ++kk) y[kk] *= rs;
          *(u32x4*)p = pack8(y); } }
    __syncthreads();
    SEC_END(F, 34);
    F0.tsec = F.tsec;
}

__device__ __forceinline__ void phase_router(Frame& F) {
    const float* H = (const float*)(F.ws + WS_H); const float* g2 = F.in[12]; const float* br = F.in[14];
    const bf16* WrThi = (const bf16*)(F.ws + WS_WRT); const bf16* WrTlo = WrThi + 32 * 1024;
    bf16* HN = (bf16*)(F.ws + WS_XN); int* cnt = (int*)(F.ws + WS_CTL) + CW_CNT; int* tokidx = (int*)(F.ws + WS_TOKIDX); float* gatex = (float*)(F.ws + WS_GATEX); float* rsx = (float*)(F.ws + WS_RSX);
    lptr ihi = F.lds, ilo = F.lds + 32 * IMG_ROW;
    LAS float* lg = (LAS float*)(F.lds + 2 * 32 * IMG_ROW);
    LAS int* hist = (LAS int*)(lg + 2048); LAS int* base = hist + 32;
    SEC_BEGIN(F, 4);
    for (int i = F.tid; i < 32 * 128; i += NTHR) { const int n = i >> 7, ch = i & 127;
        *(LAS u32x4*)(ihi + n * IMG_ROW + 16 * ch) = *(const u32x4*)(WrThi + (size_t)n * 1024 + 8 * ch);
        *(LAS u32x4*)(ilo + n * IMG_ROW + 16 * ch) = *(const u32x4*)(WrTlo + (size_t)n * 1024 + 8 * ch); }
    if (F.tid < 32) hist[F.tid] = 0;
    __syncthreads();
    SEC_END(F, 4); SEC_BEGIN(F, 5);
    const int tok0 = F.vcu * 64 + (F.wave & 3) * 16, lane = F.lane;
    int be[4] = {0, 0, 0, 0}, lr[4] = {0, 0, 0, 0}; float gt[4] = {0.f, 0.f, 0.f, 0.f}; float rstd = 0.f;
    if (F.wave >= 4) {
        const float* w_dn = F.in[17]; char* WdnT = (char*)(F.ws + WS_WDNT);
        const int cw = F.vcu * 4 + (F.wave - 4), NCW = F.G * 4;
#pragma unroll 1
        for (int j = 0; j < 24; j += 2) { P0Item it[2]; f32x4 v[2][8];
#pragma unroll
            for (int q = 0; q < 2; ++q) { const int jj = j + q;
                if (jj < 16) { const int r = cw + jj * NCW, e = r / 512, qq = r % 512, kb = qq / 32, nb = qq % 32;
                    it[q].src = w_dn + ((size_t)e * 1024 + 64 * kb) * 1024 + 32 * nb; it[q].ld = 1024; it[q].esz = MOE_ESZ; it[q].dst = WdnT + (((size_t)e * 1024 + 32 * nb) * 1024 + 64 * kb) * MOE_ESZ; }
                else { const int r = cw + (jj - 16) * NCW, e = 24 + r / 1024, qq = r % 1024, kb = qq / 64, nb = qq % 64, n = 32 * nb, half = n >> 10, j2 = n & 1023, pn = j2 >> 7, j3 = j2 & 127, nd = 256 * pn + 128 * half + j3;
                    it[q].src = F.in[15] + ((size_t)e * 1024 + 64 * kb) * 2048 + n; it[q].ld = 2048; it[q].esz = MOE_ESZ; it[q].dst = (char*)(F.ws + WS_WUPT) + (((size_t)e * 2048 + nd) * 1024 + 64 * kb) * MOE_ESZ; }
                p0_load(it[q], lane, v[q]); }
#pragma unroll
            for (int q = 0; q < 2; ++q) p0_store(it[q], lane, v[q]); } }
    if (F.wave < 4) {
        f32x4 acc[2];
        rstd = row_pass<2, MOE_FP8 != 0>(H, g2, HN, ihi, ilo, tok0, lane, acc);
        { float rr[4];
#pragma unroll
          for (int rg = 0; rg < 4; ++rg) rr[rg] = __shfl(rstd, 4 * (lane >> 4) + rg);
#pragma unroll
          for (int nf = 0; nf < 2; ++nf)
#pragma unroll
              for (int rg = 0; rg < 4; ++rg) lg[(F.wave * 16 + 4 * (lane >> 4) + rg) * 32 + 16 * nf + (lane & 15)] = acc[nf][rg] * rr[rg]; }
        if (lane < 16) { float v[32];
#pragma unroll
            for (int q4 = 0; q4 < 8; ++q4) { const f32x4 x = *(const LAS f32x4*)(lg + (F.wave * 16 + lane) * 32 + 4 * q4), bb = *(const f32x4*)(br + 4 * q4);
                v[4 * q4] = x[0] + bb[0]; v[4 * q4 + 1] = x[1] + bb[1]; v[4 * q4 + 2] = x[2] + bb[2]; v[4 * q4 + 3] = x[3] + bb[3]; }
            float bv[4];
#pragma unroll
            for (int k = 0; k < 4; ++k) { float best = -INFINITY; int bi = 0;
#pragma unroll
                for (int e = 0; e < 32; ++e) if (v[e] > best) { best = v[e]; bi = e; }
                be[k] = bi; bv[k] = best;
#pragma unroll
                for (int e = 0; e < 32; ++e) v[e] = (e == bi) ? -INFINITY : v[e]; }
            float den = 0.f;
#pragma unroll
            for (int k = 0; k < 4; ++k) { gt[k] = fexp(bv[k] - bv[0]); den += gt[k]; }
            const float rd = 1.0f / den;
#pragma unroll
            for (int k = 0; k < 4; ++k) { gt[k] *= rd; lr[k] = __hip_atomic_fetch_add(hist + be[k], 1, __ATOMIC_RELAXED, __HIP_MEMORY_SCOPE_WORKGROUP); } } }
    SEC_END(F, 5); SEC_BEGIN(F, 6);
    __syncthreads();
    if (F.tid < 32) base[F.tid] = hist[F.tid] > 0 ? atomicAdd(&cnt[F.tid], hist[F.tid]) : 0;
    __syncthreads();
    if (F.wave < 4 && lane < 16) { const int tok = tok0 + lane;
#pragma unroll
        for (int k = 0; k < 4; ++k) { const int rk = base[be[k]] + lr[k]; const size_t p = (size_t)be[k] * 65536 + rk; tokidx[p] = tok * 4 + k; gatex[p] = gt[k]; rsx[p] = rstd; } }
    __syncthreads();
    SEC_END(F, 6);
}

__device__ __forceinline__ int build_ttab(const Frame& F) {
    const int* cnt = (const int*)(F.ws + WS_CTL) + CW_CNT; LAS unsigned* ttab = (LAS unsigned*)(F.lds + TTAB_OFF); LAS int* tot = (LAS int*)(F.lds + MISC_OFF + 64);
    if (F.wave == 0) { const int l = F.lane; const int c = l < 32 ? __hip_atomic_load(cnt + l, RLX_AGENT) : 0; const int nt = (c + 255) >> 8;
        int inc = nt;
#pragma unroll
        for (int o = 1; o < 64; o <<= 1) { const int tt = __shfl_up(inc, o); if (l >= o) inc += tt; }
        const int start = inc - nt;
        for (int r = 0; r < nt; ++r) { const int left = c - 256 * r; ttab[start + r] = (unsigned)l | ((unsigned)r << 5) | ((unsigned)((left < 256 ? left : 256) - 1) << 14); }
        if (l == 63) tot[0] = inc; }
    __syncthreads();
    return tot[0];
}

__device__ __forceinline__ void phase_final(const Frame& F) {
    const float* H = (const float*)(F.ws + WS_H); const bf16* Y = (const bf16*)(F.ws + WS_Y); const float* gf = F.in[19];
    const int gw = F.vcu * NWAVES + F.wave, lane = F.lane;
    f32x4 gg[4];
#pragma unroll
    for (int j = 0; j < 4; ++j) gg[j] = *(const f32x4*)(gf + 4 * (lane + 64 * j));
#pragma unroll 1
    for (int i = 0; i < 8; i += 2) { const int tok = gw * 8 + i;
        f32x4 v[2][4]; u32x2 y[2][4][4];
#pragma unroll
        for (int q = 0; q < 2; ++q)
#pragma unroll
            for (int j = 0; j < 4; ++j) { v[q][j] = __builtin_nontemporal_load((const f32x4*)(H + (size_t)(tok + q) * 1024 + 4 * (lane + 64 * j)));
#pragma unroll
                for (int k = 0; k < 4; ++k) y[q][j][k] = __builtin_nontemporal_load((const u32x2*)(Y + (size_t)((tok + q) * 4 + k) * 1024 + 4 * (lane + 64 * j))); }
#pragma unroll
        for (int q = 0; q < 2; ++q) { float s = 0.f;
#pragma unroll
            for (int j = 0; j < 4; ++j) {
#pragma unroll
                for (int k = 0; k < 4; ++k) { const u32x2 yy = y[q][j][k];
                    v[q][j][0] += __builtin_bit_cast(float, yy.x << 16); v[q][j][1] += __builtin_bit_cast(float, yy.x & 0xffff0000u);
                    v[q][j][2] += __builtin_bit_cast(float, yy.y << 16); v[q][j][3] += __builtin_bit_cast(float, yy.y & 0xffff0000u); }
                s += (v[q][j][0] * v[q][j][0] + v[q][j][1] * v[q][j][1]) + (v[q][j][2] * v[q][j][2] + v[q][j][3] * v[q][j][3]); }
            const float r = 1.0f / sqrtf(wsum_all(s) * (1.0f / 1024.0f) + 1e-6f);
#pragma unroll
            for (int j = 0; j < 4; ++j) __builtin_nontemporal_store(v[q][j] * r * gg[j], (f32x4*)(F.out + (size_t)(tok + q) * 1024 + 4 * (lane + 64 * j))); } }
}

constexpr int N_PHASES = 10;
struct Args { const float* in[20]; float* out; unsigned char* ws; int ph_lo, ph_hi; };
__global__ void __launch_bounds__(NTHR, 2) mk_fwd(Args args) {
    extern __shared__ __attribute__((aligned(16))) unsigned char lds_raw[];
    Frame F; F.t0 = 0ull; F.tsec = 0ull;
    F.lds = (lptr)lds_raw; F.tid = threadIdx.x; F.lane = F.tid & 63; F.wave = __builtin_amdgcn_readfirstlane(F.tid >> 6);
    F.G = gridDim.x; { const int bx = blockIdx.x; F.vcu = (F.G % 8 == 0) ? (bx % 8) * (F.G / 8) + bx / 8 : bx; }
#pragma unroll
    for (int i = 0; i < 20; ++i) F.in[i] = args.in[i];
    F.out = args.out; F.ws = args.ws;
    for (int u = F.tid; u < (LDS_BYTES - CTL_OFF) / 4; u += NTHR) ((LAS unsigned*)(F.lds + CTL_OFF))[u] = 0u;
    __syncthreads();
    XcdBarrier bar = xcd_barrier_post((unsigned*)(F.ws + WS_CTL) + CW_BAR, (volatile LAS unsigned*)(F.lds + MISC_OFF));
    const int lo = args.ph_lo, hi = args.ph_hi;
#define IN(k) (lo <= (k) && (k) < hi)
#ifndef PROBE_LO
#define PROBE_LO -1
#define PROBE_HI -1
#endif
    unsigned long long tp0 = 0ull;
#define SEAM(k) do { if (IN(k) && IN((k) + 1)) xcd_barrier(bar); \
        if (PROBE_HI == (k) + 1) { const unsigned long long tn = __builtin_amdgcn_s_memrealtime(), dt = tn - tp0; while (__builtin_amdgcn_s_memrealtime() - tn < dt) __builtin_amdgcn_s_sleep(8); __syncthreads(); } \
        if (PROBE_LO == (k) + 1) tp0 = __builtin_amdgcn_s_memrealtime(); } while (0)
    const int bx = blockIdx.x;
    if (PROBE_LO == 0) tp0 = __builtin_amdgcn_s_memrealtime();
    if (IN(0)) { phase0(F); } SEAM(0);
    if (IN(1)) { pg8::DenseOps ops{(const bf16*)(F.ws + WS_XN), (const bf16*)(F.ws + WS_WINT), 1024}; pg8::StaticOrder S; S.init(64, 12, F.G, bx, 4);
        pg8::EpiProj E{(bf16*)(F.ws + WS_PROJ), PROJ_LD, (const float*)(F.ws + WS_RS1)};
        pg8::gemm_phase<pg8::EpiProj, pg8::StaticOrder, pg8::DenseOps, false, true>(F.lds, 1024, S, ops, E); } SEAM(1);
    if (IN(2)) {
#pragma unroll 1
        for (int j = 0; j < 2; ++j) mlstm_local_unit(F, F.vcu * 2 + j);
#pragma unroll 1
        for (int j = 0; j < 2; ++j) gmlp_unit(F, F.vcu * 2 + j); } SEAM(2);
    if (IN(3)) { phase_scan(F); } SEAM(3);
    if (IN(4)) {
#pragma unroll 1
        for (int j = 0; j < 2; ++j) mlstm_out_unit(F, F.vcu * 2 + j); } SEAM(4);
    if (IN(5)) { pg8::DenseOps ops{(const bf16*)(F.ws + WS_MIX), (const bf16*)(F.ws + WS_WOUTT), 1024}; pg8::StaticOrder S; S.init(64, 4, F.G, bx);
        pg8::EpiRes E{F.in[0], (float*)(F.ws + WS_H), 1024};
        pg8::gemm_phase<pg8::EpiRes, pg8::StaticOrder, pg8::DenseOps, false, false>(F.lds, 1024, S, ops, E); } SEAM(5);
    if (IN(6)) { phase_router(F); } SEAM(6);
    if (IN(7)) { const int nM = build_ttab(F);
        pg8::UpOps ops{F.ws + WS_XN, F.ws + WS_WUPT, (const int*)(F.ws + WS_TOKIDX), 1024u * MOE_ESZ};
        pg8::MoeOrder S; S.init(nM, 8, F.G, bx, 4); S.ttab = (const LAS unsigned*)(F.lds + TTAB_OFF);
        pg8::EpiUp<MOE_FP8 != 0> E{F.ws + WS_ACT, F.in[16], (const float*)(F.ws + WS_RSX), MOE_FP8 ? 1.0f / W8_SCALE : 1.0f};
        pg8::gemm_phase<pg8::EpiUp<MOE_FP8 != 0>, pg8::MoeOrder, pg8::UpOps, true, true, MOE_FP8 != 0>(F.lds, 512 * MOE_ESZ, S, ops, E); } SEAM(7);
    if (IN(8)) { const int nM = build_ttab(F);
        pg8::DownOps ops{F.ws + WS_ACT, F.ws + WS_WDNT, 1024u * MOE_ESZ};
        pg8::MoeOrder S; S.init(nM, 4, F.G, bx); S.ttab = (const LAS unsigned*)(F.lds + TTAB_OFF);
        pg8::EpiDown E{(bf16*)(F.ws + WS_Y), F.in[18], (const float*)(F.ws + WS_GATEX), (const int*)(F.ws + WS_TOKIDX), MOE_FP8 ? 1.0f / W8_SCALE : 1.0f};
        pg8::gemm_phase<pg8::EpiDown, pg8::MoeOrder, pg8::DownOps, false, true, MOE_FP8 != 0>(F.lds, 512 * MOE_ESZ, S, ops, E); } SEAM(8);
    if (IN(9)) { phase_final(F); } SEAM(9);
    if (PROBE_SEC >= 0) { const unsigned long long tn = __builtin_amdgcn_s_memrealtime(); while (__builtin_amdgcn_s_memrealtime() - tn < F.tsec) __builtin_amdgcn_s_sleep(8); }
#undef IN
#undef SEAM
}

extern "C" void kernel_launch(void* const* d_in, const int* in_sizes, int n_in, void* d_out, int out_size, void* d_ws, size_t ws_size, hipStream_t stream) {
    static int ready = 0;
    if (!ready) {
        if (hipFuncSetAttribute((const void*)mk_fwd, hipFuncAttributeMaxDynamicSharedMemorySize, LDS_BYTES) != hipSuccess) { fprintf(stderr, "hipFuncSetAttribute failed\n"); return; }
        ready = 1;
    }
    char* ws = (char*)d_ws;
    if (ws_size < 800 * MiB) { fprintf(stderr, "ws too small: %zu\n", ws_size); return; }
    (void)hipMemsetAsync(ws + WS_CTL, 0, CTL_ZERO_BYTES, stream);
    Args a{};
    for (int i = 0; i < 20; ++i) a.in[i] = (const float*)d_in[i];
    a.out = (float*)d_out; a.ws = (unsigned char*)d_ws; a.ph_lo = 0; a.ph_hi = N_PHASES;
    hipLaunchKernelGGL(mk_fwd, dim3(256), dim3(NTHR), LDS_BYTES, stream, a);
}
```

```cpp
#include <hip/hip_runtime.h>
#include <cstdio>
#include <cstdint>
#include <cstddef>
#include <cmath>


namespace pg8 {
#define PG8_LAS __attribute__((address_space(3)))
typedef unsigned short bf16_t;
typedef short bf16x8 __attribute__((ext_vector_type(8)));
typedef float f32x4 __attribute__((ext_vector_type(4)));
typedef float f32x2 __attribute__((ext_vector_type(2)));
typedef unsigned u32x4 __attribute__((ext_vector_type(4)));
typedef unsigned u32x2 __attribute__((ext_vector_type(2)));
typedef int i32x4 __attribute__((ext_vector_type(4)));
typedef int i32x8 __attribute__((ext_vector_type(8)));
constexpr int BM = 256, BK = 64, HALF = 128, HTB = HALF * BK * 2, STAGE_BYTES = 8 * HTB, NXCD = 8, WGM = 8;

__host__ __device__ __forceinline__ int lds_byte(int r, int c) { const int st = (r >> 4) * 2 + (c >> 5), rr = r & 15, cc = c & 31, ob = rr * 64 + cc * 2; return st * 1024 + (ob ^ (((ob >> 9) & 1) << 5)); }
__host__ __device__ __forceinline__ void stage_rc(int b, int& R, int& C) { const int st = b / 1024, sb = b % 1024, swz = sb ^ (((sb >> 9) & 1) << 5); R = (st >> 1) * 16 + swz / 64; C = (st & 1) * 32 + (swz % 64) / 2; }
__host__ __device__ __forceinline__ int perm32(int rho) { const int n = rho >> 4, i = rho & 15; return 8 * (i >> 2) + 4 * n + (i & 3); }

struct Unit { int pm, pn, e, rt, nrows; };

struct StaticOrder {
    int nM, nN, nwg, G, c, wgm;
    __device__ void init(int nM_, int nN_, int G_, int c_, int wgm_ = WGM) { nM = nM_; nN = nN_; nwg = nM * nN; G = G_; c = c_; wgm = wgm_; }
    __device__ bool next(int i, Unit& u) const {
        const long L = (long)i * G + c; if (L >= nwg) return false;
        int wgid = (int)L; { const int q = nwg / NXCD, r = nwg % NXCD, xcd = wgid % NXCD, off = wgid / NXCD; wgid = (xcd < r ? xcd * (q + 1) : r * (q + 1) + (xcd - r) * q) + off; }
        const int nig = wgm * nN, gid = wgid / nig, fm = gid * wgm, gsz = (nM - fm) < wgm ? (nM - fm) : wgm;
        u.pm = fm + ((wgid % nig) % gsz); u.pn = (wgid % nig) / gsz; u.e = 0; u.rt = 0; u.nrows = 256; return true;
    }
};
struct MoeOrder : StaticOrder {
    const PG8_LAS unsigned* ttab;
    __device__ bool next(int i, Unit& u) const {
        if (!StaticOrder::next(i, u)) return false;
        const unsigned w = ttab[u.pm]; u.e = (int)(w & 31u); u.rt = (int)((w >> 5) & 511u); u.nrows = (int)((w >> 14) & 255u) + 1; return true;
    }
};

__device__ __forceinline__ unsigned cvt_pk_bf16(float lo, float hi) { unsigned r; asm volatile("v_cvt_pk_bf16_f32 %0, %1, %2" : "=v"(r) : "v"(lo), "v"(hi)); return r; }

struct DenseOps {
    const bf16_t* A; const bf16_t* Bt; int K;
    __device__ __forceinline__ const char* a_base(const Unit& u) const { return (const char*)A + (size_t)u.pm * BM * K * 2; }
    __device__ __forceinline__ const char* b_base(const Unit& u) const { return (const char*)Bt + (size_t)u.pn * BM * K * 2; }
    __device__ __forceinline__ void gather(const Unit&, const int (&)[2], const int (&)[2], unsigned (&)[2][2]) const {}
};
struct UpOps {
    const void* HN; const void* WupT; const int* tokidx; unsigned pitch;
    __device__ __forceinline__ const char* a_base(const Unit&) const { return (const char*)HN; }
    __device__ __forceinline__ const char* b_base(const Unit& u) const { return (const char*)WupT + ((size_t)u.e * 2048 + (size_t)u.pn * BM) * pitch; }
    __device__ __forceinline__ void gather(const Unit& u, const int (&R)[2], const int (&C)[2], unsigned (&v)[2][2]) const {
        const int* tl = tokidx + (size_t)u.e * 65536 + u.rt * 256;
#pragma unroll
        for (int h = 0; h < 2; ++h)
#pragma unroll
            for (int i = 0; i < 2; ++i) { const int r = R[i] + 128 * h; const int idx = tl[r < u.nrows ? r : 0]; v[h][i] = (unsigned)(idx >> 2) * pitch + (unsigned)C[i] * 2u; }
    }
};
struct DownOps {
    const void* ACT; const void* WdnT; unsigned pitch;
    __device__ __forceinline__ const char* a_base(const Unit& u) const { return (const char*)ACT + (size_t)u.pm * BM * pitch; }
    __device__ __forceinline__ const char* b_base(const Unit& u) const { return (const char*)WdnT + ((size_t)u.e * 1024 + (size_t)u.pn * BM) * pitch; }
    __device__ __forceinline__ void gather(const Unit&, const int (&)[2], const int (&)[2], unsigned (&)[2][2]) const {}
};
__device__ __forceinline__ unsigned pk4_fp8(float a, float b, float c, float d) { int r = __builtin_amdgcn_cvt_pk_fp8_f32(a, b, 0, false); r = __builtin_amdgcn_cvt_pk_fp8_f32(c, d, r, true); return (unsigned)r; }

struct EpiProj {
    static constexpr bool PERM = true;
    bf16_t* O; int ldc; const float* rs;
    static __device__ __forceinline__ float sigm(float x) { return __builtin_amdgcn_rcpf(1.0f + __builtin_amdgcn_exp2f(-1.4426950408889634f * x)); }
    static __device__ __forceinline__ float act(float x, int mode) {
        if (mode == 1) return sigm(x);
        if (mode == 2) return x * sigm(1.5957691216057308f * (x + 0.044715f * x * x * x));
        return x; }
    __device__ __forceinline__ void operator()(const f32x4 (&acc)[2][2][4][2], const Unit& u, int wr, int wc, int fr, int fq) const {
        const int row0 = u.pm * BM + wr * 64 + fr, col0 = u.pn * BM + wc * 32 + 8 * fq;
        const int mode = u.pn >= 8 ? 2 : (u.pn >= 6 ? 1 : 0);
        float sc[2][4];
#pragma unroll
        for (int ai = 0; ai < 2; ++ai)
#pragma unroll
            for (int m = 0; m < 4; ++m) sc[ai][m] = rs[row0 + ai * HALF + m * 16];
#pragma unroll
        for (int ai = 0; ai < 2; ++ai)
#pragma unroll
            for (int m = 0; m < 4; ++m) { bf16_t* rowp = O + (size_t)(row0 + ai * HALF + m * 16) * ldc + col0;
#pragma unroll
                for (int bj = 0; bj < 2; ++bj) { f32x4 v0 = acc[ai][bj][m][0] * sc[ai][m], v1 = acc[ai][bj][m][1] * sc[ai][m];
                    if (mode != 0) {
#pragma unroll
                        for (int i = 0; i < 4; ++i) { v0[i] = act(v0[i], mode); v1[i] = act(v1[i], mode); } }
                    u32x4 w; w.x = cvt_pk_bf16(v0[0], v0[1]); w.y = cvt_pk_bf16(v0[2], v0[3]); w.z = cvt_pk_bf16(v1[0], v1[1]); w.w = cvt_pk_bf16(v1[2], v1[3]);
                    *(u32x4*)(rowp + bj * HALF) = w; } }
    }
};
struct EpiRes {
    static constexpr bool PERM = false;
    const float* base; float* C; int ldc;
    __device__ __forceinline__ void operator()(const f32x4 (&acc)[2][2][4][2], const Unit& u, int wr, int wc, int fr, int fq) const {
        const int row0 = u.pm * BM + wr * 64 + fr, col0 = u.pn * BM + wc * 32 + 4 * fq;
#pragma unroll
        for (int ai = 0; ai < 2; ++ai)
#pragma unroll
            for (int m = 0; m < 4; ++m) { const size_t off = (size_t)(row0 + ai * HALF + m * 16) * ldc + col0;
#pragma unroll
                for (int bj = 0; bj < 2; ++bj)
#pragma unroll
                    for (int n = 0; n < 2; ++n) *(f32x4*)(C + off + bj * HALF + n * 16) = *(const f32x4*)(base + off + bj * HALF + n * 16) + acc[ai][bj][m][n]; }
    }
};
template <bool OUT8>
struct EpiUp {
    static constexpr bool PERM = true;
    void* ACT; const float* b_up; const float* rsx; float wsc;
    __device__ __forceinline__ void operator()(const f32x4 (&acc)[2][2][4][2], const Unit& u, int wr, int wc, int fr, int fq) const {
        const int r0 = wr * 64 + fr, row0 = u.pm * BM + r0, j0 = wc * 32 + 8 * fq;
        const float* bg = b_up + (size_t)u.e * 2048 + u.pn * 128 + j0;
        const float* rp = rsx + (size_t)u.e * 65536 + u.rt * 256;
        f32x4 bgl[2], bln[2]; float sc[2][4];
#pragma unroll
        for (int n = 0; n < 2; ++n) { bgl[n] = *(const f32x4*)(bg + 4 * n); bln[n] = *(const f32x4*)(bg + 1024 + 4 * n); }
#pragma unroll
        for (int ai = 0; ai < 2; ++ai)
#pragma unroll
            for (int m = 0; m < 4; ++m) { const int r = r0 + ai * HALF + m * 16; sc[ai][m] = rp[r < u.nrows ? r : 0] * wsc; }
#pragma unroll
        for (int ai = 0; ai < 2; ++ai)
#pragma unroll
            for (int m = 0; m < 4; ++m) { const size_t eoff = (size_t)(row0 + ai * HALF + m * 16) * 1024 + u.pn * 128 + j0;
                float o[8];
#pragma unroll
                for (int n = 0; n < 2; ++n) { const f32x4 g = acc[ai][0][m][n] * sc[ai][m] + bgl[n], l = acc[ai][1][m][n] * sc[ai][m] + bln[n];
#pragma unroll
                    for (int i = 0; i < 4; ++i) { const float gl = fminf(g[i], 7.0f), ln = fminf(fmaxf(l[i], -7.0f), 7.0f);
                        o[n * 4 + i] = gl * __builtin_amdgcn_rcpf(1.0f + __builtin_amdgcn_exp2f(-2.4554669595930157f * gl)) * (ln + 1.0f); } }
                if (OUT8) { u32x2 w; w.x = pk4_fp8(o[0], o[1], o[2], o[3]); w.y = pk4_fp8(o[4], o[5], o[6], o[7]); *(u32x2*)((char*)ACT + eoff) = w; }
                else { u32x4 w; w.x = cvt_pk_bf16(o[0], o[1]); w.y = cvt_pk_bf16(o[2], o[3]); w.z = cvt_pk_bf16(o[4], o[5]); w.w = cvt_pk_bf16(o[6], o[7]); *(u32x4*)((char*)ACT + 2 * eoff) = w; } }
    }
};
struct EpiDown {
    static constexpr bool PERM = true;
    bf16_t* Y; const float* b_dn; const float* gatex; const int* tokidx; float wsc;
    __device__ __forceinline__ void operator()(const f32x4 (&acc)[2][2][4][2], const Unit& u, int wr, int wc, int fr, int fq) const {
        const int r0 = wr * 64 + fr, col0 = u.pn * BM + wc * 32 + 8 * fq;
        const int* tl = tokidx + (size_t)u.e * 65536 + u.rt * 256; const float* gl = gatex + (size_t)u.e * 65536 + u.rt * 256;
        const float* bb = b_dn + (size_t)u.e * 1024 + col0;
        f32x4 bv[2][2]; int idx[2][4]; float gt[2][4];
#pragma unroll
        for (int ai = 0; ai < 2; ++ai)
#pragma unroll
            for (int m = 0; m < 4; ++m) { const int r = r0 + ai * HALF + m * 16, rr = r < u.nrows ? r : 0; idx[ai][m] = tl[rr]; gt[ai][m] = gl[rr]; }
#pragma unroll
        for (int bj = 0; bj < 2; ++bj)
#pragma unroll
            for (int n = 0; n < 2; ++n) bv[bj][n] = *(const f32x4*)(bb + bj * HALF + 4 * n);
#pragma unroll
        for (int ai = 0; ai < 2; ++ai)
#pragma unroll
            for (int m = 0; m < 4; ++m) { const int r = r0 + ai * HALF + m * 16;
                if (r < u.nrows) { bf16_t* rowp = Y + (size_t)idx[ai][m] * 1024 + col0; const float g1 = gt[ai][m];
#pragma unroll
                    for (int bj = 0; bj < 2; ++bj) { const f32x4 v0 = (acc[ai][bj][m][0] * wsc + bv[bj][0]) * g1, v1 = (acc[ai][bj][m][1] * wsc + bv[bj][1]) * g1;
                        u32x4 w; w.x = cvt_pk_bf16(v0[0], v0[1]); w.y = cvt_pk_bf16(v0[2], v0[3]); w.z = cvt_pk_bf16(v1[0], v1[1]); w.w = cvt_pk_bf16(v1[2], v1[3]);
                        *(u32x4*)(rowp + bj * HALF) = w; } } }
    }
};

#ifndef FP8_SCALE
#define FP8_SCALE 0
#endif
template <class Epi, class Sched, class Ops, bool GATHER, bool ALIGN_EPI, bool FP8 = false>
__device__ __forceinline__ void gemm_phase(PG8_LAS unsigned char* lds, const int K, const Sched& S, const Ops& O, const Epi& E) {
    const int tid = threadIdx.x, wid = __builtin_amdgcn_readfirstlane(tid >> 6), lane = tid & 63, wr = wid >> 2, wc = wid & 3, fr = lane & 15, fq = lane >> 4;
    const int nt = K / BK;
    unsigned voffA[2], voffB[2]; int sR[2], sC[2];
#pragma unroll
    for (int i = 0; i < 2; ++i) { int R, C; stage_rc(tid * 16 + i * 8192, R, C); const int Rb = Epi::PERM ? ((R & ~31) + perm32(R & 31)) : R; sR[i] = R; sC[i] = C;
        voffA[i] = (unsigned)(R * K + C) * 2u; voffB[i] = (unsigned)(Rb * K + C) * 2u; }
    const size_t kstep = (size_t)(BK * 2);
    const size_t hstep = (size_t)HALF * K * 2;
    const unsigned ldsw = (unsigned)wid * 1024u;
    const int aoff = lds_byte(wr * 64 + fr, fq * 8), boff = lds_byte(wc * 32 + fr, fq * 8);
#define PG8_SA(b, h) (((b) * 2 + (h)) * HTB)
#define PG8_SB(b, h) ((4 + (b) * 2 + (h)) * HTB)
#define PG8_STAGE(bufoff, gbase, voff) do { _Pragma("unroll") for (int _i = 0; _i < 2; ++_i) \
        __builtin_amdgcn_global_load_lds((const unsigned*)((const char*)(gbase) + (voff)[_i]), (PG8_LAS unsigned*)(lds + (bufoff) + ldsw + _i * 8192), 16, 0, 0); } while (0)
#define PG8_STAGE_AC(bufoff, kptr, h) do { if constexpr (GATHER) PG8_STAGE(bufoff, kptr, vC[h]); else PG8_STAGE(bufoff, (kptr) + (h) * hstep, voffA); } while (0)
#define PG8_STAGE_AS(bufoff, kptr, h) do { if constexpr (GATHER) PG8_STAGE(bufoff, kptr, vS[h]); else PG8_STAGE(bufoff, (kptr) + (h) * hstep, voffA); } while (0)
#define PG8_LDA(dst, b, h) do { _Pragma("unroll") for (int m = 0; m < 4; ++m) _Pragma("unroll") for (int k = 0; k < 2; ++k) dst[m][k] = *(const PG8_LAS bf16x8*)(lds + PG8_SA(b, h) + aoff + m * 2048 + k * 1024); } while (0)
#define PG8_LDB(dst, b, h) do { _Pragma("unroll") for (int n = 0; n < 2; ++n) _Pragma("unroll") for (int k = 0; k < 2; ++k) dst[n][k] = *(const PG8_LAS bf16x8*)(lds + PG8_SB(b, h) + boff + n * 2048 + k * 1024); } while (0)
#define PG8_CAT8(x) __builtin_shufflevector(__builtin_bit_cast(i32x4, (x)[0]), __builtin_bit_cast(i32x4, (x)[1]), 0, 1, 2, 3, 4, 5, 6, 7)
#define PG8_MMA(ai, bj, At, Bt) do { __builtin_amdgcn_s_setprio(1); \
        if constexpr (FP8) { _Pragma("unroll") for (int m = 0; m < 4; ++m) _Pragma("unroll") for (int n = 0; n < 2; ++n) \
            asm volatile("v_mfma_f32_16x16x128_f8f6f4 %0, %1, %2, %0" : "+v"(acc[ai][bj][m][n]) : "v"(PG8_CAT8(Bt[n])), "v"(PG8_CAT8(At[m]))); } \
        else { _Pragma("unroll") for (int m = 0; m < 4; ++m) _Pragma("unroll") for (int n = 0; n < 2; ++n) _Pragma("unroll") for (int k = 0; k < 2; ++k) \
            acc[ai][bj][m][n] = __builtin_amdgcn_mfma_f32_16x16x32_bf16(Bt[n][k], At[m][k], acc[ai][bj][m][n], 0, 0, 0); } \
        __builtin_amdgcn_s_setprio(0); } while (0)
#define PG8_WAIT_V(n) asm volatile("s_waitcnt vmcnt(" #n ")" ::: "memory")
#define PG8_WAIT_L(n) asm volatile("s_waitcnt lgkmcnt(" #n ")" ::: "memory")
#define PG8_BAR __builtin_amdgcn_s_barrier()
#define PG8_SCHED __builtin_amdgcn_sched_barrier(0)
    Unit cur, nxt; int ui = 0;
    if (!S.next(0, cur)) return;
    f32x4 acc[2][2][4][2];
#pragma unroll
    for (int a = 0; a < 2; ++a)
#pragma unroll
        for (int b = 0; b < 2; ++b)
#pragma unroll
            for (int m = 0; m < 4; ++m)
#pragma unroll
                for (int n = 0; n < 2; ++n) acc[a][b][m][n] = (f32x4){0.f, 0.f, 0.f, 0.f};
    bf16x8 At[4][2], B0[2][2], B1[2][2];
    unsigned vC[2][2] = {{0u, 0u}, {0u, 0u}}, vN[2][2] = {{0u, 0u}, {0u, 0u}}, vS[2][2] = {{0u, 0u}, {0u, 0u}};
    if constexpr (GATHER) O.gather(cur, sR, sC, vC);
    const char* cA = O.a_base(cur); const char* cB = O.b_base(cur);
    PG8_STAGE(PG8_SB(0, 0), cB, voffB); PG8_STAGE(PG8_SB(0, 1), cB + hstep, voffB); PG8_STAGE_AC(PG8_SA(0, 0), cA, 0); PG8_STAGE_AC(PG8_SA(0, 1), cA, 1);
    if (wr == 1) PG8_BAR;
    PG8_WAIT_V(2); PG8_BAR;
    PG8_STAGE(PG8_SB(1, 0), cB + kstep, voffB); PG8_STAGE_AC(PG8_SA(1, 0), cA + kstep, 0); PG8_STAGE(PG8_SB(1, 1), cB + hstep + kstep, voffB);
    PG8_WAIT_V(6); PG8_BAR;
    for (;;) {
        const bool has_next = S.next(ui + 1, nxt);
        const char* nA = has_next ? O.a_base(nxt) : cA; const char* nB = has_next ? O.b_base(nxt) : cB;
        if constexpr (GATHER) { if (has_next) O.gather(nxt, sR, sC, vN); else {
#pragma unroll
            for (int h = 0; h < 2; ++h)
#pragma unroll
                for (int i = 0; i < 2; ++i) vN[h][i] = vC[h][i]; } }
#pragma unroll 1
        for (int t = 0; t < nt; t += 2) {
            const bool last = (t == nt - 2);
            const char* a1 = cA + (size_t)(t + 1) * kstep;
            const char* a2 = last ? nA : cA + (size_t)(t + 2) * kstep; const char* b2 = last ? nB : cB + (size_t)(t + 2) * kstep;
            const char* a3 = a2 + kstep; const char* b3 = b2 + kstep;
            if constexpr (GATHER) {
#pragma unroll
                for (int h = 0; h < 2; ++h)
#pragma unroll
                    for (int i = 0; i < 2; ++i) vS[h][i] = last ? vN[h][i] : vC[h][i]; }
            PG8_LDB(B0, 0, 0); PG8_LDB(B1, 0, 1); PG8_SCHED; PG8_LDA(At, 0, 0); PG8_STAGE_AC(PG8_SA(1, 1), a1, 1);
            PG8_WAIT_V(8); PG8_WAIT_L(0); PG8_BAR; PG8_MMA(0, 0, At, B0); PG8_MMA(0, 1, At, B1); PG8_BAR; PG8_SCHED;
            PG8_LDA(At, 0, 1); PG8_STAGE(PG8_SB(0, 0), b2, voffB); PG8_STAGE(PG8_SB(0, 1), b2 + hstep, voffB); PG8_STAGE_AS(PG8_SA(0, 0), a2, 0);
            PG8_WAIT_V(8); PG8_WAIT_L(0); PG8_BAR; PG8_MMA(1, 0, At, B0); PG8_MMA(1, 1, At, B1); PG8_BAR; PG8_SCHED;
            PG8_LDB(B0, 1, 0); PG8_LDB(B1, 1, 1); PG8_SCHED; PG8_LDA(At, 1, 0); PG8_STAGE_AS(PG8_SA(0, 1), a2, 1);
            PG8_WAIT_V(8); PG8_WAIT_L(0); PG8_BAR; PG8_MMA(0, 0, At, B0); PG8_MMA(0, 1, At, B1); PG8_BAR; PG8_SCHED;
            PG8_LDA(At, 1, 1); PG8_STAGE(PG8_SB(1, 0), b3, voffB); PG8_STAGE(PG8_SB(1, 1), b3 + hstep, voffB); PG8_STAGE_AS(PG8_SA(1, 0), a3, 0);
            PG8_WAIT_V(8); PG8_WAIT_L(0); PG8_BAR; PG8_MMA(1, 0, At, B0); PG8_MMA(1, 1, At, B1); PG8_BAR; PG8_SCHED;
        }
        if constexpr (ALIGN_EPI) { if (wr == 0) PG8_BAR; }
        if constexpr (FP8) asm volatile("s_nop 15\n\ts_nop 3" ::: "memory");
        { int fr_e = fr, fq_e = fq; asm volatile("" : "+v"(fr_e), "+v"(fq_e));
          E(acc, cur, wr, wc, fr_e, fq_e); }
        if (!has_next) break;
#pragma unroll
        for (int a = 0; a < 2; ++a)
#pragma unroll
            for (int b = 0; b < 2; ++b)
#pragma unroll
                for (int m = 0; m < 4; ++m)
#pragma unroll
                    for (int n = 0; n < 2; ++n) acc[a][b][m][n] = (f32x4){0.f, 0.f, 0.f, 0.f};
        cur = nxt; cA = nA; cB = nB; ++ui;
        if constexpr (GATHER) {
#pragma unroll
            for (int h = 0; h < 2; ++h)
#pragma unroll
                for (int i = 0; i < 2; ++i) vC[h][i] = vN[h][i]; }
        if constexpr (ALIGN_EPI) { if (wr == 1) PG8_BAR; }
    }
    PG8_WAIT_V(0);
    if constexpr (!ALIGN_EPI) { if (wr == 0) PG8_BAR; }
    PG8_BAR;
#undef PG8_SA
#undef PG8_SB
#undef PG8_STAGE
#undef PG8_STAGE_AC
#undef PG8_STAGE_AS
#undef PG8_LDA
#undef PG8_LDB
#undef PG8_MMA
#undef PG8_CAT8
#undef PG8_WAIT_V
#undef PG8_WAIT_L
#undef PG8_BAR
#undef PG8_SCHED
}
}
#define GAS __attribute__((address_space(1)))
#define LAS __attribute__((address_space(3)))
typedef unsigned short bf16;
typedef short bf16x8 __attribute__((ext_vector_type(8)));
typedef short s16x4 __attribute__((ext_vector_type(4)));
typedef float f32x4 __attribute__((ext_vector_type(4)));
typedef unsigned u32x4 __attribute__((ext_vector_type(4)));
typedef unsigned u32x2 __attribute__((ext_vector_type(2)));
typedef LAS unsigned char* lptr;

constexpr int NWAVES = 8, NTHR = 512;
#ifndef MOE_FP8
#define MOE_FP8 1
#endif
constexpr int MOE_ESZ = MOE_FP8 ? 1 : 2;
constexpr size_t MiB = 1u << 20;
constexpr size_t WS_CTL = 0, CTL_ZERO_BYTES = 64 * 1024;
constexpr size_t WS_SMALL = 1 * MiB;
constexpr size_t WS_GATES = 2 * MiB;
constexpr size_t WS_RSG = 2 * MiB + 512 * 1024;
constexpr size_t WS_RS1 = 2 * MiB + 768 * 1024;
constexpr size_t WS_GATE = 3 * MiB;
constexpr size_t WS_TOKIDX = 4 * MiB;
constexpr size_t WS_GATEX = 760 * MiB, WS_RSX = 768 * MiB;
constexpr size_t WS_KC = 776 * MiB;
constexpr size_t WS_WRT = 12 * MiB;
constexpr size_t WS_WINT = 16 * MiB, WS_WOUTT = 22 * MiB, WS_WDNT = 24 * MiB, WS_WUPT = 88 * MiB;
constexpr size_t WS_XN = 216 * MiB;
constexpr size_t WS_PROJ = 248 * MiB;
constexpr size_t WS_CLOC = 344 * MiB;
constexpr size_t WS_CPREV = 376 * MiB;
constexpr size_t WS_MIX = 392 * MiB;
constexpr size_t WS_H = 424 * MiB;
constexpr size_t WS_ACT = 488 * MiB;
constexpr size_t WS_Y = 632 * MiB;
constexpr size_t WS_OPT_END = 760 * MiB;
constexpr int CW_CNT = 64;
constexpr int CW_BAR = 4096;
constexpr int PROJ_LD = 3072;
constexpr int QO = 0, KO = 512, VO = 1024, OO = 1536, UO = 2048, VGO = 2560;
constexpr int RING_BYTES = 131072, VEC_OFF = 131072, VEC_BYTES = 16384, CTL_OFF = VEC_OFF + VEC_BYTES, TTAB_OFF = CTL_OFF, MISC_OFF = CTL_OFF + 2048, LDS_BYTES = MISC_OFF + 256;
constexpr int T0 = 0, T1 = 32768, T2 = 65536, T3 = 98304;

#define RLX_AGENT __ATOMIC_RELAXED, __HIP_MEMORY_SCOPE_AGENT
#define XB_TMO      128
#define XB_XCNT(j)  (256  + 64 * (j))
#define XB_XSUB(j)  (1280 + 64 * (j))
#define XB_XGEN(j)  (2304 + 64 * (j))
#define XB_TOP      3328
#define XB_TOPGEN   3392
#define XCD_BAR_WORDS 3456
#define XB_SPIN_CAP (1u << 18)
__device__ __forceinline__ unsigned xb_ld(unsigned* p)              { return __hip_atomic_load(p, __ATOMIC_RELAXED, __HIP_MEMORY_SCOPE_AGENT); }
__device__ __forceinline__ unsigned xb_add(unsigned* p, unsigned v) { return __hip_atomic_fetch_add(p, v, __ATOMIC_RELAXED, __HIP_MEMORY_SCOPE_AGENT); }
__device__ __forceinline__ unsigned xb_xcc_id() { return (unsigned)__builtin_amdgcn_s_getreg((3 << 11) | 20) & 0xFu; }
#define XB_SPIN(cond, bar) do { unsigned _sp = 0; while (cond) { __builtin_amdgcn_s_sleep(1); \
    if ((++_sp & 255u) == 0u) { if (xb_ld(&(bar)[XB_TMO])) break; if (_sp > XB_SPIN_CAP) { atomicAdd(&(bar)[XB_TMO], 1u); break; } } } } while (0)
struct XcdBarrier { unsigned* bar; unsigned x; volatile LAS unsigned* st; };
__device__ __forceinline__ XcdBarrier xcd_barrier_post(unsigned* bar, volatile LAS unsigned* st) {
    XcdBarrier b; b.bar = bar; b.x = xb_xcc_id(); b.st = st;
    if (threadIdx.x == 0) (void)xb_add(&bar[XB_XCNT(b.x)], 1u);
    return b;
}
__device__ __forceinline__ void xcd_barrier_complete(unsigned* bar, unsigned x, unsigned& nloc, unsigned& nx) {
    const unsigned G = gridDim.x * gridDim.y * gridDim.z;
    unsigned sum, cnt, mine, sp = 0u;
    for (;;) {
        sum = 0u; cnt = 0u; mine = 0u;
#pragma unroll
        for (unsigned j = 0; j < 16; ++j) { const unsigned c = xb_ld(&bar[XB_XCNT(j)]); sum += c; cnt += (c > 0u) ? 1u : 0u; mine = (j == x) ? c : mine; }
        if (sum == G) break;
        __builtin_amdgcn_s_sleep(1);
        if ((++sp & 255u) == 0u) { if (xb_ld(&bar[XB_TMO])) break; if (sp > XB_SPIN_CAP) { atomicAdd(&bar[XB_TMO], 1u); break; } }
    }
    nloc = mine > 0u ? mine : 1u; nx = cnt > 0u ? cnt : 1u;
}
__device__ __forceinline__ void xcd_barrier(const XcdBarrier& b) {
    asm volatile("s_waitcnt vmcnt(0)" ::: "memory");
    __syncthreads();
    if (threadIdx.x == 0) {
        unsigned* bar = b.bar;
        __builtin_amdgcn_s_waitcnt(0);
        unsigned nloc = b.st[0], nx = b.st[1];
        if (nloc == 0u) { xcd_barrier_complete(bar, b.x, nloc, nx); b.st[0] = nloc; b.st[1] = nx; }
        const unsigned old = xb_add(&bar[XB_XSUB(b.x)], 1u);
        const unsigned gen = old / nloc;
        if (old + 1u == (gen + 1u) * nloc) {
            __builtin_amdgcn_fence(__ATOMIC_RELEASE, "agent");
            asm volatile("s_waitcnt vmcnt(0)" ::: "memory");
            const unsigned og = xb_add(&bar[XB_TOP], 1u);
            const unsigned tg = og / nx;
            if (og + 1u == (tg + 1u) * nx) xb_add(&bar[XB_TOPGEN], 1u);
            else XB_SPIN(xb_ld(&bar[XB_TOPGEN]) == tg, bar);
            __builtin_amdgcn_fence(__ATOMIC_ACQUIRE, "agent");
            xb_add(&bar[XB_XGEN(b.x)], 1u);
            asm volatile("s_waitcnt vmcnt(0)" ::: "memory");
        } else {
            XB_SPIN(xb_ld(&bar[XB_XGEN(b.x)]) == gen, bar);
            __builtin_amdgcn_fence(__ATOMIC_ACQUIRE, "agent");
            asm volatile("s_waitcnt vmcnt(0)" ::: "memory");
        }
    }
    __syncthreads();
}

__device__ __forceinline__ float bf2f(unsigned short h) { return __builtin_bit_cast(float, (unsigned)h << 16); }
__device__ __forceinline__ unsigned f2bf(float f) { unsigned u = __builtin_bit_cast(unsigned, f); return (u + 0x7fffu + ((u >> 16) & 1u)) >> 16; }
__device__ __forceinline__ unsigned pk2(float lo, float hi) { return pg8::cvt_pk_bf16(lo, hi); }
__device__ __forceinline__ float fexp(float x) { return __builtin_amdgcn_exp2f(x * 1.4426950408889634f); }
__device__ __forceinline__ float fsigmoid(float x) { return __builtin_amdgcn_rcpf(1.0f + fexp(-x)); }
__device__ __forceinline__ float fgelu(float x) {
    const float u = 1.5957691216057308f * (x + 0.044715f * x * x * x);
    return x * fsigmoid(u);
}
__device__ __forceinline__ float wsum_all(float v) {
#pragma unroll
    for (int o = 32; o > 0; o >>= 1) v += __shfl_xor(v, o);
    return v;
}
__device__ __forceinline__ void unpack8(const u32x4 w, float (&f)[8]) {
    f[0] = __builtin_bit_cast(float, w.x << 16); f[1] = __builtin_bit_cast(float, w.x & 0xffff0000u);
    f[2] = __builtin_bit_cast(float, w.y << 16); f[3] = __builtin_bit_cast(float, w.y & 0xffff0000u);
    f[4] = __builtin_bit_cast(float, w.z << 16); f[5] = __builtin_bit_cast(float, w.z & 0xffff0000u);
    f[6] = __builtin_bit_cast(float, w.w << 16); f[7] = __builtin_bit_cast(float, w.w & 0xffff0000u);
}
__device__ __forceinline__ u32x4 pack8(const float (&f)[8]) { u32x4 w; w.x = pk2(f[0], f[1]); w.y = pk2(f[2], f[3]); w.z = pk2(f[4], f[5]); w.w = pk2(f[6], f[7]); return w; }

__device__ __forceinline__ unsigned off_b(unsigned row, unsigned ch) { return 256u * row + 16u * (ch ^ (((row & 3u) << 2) | ((row >> 2) & 3u))); }
__device__ __forceinline__ bf16x8 frag_row(lptr T, int r0, int ks, int lane) { return *(const LAS bf16x8*)(T + off_b((unsigned)(r0 + (lane & 15)), (unsigned)(4 * ks + (lane >> 4)))); }
__device__ __forceinline__ bf16x8 frag_tr(lptr T, int c, int ks, int lane) {
    const unsigned g = lane >> 4, q = (lane & 15) >> 2, p = lane & 3;
    const unsigned a0 = off_b(32u * ks + 8u * g + q, 2u * c + (p >> 1)) + 8u * (p & 1);
    const unsigned a1 = off_b(32u * ks + 8u * g + 4u + q, 2u * c + (p >> 1)) + 8u * (p & 1);
    const s16x4 lo = __builtin_amdgcn_ds_read_tr16_b64_v4i16((LAS s16x4*)(T + a0));
    const s16x4 hi = __builtin_amdgcn_ds_read_tr16_b64_v4i16((LAS s16x4*)(T + a1));
    return __builtin_shufflevector(lo, hi, 0, 1, 2, 3, 4, 5, 6, 7);
}
#define MFMA16(a, b, c) __builtin_amdgcn_mfma_f32_16x16x32_bf16(a, b, c, 0, 0, 0)

#ifndef PROBE_SEC
#define PROBE_SEC -1
#endif
#define SEC_BEGIN(F, id) do { if (PROBE_SEC == (id)) { __syncthreads(); (F).t0 = __builtin_amdgcn_s_memrealtime(); } } while (0)
#define SEC_END(F, id) do { if (PROBE_SEC == (id)) { __syncthreads(); (F).tsec += __builtin_amdgcn_s_memrealtime() - (F).t0; } } while (0)
struct Frame {
    unsigned long long t0, tsec;
    lptr lds; int tid, lane, wave, G, vcu;
    const float* in[20]; float* out; unsigned char* ws;
};

template <bool SCALE>
__device__ __forceinline__ void stage_tile(const Frame& F, lptr T, const bf16* src, int ld, const LAS float* rowscale) {
    const int cg = F.tid & 15, sb = F.tid >> 4;
    u32x4 w[4];
#pragma unroll
    for (int r = 0; r < 4; ++r) w[r] = *(const u32x4*)(src + (size_t)(4 * sb + r) * ld + 8 * cg);
#pragma unroll
    for (int r = 0; r < 4; ++r) { const int s = 4 * sb + r;
        if (SCALE) { float f[8]; unpack8(w[r], f); const float sc = rowscale[s];
#pragma unroll
            for (int i = 0; i < 8; ++i) f[i] *= sc;
            w[r] = pack8(f); }
        *(LAS u32x4*)(T + off_b(s, cg)) = w[r]; }
}
__device__ __forceinline__ void stage_conv(const Frame& F, lptr T, const bf16* src, const LAS float* cw, int tpos, float scale, u32x4 (&out)[4]) {
    const int cg = F.tid & 15, sb = F.tid >> 4;
    u32x4 w[7];
#pragma unroll
    for (int j = 0; j < 7; ++j) { const int s = 4 * sb - 3 + j; w[j] = (tpos + s >= 0) ? *(const u32x4*)(src + (ptrdiff_t)s * PROJ_LD + 8 * cg) : (u32x4){0u, 0u, 0u, 0u}; }
#pragma unroll
    for (int hf = 0; hf < 2; ++hf) {
        f32x4 tp4[4];
#pragma unroll
        for (int tp = 0; tp < 4; ++tp) tp4[tp] = *(const LAS f32x4*)(cw + tp * 128 + 8 * cg + 4 * hf);
        float a[4][4];
#pragma unroll
        for (int r = 0; r < 4; ++r)
#pragma unroll
            for (int i = 0; i < 4; ++i) a[r][i] = 0.f;
#pragma unroll
        for (int j = 0; j < 7; ++j) { const unsigned u0 = hf ? w[j].z : w[j].x, u1 = hf ? w[j].w : w[j].y;
            const float f[4] = {__builtin_bit_cast(float, u0 << 16), __builtin_bit_cast(float, u0 & 0xffff0000u), __builtin_bit_cast(float, u1 << 16), __builtin_bit_cast(float, u1 & 0xffff0000u)};
#pragma unroll
            for (int r = 0; r < 4; ++r) { const int tp = j - r; if (tp >= 0 && tp < 4) {
#pragma unroll
                for (int i = 0; i < 4; ++i) a[r][i] += tp4[tp][i] * f[i]; } } }
#pragma unroll
        for (int r = 0; r < 4; ++r) {
#pragma unroll
            for (int i = 0; i < 4; ++i) a[r][i] = a[r][i] * fsigmoid(a[r][i]) * scale;
            const unsigned p0 = pk2(a[r][0], a[r][1]), p1 = pk2(a[r][2], a[r][3]);
            if (hf == 0) { out[r].x = p0; out[r].y = p1; } else { out[r].z = p0; out[r].w = p1; } }
        __builtin_amdgcn_sched_barrier(0);
    }
#pragma unroll
    for (int r = 0; r < 4; ++r) *(LAS u32x4*)(T + off_b(4 * sb + r, cg)) = out[r];
}
__device__ __forceinline__ void p0_item(const float* Wsrc, int ld, bf16* dst, int Kd, LAS float* scr, int lane) {
#pragma unroll 8
    for (int i = 0; i < 32; ++i) { const int kk = 2 * i + (lane >> 5); scr[kk * 33 + (lane & 31)] = Wsrc[(size_t)kk * ld + (lane & 31)]; }
    asm volatile("s_waitcnt lgkmcnt(0)" ::: "memory");
    const int c = lane & 7;
#pragma unroll
    for (int j = 0; j < 4; ++j) { const int n = (lane >> 3) + 8 * j; const LAS float* s = scr + (8 * c) * 33 + n;
        u32x4 o; o.x = pk2(s[0 * 33], s[1 * 33]); o.y = pk2(s[2 * 33], s[3 * 33]); o.z = pk2(s[4 * 33], s[5 * 33]); o.w = pk2(s[6 * 33], s[7 * 33]);
        *(u32x4*)(dst + (size_t)n * Kd + 8 * c) = o; }
    asm volatile("s_waitcnt lgkmcnt(0)" ::: "memory");
}
__device__ __forceinline__ void p0_item_split(const float* Wsrc, int ld, bf16* dhi, bf16* dlo, int Kd, LAS float* scr, int lane) {
#pragma unroll 8
    for (int i = 0; i < 32; ++i) { const int kk = 2 * i + (lane >> 5); scr[kk * 33 + (lane & 31)] = Wsrc[(size_t)kk * ld + (lane & 31)]; }
    asm volatile("s_waitcnt lgkmcnt(0)" ::: "memory");
    const int c = lane & 7;
#pragma unroll
    for (int j = 0; j < 4; ++j) { const int n = (lane >> 3) + 8 * j; const LAS float* s = scr + (8 * c) * 33 + n;
        float v[8], l[8];
#pragma unroll
        for (int i = 0; i < 8; ++i) { v[i] = s[i * 33]; l[i] = v[i] - bf2f((unsigned short)f2bf(v[i])); }
        *(u32x4*)(dhi + (size_t)n * Kd + 8 * c) = pack8(v); *(u32x4*)(dlo + (size_t)n * Kd + 8 * c) = pack8(l); }
    asm volatile("s_waitcnt lgkmcnt(0)" ::: "memory");
}

struct P0Item { const float* src; char* dst; int ld; int esz; };
constexpr float W8_SCALE = 64.0f;
__device__ __forceinline__ void p0_load(const P0Item& it, int lane, f32x4 (&v)[8]) {
    const float* p = it.src + (size_t)(8 * (lane & 7)) * it.ld + 4 * (lane >> 3);
#pragma unroll
    for (int j = 0; j < 8; ++j) v[j] = __builtin_nontemporal_load((const f32x4*)(p + (size_t)j * it.ld));
}
__device__ __forceinline__ void p0_store(const P0Item& it, int lane, const f32x4 (&v)[8]) {
    const size_t eo = (size_t)(4 * (lane >> 3)) * 1024 + 8 * (lane & 7);
    if (it.esz == 2) { char* q = it.dst + 2 * eo;
#pragma unroll
        for (int i = 0; i < 4; ++i) { u32x4 o; o.x = pk2(v[0][i], v[1][i]); o.y = pk2(v[2][i], v[3][i]); o.z = pk2(v[4][i], v[5][i]); o.w = pk2(v[6][i], v[7][i]);
            *(u32x4*)(q + (size_t)i * 2048) = o; } }
    else { char* q = it.dst + eo;
#pragma unroll
        for (int i = 0; i < 4; ++i) { u32x2 o; o.x = pg8::pk4_fp8(v[0][i] * W8_SCALE, v[1][i] * W8_SCALE, v[2][i] * W8_SCALE, v[3][i] * W8_SCALE);
            o.y = pg8::pk4_fp8(v[4][i] * W8_SCALE, v[5][i] * W8_SCALE, v[6][i] * W8_SCALE, v[7][i] * W8_SCALE);
            *(u32x2*)(q + (size_t)i * 1024) = o; } }
}
constexpr int IMG_ROW = 2064;
template <int NF, bool OUT8>
__device__ __forceinline__ float row_pass(const float* X, const float* gain, void* XNout, lptr img_hi, lptr img_lo, int tok0, int lane, f32x4 (&acc)[NF]) {
    const int r = lane & 15, g = lane >> 4;
    const float* xr = X + (size_t)(tok0 + r) * 1024 + 8 * g;
    float ss = 0.f;
#pragma unroll
    for (int nf = 0; nf < NF; ++nf) acc[nf] = (f32x4){0.f, 0.f, 0.f, 0.f};
    char* orow = (char*)XNout + ((size_t)(tok0 + r) * 1024 + 8 * g) * (OUT8 ? 1 : 2);
#pragma unroll 16
    for (int ks = 0; ks < 32; ++ks) { const f32x4 a = __builtin_nontemporal_load((const f32x4*)(xr + 32 * ks)), b = __builtin_nontemporal_load((const f32x4*)(xr + 32 * ks + 4));
        ss += (a[0] * a[0] + a[1] * a[1]) + (a[2] * a[2] + a[3] * a[3]) + (b[0] * b[0] + b[1] * b[1]) + (b[2] * b[2] + b[3] * b[3]);
        const f32x4 ga = *(const f32x4*)(gain + 32 * ks + 8 * g), gb = *(const f32x4*)(gain + 32 * ks + 8 * g + 4);
        float v[8], l[8];
#pragma unroll
        for (int i = 0; i < 4; ++i) { v[i] = a[i] * ga[i]; v[4 + i] = b[i] * gb[i]; }
        const u32x4 hi = pack8(v);
        { float h[8]; unpack8(hi, h);
#pragma unroll
          for (int i = 0; i < 8; ++i) l[i] = v[i] - h[i]; }
        const u32x4 lo = pack8(l);
        if (OUT8) { u32x2 o8; o8.x = pg8::pk4_fp8(v[0], v[1], v[2], v[3]); o8.y = pg8::pk4_fp8(v[4], v[5], v[6], v[7]); *(u32x2*)(orow + 32 * ks) = o8; }
        else *(u32x4*)(orow + 64 * ks) = hi;
        const bf16x8 ahi = __builtin_bit_cast(bf16x8, hi), alo = __builtin_bit_cast(bf16x8, lo);
#pragma unroll
        for (int nf = 0; nf < NF; ++nf) { const unsigned bo = (unsigned)(16 * nf + (lane & 15)) * IMG_ROW + 64u * ks + 16u * g;
            const bf16x8 bhi = *(const LAS bf16x8*)(img_hi + bo), blo = *(const LAS bf16x8*)(img_lo + bo);
            acc[nf] = MFMA16(ahi, bhi, acc[nf]); acc[nf] = MFMA16(ahi, blo, acc[nf]); acc[nf] = MFMA16(alo, bhi, acc[nf]); } }
    ss += __shfl_xor(ss, 16); ss += __shfl_xor(ss, 32);
    return 1.0f / sqrtf(ss * (1.0f / 1024.0f) + 1e-6f);
}

__device__ __forceinline__ void phase0(Frame& F) {
    const float* x = F.in[0]; const float* g1 = F.in[1]; const float* w_in = F.in[2]; const float* b_i = F.in[4]; const float* b_f = F.in[5];
    const float* w_out = F.in[11]; const float* wr = F.in[13]; const float* w_up = F.in[15]; const float* w_dn = F.in[17];
    bf16* WinT = (bf16*)(F.ws + WS_WINT); bf16* WoutT = (bf16*)(F.ws + WS_WOUTT); bf16* WdnT = (bf16*)(F.ws + WS_WDNT); bf16* WupT = (bf16*)(F.ws + WS_WUPT);
    bf16* WrThi = (bf16*)(F.ws + WS_WRT); bf16* WrTlo = WrThi + 32 * 1024;
    bf16* XN = (bf16*)(F.ws + WS_XN); float* GATES = (float*)(F.ws + WS_GATES); float* RS1 = (float*)(F.ws + WS_RS1);
    lptr ghi = F.lds + T0, glo = F.lds + T0 + 16 * IMG_ROW;
    SEC_BEGIN(F, 1);
#pragma unroll
    for (int q = 0; q < 2; ++q) { const int kk = F.tid + NTHR * q; const f32x4 a = *(const f32x4*)(w_in + (size_t)kk * 3080 + 2048), b = *(const f32x4*)(w_in + (size_t)kk * 3080 + 2052);
        const float v[8] = {a[0], a[1], a[2], a[3], b[0], b[1], b[2], b[3]};
#pragma unroll
        for (int j = 0; j < 8; ++j) { const unsigned h = f2bf(v[j]); const float l = v[j] - bf2f((unsigned short)h);
            *(LAS unsigned short*)(ghi + j * IMG_ROW + 2 * kk) = (unsigned short)h; *(LAS unsigned short*)(glo + j * IMG_ROW + 2 * kk) = (unsigned short)f2bf(l); } }
    __syncthreads();
    SEC_END(F, 1); SEC_BEGIN(F, 2);
    if (F.wave < 4) { const int tok0 = F.vcu * 64 + F.wave * 16; f32x4 acc[1];
      const float rstd = row_pass<1, false>(x, g1, XN, ghi, glo, tok0, F.lane, acc);
      if (F.lane < 16) RS1[tok0 + F.lane] = rstd;
      const int j = F.lane & 15, gq = F.lane >> 4;
      float rr[4];
#pragma unroll
      for (int rg = 0; rg < 4; ++rg) rr[rg] = __shfl(rstd, 4 * gq + rg);
      if (j < 8) {
#pragma unroll
          for (int rg = 0; rg < 4; ++rg) { const int tok = tok0 + 4 * gq + rg; float v = acc[0][rg] * rr[rg];
              if (j < 4) v += b_i[j]; else { v += b_f[j - 4]; v = fminf(v, 0.f) - log1pf(expf(-fabsf(v))); }
              GATES[(size_t)tok * 8 + j] = v; } } }
    SEC_END(F, 2); SEC_BEGIN(F, 3);
    const float* b_unused = nullptr; (void)b_unused;
    const int gw = F.vcu * NWAVES + F.wave, NGW = F.G * NWAVES;
    if (F.vcu < 4 && F.wave >= 4) { const int ri = F.vcu * 4 + F.wave - 4; LAS float* scr = (LAS float*)(F.lds + 66560 + (F.wave - 4) * 8448);
        p0_item_split(wr + (size_t)(64 * ri) * 32, 32, WrThi + 64 * ri, WrTlo + 64 * ri, 1024, scr, F.lane); }
    constexpr int I_IN = 16 * 96, I_OUT = 16 * 32, I_UP = 0, NITEMS = I_IN + I_OUT + I_UP;
    auto decode = [&](int it) -> P0Item {
        int r = it; P0Item o;
        if (r < I_IN) { const int kb = r / 96, nb = r % 96, nd = 32 * nb, nsrc = nd < 2048 ? nd : nd + 8;
            o.src = w_in + (size_t)(64 * kb) * 3080 + nsrc; o.ld = 3080; o.esz = 2; o.dst = (char*)(WinT + (size_t)nd * 1024 + 64 * kb); return o; } r -= I_IN;
        if (r < I_OUT) { const int kb = r / 32, nb = r % 32;
            o.src = w_out + (size_t)(64 * kb) * 1024 + 32 * nb; o.ld = 1024; o.esz = 2; o.dst = (char*)(WoutT + (size_t)(32 * nb) * 1024 + 64 * kb); return o; } r -= I_OUT;
        { const int e = r / 1024, q = r % 1024, kb = q / 64, nb = q % 64, n = 32 * nb, half = n >> 10, jj = n & 1023, pn = jj >> 7, j = jj & 127, nd = 256 * pn + 128 * half + j;
          o.src = w_up + ((size_t)e * 1024 + 64 * kb) * 2048 + n; o.ld = 2048; o.esz = MOE_ESZ; o.dst = (char*)WupT + (((size_t)e * 2048 + nd) * 1024 + 64 * kb) * MOE_ESZ; return o; }
    };
    constexpr int PER_WAVE = NITEMS / (256 * NWAVES), SHIFT = 0;
    static_assert(NITEMS % (256 * NWAVES) == 0, "item split");
    const int nown = F.wave < 4 ? PER_WAVE - SHIFT : PER_WAVE + SHIFT;
    for (int j = 0; j < nown; j += 2) {
        const bool two = j + 1 < nown;
        const int j0 = j, j1 = two ? j + 1 : j;
        const int ita = (j0 < PER_WAVE) ? gw + j0 * NGW : (gw - 4) + (j0 - SHIFT) * NGW;
        const int itb = (j1 < PER_WAVE) ? gw + j1 * NGW : (gw - 4) + (j1 - SHIFT) * NGW;
        const P0Item ia = decode(ita), ib = decode(itb);
        f32x4 va[8], vb[8];
        p0_load(ia, F.lane, va); p0_load(ib, F.lane, vb);
        p0_store(ia, F.lane, va); if (two) p0_store(ib, F.lane, vb);
    }
    SEC_END(F, 3);
}

__device__ __forceinline__ float wscan_add(float v, int lane) {
#pragma unroll
    for (int o = 1; o < 64; o <<= 1) { const float t = __shfl_up(v, o); if (lane >= o) v += t; }
    return v;
}
__device__ __forceinline__ float wscan_max(float v, int lane) {
#pragma unroll
    for (int o = 1; o < 64; o <<= 1) { const float t = __shfl_up(v, o); if (lane >= o) v = fmaxf(v, t); }
    return v;
}
__device__ __forceinline__ float wmax_all(float v) {
#pragma unroll
    for (int o = 32; o > 0; o >>= 1) v = fmaxf(v, __shfl_xor(v, o));
    return v;
}

__device__ __forceinline__ void mlstm_local_unit(Frame& F0, int u) {
    Frame F = F0; asm volatile("" : "+v"(F.tid), "+v"(F.lane));
    const int c = u & 63, h = (u >> 6) & 3, b = u >> 8, row0 = b * 8192 + c * 128;
    const bf16* PROJ = (const bf16*)(F.ws + WS_PROJ); const float* GATES = (const float*)(F.ws + WS_GATES); const float* conv = F.in[3];
    float* CLOC = (float*)(F.ws + WS_CLOC); float* MLOC = (float*)(F.ws + WS_SMALL); float* BLAST = MLOC + 512; float* NLOC = MLOC + 2048; bf16* KC = (bf16*)(F.ws + WS_KC);
    LAS float* wv = (LAS float*)(F.lds + VEC_OFF);
    LAS float* cw = wv + 128;
    LAS float* part = cw + 512;
    const int lane = F.lane, w = F.wave;
    SEC_BEGIN(F, 10);
#pragma unroll
    for (int j = 0; j < 8; ++j) { const int i = lane + 64 * j; cw[i] = conv[(i >> 7) * 1024 + 512 + h * 128 + (i & 127)]; }
    { const int l = lane, s0 = 2 * l, s1 = s0 + 1;
        const float li0 = GATES[(size_t)(row0 + s0) * 8 + h], li1 = GATES[(size_t)(row0 + s1) * 8 + h], lf0 = GATES[(size_t)(row0 + s0) * 8 + 4 + h], lf1 = GATES[(size_t)(row0 + s1) * 8 + 4 + h];
        const float inc = wscan_add(lf0 + lf1, l), b1 = inc, b0 = inc - lf1, blast = __shfl(inc, 63);
        const float g0 = blast - b0 + li0, g1 = blast - b1 + li1, mloc = wmax_all(fmaxf(g0, g1));
        wv[s0] = fexp(g0 - mloc); wv[s1] = fexp(g1 - mloc);
        if (l == 0 && w == 0) { MLOC[u] = mloc; BLAST[u] = blast; } }
    SEC_END(F, 10); SEC_BEGIN(F, 11);
    { u32x4 kv[4]; const int cg = F.tid & 15, sb = F.tid >> 4;
      stage_conv(F, F.lds + T1, PROJ + (size_t)row0 * PROJ_LD + KO + h * 128, cw, c * 128, 0.08838834764831845f, kv);
      float pn[8];
#pragma unroll
      for (int i = 0; i < 8; ++i) pn[i] = 0.f;
#pragma unroll
      for (int r = 0; r < 4; ++r) { *(u32x4*)(KC + (size_t)(row0 + 4 * sb + r) * 512 + h * 128 + 8 * cg) = kv[r];
          float f[8]; unpack8(kv[r], f); const float ws = wv[4 * sb + r];
#pragma unroll
          for (int i = 0; i < 8; ++i) pn[i] += ws * f[i]; }
#pragma unroll
      for (int i = 0; i < 8; ++i) { pn[i] += __shfl_xor(pn[i], 16); pn[i] += __shfl_xor(pn[i], 32); }
      if (lane < 16) { *(LAS f32x4*)(part + w * 128 + 8 * cg) = (f32x4){pn[0], pn[1], pn[2], pn[3]}; *(LAS f32x4*)(part + w * 128 + 8 * cg + 4) = (f32x4){pn[4], pn[5], pn[6], pn[7]}; } }
    stage_tile<true>(F, F.lds + T2, PROJ + (size_t)row0 * PROJ_LD + VO + h * 128, PROJ_LD, wv);
    __syncthreads();
    SEC_END(F, 11); SEC_BEGIN(F, 12);
    { f32x4 acc[8];
#pragma unroll
      for (int kb = 0; kb < 8; ++kb) acc[kb] = (f32x4){0.f, 0.f, 0.f, 0.f};
#pragma unroll
      for (int ks = 0; ks < 4; ++ks) { const bf16x8 a = frag_tr(F.lds + T2, w, ks, lane);
#pragma unroll
          for (int kb = 0; kb < 8; ++kb) { const bf16x8 bb = frag_tr(F.lds + T1, kb, ks, lane); acc[kb] = MFMA16(a, bb, acc[kb]); } }
      float* cl = CLOC + (size_t)u * 16384 + (size_t)(16 * w + 4 * (lane >> 4)) * 128 + (lane & 15);
#pragma unroll
      for (int kb = 0; kb < 8; ++kb)
#pragma unroll
          for (int rg = 0; rg < 4; ++rg) cl[rg * 128 + 16 * kb] = acc[kb][rg]; }
    if (F.tid < 128) { float a = 0.f;
#pragma unroll
        for (int ww = 0; ww < 8; ++ww) a += part[ww * 128 + F.tid];
        NLOC[(size_t)u * 128 + F.tid] = a; }
    __syncthreads();
    SEC_END(F, 12);
    F0.tsec = F.tsec;
}

__device__ __forceinline__ void gmlp_unit(Frame& F0, int ug) {
    Frame F = F0; asm volatile("" : "+v"(F.tid), "+v"(F.lane));
    const int g = ug & 3, row0 = (ug >> 2) * 128;
    const bf16* PROJ = (const bf16*)(F.ws + WS_PROJ); bf16* MIX = (bf16*)(F.ws + WS_MIX);
    const float* lng = F.in[7]; const float* wsp = F.in[8]; const float* bsp = F.in[9]; const float* og = F.in[10]; float* PSSQ = (float*)(F.ws + WS_RSG);
    LAS float* st_mean = (LAS float*)(F.lds + VEC_OFF); LAS float* st_rstd = st_mean + 128;
    const int w = F.wave, lane = F.lane;
    SEC_BEGIN(F, 20);
    { const int t = F.tid >> 2, q = F.tid & 3; const bf16* vp = PROJ + (size_t)(row0 + t) * PROJ_LD + VGO + 128 * q;
      float s = 0.f, s2 = 0.f;
#pragma unroll 8
      for (int j = 0; j < 16; ++j) { float f[8]; unpack8(*(const u32x4*)(vp + 8 * j), f);
#pragma unroll
          for (int i = 0; i < 8; ++i) { s += f[i]; s2 += f[i] * f[i]; } }
      s += __shfl_xor(s, 1); s += __shfl_xor(s, 2); s2 += __shfl_xor(s2, 1); s2 += __shfl_xor(s2, 2);
      const float mean = s * (1.0f / 512.0f), var = fmaxf(s2 * (1.0f / 512.0f) - mean * mean, 0.f);
      if (q == 0) { st_mean[t] = mean; st_rstd[t] = 1.0f / sqrtf(var + 1e-6f); } }
    __syncthreads();
    SEC_END(F, 20); SEC_BEGIN(F, 21);
    { const int cg = F.tid & 15, sb = F.tid >> 4;
      const f32x4 l0 = *(const f32x4*)(lng + g * 128 + 8 * cg), l1 = *(const f32x4*)(lng + g * 128 + 8 * cg + 4);
      u32x4 vv[4], uu[4]; f32x4 wa[4], wb[4];
#pragma unroll
      for (int r = 0; r < 4; ++r) { const int t = 4 * sb + r;
          vv[r] = *(const u32x4*)(PROJ + (size_t)(row0 + t) * PROJ_LD + VGO + g * 128 + 8 * cg); uu[r] = *(const u32x4*)(PROJ + (size_t)(row0 + t) * PROJ_LD + UO + g * 128 + 8 * cg);
          const float* wp = wsp + ((size_t)(g * 128 + t)) * 128 + 8 * cg; wa[r] = *(const f32x4*)wp; wb[r] = *(const f32x4*)(wp + 4); }
#pragma unroll
      for (int r = 0; r < 4; ++r) { const int t = 4 * sb + r;
          float f[8] = {wa[r][0], wa[r][1], wa[r][2], wa[r][3], wb[r][0], wb[r][1], wb[r][2], wb[r][3]};
#pragma unroll
          for (int kk = 0; kk < 8; ++kk) if (8 * cg + kk > t) f[kk] = 0.f;
          *(LAS u32x4*)(F.lds + T0 + off_b(t, cg)) = pack8(f);
          float v[8]; unpack8(vv[r], v); const float mean = st_mean[t], rstd = st_rstd[t];
#pragma unroll
          for (int kk = 0; kk < 8; ++kk) v[kk] = (v[kk] - mean) * rstd * (kk < 4 ? l0[kk] : l1[kk - 4]);
          *(LAS u32x4*)(F.lds + T1 + off_b(t, cg)) = pack8(v);
          *(LAS u32x4*)(F.lds + T2 + off_b(t, cg)) = uu[r]; } }
    __syncthreads();
    SEC_END(F, 21); SEC_BEGIN(F, 22);
    f32x4 acc[8];
#pragma unroll
    for (int db = 0; db < 8; ++db) acc[db] = (f32x4){0.f, 0.f, 0.f, 0.f};
    for (int ks = 0; ks <= (w >> 1); ++ks) { const bf16x8 a = frag_row(F.lds + T0, 16 * w, ks, lane);
#pragma unroll
        for (int db = 0; db < 8; ++db) { const bf16x8 bb = frag_tr(F.lds + T1, db, ks, lane); acc[db] = MFMA16(a, bb, acc[db]); } }
    float ssq[4] = {0.f, 0.f, 0.f, 0.f}; float ogv[8];
#pragma unroll
    for (int db = 0; db < 8; ++db) ogv[db] = og[g * 128 + 16 * db + (lane & 15)];
#pragma unroll
    for (int rg = 0; rg < 4; ++rg) { int t = 16 * w + 4 * (lane >> 4) + rg; const float bs = bsp[g * 128 + t]; asm volatile("" : "+v"(t));
#pragma unroll
        for (int db = 0; db < 8; ++db) { const int d = 16 * db + (lane & 15);
            const float gu = bf2f(*(const LAS unsigned short*)(F.lds + T2 + off_b(t, d >> 3) + 2 * (d & 7)));
            const float val = (acc[db][rg] + bs) * gu; ssq[rg] += val * val;
            *(LAS unsigned short*)(F.lds + T3 + off_b(t, d >> 3) + 2 * (d & 7)) = (unsigned short)(pk2(val * ogv[db], 0.f) & 0xffffu); } }
#pragma unroll
    for (int i = 0; i < 4; ++i) { const int id = lane + 64 * i, r = id >> 4, ch = id & 15, t = 16 * w + r;
        *(u32x4*)(MIX + (size_t)(row0 + t) * 1024 + 512 + g * 128 + 8 * ch) = *(const LAS u32x4*)(F.lds + T3 + off_b(t, ch)); }
#pragma unroll
    for (int rg = 0; rg < 4; ++rg) { float q = ssq[rg]; q += __shfl_xor(q, 1); q += __shfl_xor(q, 2); q += __shfl_xor(q, 4); q += __shfl_xor(q, 8);
        if ((lane & 15) == 0) PSSQ[(size_t)g * 16384 + row0 + 16 * w + 4 * (lane >> 4) + rg] = q; }
    __syncthreads();
    SEC_END(F, 22);
    F0.tsec = F.tsec;
}

__device__ __forceinline__ void phase_scan(const Frame& F) {
    const float* CLOC = (const float*)(F.ws + WS_CLOC); float* MLOC = (float*)(F.ws + WS_SMALL); float* BLAST = MLOC + 512; float* MPREV = MLOC + 1024;
    float* NLOC = MLOC + 2048; float* NPREV = NLOC + 512 * 128; bf16* CPREV = (bf16*)(F.ws + WS_CPREV);
    LAS float* av = (LAS float*)(F.lds + VEC_OFF); LAS float* cv = av + 64;
    const int wg = F.vcu, bh = wg >> 5;
    if (F.wave == 0) { const int l = F.lane; const float ml = MLOC[bh * 64 + l], bl = BLAST[bh * 64 + l];
        float m = 0.f, mym = 0.f, mynext = 0.f;
        for (int c = 0; c < 64; ++c) { const float mlc = __shfl(ml, c), blc = __shfl(bl, c); const float mn = fmaxf(blc + m, mlc); if (l == c) { mym = m; mynext = mn; } m = mn; }
        av[l] = fexp(bl + mym - mynext); cv[l] = fexp(ml - mynext);
        if ((wg & 31) == 0) MPREV[bh * 64 + l] = mym; }
    __syncthreads();
    if (F.tid < 256) { const int p = (wg & 31) * 256 + F.tid; float v0 = 0.f, v1 = 0.f;
        const float* src = CLOC + (size_t)(bh * 64) * 16384 + 2 * p; bf16* dst = CPREV + (size_t)(bh * 64) * 16384 + 2 * p;
#pragma unroll 8
        for (int c = 0; c < 64; ++c) { const float2 x = *(const float2*)(src + (size_t)c * 16384);
            *(unsigned*)(dst + (size_t)c * 16384) = pk2(v0, v1);
            const float a = av[c], cc = cv[c]; v0 = a * v0 + cc * x.x; v1 = a * v1 + cc * x.y; } }
    else if (F.tid < 320 && (wg & 31) == 0) { const int p = F.tid - 256; float v0 = 0.f, v1 = 0.f;
        for (int c = 0; c < 64; ++c) { const float2 x = *(const float2*)(NLOC + (size_t)(bh * 64 + c) * 128 + 2 * p);
            *(float2*)(NPREV + (size_t)(bh * 64 + c) * 128 + 2 * p) = make_float2(v0, v1);
            const float a = av[c], cc = cv[c]; v0 = a * v0 + cc * x.x; v1 = a * v1 + cc * x.y; } }
    __syncthreads();
}

__device__ __forceinline__ void mlstm_out_unit(Frame& F0, int u) {
    Frame F = F0; asm volatile("" : "+v"(F.tid), "+v"(F.lane));
    const int c = u & 63, h = (u >> 6) & 3, b = u >> 8, row0 = b * 8192 + c * 128;
    const bf16* PROJ = (const bf16*)(F.ws + WS_PROJ); const float* GATES = (const float*)(F.ws + WS_GATES); const float* conv = F.in[3]; const float* ngain = F.in[6];
    const float* MPREV = (const float*)(F.ws + WS_SMALL) + 1024; const float* NPREV = (const float*)(F.ws + WS_SMALL) + 2048 + 512 * 128;
    const bf16* CPREV = (const bf16*)(F.ws + WS_CPREV); bf16* MIX = (bf16*)(F.ws + WS_MIX);
    LAS float* colc = (LAS float*)(F.lds + VEC_OFF); LAS float* rowc = colc + 128; LAS float* inter = rowc + 128; LAS float* emn = inter + 128; LAS float* rdn = emn + 128;
    LAS float* npv = rdn + 128; LAS float* cw = npv + 128;
    const int w = F.wave, lane = F.lane;
    SEC_BEGIN(F, 30);
#pragma unroll
    for (int j = 0; j < 8; ++j) { const int i = lane + 64 * j; cw[i] = conv[(i >> 7) * 1024 + h * 128 + (i & 127)]; }
    npv[lane] = NPREV[(size_t)u * 128 + lane]; npv[64 + lane] = NPREV[(size_t)u * 128 + 64 + lane];
    { const int l = lane, s0 = 2 * l, s1 = s0 + 1;
        const float li0 = GATES[(size_t)(row0 + s0) * 8 + h], li1 = GATES[(size_t)(row0 + s1) * 8 + h], lf0 = GATES[(size_t)(row0 + s0) * 8 + 4 + h], lf1 = GATES[(size_t)(row0 + s1) * 8 + 4 + h];
        const float inc = wscan_add(lf0 + lf1, l), b1 = inc, b0 = inc - lf1;
        const float c0 = li0 - b0, c1 = li1 - b1;
        const float pmx = wscan_max(fmaxf(c0, c1), l); float pprev = __shfl_up(pmx, 1); if (l == 0) pprev = -INFINITY;
        const float pm0 = fmaxf(pprev, c0), pm1 = pmx, mprev = MPREV[u];
        const float m0 = b0 + fmaxf(mprev, pm0), m1 = b1 + fmaxf(mprev, pm1);
        colc[s0] = c0; colc[s1] = c1; rowc[s0] = b0 - m0; rowc[s1] = b1 - m1;
        inter[s0] = fexp(b0 + mprev - m0); inter[s1] = fexp(b1 + mprev - m1); emn[s0] = fexp(-m0); emn[s1] = fexp(-m1); }
    SEC_END(F, 30); SEC_BEGIN(F, 31);
    { u32x4 qv[4]; stage_conv(F, F.lds + T0, PROJ + (size_t)row0 * PROJ_LD + QO + h * 128, cw, c * 128, 1.0f, qv); }
    stage_tile<false>(F, F.lds + T1, (const bf16*)(F.ws + WS_KC) + (size_t)row0 * 512 + h * 128, 512, nullptr);
    stage_tile<false>(F, F.lds + T2, PROJ + (size_t)row0 * PROJ_LD + VO + h * 128, PROJ_LD, nullptr);
    stage_tile<false>(F, F.lds + T3, CPREV + (size_t)u * 16384, 128, nullptr);
    __syncthreads();
    SEC_END(F, 31); SEC_BEGIN(F, 32);
    const int t = 16 * w + (lane & 15);
    u32x2 wpk[8]; float rsum = 0.f;
    { const float rc = rowc[t];
#pragma unroll
      for (int sb = 0; sb < 8; ++sb) { wpk[sb] = (u32x2){0u, 0u};
          if (sb <= w) { f32x4 a4 = (f32x4){0.f, 0.f, 0.f, 0.f};
#pragma unroll
              for (int ks = 0; ks < 4; ++ks) { const bf16x8 a = frag_row(F.lds + T1, 16 * sb, ks, lane), bb = frag_row(F.lds + T0, 16 * w, ks, lane); a4 = MFMA16(a, bb, a4); }
              float wv4[4];
#pragma unroll
              for (int rg = 0; rg < 4; ++rg) { const int s = 16 * sb + 4 * (lane >> 4) + rg; const float e = fexp(rc + colc[s]) * a4[rg]; wv4[rg] = (s <= t) ? e : 0.f; }
              wpk[sb].x = pk2(wv4[0], wv4[1]); wpk[sb].y = pk2(wv4[2], wv4[3]);
              rsum += bf2f((unsigned short)(wpk[sb].x & 0xffffu)) + bf2f((unsigned short)(wpk[sb].x >> 16)) + bf2f((unsigned short)(wpk[sb].y & 0xffffu)) + bf2f((unsigned short)(wpk[sb].y >> 16)); } } }
    __syncthreads();
    SEC_END(F, 32); SEC_BEGIN(F, 33);
    { int t2 = t; asm volatile("" : "+v"(t2));
#pragma unroll
    for (int sb = 0; sb < 8; ++sb) if (sb <= (w | 1)) *(LAS u32x2*)(F.lds + T1 + off_b(t2, 2 * sb + (lane >> 5)) + 8 * ((lane >> 4) & 1)) = wpk[sb]; }
    rsum += __shfl_xor(rsum, 16); rsum += __shfl_xor(rsum, 32);
    { float qn = 0.f; const int part = lane >> 4;
#pragma unroll
      for (int i = 0; i < 4; ++i) { float f[8]; unpack8(*(const LAS u32x4*)(F.lds + T0 + off_b(t, 4 * part + i)), f);
#pragma unroll
          for (int k = 0; k < 8; ++k) qn += f[k] * npv[32 * part + 8 * i + k]; }
      qn += __shfl_xor(qn, 16); qn += __shfl_xor(qn, 32);
      const float den = rsum + inter[t] * qn;
      if (lane < 16) rdn[t] = 1.0f / fmaxf(fabsf(den), emn[t]); }
    f32x4 acc[8];
#pragma unroll
    for (int vb = 0; vb < 8; ++vb) acc[vb] = (f32x4){0.f, 0.f, 0.f, 0.f};
#pragma unroll
    for (int ks = 0; ks < 4; ++ks) { const bf16x8 a = frag_row(F.lds + T0, 16 * w, ks, lane);
#pragma unroll
        for (int vb = 0; vb < 8; ++vb) { const bf16x8 bb = frag_row(F.lds + T3, 16 * vb, ks, lane); acc[vb] = MFMA16(a, bb, acc[vb]); } }
    float it4[4], rd4[4];
#pragma unroll
    for (int rg = 0; rg < 4; ++rg) { const int tr = 16 * w + 4 * (lane >> 4) + rg; it4[rg] = inter[tr]; rd4[rg] = rdn[tr]; }
#pragma unroll
    for (int vb = 0; vb < 8; ++vb)
#pragma unroll
        for (int rg = 0; rg < 4; ++rg) acc[vb][rg] *= it4[rg];
    for (int ks = 0; ks <= (w >> 1); ++ks) { const bf16x8 a = frag_row(F.lds + T1, 16 * w, ks, lane);
#pragma unroll
        for (int vb = 0; vb < 8; ++vb) { const bf16x8 bb = frag_tr(F.lds + T2, vb, ks, lane); acc[vb] = MFMA16(a, bb, acc[vb]); } }
    SEC_END(F, 33); SEC_BEGIN(F, 34);
#pragma unroll
    for (int rg = 0; rg < 4; ++rg) { float s = 0.f;
#pragma unroll
        for (int vb = 0; vb < 8; ++vb) { acc[vb][rg] *= rd4[rg]; s += acc[vb][rg]; }
        s += __shfl_xor(s, 1); s += __shfl_xor(s, 2); s += __shfl_xor(s, 4); s += __shfl_xor(s, 8);
        const float mean = s * (1.0f / 128.0f); float q = 0.f;
#pragma unroll
        for (int vb = 0; vb < 8; ++vb) { acc[vb][rg] -= mean; q += acc[vb][rg] * acc[vb][rg]; }
        q += __shfl_xor(q, 1); q += __shfl_xor(q, 2); q += __shfl_xor(q, 4); q += __shfl_xor(q, 8);
        const float rstd = 1.0f / sqrtf(q * (1.0f / 128.0f) + 1e-6f);
#pragma unroll
        for (int vb = 0; vb < 8; ++vb) acc[vb][rg] *= rstd; }
#pragma unroll
    for (int vb = 0; vb < 8; ++vb) { const int d = 16 * vb + (lane & 15); const float gg = ngain[h * 128 + d];
#pragma unroll
        for (int rg = 0; rg < 4; ++rg) { int tr = 16 * w + 4 * (lane >> 4) + rg; asm volatile("" : "+v"(tr));
            *(LAS unsigned short*)(F.lds + T1 + off_b(tr, d >> 3) + 2 * (d & 7)) = (unsigned short)(pk2(acc[vb][rg] * gg, 0.f) & 0xffffu); } }
#pragma unroll
    for (int i = 0; i < 4; ++i) { const int id = lane + 64 * i, r = id >> 4, ch = id & 15, tr = 16 * w + r;
        float y[8], o[8]; unpack8(*(const LAS u32x4*)(F.lds + T1 + off_b(tr, ch)), y);
        unpack8(*(const u32x4*)(PROJ + (size_t)(row0 + tr) * PROJ_LD + OO + h * 128 + 8 * ch), o);
#pragma unroll
        for (int k = 0; k < 8; ++k) y[k] *= o[k];
        *(u32x4*)(MIX + (size_t)(row0 + tr) * 1024 + h * 128 + 8 * ch) = pack8(y); }
    { const float* RSG = (const float*)(F.ws + WS_RSG);
#pragma unroll
      for (int i = 0; i < 4; ++i) { const int id = lane + 64 * i, r = id >> 4, ch = id & 15, tr = 16 * w + r;
          bf16* p = MIX + (size_t)(row0 + tr) * 1024 + 512 + h * 128 + 8 * ch; float y[8]; unpack8(*(const u32x4*)p, y);
          const float rs = 1.0f / sqrtf(((RSG[row0 + tr] + RSG[16384 + row0 + tr]) + (RSG[32768 + row0 + tr] + RSG[49152 + row0 + tr])) * (1.0f / 512.0f) + 1e-6f);
#pragma unroll
          for (int kk = 0; kk < 8; ++kk) y[kk] *= rs;
          *(u32x4*)p = pack8(y); } }
    __syncthreads();
    SEC_END(F, 34);
    F0.tsec = F.tsec;
}

__device__ __forceinline__ void phase_router(Frame& F) {
    const float* H = (const float*)(F.ws + WS_H); const float* g2 = F.in[12]; const float* br = F.in[14];
    const bf16* WrThi = (const bf16*)(F.ws + WS_WRT); const bf16* WrTlo = WrThi + 32 * 1024;
    bf16* HN = (bf16*)(F.ws + WS_XN); int* cnt = (int*)(F.ws + WS_CTL) + CW_CNT; int* tokidx = (int*)(F.ws + WS_TOKIDX); float* gatex = (float*)(F.ws + WS_GATEX); float* rsx = (float*)(F.ws + WS_RSX);
    lptr ihi = F.lds, ilo = F.lds + 32 * IMG_ROW;
    LAS float* lg = (LAS float*)(F.lds + 2 * 32 * IMG_ROW);
    LAS int* hist = (LAS int*)(lg + 2048); LAS int* base = hist + 32;
    SEC_BEGIN(F, 4);
    for (int i = F.tid; i < 32 * 128; i += NTHR) { const int n = i >> 7, ch = i & 127;
        *(LAS u32x4*)(ihi + n * IMG_ROW + 16 * ch) = *(const u32x4*)(WrThi + (size_t)n * 1024 + 8 * ch);
        *(LAS u32x4*)(ilo + n * IMG_ROW + 16 * ch) = *(const u32x4*)(WrTlo + (size_t)n * 1024 + 8 * ch); }
    if (F.tid < 32) hist[F.tid] = 0;
    __syncthreads();
    SEC_END(F, 4); SEC_BEGIN(F, 5);
    const int tok0 = F.vcu * 64 + (F.wave & 3) * 16, lane = F.lane;
    int be[4] = {0, 0, 0, 0}, lr[4] = {0, 0, 0, 0}; float gt[4] = {0.f, 0.f, 0.f, 0.f}; float rstd = 0.f;
    if (F.wave >= 4) {
        const float* w_dn = F.in[17]; char* WdnT = (char*)(F.ws + WS_WDNT);
        const int cw = F.vcu * 4 + (F.wave - 4), NCW = F.G * 4;
#pragma unroll 1
        for (int j = 0; j < 48; j += 2) { P0Item it[2]; f32x4 v[2][8];
#pragma unroll
            for (int q = 0; q < 2; ++q) { const int jj = j + q;
                if (jj < 16) { const int r = cw + jj * NCW, e = r / 512, qq = r % 512, kb = qq / 32, nb = qq % 32;
                    it[q].src = w_dn + ((size_t)e * 1024 + 64 * kb) * 1024 + 32 * nb; it[q].ld = 1024; it[q].esz = MOE_ESZ; it[q].dst = WdnT + (((size_t)e * 1024 + 32 * nb) * 1024 + 64 * kb) * MOE_ESZ; }
                else { const int r = cw + (jj - 16) * NCW, e = r / 1024, qq = r % 1024, kb = qq / 64, nb = qq % 64, n = 32 * nb, half = n >> 10, j2 = n & 1023, pn = j2 >> 7, j3 = j2 & 127, nd = 256 * pn + 128 * half + j3;
                    it[q].src = F.in[15] + ((size_t)e * 1024 + 64 * kb) * 2048 + n; it[q].ld = 2048; it[q].esz = MOE_ESZ; it[q].dst = (char*)(F.ws + WS_WUPT) + (((size_t)e * 2048 + nd) * 1024 + 64 * kb) * MOE_ESZ; }
                p0_load(it[q], lane, v[q]); }
#pragma unroll
            for (int q = 0; q < 2; ++q) p0_store(it[q], lane, v[q]); } }
    if (F.wave < 4) {
        f32x4 acc[2];
        rstd = row_pass<2, MOE_FP8 != 0>(H, g2, HN, ihi, ilo, tok0, lane, acc);
        { float rr[4];
#pragma unroll
          for (int rg = 0; rg < 4; ++rg) rr[rg] = __shfl(rstd, 4 * (lane >> 4) + rg);
#pragma unroll
          for (int nf = 0; nf < 2; ++nf)
#pragma unroll
              for (int rg = 0; rg < 4; ++rg) lg[(F.wave * 16 + 4 * (lane >> 4) + rg) * 32 + 16 * nf + (lane & 15)] = acc[nf][rg] * rr[rg]; }
        if (lane < 16) { float v[32];
#pragma unroll
            for (int q4 = 0; q4 < 8; ++q4) { const f32x4 x = *(const LAS f32x4*)(lg + (F.wave * 16 + lane) * 32 + 4 * q4), bb = *(const f32x4*)(br + 4 * q4);
                v[4 * q4] = x[0] + bb[0]; v[4 * q4 + 1] = x[1] + bb[1]; v[4 * q4 + 2] = x[2] + bb[2]; v[4 * q4 + 3] = x[3] + bb[3]; }
            float bv[4];
#pragma unroll
            for (int k = 0; k < 4; ++k) { float best = -INFINITY; int bi = 0;
#pragma unroll
                for (int e = 0; e < 32; ++e) if (v[e] > best) { best = v[e]; bi = e; }
                be[k] = bi; bv[k] = best;
#pragma unroll
                for (int e = 0; e < 32; ++e) v[e] = (e == bi) ? -INFINITY : v[e]; }
            float den = 0.f;
#pragma unroll
            for (int k = 0; k < 4; ++k) { gt[k] = fexp(bv[k] - bv[0]); den += gt[k]; }
            const float rd = 1.0f / den;
#pragma unroll
            for (int k = 0; k < 4; ++k) { gt[k] *= rd; lr[k] = __hip_atomic_fetch_add(hist + be[k], 1, __ATOMIC_RELAXED, __HIP_MEMORY_SCOPE_WORKGROUP); } } }
    SEC_END(F, 5); SEC_BEGIN(F, 6);
    __syncthreads();
    if (F.tid < 32) base[F.tid] = hist[F.tid] > 0 ? atomicAdd(&cnt[F.tid], hist[F.tid]) : 0;
    __syncthreads();
    if (F.wave < 4 && lane < 16) { const int tok = tok0 + lane;
#pragma unroll
        for (int k = 0; k < 4; ++k) { const int rk = base[be[k]] + lr[k]; const size_t p = (size_t)be[k] * 65536 + rk; tokidx[p] = tok * 4 + k; gatex[p] = gt[k]; rsx[p] = rstd; } }
    __syncthreads();
    SEC_END(F, 6);
}

__device__ __forceinline__ int build_ttab(const Frame& F) {
    const int* cnt = (const int*)(F.ws + WS_CTL) + CW_CNT; LAS unsigned* ttab = (LAS unsigned*)(F.lds + TTAB_OFF); LAS int* tot = (LAS int*)(F.lds + MISC_OFF + 64);
    if (F.wave == 0) { const int l = F.lane; const int c = l < 32 ? __hip_atomic_load(cnt + l, RLX_AGENT) : 0; const int nt = (c + 255) >> 8;
        int inc = nt;
#pragma unroll
        for (int o = 1; o < 64; o <<= 1) { const int tt = __shfl_up(inc, o); if (l >= o) inc += tt; }
        const int start = inc - nt;
        for (int r = 0; r < nt; ++r) { const int left = c - 256 * r; ttab[start + r] = (unsigned)l | ((unsigned)r << 5) | ((unsigned)((left < 256 ? left : 256) - 1) << 14); }
        if (l == 63) tot[0] = inc; }
    __syncthreads();
    return tot[0];
}

__device__ __forceinline__ void phase_final(const Frame& F) {
    const float* H = (const float*)(F.ws + WS_H); const bf16* Y = (const bf16*)(F.ws + WS_Y); const float* gf = F.in[19];
    const int gw = F.vcu * NWAVES + F.wave, lane = F.lane;
    f32x4 gg[4];
#pragma unroll
    for (int j = 0; j < 4; ++j) gg[j] = *(const f32x4*)(gf + 4 * (lane + 64 * j));
#pragma unroll 1
    for (int i = 0; i < 8; i += 2) { const int tok = gw * 8 + i;
        f32x4 v[2][4]; u32x2 y[2][4][4];
#pragma unroll
        for (int q = 0; q < 2; ++q)
#pragma unroll
            for (int j = 0; j < 4; ++j) { v[q][j] = __builtin_nontemporal_load((const f32x4*)(H + (size_t)(tok + q) * 1024 + 4 * (lane + 64 * j)));
#pragma unroll
                for (int k = 0; k < 4; ++k) y[q][j][k] = __builtin_nontemporal_load((const u32x2*)(Y + (size_t)((tok + q) * 4 + k) * 1024 + 4 * (lane + 64 * j))); }
#pragma unroll
        for (int q = 0; q < 2; ++q) { float s = 0.f;
#pragma unroll
            for (int j = 0; j < 4; ++j) {
#pragma unroll
                for (int k = 0; k < 4; ++k) { const u32x2 yy = y[q][j][k];
                    v[q][j][0] += __builtin_bit_cast(float, yy.x << 16); v[q][j][1] += __builtin_bit_cast(float, yy.x & 0xffff0000u);
                    v[q][j][2] += __builtin_bit_cast(float, yy.y << 16); v[q][j][3] += __builtin_bit_cast(float, yy.y & 0xffff0000u); }
                s += (v[q][j][0] * v[q][j][0] + v[q][j][1] * v[q][j][1]) + (v[q][j][2] * v[q][j][2] + v[q][j][3] * v[q][j][3]); }
            const float r = 1.0f / sqrtf(wsum_all(s) * (1.0f / 1024.0f) + 1e-6f);
#pragma unroll
            for (int j = 0; j < 4; ++j) __builtin_nontemporal_store(v[q][j] * r * gg[j], (f32x4*)(F.out + (size_t)(tok + q) * 1024 + 4 * (lane + 64 * j))); } }
}

constexpr int N_PHASES = 10;
struct Args { const float* in[20]; float* out; unsigned char* ws; int ph_lo, ph_hi; };
__global__ void __launch_bounds__(NTHR, 2) mk_fwd(Args args) {
    extern __shared__ __attribute__((aligned(16))) unsigned char lds_raw[];
    Frame F; F.t0 = 0ull; F.tsec = 0ull;
    F.lds = (lptr)lds_raw; F.tid = threadIdx.x; F.lane = F.tid & 63; F.wave = __builtin_amdgcn_readfirstlane(F.tid >> 6);
    F.G = gridDim.x; { const int bx = blockIdx.x; F.vcu = (F.G % 8 == 0) ? (bx % 8) * (F.G / 8) + bx / 8 : bx; }
#pragma unroll
    for (int i = 0; i < 20; ++i) F.in[i] = args.in[i];
    F.out = args.out; F.ws = args.ws;
    for (int u = F.tid; u < (LDS_BYTES - CTL_OFF) / 4; u += NTHR) ((LAS unsigned*)(F.lds + CTL_OFF))[u] = 0u;
    __syncthreads();
    XcdBarrier bar = xcd_barrier_post((unsigned*)(F.ws + WS_CTL) + CW_BAR, (volatile LAS unsigned*)(F.lds + MISC_OFF));
    const int lo = args.ph_lo, hi = args.ph_hi;
#define IN(k) (lo <= (k) && (k) < hi)
#ifndef PROBE_LO
#define PROBE_LO -1
#define PROBE_HI -1
#endif
    unsigned long long tp0 = 0ull;
#define SEAM(k) do { if (IN(k) && IN((k) + 1)) xcd_barrier(bar); \
        if (PROBE_HI == (k) + 1) { const unsigned long long tn = __builtin_amdgcn_s_memrealtime(), dt = tn - tp0; while (__builtin_amdgcn_s_memrealtime() - tn < dt) __builtin_amdgcn_s_sleep(8); __syncthreads(); } \
        if (PROBE_LO == (k) + 1) tp0 = __builtin_amdgcn_s_memrealtime(); } while (0)
    const int bx = blockIdx.x;
    if (PROBE_LO == 0) tp0 = __builtin_amdgcn_s_memrealtime();
    if (IN(0)) { phase0(F); } SEAM(0);
    if (IN(1)) { pg8::DenseOps ops{(const bf16*)(F.ws + WS_XN), (const bf16*)(F.ws + WS_WINT), 1024}; pg8::StaticOrder S; S.init(64, 12, F.G, bx, 4);
        pg8::EpiProj E{(bf16*)(F.ws + WS_PROJ), PROJ_LD, (const float*)(F.ws + WS_RS1)};
        pg8::gemm_phase<pg8::EpiProj, pg8::StaticOrder, pg8::DenseOps, false, true>(F.lds, 1024, S, ops, E); } SEAM(1);
    if (IN(2)) {
#pragma unroll 1
        for (int j = 0; j < 2; ++j) mlstm_local_unit(F, F.vcu * 2 + j);
#pragma unroll 1
        for (int j = 0; j < 2; ++j) gmlp_unit(F, F.vcu * 2 + j); } SEAM(2);
    if (IN(3)) { phase_scan(F); } SEAM(3);
    if (IN(4)) {
#pragma unroll 1
        for (int j = 0; j < 2; ++j) mlstm_out_unit(F, F.vcu * 2 + j); } SEAM(4);
    if (IN(5)) { pg8::DenseOps ops{(const bf16*)(F.ws + WS_MIX), (const bf16*)(F.ws + WS_WOUTT), 1024}; pg8::StaticOrder S; S.init(64, 4, F.G, bx);
        pg8::EpiRes E{F.in[0], (float*)(F.ws + WS_H), 1024};
        pg8::gemm_phase<pg8::EpiRes, pg8::StaticOrder, pg8::DenseOps, false, false>(F.lds, 1024, S, ops, E); } SEAM(5);
    if (IN(6)) { phase_router(F); } SEAM(6);
    if (IN(7)) { const int nM = build_ttab(F);
        pg8::UpOps ops{F.ws + WS_XN, F.ws + WS_WUPT, (const int*)(F.ws + WS_TOKIDX), 1024u * MOE_ESZ};
        pg8::MoeOrder S; S.init(nM, 8, F.G, bx, 4); S.ttab = (const LAS unsigned*)(F.lds + TTAB_OFF);
        pg8::EpiUp<MOE_FP8 != 0> E{F.ws + WS_ACT, F.in[16], (const float*)(F.ws + WS_RSX), MOE_FP8 ? 1.0f / W8_SCALE : 1.0f};
        pg8::gemm_phase<pg8::EpiUp<MOE_FP8 != 0>, pg8::MoeOrder, pg8::UpOps, true, true, MOE_FP8 != 0>(F.lds, 512 * MOE_ESZ, S, ops, E); } SEAM(7);
    if (IN(8)) { const int nM = build_ttab(F);
        pg8::DownOps ops{F.ws + WS_ACT, F.ws + WS_WDNT, 1024u * MOE_ESZ};
        pg8::MoeOrder S; S.init(nM, 4, F.G, bx); S.ttab = (const LAS unsigned*)(F.lds + TTAB_OFF);
        pg8::EpiDown E{(bf16*)(F.ws + WS_Y), F.in[18], (const float*)(F.ws + WS_GATEX), (const int*)(F.ws + WS_TOKIDX), MOE_FP8 ? 1.0f / W8_SCALE : 1.0f};
        pg8::gemm_phase<pg8::EpiDown, pg8::MoeOrder, pg8::DownOps, false, true, MOE_FP8 != 0>(F.lds, 512 * MOE_ESZ, S, ops, E); } SEAM(8);
    if (IN(9)) { phase_final(F); } SEAM(9);
    if (PROBE_SEC >= 0) { const unsigned long long tn = __builtin_amdgcn_s_memrealtime(); while (__builtin_amdgcn_s_memrealtime() - tn < F.tsec) __builtin_amdgcn_s_sleep(8); }
#undef IN
#undef SEAM
}

extern "C" void kernel_launch(void* const* d_in, const int* in_sizes, int n_in, void* d_out, int out_size, void* d_ws, size_t ws_size, hipStream_t stream) {
    static int ready = 0;
    if (!ready) {
        if (hipFuncSetAttribute((const void*)mk_fwd, hipFuncAttributeMaxDynamicSharedMemorySize, LDS_BYTES) != hipSuccess) { fprintf(stderr, "hipFuncSetAttribute failed\n"); return; }
        ready = 1;
    }
    char* ws = (char*)d_ws;
    if (ws_size < 800 * MiB) { fprintf(stderr, "ws too small: %zu\n", ws_size); return; }
    (void)hipMemsetAsync(ws + WS_CTL, 0, CTL_ZERO_BYTES, stream);
    Args a{};
    for (int i = 0; i < 20; ++i) a.in[i] = (const float*)d_in[i];
    a.out = (float*)d_out; a.ws = (unsigned char*)d_ws; a.ph_lo = 0; a.ph_hi = N_PHASES;
    hipLaunchKernelGGL(mk_fwd, dim3(256), dim3(NTHR), LDS_BYTES, stream, a);
}
```
